# Optimizing an MI355X kernel written in HIP

```python
import math
import jax, jax.numpy as jnp
from jax import lax
import numpy as np

D_MODEL = 1024
BATCH = 4
SEQ = 4096
DEPTH = 4

HEAD_DIM = 64
ROPE_THETA = 10000.0
BLOCK_Q = 128
NEG_INF = -1e30
NORM_EPS = 1e-6

DA_HEADS = 4
DA_QK = DA_HEADS * 2 * HEAD_DIM
DA_V = DA_HEADS * 2 * HEAD_DIM

GRID_W = 64
NA_HEADS = 4
NA_WIDTH = NA_HEADS * HEAD_DIM
NA_WIN_ROWS = 8
NA_WIN_COLS = 16

DIL_CONFIGS = ((128, 1), (512, 4), (2048, 16))
DIL_GROUPS = 3
DIL_HEADS = 4
DIL_WIDTH = DIL_GROUPS * DIL_HEADS * HEAD_DIM
DIL_OUT = DIL_HEADS * HEAD_DIM

N_BRANCHES = 3
IN_SIZES = (DA_QK, DA_QK, DA_V, NA_WIDTH, NA_WIDTH, NA_WIDTH,
            DIL_WIDTH, DIL_WIDTH, DIL_WIDTH, N_BRANCHES * D_MODEL)
IN_WIDTH = 2 * DA_QK + DA_V + 3 * NA_WIDTH + 3 * DIL_WIDTH + N_BRANCHES * D_MODEL

N_GROUPS = 4
EXPERTS_PER_GROUP = 8
N_EXPERTS = N_GROUPS * EXPERTS_PER_GROUP
TOP_K_FINE = 2
EXPERT_HIDDEN = 512
MOE_BLOCK = 128

kernel_name = 'hybrid_diff_na_dilated_hmoe_adaln'


def rms_norm(x, g):
    xf = x.astype(jnp.float32)
    y = xf * lax.rsqrt(jnp.mean(xf * xf, axis=-1, keepdims=True) + NORM_EPS)
    return (y * g.astype(jnp.float32)).astype(x.dtype)


def rotary_tables(seq, dim, dtype):
    inv = 1.0 / (ROPE_THETA ** (jnp.arange(0, dim, 2, dtype=jnp.float32) / dim))
    ang = jnp.arange(seq, dtype=jnp.float32)[:, None] * inv[None, :]
    ang = jnp.concatenate([ang, ang], axis=-1)
    return jnp.cos(ang).astype(dtype), jnp.sin(ang).astype(dtype)


def apply_rotary(x, cos, sin):
    x1, x2 = jnp.split(x, 2, axis=-1)
    return x * cos + jnp.concatenate([-x2, x1], axis=-1) * sin


def diff_attention(q, k, v, lam_params, subln_g, lam_init, cos, sin):
    B, S, _ = q.shape
    H, dh = DA_HEADS, HEAD_DIM
    q = apply_rotary(q.reshape(B, S, H, 2, dh).transpose(0, 2, 3, 1, 4), cos, sin)
    k = apply_rotary(k.reshape(B, S, H, 2, dh).transpose(0, 2, 3, 1, 4), cos, sin)
    v = v.reshape(B, S, H, 2 * dh).transpose(0, 2, 1, 3)
    lp = lam_params.astype(jnp.float32)
    lam = jnp.exp(jnp.sum(lp[0] * lp[1])) - jnp.exp(jnp.sum(lp[2] * lp[3])) + lam_init
    nblk = S // BLOCK_Q
    qblocks = q.reshape(B, H, 2, nblk, BLOCK_Q, dh).transpose(3, 0, 1, 2, 4, 5)
    scale = HEAD_DIM ** -0.5

    def block(qi):
        s = jnp.einsum('bhmqd,bhmkd->bhmqk', qi, k).astype(jnp.float32) * scale
        p = jax.nn.softmax(s, axis=-1)
        a = p[:, :, 0] - lam * p[:, :, 1]
        return jnp.einsum('bhqk,bhkd->bhqd', a.astype(v.dtype), v)

    o = lax.map(block, qblocks)
    o = o.transpose(1, 0, 3, 2, 4).reshape(B, S, H, 2 * dh)
    o = rms_norm(o, subln_g) * (1.0 - lam_init)
    return o.reshape(B, S, H * 2 * dh)


def neighbourhood_attention(q, k, v, rpb):
    B, S, _ = q.shape
    H, dh = NA_HEADS, HEAD_DIM
    rows = S // GRID_W
    kh = min(NA_WIN_ROWS, rows)
    kw = NA_WIN_COLS
    L = kh * kw
    r = jnp.arange(rows)
    cq = jnp.arange(GRID_W)
    key_rows = jnp.clip(r - kh // 2, 0, rows - kh)[:, None] + jnp.arange(kh)[None, :]
    key_cols = jnp.clip(cq - kw // 2, 0, GRID_W - kw)[:, None] + jnp.arange(kw)[None, :]
    kidx = (key_rows[:, None, :, None] * GRID_W + key_cols[None, :, None, :]).reshape(rows, GRID_W, L)
    br = key_rows - r[:, None] + (NA_WIN_ROWS - 1)
    bc = key_cols - cq[:, None] + (NA_WIN_COLS - 1)
    bias = rpb[:, br[:, None, :, None], bc[None, :, None, :]]
    bias = bias.reshape(H, rows, GRID_W, L).transpose(1, 0, 2, 3).astype(jnp.float32)
    qr = q.reshape(B, rows, GRID_W, H, dh).transpose(1, 0, 3, 2, 4)
    kt = k.reshape(B, S, H, dh).transpose(0, 2, 1, 3)
    vt = v.reshape(B, S, H, dh).transpose(0, 2, 1, 3)
    scale = HEAD_DIM ** -0.5

    def row_block(args):
        qi, idx, bi = args
        kg = kt[:, :, idx]
        vg = vt[:, :, idx]
        s = jnp.einsum('bhqd,bhqld->bhql', qi, kg).astype(jnp.float32) * scale + bi
        p = jax.nn.softmax(s, axis=-1).astype(vg.dtype)
        return jnp.einsum('bhql,bhqld->bhqd', p, vg)

    o = lax.map(row_block, (qr, kidx, bias))
    return o.transpose(1, 0, 3, 2, 4).reshape(B, S, H * dh)


def dilated_group(q, k, v, window, dilation):
    B, H, S, dh = q.shape
    n_side = window // 2 // dilation
    offs = dilation * jnp.arange(-n_side, n_side + 1)
    nblk = S // BLOCK_Q
    qblocks = q.reshape(B, H, nblk, BLOCK_Q, dh).transpose(2, 0, 1, 3, 4)
    tblocks = jnp.arange(S).reshape(nblk, BLOCK_Q)
    scale = HEAD_DIM ** -0.5

    def block(args):
        qi, t = args
        pos = t[:, None] + offs[None, :]
        valid = (pos >= 0) & (pos < S)
        pos = jnp.clip(pos, 0, S - 1)
        kk = k[:, :, pos]
        vv = v[:, :, pos]
        s = jnp.einsum('bhqd,bhqld->bhql', qi, kk).astype(jnp.float32) * scale
        s = jnp.where(valid, s, NEG_INF)
        lse = jax.nn.logsumexp(s, axis=-1)
        p = jnp.exp(s - lse[..., None])
        return jnp.einsum('bhql,bhqld->bhqd', p.astype(vv.dtype), vv), lse

    o, lse = lax.map(block, (qblocks, tblocks))
    o = o.transpose(1, 2, 0, 3, 4).reshape(B, H, S, dh)
    lse = lse.transpose(1, 2, 0, 3).reshape(B, H, S)
    return o, lse


def dilated_attention(q, k, v, cos, sin):
    B, S, _ = q.shape
    G, H, dh = DIL_GROUPS, DIL_HEADS, HEAD_DIM
    q = apply_rotary(q.reshape(B, S, G, H, dh).transpose(2, 0, 3, 1, 4), cos, sin)
    k = apply_rotary(k.reshape(B, S, G, H, dh).transpose(2, 0, 3, 1, 4), cos, sin)
    v = v.reshape(B, S, G, H, dh).transpose(2, 0, 3, 1, 4)
    outs, lses = [], []
    for g, (window, dilation) in enumerate(DIL_CONFIGS):
        o, lse = dilated_group(q[g], k[g], v[g], window, dilation)
        outs.append(o)
        lses.append(lse)
    alpha = jax.nn.softmax(jnp.stack(lses, axis=0), axis=0)
    o = jnp.sum(alpha[..., None].astype(v.dtype) * jnp.stack(outs, axis=0), axis=0)
    return o.transpose(0, 2, 1, 3).reshape(B, S, H * dh)


def hybrid_mixer(h, w_in, da_lam, da_subln_g, lam_init, na_rpb, w_proj_a, w_proj_n, w_proj_d, w_out, cos, sin):
    z = h @ w_in
    splits = np.cumsum(IN_SIZES)[:-1].tolist()
    q_a, k_a, v_a, q_n, k_n, v_n, q_d, k_d, v_d, gates = jnp.split(z, splits, axis=-1)
    o_a = diff_attention(q_a, k_a, v_a, da_lam, da_subln_g, lam_init, cos, sin)
    o_n = neighbourhood_attention(q_n, k_n, v_n, na_rpb)
    o_d = dilated_attention(q_d, k_d, v_d, cos, sin)
    g_a, g_n, g_d = jnp.split(jax.nn.sigmoid(gates), N_BRANCHES, axis=-1)
    merged = g_a * (o_a @ w_proj_a) + g_n * (o_n @ w_proj_n) + g_d * (o_d @ w_proj_d)
    return merged @ w_out


def grouped_swiglu(xt, expert, weight, w1, w3, w2):
    N, D = xt.shape
    A = N * TOP_K_FINE
    flat_e = expert.reshape(-1)
    flat_w = weight.reshape(-1)
    order = jnp.argsort(flat_e)
    sorted_e = flat_e[order]
    tok = order // TOP_K_FINE
    sizes = jnp.bincount(flat_e, length=N_EXPERTS)
    padded = ((sizes + MOE_BLOCK - 1) // MOE_BLOCK) * MOE_BLOCK
    seg_start = jnp.cumsum(sizes) - sizes
    pad_end = jnp.cumsum(padded)
    pad_start = pad_end - padded
    dest = pad_start[sorted_e] + (jnp.arange(A) - seg_start[sorted_e])
    n_blocks = A // MOE_BLOCK + N_EXPERTS
    M = n_blocks * MOE_BLOCK
    slot_tok = jnp.zeros((M,), jnp.int32).at[dest].set(tok.astype(jnp.int32))
    slot_w = jnp.zeros((M,), jnp.float32).at[dest].set(flat_w[order])
    block_e = jnp.searchsorted(pad_end, jnp.arange(n_blocks) * MOE_BLOCK, side='right')
    block_e = jnp.minimum(block_e, N_EXPERTS - 1)
    xs = xt[slot_tok].reshape(n_blocks, MOE_BLOCK, D)

    def run(args):
        xb, e = args
        return (jax.nn.silu(xb @ w1[e]) * (xb @ w3[e])) @ w2[e]

    y = lax.map(run, (xs, block_e)).reshape(M, D)
    y = y * slot_w[:, None].astype(y.dtype)
    return jnp.zeros_like(xt).at[slot_tok].add(y)


def hier_moe(h, wg, bg, we, be, w1, w3, w2):
    B, S, D = h.shape
    xt = h.reshape(B * S, D)
    N = xt.shape[0]
    pg = jax.nn.softmax((xt @ wg + bg).astype(jnp.float32), axis=-1)
    pg_top, g_idx = lax.top_k(pg, 1)
    le = (xt @ we + be).astype(jnp.float32).reshape(N, N_GROUPS, EXPERTS_PER_GROUP)
    le = jnp.take_along_axis(le, g_idx[:, :, None], axis=1)[:, 0]
    pe_top, e_idx = lax.top_k(jax.nn.softmax(le, axis=-1), TOP_K_FINE)
    pe_top = pe_top / jnp.sum(pe_top, axis=-1, keepdims=True)
    weight = pg_top * pe_top
    expert = g_idx * EXPERTS_PER_GROUP + e_idx
    return grouped_swiglu(xt, expert, weight, w1, w3, w2).reshape(B, S, D)


def setup_inputs(seed: int = 0) -> dict:
    key = jax.random.key(seed)
    ks = jax.random.split(key, 24)
    f32 = jnp.float32
    D = D_MODEL

    def nrm(k, shape, scale):
        return jax.random.normal(k, shape, f32) * scale

    return {
        'x': nrm(ks[0], (BATCH, SEQ, D), 1.0),
        'c': nrm(ks[1], (BATCH, D), 1.0),
        'ada_w': nrm(ks[2], (DEPTH, D, 6 * D), 0.5 * D ** -0.5),
        'ada_b': nrm(ks[3], (DEPTH, 6 * D), 0.02),
        'mix_norm_g': 1.0 + nrm(ks[4], (DEPTH, D), 0.02),
        'ffn_norm_g': 1.0 + nrm(ks[5], (DEPTH, D), 0.02),
        'w_in': nrm(ks[6], (DEPTH, D, IN_WIDTH), D ** -0.5),
        'da_lambda': nrm(ks[7], (DEPTH, 4, HEAD_DIM), 0.1),
        'da_subln_g': 1.0 + nrm(ks[8], (DEPTH, 2 * HEAD_DIM), 0.02),
        'na_rpb': nrm(ks[9], (DEPTH, NA_HEADS, 2 * NA_WIN_ROWS - 1, 2 * NA_WIN_COLS - 1), 0.02),
        'w_proj_a': nrm(ks[10], (DEPTH, DA_V, D), DA_V ** -0.5),
        'w_proj_n': nrm(ks[11], (DEPTH, NA_WIDTH, D), NA_WIDTH ** -0.5),
        'w_proj_d': nrm(ks[12], (DEPTH, DIL_OUT, D), DIL_OUT ** -0.5),
        'w_out': nrm(ks[13], (DEPTH, D, D), D ** -0.5),
        'router_group_w': nrm(ks[14], (DEPTH, D, N_GROUPS), D ** -0.5),
        'router_group_b': nrm(ks[15], (DEPTH, N_GROUPS), 0.01),
        'router_expert_w': nrm(ks[16], (DEPTH, D, N_EXPERTS), D ** -0.5),
        'router_expert_b': nrm(ks[17], (DEPTH, N_EXPERTS), 0.01),
        'expert_w1': nrm(ks[18], (DEPTH, N_EXPERTS, D, EXPERT_HIDDEN), D ** -0.5),
        'expert_w3': nrm(ks[19], (DEPTH, N_EXPERTS, D, EXPERT_HIDDEN), D ** -0.5),
        'expert_w2': nrm(ks[20], (DEPTH, N_EXPERTS, EXPERT_HIDDEN, D), EXPERT_HIDDEN ** -0.5),
        'final_norm_g': 1.0 + nrm(ks[21], (D,), 0.02),
    }


def reference(x, c, ada_w, ada_b, mix_norm_g, ffn_norm_g, w_in, da_lambda, da_subln_g, na_rpb,
              w_proj_a, w_proj_n, w_proj_d, w_out, router_group_w, router_group_b,
              router_expert_w, router_expert_b, expert_w1, expert_w3, expert_w2, final_norm_g):
    B, S, D = x.shape
    cos, sin = rotary_tables(S, HEAD_DIM, x.dtype)
    c_act = jax.nn.silu(c)
    for l in range(DEPTH):
        mod = c_act @ ada_w[l] + ada_b[l]
        shift_m, scale_m, gate_m, shift_f, scale_f, gate_f = jnp.split(mod[:, None, :], 6, axis=-1)
        lam_init = 0.8 - 0.6 * math.exp(-0.3 * l)
        h = rms_norm(x, mix_norm_g[l]) * (1.0 + scale_m) + shift_m
        y = hybrid_mixer(h, w_in[l], da_lambda[l], da_subln_g[l], lam_init, na_rpb[l],
                         w_proj_a[l], w_proj_n[l], w_proj_d[l], w_out[l], cos, sin)
        x = x + gate_m * y
        h = rms_norm(x, ffn_norm_g[l]) * (1.0 + scale_f) + shift_f
        y = hier_moe(h, router_group_w[l], router_group_b[l], router_expert_w[l], router_expert_b[l],
                     expert_w1[l], expert_w3[l], expert_w2[l])
        x = x + gate_f * y
    return rms_norm(x, final_norm_g)
```

```cpp
#include <hip/hip_runtime.h>
#include <cstdio>
#include <cstdint>

#ifndef MK_PER_PHASE
#define MK_PER_PHASE 0
#endif

#define LAS __attribute__((address_space(3)))
#define GAS __attribute__((address_space(1)))
typedef unsigned short bf16_t;
typedef short bf16x8 __attribute__((ext_vector_type(8)));
typedef short s16x4 __attribute__((ext_vector_type(4)));
typedef float f32x4 __attribute__((ext_vector_type(4)));
typedef float f32x2 __attribute__((ext_vector_type(2)));
typedef float f32x16 __attribute__((ext_vector_type(16)));
typedef unsigned u32x4 __attribute__((ext_vector_type(4)));
typedef unsigned u32x2 __attribute__((ext_vector_type(2)));

constexpr int D = 1024, NBATCH = 4, SEQ = 4096, M = NBATCH * SEQ, DEPTH = 4, ZW = 7680;
constexpr int ZQA = 0, ZKA = 512, ZVA = 1024, ZQN = 1536, ZKN = 1792, ZVN = 2048, ZQD = 2304, ZKD = 3072, ZVD = 3840, ZG = 4608;
constexpr int NEXP = 32, EH = 512;
constexpr int MAXTILES = 160, XROWS = MAXTILES * 256;
constexpr float C2 = 0.125f * 1.4426950408889634f;
constexpr float LOG2E = 1.4426950408889634f;
constexpr float NORM_EPS = 1e-6f;
constexpr float NEGBIG = -1e30f;
constexpr float RESCALE_THR = 8.0f;

constexpr size_t MiB = 1u << 20;
constexpr size_t WS_CTL = 0, CTL_ZERO_BYTES = 1 * MiB;
constexpr size_t WS_RT = 1 * MiB;
constexpr size_t WS_MOD = 2 * MiB;
constexpr size_t WS_ROPE = 3 * MiB;
constexpr size_t WS_ROUTE = 4 * MiB;
constexpr size_t WS_X = 8 * MiB;
constexpr size_t WS_H = 72 * MiB;
constexpr size_t WS_OCAT = 104 * MiB;
constexpr size_t WS_MERGED = 136 * MiB;
constexpr size_t WS_Z = 168 * MiB;
constexpr size_t WS_XG = WS_Z;
constexpr size_t WS_HB = WS_Z + 80 * MiB;
constexpr size_t WS_YB = WS_Z + 120 * MiB;
constexpr size_t WS_WIN = 408 * MiB;
constexpr size_t WS_WPROJ = 468 * MiB;
constexpr size_t WS_WOUT = 476 * MiB;
constexpr size_t WS_W13 = 484 * MiB;
constexpr size_t WS_W2 = 740 * MiB;
constexpr size_t WS_END = 868 * MiB;
constexpr int CW_BAR = 4096;
constexpr int CW_CNT = 16384;
constexpr int CW_TILE = 32768;

constexpr int RING_BYTES = 131072;
constexpr int RT_LD = 1028;
constexpr int RT_BYTES = 36 * RT_LD * 4;
constexpr int MISC_OFF = RT_BYTES;
constexpr int LDS_BYTES = MISC_OFF + 512;

__device__ __forceinline__ unsigned f2bf(float f) { unsigned u = __builtin_bit_cast(unsigned, f); return (u + 0x7fffu + ((u >> 16) & 1u)) >> 16; }
__device__ __forceinline__ unsigned pk2(float lo, float hi) { return f2bf(lo) | (f2bf(hi) << 16); }
__device__ __forceinline__ unsigned cvt_pk_bf16(float lo, float hi) { unsigned r; asm("v_cvt_pk_bf16_f32 %0, %1, %2" : "=v"(r) : "v"(lo), "v"(hi)); return r; }
typedef __bf16 bf16x2_t __attribute__((ext_vector_type(2)));
__device__ __forceinline__ unsigned cvtpk_s(float lo, float hi) { f32x2 v = {lo, hi}; bf16x2_t b = __builtin_convertvector(v, bf16x2_t); return __builtin_bit_cast(unsigned, b); }
__device__ __forceinline__ float bflo(unsigned u) { return __builtin_bit_cast(float, u << 16); }
__device__ __forceinline__ float bfhi(unsigned u) { return __builtin_bit_cast(float, u & 0xffff0000u); }
__device__ __forceinline__ f32x4 bf4(u32x2 r) { return (f32x4){bflo(r.x), bfhi(r.x), bflo(r.y), bfhi(r.y)}; }
__device__ __forceinline__ float fexp2(float x) { return __builtin_amdgcn_exp2f(x); }
__device__ __forceinline__ float frcp(float x) { return __builtin_amdgcn_rcpf(x); }
__device__ __forceinline__ void swap32(float& a, float& b) { asm volatile("s_nop 1\n\tv_permlane32_swap_b32 %0, %1\n\ts_nop 1" : "+v"(a), "+v"(b)); }
template <int X> __device__ __forceinline__ float xor_lane(float v) { return __builtin_bit_cast(float, __builtin_amdgcn_ds_swizzle(__builtin_bit_cast(int, v), (X << 10) | 0x1f)); }
__device__ __forceinline__ float half_sum(float v) { v += xor_lane<1>(v); v += xor_lane<2>(v); v += xor_lane<4>(v); v += xor_lane<8>(v); v += xor_lane<16>(v); return v; }
__device__ __forceinline__ float wave_sum(float v) {
    v = half_sum(v);
    float a = v, b = v; swap32(a, b);
    return a + b;
}
template <int CTRL> __device__ __forceinline__ float dpp_f(float v) { return __builtin_bit_cast(float, __builtin_amdgcn_update_dpp(0, __builtin_bit_cast(int, v), CTRL, 0xf, 0xf, false)); }
__device__ __forceinline__ float wave_sum_u(float v) {
    v += dpp_f<0xB1>(v); v += dpp_f<0x4E>(v); v += dpp_f<0x141>(v); v += dpp_f<0x140>(v);
    const int iv = __builtin_bit_cast(int, v);
    float r = (__builtin_bit_cast(float, __builtin_amdgcn_readlane(iv, 0)) + __builtin_bit_cast(float, __builtin_amdgcn_readlane(iv, 16))) +
              (__builtin_bit_cast(float, __builtin_amdgcn_readlane(iv, 32)) + __builtin_bit_cast(float, __builtin_amdgcn_readlane(iv, 48)));
    asm volatile("" : "+v"(r));
    return r;
}
__device__ __forceinline__ void st16_wt(void* p, u32x4 v) { asm volatile("global_store_dwordx4 %0, %1, off sc1\n\ts_nop 1" :: "v"(p), "v"(v) : "memory"); }
#define LDS_WAIT() asm volatile("s_waitcnt lgkmcnt(0)" ::: "memory")
#define VM_WAIT() asm volatile("s_waitcnt vmcnt(0)" ::: "memory")
#define CBAR() asm volatile("" ::: "memory")

namespace pg8 {
constexpr int BM = 256, BK = 64, HALF = 128, HTB = HALF * BK * 2, STAGE_BYTES = 8 * HTB, NXCD = 8, WGM = 8;
__host__ __device__ __forceinline__ int lds_byte(int r, int c) { const int st = (r >> 4) * 2 + (c >> 5), rr = r & 15, cc = c & 31, ob = rr * 64 + cc * 2; return st * 1024 + (ob ^ (((ob >> 9) & 1) << 5)); }
__host__ __device__ __forceinline__ void stage_rc(int b, int& R, int& C) { const int st = b / 1024, sb = b % 1024, swz = sb ^ (((sb >> 9) & 1) << 5); R = (st >> 1) * 16 + swz / 64; C = (st & 1) * 32 + (swz % 64) / 2; }
__host__ __device__ __forceinline__ int perm32(int rho) { const int n = rho >> 4, i = rho & 15; return 8 * (i >> 2) + 4 * n + (i & 3); }

struct Unit { int pm, pn, e, x0, x1; };
struct Gemm { const bf16_t* A; const bf16_t* Bt; int lda, ldb, K; };

struct StaticOrder {
    int nM, nN, nwg, G, c;
    __device__ void init(int M_, int N_, int G_, int c_) { nM = M_ / BM; nN = N_ / BM; nwg = nM * nN; G = G_; c = c_; }
    __device__ bool next(int i, Unit& u) const {
        const long L = (long)i * G + c; if (L >= nwg) return false;
        int wgid = (int)L; { const int q = nwg / NXCD, r = nwg % NXCD, xcd = wgid % NXCD, off = wgid / NXCD; wgid = (xcd < r ? xcd * (q + 1) : r * (q + 1) + (xcd - r) * q) + off; }
        const int nig = WGM * nN, gid = wgid / nig, fm = gid * WGM, gsz = (nM - fm) < WGM ? (nM - fm) : WGM;
        u.pm = fm + ((wgid % nig) % gsz); u.pn = (wgid % nig) / gsz; u.e = 0; u.x0 = 0; u.x1 = 0; return true;
    }
    __device__ __forceinline__ size_t aoff(const Gemm& g, const Unit& u) const { return (size_t)u.pm * BM * g.lda * 2; }
    __device__ __forceinline__ size_t boff(const Gemm& g, const Unit& u) const { return (size_t)u.pn * BM * g.ldb * 2; }
    __device__ __forceinline__ int ktiles(const Gemm& g, const Unit&) const { return g.K / BK; }
    __device__ __forceinline__ void done(const Unit&, int) const {}
};
__device__ const int G1_TILE[30] = {4, 5, 13, 14, 6, 7, 18, 19, 8, 15, 20, 21, 16, 17, 22, 23, 0, 1, 24, 25, 2, 3, 26, 27, 9, 10, 28, 29, 11, 12};
struct G1Order : StaticOrder {
    __device__ bool next(int i, Unit& u) const { if (!StaticOrder::next(i, u)) return false; u.pn = G1_TILE[u.pn]; return true; }
};
struct MoeOrder {
    int n; int pm0, pm1, pn0, pn1, e0, e1; size_t estride;
    int ts0, ts1, cn0, cn1; const int* etok;
    unsigned* tcnt;
    __device__ __forceinline__ void done(const Unit& u, int lane) const {
        if (tcnt) { asm volatile("s_waitcnt vmcnt(0)" ::: "memory"); if (lane == 0) __hip_atomic_fetch_add(tcnt + u.pm * 16, 1u, __ATOMIC_RELAXED, __HIP_MEMORY_SCOPE_AGENT); }
    }
    __device__ bool next(int i, Unit& u) const {
        if (i >= n) return false;
        u.pm = i == 0 ? pm0 : pm1; u.pn = i == 0 ? pn0 : pn1; u.e = i == 0 ? e0 : e1;
        u.x0 = i == 0 ? ts0 : ts1; u.x1 = i == 0 ? cn0 : cn1; return true;
    }
    __device__ __forceinline__ size_t aoff(const Gemm& g, const Unit& u) const { return (size_t)u.pm * BM * g.lda * 2; }
    __device__ __forceinline__ size_t boff(const Gemm& g, const Unit& u) const { return (size_t)u.e * estride + (size_t)u.pn * BM * g.ldb * 2; }
    __device__ __forceinline__ int ktiles(const Gemm& g, const Unit&) const { return g.K / BK; }
    __device__ __forceinline__ int gather_row(const Unit& u, int r) const {
        const int pos = min((u.pm - u.x0) * BM + r, u.x1 - 1);
        return etok[u.e * 16384 + pos];
    }
};
struct ProjOrder {
    int pm, pn, rot;
    __device__ bool next(int i, Unit& u) const { if (i >= 3) return false; int seg = i + rot; seg = seg >= 3 ? seg - 3 : seg; u.pm = pm; u.pn = pn; u.e = seg | ((i == 0) ? 16 : 0); u.x0 = 0; u.x1 = 0; return true; }
    __device__ __forceinline__ int kofs(const Unit& u) const { const int seg = u.e & 15; return seg == 0 ? 0 : (seg == 1 ? 512 : 768); }
    __device__ __forceinline__ size_t aoff(const Gemm& g, const Unit& u) const { return (size_t)u.pm * BM * g.lda * 2 + (size_t)kofs(u) * 2; }
    __device__ __forceinline__ size_t boff(const Gemm& g, const Unit& u) const { return (size_t)u.pn * BM * g.ldb * 2 + (size_t)kofs(u) * 2; }
    __device__ __forceinline__ int ktiles(const Gemm&, const Unit& u) const { return (u.e & 15) == 0 ? 8 : 4; }
    __device__ __forceinline__ void done(const Unit&, int) const {}
};

template <class Epi, class Sched, bool ALIGN_EPI = true, bool SP2 = true, bool GATHER = false>
__device__ __forceinline__ void gemm_phase(LAS unsigned char* lds, const Gemm g, const Sched& S, const Epi& E) {
    int tid_ = threadIdx.x; asm volatile("" : "+v"(tid_));
    const int tid = tid_, wid = __builtin_amdgcn_readfirstlane(tid >> 6), lane = tid & 63, wr = wid >> 2, wc = wid & 3, fr = lane & 15, fq = lane >> 4;
    int nt = S.ktiles(g, Unit{0, 0, 0, 0, 0});
    unsigned voffA[2], voffB[2];
#pragma unroll
    for (int i = 0; i < 2; ++i) { int R, C; stage_rc(tid * 16 + i * 8192, R, C); const int Rb = Epi::PERM ? ((R & ~31) + perm32(R & 31)) : R;
        voffA[i] = (unsigned)(R * g.lda + C) * 2u; voffB[i] = (unsigned)(Rb * g.ldb + C) * 2u; }
    const size_t kstep = (size_t)(BK * 2);
    const size_t hstepA = (size_t)HALF * g.lda * 2, hstepB = (size_t)HALF * g.ldb * 2;
    const unsigned ldsw = (unsigned)wid * 1024u;
    const int aoff = lds_byte(wr * 64 + fr, fq * 8), boff = lds_byte(wc * 32 + fr, fq * 8);
#define PG8_SA(b, h) (((b) * 2 + (h)) * HTB)
#define PG8_SB(b, h) ((4 + (b) * 2 + (h)) * HTB)
#define PG8_STAGE(bufoff, gbase, voff) do { _Pragma("unroll") for (int _i = 0; _i < 2; ++_i) \
        __builtin_amdgcn_global_load_lds((const unsigned*)((const char*)(gbase) + (voff)[_i]), (LAS unsigned*)(lds + (bufoff) + ldsw + _i * 8192), 16, 0, 0); } while (0)
    unsigned vo0[2] = {0u, 0u}, vo1[2] = {0u, 0u}, nvo0[2] = {0u, 0u}, nvo1[2] = {0u, 0u};
#define PG8_GOFF(u_, d0_, d1_) do { _Pragma("unroll") for (int _i = 0; _i < 2; ++_i) { int R_, C_; stage_rc(tid * 16 + _i * 8192, R_, C_); \
        d0_[_i] = (unsigned)(S.gather_row(u_, R_) * g.lda + C_) * 2u; d1_[_i] = (unsigned)(S.gather_row(u_, HALF + R_) * g.lda + C_) * 2u; } } while (0)
#define PG8_STAGEA(bufoff, ptr, h, nx) do { if constexpr (GATHER) { unsigned o_[2]; o_[0] = (nx) ? ((h) ? nvo1[0] : nvo0[0]) : ((h) ? vo1[0] : vo0[0]); o_[1] = (nx) ? ((h) ? nvo1[1] : nvo0[1]) : ((h) ? vo1[1] : vo0[1]); \
        PG8_STAGE(bufoff, ptr, o_); } else { PG8_STAGE(bufoff, (ptr) + ((h) ? hstepA : 0), voffA); } } while (0)
#define PG8_LDA(dst, b, h) do { _Pragma("unroll") for (int m = 0; m < 4; ++m) _Pragma("unroll") for (int k = 0; k < 2; ++k) dst[m][k] = *(const LAS bf16x8*)(lds + PG8_SA(b, h) + aoff + m * 2048 + k * 1024); } while (0)
#define PG8_LDB(dst, b, h) do { _Pragma("unroll") for (int n = 0; n < 2; ++n) _Pragma("unroll") for (int k = 0; k < 2; ++k) dst[n][k] = *(const LAS bf16x8*)(lds + PG8_SB(b, h) + boff + n * 2048 + k * 1024); } while (0)
#define PG8_MMA(ai, bj, At, Bt) do { __builtin_amdgcn_s_setprio(1); _Pragma("unroll") for (int m = 0; m < 4; ++m) _Pragma("unroll") for (int n = 0; n < 2; ++n) _Pragma("unroll") for (int k = 0; k < 2; ++k) \
        acc[ai][bj][m][n] = __builtin_amdgcn_mfma_f32_16x16x32_bf16(Bt[n][k], At[m][k], acc[ai][bj][m][n], 0, 0, 0); __builtin_amdgcn_s_setprio(0); } while (0)
#define PG8_WAIT_V(n) asm volatile("s_waitcnt vmcnt(" #n ")" ::: "memory")
#define PG8_WAIT_L(n) asm volatile("s_waitcnt lgkmcnt(" #n ")" ::: "memory")
#define PG8_BAR __builtin_amdgcn_s_barrier()
#define PG8_SCHED __builtin_amdgcn_sched_barrier(0)
    Unit cur, nxt; int ui = 0;
    if (!S.next(0, cur)) return;
    nt = S.ktiles(g, cur);
    f32x4 acc[2][2][4][2];
#pragma unroll
    for (int a = 0; a < 2; ++a)
#pragma unroll
        for (int b = 0; b < 2; ++b)
#pragma unroll
            for (int m = 0; m < 4; ++m)
#pragma unroll
                for (int n = 0; n < 2; ++n) acc[a][b][m][n] = (f32x4){0.f, 0.f, 0.f, 0.f};
    bf16x8 At[4][2], B0[2][2], B1[2][2];
    const char* cA = (const char*)g.A + (GATHER ? (size_t)0 : S.aoff(g, cur)); const char* cB = (const char*)g.Bt + S.boff(g, cur);
    if constexpr (GATHER) { PG8_GOFF(cur, vo0, vo1); asm volatile("s_waitcnt vmcnt(0)" : "+v"(vo0[0]), "+v"(vo0[1]), "+v"(vo1[0]), "+v"(vo1[1]) :: "memory"); }
    if constexpr (SP2) {
        PG8_STAGE(PG8_SB(0, 0), cB, voffB); PG8_STAGE(PG8_SB(0, 1), cB + hstepB, voffB); PG8_STAGEA(PG8_SA(0, 0), cA, 0, false); PG8_STAGEA(PG8_SA(0, 1), cA, 1, false);
        if (wr == 1) PG8_BAR;
        PG8_WAIT_V(2); PG8_BAR;
        PG8_STAGE(PG8_SB(1, 0), cB + kstep, voffB); PG8_STAGEA(PG8_SA(1, 0), cA + kstep, 0, false); PG8_STAGE(PG8_SB(1, 1), cB + hstepB + kstep, voffB);
        PG8_WAIT_V(6); PG8_BAR;
    } else {
        PG8_STAGE(PG8_SB(0, 0), cB, voffB); PG8_STAGE(PG8_SA(0, 0), cA, voffA); PG8_STAGE(PG8_SB(0, 1), cB + hstepB, voffB); PG8_STAGE(PG8_SA(0, 1), cA + hstepA, voffA);
        if (wr == 1) PG8_BAR;
        PG8_WAIT_V(4); PG8_BAR;
        PG8_STAGE(PG8_SB(1, 0), cB + kstep, voffB); PG8_STAGE(PG8_SA(1, 0), cA + kstep, voffA); PG8_STAGE(PG8_SB(1, 1), cB + hstepB + kstep, voffB);
        PG8_WAIT_V(6); PG8_BAR;
    }
    for (;;) {
        const bool has_next = S.next(ui + 1, nxt);
        const char* nA = (has_next && !GATHER) ? (const char*)g.A + S.aoff(g, nxt) : cA; const char* nB = has_next ? (const char*)g.Bt + S.boff(g, nxt) : cB;
        if constexpr (GATHER) { if (has_next) { PG8_GOFF(nxt, nvo0, nvo1); } else { nvo0[0] = vo0[0]; nvo0[1] = vo0[1]; nvo1[0] = vo1[0]; nvo1[1] = vo1[1]; }
            asm volatile("s_waitcnt vmcnt(0)" : "+v"(nvo0[0]), "+v"(nvo0[1]), "+v"(nvo1[0]), "+v"(nvo1[1]) :: "memory"); }
        for (int t = 0; t < nt; t += 2) {
            const bool last = (t == nt - 2);
            const char* a1 = cA + (size_t)(t + 1) * kstep;
            const char* a2 = last ? nA : cA + (size_t)(t + 2) * kstep; const char* b2 = last ? nB : cB + (size_t)(t + 2) * kstep;
            const char* a3 = a2 + kstep; const char* b3 = b2 + kstep;
            if constexpr (SP2) {
            PG8_LDB(B0, 0, 0); PG8_LDB(B1, 0, 1); PG8_SCHED; PG8_LDA(At, 0, 0); PG8_STAGEA(PG8_SA(1, 1), a1, 1, false);
            PG8_WAIT_V(8); PG8_WAIT_L(0); PG8_BAR; PG8_MMA(0, 0, At, B0); PG8_MMA(0, 1, At, B1); PG8_BAR; PG8_SCHED;
            PG8_LDA(At, 0, 1); PG8_STAGE(PG8_SB(0, 0), b2, voffB); PG8_STAGE(PG8_SB(0, 1), b2 + hstepB, voffB); PG8_STAGEA(PG8_SA(0, 0), a2, 0, last);
            PG8_WAIT_V(8); PG8_WAIT_L(0); PG8_BAR; PG8_MMA(1, 0, At, B0); PG8_MMA(1, 1, At, B1); PG8_BAR; PG8_SCHED;
            PG8_LDB(B0, 1, 0); PG8_LDB(B1, 1, 1); PG8_SCHED; PG8_LDA(At, 1, 0); PG8_STAGEA(PG8_SA(0, 1), a2, 1, last);
            PG8_WAIT_V(8); PG8_WAIT_L(0); PG8_BAR; PG8_MMA(0, 0, At, B0); PG8_MMA(0, 1, At, B1); PG8_BAR; PG8_SCHED;
            PG8_LDA(At, 1, 1); PG8_STAGE(PG8_SB(1, 0), b3, voffB); PG8_STAGE(PG8_SB(1, 1), b3 + hstepB, voffB); PG8_STAGEA(PG8_SA(1, 0), a3, 0, last);
            PG8_WAIT_V(8); PG8_WAIT_L(0); PG8_BAR; PG8_MMA(1, 0, At, B0); PG8_MMA(1, 1, At, B1); PG8_BAR; PG8_SCHED;
            } else {
            PG8_LDB(B0, 0, 0); PG8_SCHED; PG8_LDA(At, 0, 0); PG8_STAGE(PG8_SA(1, 1), a1 + hstepA, voffA);
            PG8_WAIT_L(8); PG8_BAR; PG8_WAIT_L(0); PG8_MMA(0, 0, At, B0); PG8_BAR; PG8_SCHED;
            PG8_LDB(B1, 0, 1); PG8_STAGE(PG8_SB(0, 0), b2, voffB);
            PG8_BAR; PG8_WAIT_L(0); PG8_MMA(0, 1, At, B1); PG8_BAR;
            PG8_LDA(At, 0, 1); PG8_STAGE(PG8_SA(0, 0), a2, voffA);
            PG8_BAR; PG8_WAIT_L(0); PG8_MMA(1, 0, At, B0); PG8_BAR; PG8_SCHED;
            PG8_STAGE(PG8_SB(0, 1), b2 + hstepB, voffB);
            PG8_WAIT_V(6); PG8_BAR; PG8_MMA(1, 1, At, B1); PG8_BAR;
            PG8_LDB(B0, 1, 0); PG8_SCHED; PG8_LDA(At, 1, 0); PG8_STAGE(PG8_SA(0, 1), a2 + hstepA, voffA);
            PG8_WAIT_L(8); PG8_BAR; PG8_WAIT_L(0); PG8_MMA(0, 0, At, B0); PG8_BAR; PG8_SCHED;
            PG8_LDB(B1, 1, 1); PG8_STAGE(PG8_SB(1, 0), b3, voffB);
            PG8_BAR; PG8_WAIT_L(0); PG8_MMA(0, 1, At, B1); PG8_BAR;
            PG8_LDA(At, 1, 1); PG8_STAGE(PG8_SA(1, 0), a3, voffA);
            PG8_BAR; PG8_WAIT_L(0); PG8_MMA(1, 0, At, B0); PG8_BAR; PG8_SCHED;
            PG8_STAGE(PG8_SB(1, 1), b3 + hstepB, voffB);
            PG8_WAIT_V(6); PG8_BAR; PG8_MMA(1, 1, At, B1); PG8_BAR;
            }
        }
        if constexpr (ALIGN_EPI) { if (wr == 0) PG8_BAR; }
        E(acc, cur, wr, wc, fr, fq);
        S.done(cur, lane);
        if (!has_next) break;
#pragma unroll
        for (int a = 0; a < 2; ++a)
#pragma unroll
            for (int b = 0; b < 2; ++b)
#pragma unroll
                for (int m = 0; m < 4; ++m)
#pragma unroll
                    for (int n = 0; n < 2; ++n) acc[a][b][m][n] = (f32x4){0.f, 0.f, 0.f, 0.f};
        cur = nxt; cA = nA; cB = nB; ++ui; nt = S.ktiles(g, cur);
        if constexpr (GATHER) { vo0[0] = nvo0[0]; vo0[1] = nvo0[1]; vo1[0] = nvo1[0]; vo1[1] = nvo1[1]; }
        if constexpr (ALIGN_EPI) { if (wr == 1) PG8_BAR; }
    }
    PG8_WAIT_V(0);
    if constexpr (!ALIGN_EPI) { if (wr == 0) PG8_BAR; }
    PG8_BAR;
#undef PG8_SA
#undef PG8_SB
#undef PG8_STAGE
#undef PG8_LDA
#undef PG8_STAGEA
#undef PG8_GOFF
#undef PG8_LDB
#undef PG8_MMA
#undef PG8_WAIT_V
#undef PG8_WAIT_L
#undef PG8_BAR
#undef PG8_SCHED
}
}

#define XB_TMO      128
#define XB_XCNT(j)  (256  + 64 * (j))
#define XB_XSUB(j)  (1280 + 64 * (j))
#define XB_XGEN(j)  (2304 + 64 * (j))
#define XB_TOP      3328
#define XB_TOPGEN   3392
#define XCD_BAR_WORDS 3456
#define XB_SPIN_CAP (1u << 18)
__device__ __forceinline__ unsigned xb_ld(unsigned* p)              { return __hip_atomic_load(p, __ATOMIC_RELAXED, __HIP_MEMORY_SCOPE_AGENT); }
__device__ __forceinline__ unsigned xb_add(unsigned* p, unsigned v) { return __hip_atomic_fetch_add(p, v, __ATOMIC_RELAXED, __HIP_MEMORY_SCOPE_AGENT); }
__device__ __forceinline__ unsigned xb_xcc_id() { return (unsigned)__builtin_amdgcn_s_getreg((3 << 11) | 20) & 0xFu; }
#define XB_SPIN(cond, bar) do { unsigned _sp = 0; while (cond) { __builtin_amdgcn_s_sleep(1); \
    if ((++_sp & 255u) == 0u) { if (xb_ld(&(bar)[XB_TMO])) break; if (_sp > XB_SPIN_CAP) { atomicAdd(&(bar)[XB_TMO], 1u); break; } } } } while (0)
struct XcdBarrier { unsigned* bar; unsigned x; volatile LAS unsigned* st; };
__device__ __forceinline__ XcdBarrier xcd_barrier_post(unsigned* bar, volatile LAS unsigned* st) {
    XcdBarrier b; b.bar = bar; b.x = xb_xcc_id(); b.st = st;
    if (threadIdx.x == 0) (void)xb_add(&bar[XB_XCNT(b.x)], 1u);
    return b;
}
__device__ __forceinline__ void xcd_barrier_complete(unsigned* bar, unsigned x, unsigned& nloc, unsigned& nx) {
    const unsigned G = gridDim.x * gridDim.y * gridDim.z;
    unsigned sum, cnt, mine, sp = 0u;
    for (;;) {
        sum = 0u; cnt = 0u; mine = 0u;
#pragma unroll
        for (unsigned j = 0; j < 16; ++j) { const unsigned c = xb_ld(&bar[XB_XCNT(j)]); sum += c; cnt += (c > 0u) ? 1u : 0u; mine = (j == x) ? c : mine; }
        if (sum == G) break;
        __builtin_amdgcn_s_sleep(1);
        if ((++sp & 255u) == 0u) { if (xb_ld(&bar[XB_TMO])) break; if (sp > XB_SPIN_CAP) { atomicAdd(&bar[XB_TMO], 1u); break; } }
    }
    nloc = mine > 0u ? mine : 1u; nx = cnt > 0u ? cnt : 1u;
}
__device__ __forceinline__ void xcd_barrier(const XcdBarrier& b) {
    asm volatile("s_waitcnt vmcnt(0)" ::: "memory");
    __syncthreads();
    if (threadIdx.x == 0) {
        unsigned* bar = b.bar;
        __builtin_amdgcn_s_waitcnt(0);
        unsigned nloc = b.st[0], nx = b.st[1];
        if (nloc == 0u) { xcd_barrier_complete(bar, b.x, nloc, nx); b.st[0] = nloc; b.st[1] = nx; }
        const unsigned old = xb_add(&bar[XB_XSUB(b.x)], 1u);
        const unsigned gen = old / nloc;
        if (old + 1u == (gen + 1u) * nloc) {
            __builtin_amdgcn_fence(__ATOMIC_RELEASE, "agent");
            asm volatile("s_waitcnt vmcnt(0)" ::: "memory");
            const unsigned og = xb_add(&bar[XB_TOP], 1u);
            const unsigned tg = og / nx;
            if (og + 1u == (tg + 1u) * nx) xb_add(&bar[XB_TOPGEN], 1u);
            else XB_SPIN(xb_ld(&bar[XB_TOPGEN]) == tg, bar);
            __builtin_amdgcn_fence(__ATOMIC_ACQUIRE, "agent");
            xb_add(&bar[XB_XGEN(b.x)], 1u);
            asm volatile("s_waitcnt vmcnt(0)" ::: "memory");
        } else {
            XB_SPIN(xb_ld(&bar[XB_XGEN(b.x)]) == gen, bar);
            __builtin_amdgcn_fence(__ATOMIC_ACQUIRE, "agent");
            asm volatile("s_waitcnt vmcnt(0)" ::: "memory");
        }
    }
    __syncthreads();
}

struct Args {
    const float* x; const float* c; const float* ada_w; const float* ada_b; const float* mix_g; const float* ffn_g; const float* w_in;
    const float* da_lambda; const float* da_subln; const float* na_rpb; const float* wpa; const float* wpn; const float* wpd; const float* w_out;
    const float* rgw; const float* rgb; const float* rew; const float* reb; const float* ew1; const float* ew3; const float* ew2; const float* fin_g;
    float* out; unsigned char* ws; int ph_lo, ph_hi; int variant, pad;
};

__device__ const double ROPE_INV[32] = {
    1.0, 0.7498942093324559, 0.5623413251903491, 0.4216965034285822, 0.31622776601683794, 0.23713737056616552, 0.1778279410038923, 0.1333521432163324,
    0.1, 0.07498942093324558, 0.05623413251903491, 0.04216965034285822, 0.031622776601683794, 0.023713737056616554, 0.01778279410038923, 0.01333521432163324,
    0.01, 0.007498942093324558, 0.005623413251903491, 0.004216965034285822, 0.0031622776601683794, 0.0023713737056616554, 0.001778279410038923, 0.001333521432163324,
    0.001, 0.0007498942093324559, 0.0005623413251903491, 0.0004216965034285822, 0.00031622776601683794, 0.00023713737056616554, 0.0001778279410038923, 0.0001333521432163324};

__device__ __forceinline__ void sincos_d(double a, float& s, float& c) {
    const double k = __builtin_rint(a * 0.6366197723675814);
    double t = __builtin_fma(-k, 1.5707963267948966, a); t = __builtin_fma(-k, 6.123233995736766e-17, t);
    const double t2 = t * t;
    double sp = -1.0 / 1307674368000.0; sp = sp * t2 + 1.0 / 6227020800.0; sp = sp * t2 - 1.0 / 39916800.0; sp = sp * t2 + 1.0 / 362880.0; sp = sp * t2 - 1.0 / 5040.0; sp = sp * t2 + 1.0 / 120.0; sp = sp * t2 - 1.0 / 6.0; sp = sp * t2 + 1.0; sp *= t;
    double cp = 1.0 / 87178291200.0; cp = cp * t2 - 1.0 / 479001600.0; cp = cp * t2 + 1.0 / 3628800.0; cp = cp * t2 - 1.0 / 40320.0; cp = cp * t2 + 1.0 / 720.0; cp = cp * t2 - 1.0 / 24.0; cp = cp * t2 + 0.5; cp = 1.0 - cp * t2;
    const int q = ((int)k) & 3;
    const double ss = (q == 0) ? sp : (q == 1) ? cp : (q == 2) ? -sp : -cp;
    const double cc = (q == 0) ? cp : (q == 1) ? -sp : (q == 2) ? -cp : sp;
    s = (float)ss; c = (float)cc;
}

__device__ __forceinline__ int dst_row(int mode, int n) {
    if (mode == 1) { const bool rot = (n < 1024) || (n >= ZQD && n < ZVD); if (rot) { const int j = n & 63; return (n & ~63) + ((j & 31) << 1) + (j >> 5); } return n; }
    if (mode == 2) return 256 * (n >> 7) + (n & 127);
    if (mode == 3) return 256 * (n >> 7) + 128 + (n & 127);
    return n;
}
__device__ __forceinline__ void tr_item(const float* W, int N, bf16_t* WT, int ldt, int koff, int mode, LAS float* scr, int item, int lane) {
    const int nblk = N / 32, kb = item / nblk, nb = item % nblk, k0 = 64 * kb, n0 = 32 * nb;
#pragma unroll 8
    for (int i = 0; i < 32; ++i) { const int kk = 2 * i + (lane >> 5); scr[kk * 33 + (lane & 31)] = __builtin_nontemporal_load(&W[(size_t)(k0 + kk) * N + n0 + (lane & 31)]); }
    LDS_WAIT();
    const int c = lane & 7;
#pragma unroll
    for (int j = 0; j < 4; ++j) { const int n = (lane >> 3) + 8 * j; const LAS float* s = scr + (8 * c) * 33 + n;
        float f = 1.0f; if (mode == 1) { const int nn = n0 + n; f = (nn < ZKA || (nn >= ZQN && nn < ZKN) || (nn >= ZQD && nn < ZKD)) ? C2 : (nn >= ZG ? -LOG2E : 1.0f); }
        u32x4 o; o.x = pk2(s[0 * 33] * f, s[1 * 33] * f); o.y = pk2(s[2 * 33] * f, s[3 * 33] * f); o.z = pk2(s[4 * 33] * f, s[5 * 33] * f); o.w = pk2(s[6 * 33] * f, s[7 * 33] * f);
        *(u32x4*)(WT + (size_t)dst_row(mode, n0 + n) * ldt + koff + k0 + 8 * c) = o; }
    LDS_WAIT();
}

__device__ __forceinline__ float max3f(float a, float b, float c) { float r; asm("v_max3_f32 %0, %1, %2, %3" : "=v"(r) : "v"(a), "v"(b), "v"(c)); return r; }
__device__ __forceinline__ int crow(int r, int hi) { return (r & 3) + 8 * (r >> 2) + 4 * hi; }
__device__ __forceinline__ float swapmax(float m) { float a = m, b = m; swap32(a, b); return __builtin_fmaxf(a, b); }
__device__ __forceinline__ float swapsum(float m) { float a = m, b = m; swap32(a, b); return a + b; }
typedef short v4i16_t __attribute__((ext_vector_type(4)));
__device__ __forceinline__ s16x4 vtr(const LAS unsigned char* p) { return __builtin_bit_cast(s16x4, __builtin_amdgcn_ds_read_tr16_b64_v4i16((LAS v4i16_t*)p)); }

template <int DV> struct AttnCfg { static constexpr int ND = DV / 32, NCH = DV / 16, VST = DV * 2 + 64; };

template <int DV> struct TileRegs { u32x4 kr[4]; u32x4 vr[4]; };
template <int DV>
__device__ __forceinline__ void tile_load(TileRegs<DV>& T, const char* zb, const unsigned (&roff)[4], unsigned kcol, unsigned vcol) {
    const unsigned cb = 16u * (threadIdx.x & 7);
#pragma unroll
    for (int i = 0; i < 4; ++i) { T.kr[i] = *(const u32x4*)(zb + (size_t)(roff[i] + kcol + cb)); T.vr[i] = *(const u32x4*)(zb + (size_t)(roff[i] + vcol + cb)); }
}
__device__ __forceinline__ float max16m(const f32x16& p, float m) { float a, b;
    asm("v_max3_f32 %0, %2, %3, %4\n\tv_max3_f32 %1, %5, %6, %7\n\tv_max3_f32 %0, %0, %8, %9\n\tv_max3_f32 %1, %1, %10, %11\n\tv_max3_f32 %0, %0, %12, %13\n\tv_max3_f32 %1, %1, %14, %15\n\t"
        "v_max3_f32 %0, %0, %16, %17\n\tv_max3_f32 %0, %0, %1, %18"
        : "=&v"(a), "=&v"(b) : "v"(p[0]), "v"(p[1]), "v"(p[2]), "v"(p[3]), "v"(p[4]), "v"(p[5]), "v"(p[6]), "v"(p[7]), "v"(p[8]), "v"(p[9]), "v"(p[10]), "v"(p[11]), "v"(p[12]), "v"(p[13]), "v"(p[14]), "v"(p[15]), "v"(m));
    return a; }
template <int DV, class MaskF, class Reload>
__device__ __forceinline__ void attn_tile(f32x16 (&o)[DV / 32], float& m, float& l, const bf16x8 (&qf)[4], TileRegs<DV>& T,
                                          LAS unsigned char* vlds, LAS float* wsf, const MaskF& maskf, const Reload& reload, int lane, int hi) {
    constexpr int ND = AttnCfg<DV>::ND, VST = AttnCfg<DV>::VST, KST = 144;
    static_assert(DV == 64, "gather tiles are 64 wide");
    CBAR();
    { LAS unsigned char* kw = vlds + 6144 + (lane >> 3) * KST + (lane & 7) * 16; LAS unsigned char* vw = vlds + (lane >> 3) * VST + (lane & 7) * 16;
#pragma unroll
      for (int i = 0; i < 4; ++i) { *(LAS u32x4*)(kw + 8 * i * KST) = T.kr[i]; *(LAS u32x4*)(vw + 8 * i * VST) = T.vr[i]; } }
    CBAR();
    reload(T);
    f32x16 p; maskf(p);
    { const LAS unsigned char* kp = vlds + 6144 + (lane & 31) * KST + hi * 16;
#pragma unroll
      for (int d0 = 0; d0 < 4; ++d0) { const bf16x8 kf = *(const LAS bf16x8*)(kp + 32 * d0); p = __builtin_amdgcn_mfma_f32_32x32x16_bf16(kf, qf[d0], p, 0, 0, 0); } }
    asm volatile("s_nop 15\n\ts_nop 7" : "+v"(p));
    float mx = max16m(p, m);
    { float a = mx, b = mx; swap32(a, b); mx = max3f(a, b, m); }
    const float mn = (mx > m + RESCALE_THR) ? mx : m;
    const float alpha = fexp2(m - mn);
    m = mn;
    float rs = 0.f;
#pragma unroll
    for (int r = 0; r < 16; ++r) { p[r] = fexp2(p[r] - mn); rs += p[r]; }
    l = l * alpha + rs;
    if (__any(alpha != 1.0f)) {
        CBAR();
        if (hi == 0) wsf[lane & 31] = alpha;
        CBAR();
#pragma unroll
        for (int g4 = 0; g4 < 4; ++g4) { const f32x4 a4 = *(const LAS f32x4*)(wsf + 8 * g4 + 4 * hi);
#pragma unroll
            for (int d0 = 0; d0 < ND; ++d0) { o[d0][4 * g4 + 0] *= a4[0]; o[d0][4 * g4 + 1] *= a4[1]; o[d0][4 * g4 + 2] *= a4[2]; o[d0][4 * g4 + 3] *= a4[3]; } }
        CBAR();
    }
    CBAR();
    u32x4 pw0, pw1;
    pw0.x = cvtpk_s(p[0], p[1]); pw0.y = cvtpk_s(p[2], p[3]); pw0.z = cvtpk_s(p[4], p[5]); pw0.w = cvtpk_s(p[6], p[7]);
    pw1.x = cvtpk_s(p[8], p[9]); pw1.y = cvtpk_s(p[10], p[11]); pw1.z = cvtpk_s(p[12], p[13]); pw1.w = cvtpk_s(p[14], p[15]);
    const bf16x8 pa0 = __builtin_bit_cast(bf16x8, pw0), pa1 = __builtin_bit_cast(bf16x8, pw1);
    const int li = lane & 15, g16 = lane >> 4;
    const LAS unsigned char* vb = vlds + (4 * hi + (li >> 2)) * VST + (16 * (g16 & 1) + 4 * (li & 3)) * 2;
    s16x4 vlo[2][ND], vhi[2][ND];
#pragma unroll
    for (int s = 0; s < 2; ++s)
#pragma unroll
        for (int d0 = 0; d0 < ND; ++d0) { vlo[s][d0] = vtr(vb + (16 * s) * VST + d0 * 64); vhi[s][d0] = vtr(vb + (16 * s + 8) * VST + d0 * 64); }
    __builtin_amdgcn_sched_barrier(0);
#pragma unroll
    for (int s = 0; s < 2; ++s)
#pragma unroll
        for (int d0 = 0; d0 < ND; ++d0) {
            const bf16x8 vf = (bf16x8){vlo[s][d0][0], vlo[s][d0][1], vlo[s][d0][2], vlo[s][d0][3], vhi[s][d0][0], vhi[s][d0][1], vhi[s][d0][2], vhi[s][d0][3]};
            o[d0] = __builtin_amdgcn_mfma_f32_32x32x16_bf16(s == 0 ? pa0 : pa1, vf, o[d0], 0, 0, 0);
        }
    CBAR();
}
template <int ND>
__device__ __forceinline__ void attn_finish(f32x16 (&o)[ND], float l, LAS float* wsf, int lane, int hi) {
    const float inv = frcp(swapsum(l));
    CBAR();
    if (hi == 0) wsf[lane & 31] = inv;
    CBAR();
#pragma unroll
    for (int g4 = 0; g4 < 4; ++g4) { const f32x4 a4 = *(const LAS f32x4*)(wsf + 8 * g4 + 4 * hi);
#pragma unroll
        for (int d0 = 0; d0 < ND; ++d0) { o[d0][4 * g4 + 0] *= a4[0]; o[d0][4 * g4 + 1] *= a4[1]; o[d0][4 * g4 + 2] *= a4[2]; o[d0][4 * g4 + 3] *= a4[3]; } }
    CBAR();
}

__device__ __forceinline__ void glds16s(const void* sbase, unsigned voff, unsigned lds_dst) { unsigned keep;
    asm volatile("s_mov_b32 %0, m0\n\ts_mov_b32 m0, %2\n\ts_nop 0\n\tglobal_load_lds_dwordx4 %1, %3\n\ts_mov_b32 m0, %0" : "=&s"(keep) : "v"(voff), "s"(lds_dst), "s"(sbase) : "memory"); }
__device__ __forceinline__ void glds16(const void* gsrc, unsigned lds_dst) { unsigned keep;
    asm volatile("s_mov_b32 %0, m0\n\ts_mov_b32 m0, %2\n\ts_nop 0\n\tglobal_load_lds_dwordx4 %1, off\n\ts_mov_b32 m0, %0" : "=&s"(keep) : "v"(gsrc), "s"(lds_dst) : "memory"); }
__device__ __forceinline__ void diff_qk(f32x16& p0, f32x16& p1, const LAS unsigned char* qlds, const LAS unsigned char* kb, int lane, int hi) {
    const int r32 = lane & 31, sw = (r32 >> 1) & 7;
    const LAS unsigned char* kp = kb + r32 * 128;
    p0 = f32x16{}; p1 = f32x16{};
#pragma unroll
    for (int d0 = 0; d0 < 4; ++d0) {
        const bf16x8 q = *(const LAS bf16x8*)(qlds + d0 * 1024 + lane * 16);
        const int po = ((2 * d0 + hi) ^ sw) << 4;
        const bf16x8 k0 = *(const LAS bf16x8*)(kp + po), k1 = *(const LAS bf16x8*)(kp + po + 4096);
        p0 = __builtin_amdgcn_mfma_f32_32x32x16_bf16(k0, q, p0, 0, 0, 0);
        p1 = __builtin_amdgcn_mfma_f32_32x32x16_bf16(k1, q, p1, 0, 0, 0);
    }
}
__device__ __forceinline__ void diff_sm_pv(f32x16 (&o)[4], float& m, float& l, f32x16& p0, f32x16& p1, const LAS unsigned char* vbuf, LAS float* wsf, int lane, int hi) {
    const int r32 = lane & 31;
    float ma = max3f(p0[0], p0[1], p1[0]), mb = max3f(p0[2], p0[3], p1[1]); ma = max3f(ma, p1[2], p1[3]);
#pragma unroll
    for (int r = 4; r < 16; r += 4) { ma = max3f(ma, p0[r], p0[r + 1]); mb = max3f(mb, p0[r + 2], p0[r + 3]); ma = max3f(ma, p1[r], p1[r + 1]); mb = max3f(mb, p1[r + 2], p1[r + 3]); }
    float mx = max3f(ma, mb, m);
    { float a = mx, b = mx; swap32(a, b); mx = max3f(a, b, m); }
    const float mn = (mx > m + RESCALE_THR) ? mx : m;
    const float alpha = fexp2(m - mn);
    m = mn;
    float rs = 0.f;
#pragma unroll
    for (int r = 0; r < 16; ++r) { p0[r] = fexp2(p0[r] - mn); p1[r] = fexp2(p1[r] - mn); rs += p0[r] + p1[r]; }
    l = l * alpha + rs;
    if (__any(alpha != 1.0f)) {
        CBAR();
        if (hi == 0) wsf[r32] = alpha;
        CBAR();
#pragma unroll
        for (int g4 = 0; g4 < 4; ++g4) { const f32x4 a4 = *(const LAS f32x4*)(wsf + 8 * g4 + 4 * hi);
#pragma unroll
            for (int d0 = 0; d0 < 4; ++d0) { o[d0][4 * g4 + 0] *= a4[0]; o[d0][4 * g4 + 1] *= a4[1]; o[d0][4 * g4 + 2] *= a4[2]; o[d0][4 * g4 + 3] *= a4[3]; } }
        CBAR();
    }
    u32x4 pw[4];
#pragma unroll
    for (int i = 0; i < 4; ++i) { pw[0][i] = cvtpk_s(p0[2 * i], p0[2 * i + 1]); pw[1][i] = cvtpk_s(p0[8 + 2 * i], p0[9 + 2 * i]); pw[2][i] = cvtpk_s(p1[2 * i], p1[2 * i + 1]); pw[3][i] = cvtpk_s(p1[8 + 2 * i], p1[9 + 2 * i]); }
    const int li = lane & 15, g16 = lane >> 4;
    const LAS unsigned char* vp = vbuf + hi * 1024 + (li >> 2) * 64 + (16 * (g16 & 1) + 4 * (li & 3)) * 2;
#pragma unroll
    for (int s4 = 0; s4 < 4; ++s4) {
        const bf16x8 pa = __builtin_bit_cast(bf16x8, pw[s4]);
#pragma unroll
        for (int d0 = 0; d0 < 4; ++d0) {
            const s16x4 lo = vtr(vp + s4 * 4096 + d0 * 256), hh = vtr(vp + s4 * 4096 + 2048 + d0 * 256);
            const bf16x8 vf = (bf16x8){lo[0], lo[1], lo[2], lo[3], hh[0], hh[1], hh[2], hh[3]};
            o[d0] = __builtin_amdgcn_mfma_f32_32x32x16_bf16(pa, vf, o[d0], 0, 0, 0);
        }
    }
}

__device__ __forceinline__ void diff_sm(f32x16 (&o)[4], float& m, float& l, f32x16& p0, f32x16& p1, u32x4 (&pw)[4], LAS float* wsf, int lane, int hi) {
    const int r32 = lane & 31;
    float ma = max3f(p0[0], p0[1], p1[0]), mb = max3f(p0[2], p0[3], p1[1]); ma = max3f(ma, p1[2], p1[3]);
#pragma unroll
    for (int r = 4; r < 16; r += 4) { ma = max3f(ma, p0[r], p0[r + 1]); mb = max3f(mb, p0[r + 2], p0[r + 3]); ma = max3f(ma, p1[r], p1[r + 1]); mb = max3f(mb, p1[r + 2], p1[r + 3]); }
    float mx = max3f(ma, mb, m);
    { float a = mx, b = mx; swap32(a, b); mx = max3f(a, b, m); }
    const float mn = (mx > m + RESCALE_THR) ? mx : m;
    const float alpha = fexp2(m - mn);
    m = mn;
    float rs = 0.f;
#pragma unroll
    for (int r = 0; r < 16; ++r) { p0[r] = fexp2(p0[r] - mn); p1[r] = fexp2(p1[r] - mn); rs += p0[r] + p1[r]; }
    l = l * alpha + rs;
    if (__any(alpha != 1.0f)) {
        CBAR();
        if (hi == 0) wsf[r32] = alpha;
        CBAR();
#pragma unroll
        for (int g4 = 0; g4 < 4; ++g4) { const f32x4 a4 = *(const LAS f32x4*)(wsf + 8 * g4 + 4 * hi);
#pragma unroll
            for (int d0 = 0; d0 < 4; ++d0) { o[d0][4 * g4 + 0] *= a4[0]; o[d0][4 * g4 + 1] *= a4[1]; o[d0][4 * g4 + 2] *= a4[2]; o[d0][4 * g4 + 3] *= a4[3]; } }
        CBAR();
    }
#pragma unroll
    for (int i = 0; i < 4; ++i) { pw[0][i] = cvtpk_s(p0[2 * i], p0[2 * i + 1]); pw[1][i] = cvtpk_s(p0[8 + 2 * i], p0[9 + 2 * i]); pw[2][i] = cvtpk_s(p1[2 * i], p1[2 * i + 1]); pw[3][i] = cvtpk_s(p1[8 + 2 * i], p1[9 + 2 * i]); }
}
__device__ __forceinline__ void diff_pv2(f32x16 (&o0)[4], f32x16 (&o1)[4], const u32x4 (&pw0)[4], const u32x4 (&pw1)[4], const LAS unsigned char* vbuf, int lane_, int hi_) {
    int lane = lane_; asm volatile("" : "+v"(lane));
    const int hi = lane >> 5; (void)hi_;
    const int li = lane & 15, g16 = lane >> 4;
    const LAS unsigned char* vp = vbuf + hi * 1024 + (li >> 2) * 64 + (16 * (g16 & 1) + 4 * (li & 3)) * 2;
    __builtin_amdgcn_s_setprio(1);
#pragma unroll
    for (int s4 = 0; s4 < 4; ++s4) {
        const bf16x8 pa0 = __builtin_bit_cast(bf16x8, pw0[s4]), pa1 = __builtin_bit_cast(bf16x8, pw1[s4]);
#pragma unroll
        for (int d0 = 0; d0 < 4; ++d0) {
            const s16x4 lo = vtr(vp + s4 * 4096 + d0 * 256), hh = vtr(vp + s4 * 4096 + 2048 + d0 * 256);
            const bf16x8 vf = (bf16x8){lo[0], lo[1], lo[2], lo[3], hh[0], hh[1], hh[2], hh[3]};
            o0[d0] = __builtin_amdgcn_mfma_f32_32x32x16_bf16(pa0, vf, o0[d0], 0, 0, 0);
            o1[d0] = __builtin_amdgcn_mfma_f32_32x32x16_bf16(pa1, vf, o1[d0], 0, 0, 0);
        }
    }
    __builtin_amdgcn_s_setprio(0);
}
__device__ __forceinline__ void diff_qk_f(f32x16& p0, f32x16& p1, const LAS unsigned char* qlds, const LAS unsigned char* kb, const LAS unsigned char* ap, const LAS unsigned char* bp, int lane_, int hi_) {
    int lane = lane_; asm volatile("" : "+v"(lane));
    const int hi = lane >> 5; (void)hi_;
    const int r32 = lane & 31, sw = (r32 >> 1) & 7;
    const LAS unsigned char* kp = kb + r32 * 128;
    { const bf16x8 a1 = *(const LAS bf16x8*)ap, bm = *(const LAS bf16x8*)bp;
      p0 = __builtin_amdgcn_mfma_f32_32x32x16_bf16(a1, bm, f32x16{}, 0, 0, 0);
      p1 = __builtin_amdgcn_mfma_f32_32x32x16_bf16(a1, bm, f32x16{}, 0, 0, 0); }
#pragma unroll
    for (int d0 = 0; d0 < 4; ++d0) {
        const bf16x8 q = *(const LAS bf16x8*)(qlds + d0 * 1024 + lane * 16);
        const int po = ((2 * d0 + hi) ^ sw) << 4;
        const bf16x8 k0 = *(const LAS bf16x8*)(kp + po), k1 = *(const LAS bf16x8*)(kp + po + 4096);
        p0 = __builtin_amdgcn_mfma_f32_32x32x16_bf16(k0, q, p0, 0, 0, 0);
        p1 = __builtin_amdgcn_mfma_f32_32x32x16_bf16(k1, q, p1, 0, 0, 0);
    }
}
__device__ __forceinline__ void diff_sm_head(f32x16 (&o)[4], float& m, float& l, f32x16& p0, f32x16& p1, LAS float* wsf, LAS unsigned char* bslot, bool first, int lane, int hi) {
    float ma = max3f(p0[0], p0[1], p1[0]), mb = max3f(p0[2], p0[3], p1[1]); ma = max3f(ma, p1[2], p1[3]);
#pragma unroll
    for (int r = 4; r < 16; r += 4) { ma = max3f(ma, p0[r], p0[r + 1]); mb = max3f(mb, p0[r + 2], p0[r + 3]); ma = max3f(ma, p1[r], p1[r + 1]); mb = max3f(mb, p1[r + 2], p1[r + 3]); }
    float mx = __builtin_fmaxf(ma, mb);
    { float a = mx, b = mx; swap32(a, b); mx = __builtin_fmaxf(a, b); }
    const bool up = first || (mx > RESCALE_THR);
    if (__any(up)) {
        const float mnew = up ? __builtin_bit_cast(float, f2bf(m + mx) << 16) : m, delta = mnew - m;
        const float alpha = fexp2(-delta);
        m = mnew; l *= alpha;
        CBAR();
        int l2 = lane; asm volatile("" : "+v"(l2));
        if (hi == 0) { wsf[l2 & 31] = alpha; *(LAS unsigned*)bslot = f2bf(-mnew); }
        CBAR();
#pragma unroll
        for (int g4 = 0; g4 < 4; ++g4) { const f32x4 a4 = *(const LAS f32x4*)(wsf + 8 * g4 + 4 * (l2 >> 5));
#pragma unroll
            for (int d0 = 0; d0 < 4; ++d0) { o[d0][4 * g4 + 0] *= a4[0]; o[d0][4 * g4 + 1] *= a4[1]; o[d0][4 * g4 + 2] *= a4[2]; o[d0][4 * g4 + 3] *= a4[3]; } }
#pragma unroll
        for (int r = 0; r < 16; ++r) { p0[r] -= delta; p1[r] -= delta; }
        CBAR();
    }
}
__device__ __forceinline__ void diff_sm_tail(float& l, f32x16& p0, f32x16& p1, u32x4 (&pw)[4]) {
    float rs = 0.f;
#pragma unroll
    for (int r = 0; r < 16; ++r) { p0[r] = fexp2(p0[r]); p1[r] = fexp2(p1[r]); rs += p0[r] + p1[r]; }
    l += rs;
#pragma unroll
    for (int i = 0; i < 4; ++i) { pw[0][i] = cvtpk_s(p0[2 * i], p0[2 * i + 1]); pw[1][i] = cvtpk_s(p0[8 + 2 * i], p0[9 + 2 * i]); pw[2][i] = cvtpk_s(p1[2 * i], p1[2 * i + 1]); pw[3][i] = cvtpk_s(p1[8 + 2 * i], p1[9 + 2 * i]); }
}
__device__ __forceinline__ void diff_tail_pv2(f32x16 (&o0)[4], f32x16 (&o1)[4], float& l0, float& l1, const f32x16& a0, const f32x16& a1, const f32x16& b0, const f32x16& b1, const LAS unsigned char* vbuf, int lane_) {
    int lane = lane_; asm volatile("" : "+v"(lane));
    const int hi = lane >> 5, li = lane & 15, g16 = lane >> 4;
    const LAS unsigned char* vp = vbuf + hi * 1024 + (li >> 2) * 64 + (16 * (g16 & 1) + 4 * (li & 3)) * 2;
    float rs0 = 0.f, rs1 = 0.f;
    u32x4 pa, pb, pan = {0u, 0u, 0u, 0u}, pbn = {0u, 0u, 0u, 0u};
#define TP_A(st, i) do { const int r_ = ((st) & 1) * 8 + 2 * (i); const float e0_ = fexp2((st) < 2 ? a0[r_] : a1[r_]), e1_ = fexp2((st) < 2 ? a0[r_ + 1] : a1[r_ + 1]); rs0 += e0_; rs0 += e1_; asm volatile("" : "+v"(rs0)); pan[i] = cvtpk_s(e0_, e1_); } while (0)
#define TP_B(st, i) do { const int r_ = ((st) & 1) * 8 + 2 * (i); const float e0_ = fexp2((st) < 2 ? b0[r_] : b1[r_]), e1_ = fexp2((st) < 2 ? b0[r_ + 1] : b1[r_ + 1]); rs1 += e0_; rs1 += e1_; asm volatile("" : "+v"(rs1)); pbn[i] = cvtpk_s(e0_, e1_); } while (0)
#pragma unroll
    for (int i = 0; i < 4; ++i) { TP_A(0, i); TP_B(0, i); }
    pa = pan; pb = pbn;
    s16x4 flo[3], fhh[3];
#define TP_RD(c) do { flo[(c) % 3] = vtr(vp + ((c) >> 2) * 4096 + ((c) & 3) * 256); fhh[(c) % 3] = vtr(vp + ((c) >> 2) * 4096 + 2048 + ((c) & 3) * 256); } while (0)
    TP_RD(0); TP_RD(1);
    __builtin_amdgcn_sched_barrier(0);
#pragma unroll
    for (int c = 0; c < 16; ++c) {
        const int st = c >> 2, d0 = c & 3;
        if (c + 2 < 16) TP_RD(c + 2);
        const bf16x8 vf = (bf16x8){flo[c % 3][0], flo[c % 3][1], flo[c % 3][2], flo[c % 3][3], fhh[c % 3][0], fhh[c % 3][1], fhh[c % 3][2], fhh[c % 3][3]};
        o0[d0] = __builtin_amdgcn_mfma_f32_32x32x16_bf16(__builtin_bit_cast(bf16x8, pa), vf, o0[d0], 0, 0, 0);
        if (st < 3) TP_A(st + 1, d0);
        __builtin_amdgcn_sched_barrier(0);
        o1[d0] = __builtin_amdgcn_mfma_f32_32x32x16_bf16(__builtin_bit_cast(bf16x8, pb), vf, o1[d0], 0, 0, 0);
        if (st < 3) TP_B(st + 1, d0);
        __builtin_amdgcn_sched_barrier(0);
        if (d0 == 3) { pa = pan; pb = pbn; }
    }
#undef TP_A
#undef TP_B
#undef TP_RD
    l0 += rs0; l1 += rs1;
}
__device__ __forceinline__ void hm_step(int k, float& ma, float& mb, const f32x16& p0, const f32x16& p1) {
    if (k == 0) ma = max3f(p0[0], p0[1], p1[0]);
    else if (k == 1) mb = max3f(p0[2], p0[3], p1[1]);
    else if (k == 2) ma = max3f(ma, p1[2], p1[3]);
    else { const int j = (k - 3) >> 2, w = (k - 3) & 3, r = 4 + 4 * j;
        if (w == 0) ma = max3f(ma, p0[r], p0[r + 1]); else if (w == 1) mb = max3f(mb, p0[r + 2], p0[r + 3]); else if (w == 2) ma = max3f(ma, p1[r], p1[r + 1]); else mb = max3f(mb, p1[r + 2], p1[r + 3]); }
}
__device__ __forceinline__ void hm_finish(f32x16 (&o)[4], float& m, float& l, float ma, float mb, f32x16& p0, f32x16& p1, LAS float* wsf, LAS unsigned char* bslot, bool first, int lane) {
    float mx = __builtin_fmaxf(ma, mb);
    { float a = mx, b = mx; swap32(a, b); mx = __builtin_fmaxf(a, b); }
    const bool up = first || (mx > RESCALE_THR);
    if (__any(up)) {
        const float mnew = up ? __builtin_bit_cast(float, f2bf(m + mx) << 16) : m, delta = mnew - m;
        const float alpha = fexp2(-delta);
        m = mnew; l *= alpha;
        CBAR();
        int l2 = lane; asm volatile("" : "+v"(l2));
        if ((l2 >> 5) == 0) { wsf[l2 & 31] = alpha; *(LAS unsigned*)bslot = f2bf(-mnew); }
        CBAR();
#pragma unroll
        for (int g4 = 0; g4 < 4; ++g4) { const f32x4 a4 = *(const LAS f32x4*)(wsf + 8 * g4 + 4 * (l2 >> 5));
#pragma unroll
            for (int d0 = 0; d0 < 4; ++d0) { o[d0][4 * g4 + 0] *= a4[0]; o[d0][4 * g4 + 1] *= a4[1]; o[d0][4 * g4 + 2] *= a4[2]; o[d0][4 * g4 + 3] *= a4[3]; } }
#pragma unroll
        for (int r = 0; r < 16; ++r) { p0[r] -= delta; p1[r] -= delta; }
        CBAR();
    }
}
__device__ __forceinline__ void diffA_step(f32x16 (&o0)[4], f32x16 (&o1)[4], float& m0, float& l0, float& m1, float& l1, const LAS unsigned char* qlds, const LAS unsigned char* kb0, const LAS unsigned char* kb1,
                                           const LAS unsigned char* vbuf, LAS unsigned char* bsel, LAS float* wsf, bool first, int lane_) {
    int lane = lane_; asm volatile("" : "+v"(lane));
    const int hi = lane >> 5;
    f32x16 s0, s1, s2, s3;
    diff_qk_f(s0, s1, qlds, kb0, bsel + 32, bsel, lane, hi);
#define SB() __builtin_amdgcn_sched_barrier(0)
    const int r32 = lane & 31, sw = (r32 >> 1) & 7;
    const LAS unsigned char* kp = kb1 + r32 * 128; const LAS unsigned char* qp = qlds + 4096 + lane * 16;
    float ma = 0.f, mb = 0.f, rs0 = 0.f, rs1 = 0.f;
    u32x4 pa, pb, pan, pbn;
#define TP_A(st, i) do { const int r_ = ((st) & 1) * 8 + 2 * (i); const float e0_ = fexp2((st) < 2 ? s0[r_] : s1[r_]), e1_ = fexp2((st) < 2 ? s0[r_ + 1] : s1[r_ + 1]); rs0 += e0_; rs0 += e1_; asm volatile("" : "+v"(rs0)); pan[i] = cvtpk_s(e0_, e1_); } while (0)
#define TP_B(st, i) do { const int r_ = ((st) & 1) * 8 + 2 * (i); const float e0_ = fexp2((st) < 2 ? s2[r_] : s3[r_]), e1_ = fexp2((st) < 2 ? s2[r_ + 1] : s3[r_ + 1]); rs1 += e0_; rs1 += e1_; asm volatile("" : "+v"(rs1)); pbn[i] = cvtpk_s(e0_, e1_); } while (0)
    {
        const bf16x8 a1 = *(const LAS bf16x8*)(bsel + 32), bm = *(const LAS bf16x8*)(bsel + 16);
        bf16x8 qf[2], k0f, k1f;
#define RD_Q(d0)  qf[(d0) & 1] = *(const LAS bf16x8*)(qp + (d0) * 1024)
#define RD_K0(d0) k0f = *(const LAS bf16x8*)(kp + (((2 * (d0) + hi) ^ sw) << 4))
#define RD_K1(d0) k1f = *(const LAS bf16x8*)(kp + (((2 * (d0) + hi) ^ sw) << 4) + 4096)
        RD_Q(0); RD_K0(0); RD_K1(0); RD_Q(1);
        SB();
        s2 = __builtin_amdgcn_mfma_f32_32x32x16_bf16(a1, bm, f32x16{}, 0, 0, 0);
        asm volatile("s_nop 7" : "+v"(s0), "+v"(s1));
        hm_step(0, ma, mb, s0, s1); hm_step(1, ma, mb, s0, s1);
        SB();
        s3 = __builtin_amdgcn_mfma_f32_32x32x16_bf16(a1, bm, f32x16{}, 0, 0, 0);
        hm_step(2, ma, mb, s0, s1); hm_step(3, ma, mb, s0, s1); hm_step(4, ma, mb, s0, s1);
        SB();
        s2 = __builtin_amdgcn_mfma_f32_32x32x16_bf16(k0f, qf[0], s2, 0, 0, 0);
        RD_K0(1);
        hm_step(5, ma, mb, s0, s1); hm_step(6, ma, mb, s0, s1); hm_step(7, ma, mb, s0, s1);
        SB();
        s3 = __builtin_amdgcn_mfma_f32_32x32x16_bf16(k1f, qf[0], s3, 0, 0, 0);
        RD_K1(1); RD_Q(2);
        hm_step(8, ma, mb, s0, s1); hm_step(9, ma, mb, s0, s1); hm_step(10, ma, mb, s0, s1);
        SB();
        s2 = __builtin_amdgcn_mfma_f32_32x32x16_bf16(k0f, qf[1], s2, 0, 0, 0);
        RD_K0(2);
        hm_step(11, ma, mb, s0, s1); hm_step(12, ma, mb, s0, s1);
        SB();
        s3 = __builtin_amdgcn_mfma_f32_32x32x16_bf16(k1f, qf[1], s3, 0, 0, 0);
        RD_K1(2); RD_Q(3);
        hm_step(13, ma, mb, s0, s1); hm_step(14, ma, mb, s0, s1);
        SB();
        hm_finish(o0, m0, l0, ma, mb, s0, s1, wsf, bsel, first, lane);
        SB();
        s2 = __builtin_amdgcn_mfma_f32_32x32x16_bf16(k0f, qf[0], s2, 0, 0, 0);
        RD_K0(3);
        TP_A(0, 0);
        SB();
        s3 = __builtin_amdgcn_mfma_f32_32x32x16_bf16(k1f, qf[0], s3, 0, 0, 0);
        RD_K1(3);
        TP_A(0, 1);
        SB();
        s2 = __builtin_amdgcn_mfma_f32_32x32x16_bf16(k0f, qf[1], s2, 0, 0, 0);
        TP_A(0, 2);
        SB();
        s3 = __builtin_amdgcn_mfma_f32_32x32x16_bf16(k1f, qf[1], s3, 0, 0, 0);
        TP_A(0, 3);
        SB();
#undef RD_Q
#undef RD_K0
#undef RD_K1
#define QK_RD(x)
#undef QK_RD
    }
    pa = pan;
    asm volatile("s_nop 15\n\ts_nop 7" : "+v"(s2), "+v"(s3));
    ma = 0.f; mb = 0.f;
#pragma unroll
    for (int k = 0; k < 15; ++k) hm_step(k, ma, mb, s2, s3);
    hm_finish(o1, m1, l1, ma, mb, s2, s3, wsf, bsel + 16, first, lane);
#pragma unroll
    for (int i = 0; i < 4; ++i) TP_B(0, i);
    pb = pbn;
    const int li = lane & 15, g16 = lane >> 4;
    const LAS unsigned char* vp = vbuf + hi * 1024 + (li >> 2) * 64 + (16 * (g16 & 1) + 4 * (li & 3)) * 2;
    s16x4 flo[3], fhh[3];
#define TP_RD(c) do { flo[(c) % 3] = vtr(vp + (((c) & 15) >> 2) * 4096 + ((c) & 3) * 256); fhh[(c) % 3] = vtr(vp + (((c) & 15) >> 2) * 4096 + 2048 + ((c) & 3) * 256); } while (0)
#define TP_VF(c) ((bf16x8){flo[(c) % 3][0], flo[(c) % 3][1], flo[(c) % 3][2], flo[(c) % 3][3], fhh[(c) % 3][0], fhh[(c) % 3][1], fhh[(c) % 3][2], fhh[(c) % 3][3]})
    TP_RD(0); TP_RD(1);
    SB();
#pragma unroll
    for (int c = 0; c < 16; ++c) {
        const int st = c >> 2, d0 = c & 3;
        if (c + 2 < 16) TP_RD(c + 2);
        o0[d0] = __builtin_amdgcn_mfma_f32_32x32x16_bf16(__builtin_bit_cast(bf16x8, pa), TP_VF(c), o0[d0], 0, 0, 0);
        if (st < 3) TP_A(st + 1, d0);
        SB();
        o1[d0] = __builtin_amdgcn_mfma_f32_32x32x16_bf16(__builtin_bit_cast(bf16x8, pb), TP_VF(c), o1[d0], 0, 0, 0);
        if (st < 3) TP_B(st + 1, d0);
        SB();
        if (d0 == 3) { pa = pan; pb = pbn; }
    }
#undef TP_A
#undef TP_B
#undef TP_RD
#undef TP_VF
#undef SB
    l0 += rs0; l1 += rs1;
}
struct NoMask { __device__ __forceinline__ void operator()(f32x16&) const {} };

using pg8::Unit;
struct EpiZ {
    static constexpr bool PERM = true;
    bf16_t* Z; const float* ropec; const float* ropes;
    __device__ __forceinline__ void operator()(const f32x4 (&acc)[2][2][4][2], const Unit& u, int wr, int wc, int fr, int fq) const {
        const int pn = u.pn;
        const int type = (pn < 2) ? 0 : (pn < 4) ? 1 : (pn < 6) ? 2 : (pn == 6) ? 3 : (pn < 9) ? 2 : (pn < 12) ? 0 : (pn < 15) ? 1 : (pn < 18) ? 2 : 4;
        const int row0 = u.pm * 256 + wr * 64 + fr, col0 = pn * 256 + wc * 32 + 8 * fq;
        const int j0 = 16 * (wc & 1) + 4 * fq;
#pragma unroll
        for (int ai = 0; ai < 2; ++ai) {
            f32x4 cq[4], sq[4];
#pragma unroll
            for (int m = 0; m < 4; ++m) { const int pos = (row0 + ai * 128 + m * 16) & (SEQ - 1); cq[m] = (f32x4){1.f, 1.f, 1.f, 1.f}; sq[m] = (f32x4){0.f, 0.f, 0.f, 0.f};
                if (type < 2) { cq[m] = *(const f32x4*)(ropec + pos * 32 + j0); sq[m] = *(const f32x4*)(ropes + pos * 32 + j0); } }
#pragma unroll
            for (int m = 0; m < 4; ++m) {
                const int row = row0 + ai * 128 + m * 16;
                const f32x4 c4 = cq[m], s4 = sq[m];
                bf16_t* rowp = Z + (size_t)row * ZW + col0;
#pragma unroll
                for (int bj = 0; bj < 2; ++bj) {
                    f32x4 v0 = acc[ai][bj][m][0], v1 = acc[ai][bj][m][1];
                    if (type < 2) {
                        f32x4 w0, w1;
                        w0[0] = v0[0] * c4[0] - v0[1] * s4[0]; w0[1] = v0[1] * c4[0] + v0[0] * s4[0];
                        w0[2] = v0[2] * c4[1] - v0[3] * s4[1]; w0[3] = v0[3] * c4[1] + v0[2] * s4[1];
                        w1[0] = v1[0] * c4[2] - v1[1] * s4[2]; w1[1] = v1[1] * c4[2] + v1[0] * s4[2];
                        w1[2] = v1[2] * c4[3] - v1[3] * s4[3]; w1[3] = v1[3] * c4[3] + v1[2] * s4[3];
                        v0 = w0; v1 = w1;
                    }
                    if (type == 4) {
#pragma unroll
                        for (int j = 0; j < 4; ++j) { v0[j] = __builtin_fmaxf(frcp(1.f + fexp2(v0[j])), 0.f); v1[j] = __builtin_fmaxf(frcp(1.f + fexp2(v1[j])), 0.f); }
                    }
                    u32x4 w; w.x = cvt_pk_bf16(v0[0], v0[1]); w.y = cvt_pk_bf16(v0[2], v0[3]); w.z = cvt_pk_bf16(v1[0], v1[1]); w.w = cvt_pk_bf16(v1[2], v1[3]);
                    st16_wt(rowp + bj * 128, w);
                }
                CBAR();
            }
        }
    }
};
struct EpiProj {
    static constexpr bool PERM = true;
    bf16_t* Mg; const bf16_t* Zg0;
    __device__ __forceinline__ void operator()(const f32x4 (&acc)[2][2][4][2], const Unit& u, int wr, int wc, int fr, int fq) const {
        const int row0 = u.pm * 256 + wr * 64 + fr, col0 = u.pn * 256 + wc * 32 + 8 * fq;
        const bf16_t* Zg = Zg0 + (u.e & 15) * 1024; const int first = u.e >> 4;
#pragma unroll
        for (int ai = 0; ai < 2; ++ai) {
            u32x4 gq[4][2], oq[4][2];
#pragma unroll
            for (int m = 0; m < 4; ++m)
#pragma unroll
                for (int bj = 0; bj < 2; ++bj) { const int row = row0 + ai * 128 + m * 16, col = col0 + bj * 128;
                    gq[m][bj] = *(const u32x4*)(Zg + (size_t)row * ZW + col);
                    oq[m][bj] = first ? (u32x4){0u, 0u, 0u, 0u} : *(const u32x4*)(Mg + (size_t)row * D + col); }
#pragma unroll
            for (int m = 0; m < 4; ++m)
#pragma unroll
                for (int bj = 0; bj < 2; ++bj) { const int row = row0 + ai * 128 + m * 16, col = col0 + bj * 128;
                    const u32x4 g = gq[m][bj], o = oq[m][bj];
                    const f32x4 v0 = acc[ai][bj][m][0], v1 = acc[ai][bj][m][1];
                    const float r0 = bflo(g.x) * v0[0] + bflo(o.x), r1 = bfhi(g.x) * v0[1] + bfhi(o.x), r2 = bflo(g.y) * v0[2] + bflo(o.y), r3 = bfhi(g.y) * v0[3] + bfhi(o.y);
                    const float r4 = bflo(g.z) * v1[0] + bflo(o.z), r5 = bfhi(g.z) * v1[1] + bfhi(o.z), r6 = bflo(g.w) * v1[2] + bflo(o.w), r7 = bfhi(g.w) * v1[3] + bfhi(o.w);
                    u32x4 w; w.x = cvt_pk_bf16(r0, r1); w.y = cvt_pk_bf16(r2, r3); w.z = cvt_pk_bf16(r4, r5); w.w = cvt_pk_bf16(r6, r7);
                    *(u32x4*)(Mg + (size_t)row * D + col) = w; }
            CBAR();
        }
    }
};
struct EpiOut {
    static constexpr bool PERM = true;
    bf16_t* X; const float* gate;
    __device__ __forceinline__ void operator()(const f32x4 (&acc)[2][2][4][2], const Unit& u, int wr, int wc, int fr, int fq) const {
        const int row0 = u.pm * 256 + wr * 64 + fr, col0 = u.pn * 256 + wc * 32 + 8 * fq;
        const int b = (u.pm * 256) / SEQ;
        f32x4 gv[2][2];
#pragma unroll
        for (int bj = 0; bj < 2; ++bj)
#pragma unroll
            for (int n = 0; n < 2; ++n) gv[bj][n] = *(const f32x4*)(gate + (size_t)b * 6 * D + col0 + bj * 128 + 4 * n);
#pragma unroll
        for (int ai = 0; ai < 2; ++ai) {
            u32x4 xq[4][2];
#pragma unroll
            for (int m = 0; m < 4; ++m)
#pragma unroll
                for (int bj = 0; bj < 2; ++bj) xq[m][bj] = *(const u32x4*)(X + (size_t)(row0 + ai * 128 + m * 16) * D + col0 + bj * 128);
#pragma unroll
            for (int m = 0; m < 4; ++m)
#pragma unroll
                for (int bj = 0; bj < 2; ++bj) { const u32x4 o = xq[m][bj];
                    const f32x4 r0 = (f32x4){bflo(o.x), bfhi(o.x), bflo(o.y), bfhi(o.y)} + gv[bj][0] * acc[ai][bj][m][0], r1 = (f32x4){bflo(o.z), bfhi(o.z), bflo(o.w), bfhi(o.w)} + gv[bj][1] * acc[ai][bj][m][1];
                    u32x4 w; w.x = cvt_pk_bf16(r0[0], r0[1]); w.y = cvt_pk_bf16(r0[2], r0[3]); w.z = cvt_pk_bf16(r1[0], r1[1]); w.w = cvt_pk_bf16(r1[2], r1[3]);
                    *(u32x4*)(X + (size_t)(row0 + ai * 128 + m * 16) * D + col0 + bj * 128) = w; }
            CBAR();
        }
    }
};
struct EpiSwiglu {
    static constexpr bool PERM = true;
    bf16_t* H;
    __device__ __forceinline__ void operator()(const f32x4 (&acc)[2][2][4][2], const Unit& u, int wr, int wc, int fr, int fq) const {
        const int row0 = u.pm * 256 + wr * 64 + fr, hc = u.pn * 128 + wc * 32 + 8 * fq;
#pragma unroll
        for (int ai = 0; ai < 2; ++ai)
#pragma unroll
            for (int m = 0; m < 4; ++m) {
                const int row = row0 + ai * 128 + m * 16;
                float h[8];
#pragma unroll
                for (int n = 0; n < 2; ++n) { const f32x4 a = acc[ai][0][m][n], b = acc[ai][1][m][n];
#pragma unroll
                    for (int j = 0; j < 4; ++j) h[4 * n + j] = a[j] * frcp(1.f + fexp2(-a[j] * LOG2E)) * b[j]; }
                u32x4 w; w.x = cvt_pk_bf16(h[0], h[1]); w.y = cvt_pk_bf16(h[2], h[3]); w.z = cvt_pk_bf16(h[4], h[5]); w.w = cvt_pk_bf16(h[6], h[7]);
                st16_wt(H + (size_t)row * EH + hc, w);
            }
    }
};
struct EpiY {
    static constexpr bool PERM = true;
    bf16_t* Y;
    __device__ __forceinline__ void operator()(const f32x4 (&acc)[2][2][4][2], const Unit& u, int wr, int wc, int fr, int fq) const {
        const int row0 = u.pm * 256 + wr * 64 + fr, col0 = u.pn * 256 + wc * 32 + 8 * fq;
#pragma unroll
        for (int ai = 0; ai < 2; ++ai)
#pragma unroll
            for (int m = 0; m < 4; ++m) { bf16_t* rowp = Y + (size_t)(row0 + ai * 128 + m * 16) * D + col0;
#pragma unroll
                for (int bj = 0; bj < 2; ++bj) { const f32x4 v0 = acc[ai][bj][m][0], v1 = acc[ai][bj][m][1];
                    u32x4 w; w.x = cvt_pk_bf16(v0[0], v0[1]); w.y = cvt_pk_bf16(v0[2], v0[3]); w.z = cvt_pk_bf16(v1[0], v1[1]); w.w = cvt_pk_bf16(v1[2], v1[3]);
                    *(u32x4*)(rowp + bj * 128) = w; } }
    }
};

constexpr int NWAVES = 8;
constexpr int NPHASE = 2 + 9 * DEPTH;

__global__ void __launch_bounds__(NWAVES * 64, 2) fwd_kernel(Args args) {
    extern __shared__ __attribute__((aligned(16))) unsigned char lds_raw[];
    LAS unsigned char* lds = (LAS unsigned char*)lds_raw;
    volatile LAS unsigned* MISC = (volatile LAS unsigned*)(lds + MISC_OFF);
    const int tid0 = threadIdx.x;
    const int G = gridDim.x, bx = blockIdx.x;
    const int vcu = (G % 8 == 0) ? (bx % 8) * (G / 8) + bx / 8 : bx;
    const int NGW = G * NWAVES;
#define WSP() size_t wsz_ = 0; asm volatile("" : "+s"(wsz_)); unsigned char* ws = args.ws + wsz_; \
    int tid = tid0; asm volatile("" : "+v"(tid)); const int lane = tid & 63, wave = __builtin_amdgcn_readfirstlane(tid >> 6), hi = lane >> 5, gw = vcu * NWAVES + wave; (void)hi; (void)gw; (void)lane; (void)wave; \
    unsigned* ctl = (unsigned*)(ws + WS_CTL); float* rtab = (float*)(ws + WS_RT); (void)rtab; float* modp = (float*)(ws + WS_MOD); float* ropec = (float*)(ws + WS_ROPE); float* ropes = ropec + SEQ * 32; \
    int* tok_e = (int*)(ws + WS_ROUTE); int* tok_pos = tok_e + 2 * M; float* tok_w = (float*)(tok_pos + 2 * M); int* tok_slot = (int*)(tok_w + 2 * M); int* etok = (int*)(ws + WS_ROUTE + 2 * MiB); \
    bf16_t* X = (bf16_t*)(ws + WS_X); bf16_t* Hn = (bf16_t*)(ws + WS_H); bf16_t* OC = (bf16_t*)(ws + WS_OCAT); bf16_t* MG = (bf16_t*)(ws + WS_MERGED); bf16_t* Z = (bf16_t*)(ws + WS_Z); \
    bf16_t* XG = (bf16_t*)(ws + WS_XG); bf16_t* HB = (bf16_t*)(ws + WS_HB); bf16_t* YB = (bf16_t*)(ws + WS_YB); \
    bf16_t* WIN = (bf16_t*)(ws + WS_WIN); bf16_t* WPR = (bf16_t*)(ws + WS_WPROJ); bf16_t* WOU = (bf16_t*)(ws + WS_WOUT); bf16_t* W13 = (bf16_t*)(ws + WS_W13); bf16_t* W2 = (bf16_t*)(ws + WS_W2); \
    (void)ctl; (void)modp; (void)ropec; (void)ropes; (void)tok_e; (void)tok_pos; (void)tok_w; (void)tok_slot; (void)etok; (void)X; (void)Hn; (void)OC; (void)MG; (void)Z; (void)XG; (void)HB; (void)YB; (void)WIN; (void)WPR; (void)WOU; (void)W13; (void)W2;
    for (int u = tid0; u < 128; u += NWAVES * 64) MISC[u] = 0u;
    __syncthreads();
#if !MK_PER_PHASE
    XcdBarrier bar = xcd_barrier_post((unsigned*)(args.ws + WS_CTL) + CW_BAR, MISC + 8);
#define GRID_BAR() xcd_barrier(bar)
#else
#define GRID_BAR() do {} while (0)
#endif
    const int lo = args.ph_lo, hi_ph = args.ph_hi;
#define IN(k) (lo <= (k) && (k) < hi_ph)
#ifndef EN_MASK
#define EN_MASK 0x3ff
#endif
#define EN(k) ((EN_MASK >> (k)) & 1)
#ifndef DUPK
#define DUPK -1
#endif
#define REP(k) for (int rep_ = 0; rep_ < ((k) == DUPK ? 2 : 1); ++rep_, __syncthreads())
#define SEAM(k) do { if (IN(k) && IN((k) + 1)) GRID_BAR(); } while (0)

    if (IN(0) && EN(0)) REP(0) {
        WSP();
        {
            LAS float* cact = (LAS float*)lds;
            LAS float* part = (LAS float*)(lds + 16384);
            for (int i = tid; i < NBATCH * D; i += NWAVES * 64) { const int b = i / D, k = i % D; const float v = args.c[i]; cact[k * 4 + b] = v / (1.f + __expf(-v)); }
            __syncthreads();
            for (int it = bx; it < DEPTH * 96; it += G) {
                const int l = it / 96, cc = it % 96, col = cc * 64 + lane;
                const float* wp = args.ada_w + (size_t)l * D * 6 * D + col;
                float a0 = 0.f, a1 = 0.f, a2 = 0.f, a3 = 0.f;
#pragma unroll 1
                for (int k0 = 0; k0 < 128; k0 += 32) {
                    float wv[32];
#pragma unroll
                    for (int kk = 0; kk < 32; ++kk) wv[kk] = wp[(size_t)(wave * 128 + k0 + kk) * 6 * D];
#pragma unroll
                    for (int kk = 0; kk < 32; ++kk) { const f32x4 cv = *(const LAS f32x4*)(cact + (wave * 128 + k0 + kk) * 4);
                        a0 += cv[0] * wv[kk]; a1 += cv[1] * wv[kk]; a2 += cv[2] * wv[kk]; a3 += cv[3] * wv[kk]; } }
                part[(wave * 4 + 0) * 64 + lane] = a0; part[(wave * 4 + 1) * 64 + lane] = a1; part[(wave * 4 + 2) * 64 + lane] = a2; part[(wave * 4 + 3) * 64 + lane] = a3;
                __syncthreads();
                if (tid < 256) { const int b = tid >> 6, cl = tid & 63; float s = 0.f;
#pragma unroll
                    for (int w = 0; w < 8; ++w) s += part[(w * 4 + b) * 64 + cl];
                    modp[((size_t)l * NBATCH + b) * 6 * D + cc * 64 + cl] = s + args.ada_b[(size_t)l * 6 * D + cc * 64 + cl]; }
                __syncthreads();
            }
        }
        for (int i = (vcu * NWAVES * 64) + tid; i < SEQ * 32; i += G * NWAVES * 64) { const int pos = i >> 5, j = i & 31; float s, c; sincos_d((double)pos * ROPE_INV[j], s, c); ropec[i] = c; ropes[i] = s; }
        for (int i = (vcu * NWAVES * 64) + tid; i < DEPTH * 36 * D; i += G * NWAVES * 64) { const int k = i & (D - 1), n = (i >> 10) % 36, l2 = i / (36 * D);
            rtab[i] = n < 4 ? args.rgw[((size_t)l2 * D + k) * 4 + n] : args.rew[((size_t)l2 * D + k) * NEXP + (n - 4)]; }
        {
            LAS float* scr = (LAS float*)(lds + wave * 16384);
            constexpr int I_WIN = 16 * 240, I_PA = 8 * 32, I_PN = 4 * 32, I_WO = 16 * 32, I_E = 256, PER_L = I_WIN + I_PA + 2 * I_PN + I_WO + NEXP * 3 * I_E;
            for (int it = gw; it < DEPTH * PER_L; it += NGW) {
                const int l = it / PER_L; int r = it % PER_L;
                if (r < I_WIN) { tr_item(args.w_in + (size_t)l * D * ZW, ZW, WIN + (size_t)l * ZW * D, D, 0, 1, scr, r, lane); continue; } r -= I_WIN;
                if (r < I_PA) { tr_item(args.wpa + (size_t)l * 512 * D, D, WPR + (size_t)l * D * D, D, 0, 0, scr, r, lane); continue; } r -= I_PA;
                if (r < I_PN) { tr_item(args.wpn + (size_t)l * 256 * D, D, WPR + (size_t)l * D * D, D, 512, 0, scr, r, lane); continue; } r -= I_PN;
                if (r < I_PN) { tr_item(args.wpd + (size_t)l * 256 * D, D, WPR + (size_t)l * D * D, D, 768, 0, scr, r, lane); continue; } r -= I_PN;
                if (r < I_WO) { tr_item(args.w_out + (size_t)l * D * D, D, WOU + (size_t)l * D * D, D, 0, 0, scr, r, lane); continue; } r -= I_WO;
                const int e = r / (3 * I_E), q = r % (3 * I_E); const size_t le = (size_t)l * NEXP + e;
                if (q < I_E) tr_item(args.ew1 + le * D * EH, EH, W13 + le * 1024 * D, D, 0, 2, scr, q, lane);
                else if (q < 2 * I_E) tr_item(args.ew3 + le * D * EH, EH, W13 + le * 1024 * D, D, 0, 3, scr, q - I_E, lane);
                else tr_item(args.ew2 + le * EH * D, D, W2 + le * D * EH, EH, 0, 0, scr, q - 2 * I_E, lane);
            }
        }
    }
    SEAM(0);

    for (int l = 0; l < DEPTH; ++l) {
        const int pb = 1 + 9 * l;
        if (IN(pb + 0) && EN(1)) {
            WSP(); const float* modl = modp + (size_t)l * NBATCH * 6 * D; (void)modl;
            const float* gam = args.mix_g + (size_t)l * D;
            const float* modprev = modp + (size_t)(l > 0 ? l - 1 : 0) * NBATCH * 6 * D;
            constexpr int RPW = M / (256 * NWAVES); const int rbase = gw * RPW, b = rbase / SEQ;
            int slot_v = 0; float w_v = 0.f;
            if (l > 0) {
                const unsigned* cntp = ctl + CW_CNT + (l - 1) * NEXP * 64;
                const int cv = (lane < NEXP) ? (int)__hip_atomic_load(cntp + lane * 64, __ATOMIC_RELAXED, __HIP_MEMORY_SCOPE_AGENT) : 0;
                const int tl = (cv + 255) >> 8; int tstart = 0, run = 0;
#pragma unroll
                for (int e = 0; e < NEXP; ++e) { if (lane == e) tstart = run; run += __builtin_amdgcn_readlane(tl, e); }
                const int i = min(lane, 2 * RPW - 1);
                const int e = tok_e[2 * rbase + i], pos = tok_pos[2 * rbase + i]; w_v = tok_w[2 * rbase + i];
                slot_v = __builtin_amdgcn_ds_bpermute(4 * e, tstart) * 256 + pos;
            }
            f32x4 ca[4], cb[4], gf[4];
#pragma unroll
            for (int j = 0; j < 4; ++j) { const int col = 4 * lane + 256 * j;
                const f32x4 g4 = *(const f32x4*)(gam + col), sc = *(const f32x4*)(modl + (size_t)b * 6 * D + 1 * D + col), sh = *(const f32x4*)(modl + (size_t)b * 6 * D + col);
                ca[j] = g4 * (sc + 1.0f); cb[j] = sh; gf[j] = *(const f32x4*)(modprev + (size_t)b * 6 * D + 5 * D + col); }
#pragma unroll 1
            for (int r0 = rbase; r0 < rbase + RPW; r0 += 4) {
                f32x4 v[4][4];
                if (l == 0) {
#pragma unroll
                    for (int q = 0; q < 4; ++q)
#pragma unroll
                        for (int j = 0; j < 4; ++j) v[q][j] = *(const f32x4*)(args.x + (size_t)(r0 + q) * D + 4 * lane + 256 * j);
                } else {
                    u32x2 xr[4][4], y0[4][4], y1[4][4]; float w0[4], w1[4];
#pragma unroll
                    for (int q = 0; q < 4; ++q) { const int ix = 2 * (r0 - rbase + q);
                        const int s0 = __builtin_amdgcn_readlane(slot_v, ix), s1 = __builtin_amdgcn_readlane(slot_v, ix + 1);
                        w0[q] = __builtin_bit_cast(float, __builtin_amdgcn_readlane(__builtin_bit_cast(int, w_v), ix)); w1[q] = __builtin_bit_cast(float, __builtin_amdgcn_readlane(__builtin_bit_cast(int, w_v), ix + 1));
#pragma unroll
                        for (int j = 0; j < 4; ++j) { const int col = 4 * lane + 256 * j;
                            xr[q][j] = *(const u32x2*)(X + (size_t)(r0 + q) * D + col); y0[q][j] = *(const u32x2*)(YB + (size_t)s0 * D + col); y1[q][j] = *(const u32x2*)(YB + (size_t)s1 * D + col); } }
#pragma unroll
                    for (int q = 0; q < 4; ++q)
#pragma unroll
                        for (int j = 0; j < 4; ++j) { const f32x4 yy = bf4(y0[q][j]) * w0[q] + bf4(y1[q][j]) * w1[q]; v[q][j] = bf4(xr[q][j]) + gf[j] * yy; }
                }
#pragma unroll
                for (int q = 0; q < 4; ++q) { const int row = r0 + q;
                    float ss = 0.f;
#pragma unroll
                    for (int j = 0; j < 4; ++j) { u32x2 xw; xw.x = cvt_pk_bf16(v[q][j][0], v[q][j][1]); xw.y = cvt_pk_bf16(v[q][j][2], v[q][j][3]); *(u32x2*)(X + (size_t)row * D + 4 * lane + 256 * j) = xw;
                        ss += (v[q][j][0] * v[q][j][0] + v[q][j][1] * v[q][j][1]) + (v[q][j][2] * v[q][j][2] + v[q][j][3] * v[q][j][3]); }
                    const float rstd = 1.0f / sqrtf(wave_sum(ss) * (1.f / D) + NORM_EPS);
#pragma unroll
                    for (int j = 0; j < 4; ++j) { const int col = 4 * lane + 256 * j;
                        const f32x4 hv = v[q][j] * rstd * ca[j] + cb[j];
                        u32x2 w; w.x = cvt_pk_bf16(hv[0], hv[1]); w.y = cvt_pk_bf16(hv[2], hv[3]);
                        *(u32x2*)(Hn + (size_t)row * D + col) = w; }
                }
            }
        }
        SEAM(pb + 0);
        if (IN(pb + 1) && EN(2)) REP(2) {
            WSP(); const float* modl = modp + (size_t)l * NBATCH * 6 * D; (void)modl;
            pg8::Gemm g{Hn, WIN + (size_t)l * ZW * D, D, D, D}; pg8::G1Order S; S.init(M, ZW, G, bx);
            EpiZ E{Z, ropec, ropes};
            pg8::gemm_phase<EpiZ, pg8::G1Order>(lds, g, S, E);
        }
        SEAM(pb + 1);
        if (IN(pb + 2) && EN(3)) REP(3) {
            WSP(); const float* modl = modp + (size_t)l * NBATCH * 6 * D; (void)modl;
            {
                int tidm = tid0; asm volatile("" : "+v"(tidm)); const int lane = tidm & 63, hi = lane >> 5;
                LAS unsigned char* vlds = lds + wave * 12288; LAS float* wsf = (LAS float*)(lds + 98304 + wave * 256);
                const float* lp = args.da_lambda + (size_t)l * 4 * 64;
                const float s01 = wave_sum(lp[lane] * lp[64 + lane]), s23 = wave_sum(lp[128 + lane] * lp[192 + lane]);
                const float lam_init = 0.8f - 0.6f * __expf(-0.3f * (float)l);
                const float lam = __expf(s01) - __expf(s23) + lam_init;
                LAS float* wsfA = (LAS float*)(lds + 131072 + wave * 128);
                const unsigned lds0 = (unsigned)(uintptr_t)lds;
                for (int un = vcu; un < NBATCH * 4 * 16; un += G) {
                    const int b = un >> 6, h = (un >> 4) & 3, qb = un & 15;
                    const size_t rowbase = (size_t)b * SEQ; const int q0 = qb * 256 + wave * 32;
                    LAS unsigned char* qlds = lds + 65536 + wave * 8192;
                    { bf16x8 qf[8];
                      const bf16_t* qp = Z + (rowbase + q0 + (lane & 31)) * ZW + ZQA + h * 128 + 8 * hi;
#pragma unroll
                      for (int i = 0; i < 8; ++i) qf[i] = *(const bf16x8*)(qp + 16 * i);
                      asm volatile("s_waitcnt vmcnt(0)" : "+v"(qf[0]), "+v"(qf[1]), "+v"(qf[2]), "+v"(qf[3]), "+v"(qf[4]), "+v"(qf[5]), "+v"(qf[6]), "+v"(qf[7]) :: "memory");
#pragma unroll
                      for (int i = 0; i < 8; ++i) *(LAS bf16x8*)(qlds + i * 1024 + lane * 16) = qf[i]; }
                    f32x16 o0[4], o1[4];
#pragma unroll
                    for (int d0 = 0; d0 < 4; ++d0) { o0[d0] = f32x16{}; o1[d0] = f32x16{}; }
                    float m0 = 0.f, l0 = 0.f, m1 = 0.f, l1 = 0.f;
                    LAS unsigned char* bsel = lds + 132096 + (hi ? 0 : 64 + (wave * 32 + (lane & 31)) * 48);
                    { unsigned z0 = 0u, e0 = hi ? 0u : 0x3F80u; asm volatile("" : "+v"(z0), "+v"(e0));
                      *(LAS u32x4*)bsel = (u32x4){z0, z0, z0, z0}; *(LAS u32x4*)(bsel + 16) = (u32x4){z0, z0, z0, z0}; *(LAS u32x4*)(bsel + 32) = (u32x4){e0, z0, z0, z0}; }
                    const int krow = 8 * wave + (lane >> 3);
                    const unsigned koff = (unsigned)(((rowbase + krow) * ZW + ZKA + h * 128) * 2 + (((lane & 7) ^ ((krow >> 1) & 7)) << 4));
                    const unsigned voff = (unsigned)(((rowbase + 8 * wave + ((lane >> 2) & 3)) * ZW + ZVA + h * 128 + (4 * (lane >> 4) + (lane & 3)) * 8) * 2);
#define DIFF_DMA(t, bo) do { const char* zb_ = (const char*)Z + (size_t)(t) * 64 * ZW * 2; \
        glds16s(zb_, koff, (unsigned)__builtin_amdgcn_readfirstlane((int)(lds0 + ((bo) * 2 + 0) * 8192 + wave * 1024))); \
        glds16s(zb_ + 128, koff, (unsigned)__builtin_amdgcn_readfirstlane((int)(lds0 + ((bo) * 2 + 1) * 8192 + wave * 1024))); \
        glds16s(zb_, voff, (unsigned)__builtin_amdgcn_readfirstlane((int)(lds0 + 32768 + (bo) * 16384 + wave * 2048))); \
        glds16s(zb_ + (size_t)4 * ZW * 2, voff, (unsigned)__builtin_amdgcn_readfirstlane((int)(lds0 + 32768 + (bo) * 16384 + wave * 2048 + 1024))); } while (0)
#define DIFF_SYNC() do { asm volatile("s_waitcnt vmcnt(0) lgkmcnt(0)" ::: "memory"); __builtin_amdgcn_s_barrier(); asm volatile("" ::: "memory"); } while (0)
                    DIFF_DMA(0, 0);
#pragma unroll 1
                    for (int t = 0; t < SEQ / 64; ++t) {
                        const int bo = t & 1;
                        DIFF_SYNC();
                        if (t + 1 < SEQ / 64) DIFF_DMA(t + 1, bo ^ 1);
                        diffA_step(o0, o1, m0, l0, m1, l1, qlds, lds + (bo * 2 + 0) * 8192, lds + (bo * 2 + 1) * 8192, lds + 32768 + bo * 16384, bsel, wsfA, t == 0, lane);
                    }
                    DIFF_SYNC();
#undef DIFF_DMA
#undef DIFF_SYNC
                    int lane_e = lane; asm volatile("" : "+v"(lane_e)); const int hi_e = lane_e >> 5;
                    attn_finish<4>(o0, l0, wsfA, lane_e, hi_e);
                    attn_finish<4>(o1, l1, wsfA, lane_e, hi_e);
                    const float* sg = args.da_subln + (size_t)l * 128;
                    float g4[4];
#pragma unroll
                    for (int d0 = 0; d0 < 4; ++d0) g4[d0] = sg[32 * d0 + (lane_e & 31)] * (1.0f - lam_init);
#pragma unroll
                    for (int r = 0; r < 16; ++r) {
                        float ov[4];
#pragma unroll
                        for (int d0 = 0; d0 < 4; ++d0) ov[d0] = o0[d0][r] - lam * o1[d0][r];
                        float ss = ov[0] * ov[0] + ov[1] * ov[1] + ov[2] * ov[2] + ov[3] * ov[3];
                        ss = half_sum(ss);
                        const float rn = 1.0f / sqrtf(ss * (1.f / 128.f) + NORM_EPS);
                        bf16_t* op = OC + (rowbase + q0 + crow(r, hi_e)) * D + h * 128 + (lane_e & 31);
#pragma unroll
                        for (int d0 = 0; d0 < 4; ++d0) op[32 * d0] = (bf16_t)f2bf(ov[d0] * rn * g4[d0]);
                    }
                }
                asm volatile("s_waitcnt vmcnt(0) lgkmcnt(0)" ::: "memory"); __builtin_amdgcn_s_barrier();
            }
            {
                int tidm = tid0; asm volatile("" : "+v"(tidm)); const int lane = tidm & 63, hi = lane >> 5;
                LAS unsigned char* vlds = lds + wave * 12288; LAS float* wsf = (LAS float*)(lds + 98304 + wave * 256);
                LAS float* tab = (LAS float*)(lds + 100352);
                { const float* rpb = args.na_rpb + (size_t)l * 4 * 15 * 31;
                  for (int i = wave * 64 + lane; i < 4 * 15 * 128; i += NWAVES * 64) { const int j = (i & 127) - 48, hb = i >> 7; tab[i] = (j >= 0 && j <= 30) ? rpb[hb * 31 + j] * LOG2E : 0.f; } }
                asm volatile("s_waitcnt vmcnt(0) lgkmcnt(0)" ::: "memory"); __builtin_amdgcn_s_barrier(); asm volatile("" ::: "memory");
                const char* zb = (const char*)Z;
                for (int wu = gw; wu < NBATCH * 4 * 64 * 2; wu += NGW) {
                    const int half = wu & 1, gr = (wu >> 1) & 63, h = (wu >> 7) & 3, b = wu >> 9;
                    const int rowb = b * SEQ; const int c0 = half * 32, cq = c0 + (lane & 31);
                    const int kr0 = min(max(gr - 4, 0), 56), cs = min(max(cq - 8, 0), 48);
                    bf16x8 qf[4];
                    { const unsigned qoff = (unsigned)(((rowb + gr * 64 + cq) * ZW + ZQN + h * 64 + 8 * hi) * 2);
#pragma unroll
                      for (int d0 = 0; d0 < 4; ++d0) qf[d0] = *(const bf16x8*)(zb + (size_t)(qoff + 32u * d0)); }
                    f32x16 o[2]; o[0] = f32x16{}; o[1] = f32x16{};
                    float mrun = NEGBIG, lrun = 0.f;
                    const unsigned kcol = (unsigned)((ZKN + h * 64) * 2), vcol = (unsigned)((ZVN + h * 64) * 2);
                    unsigned rb0[4];
#pragma unroll
                    for (int i = 0; i < 4; ++i) rb0[i] = (unsigned)((rowb + kr0 * 64 + 8 * i + (lane >> 3)) * ZW * 2);
                    TileRegs<64> cur;
                    tile_load<64>(cur, zb, rb0, kcol, vcol);
#pragma unroll 1
                    for (int t = 0; t < 16; ++t) {
                        const int kr = kr0 + (t >> 1), ch = t & 1;
                        auto reload = [&](TileRegs<64>& T) { const unsigned adv = (unsigned)min(t + 1, 15) * (32u * ZW * 2u); unsigned rr[4];
#pragma unroll
                          for (int i = 0; i < 4; ++i) rr[i] = rb0[i] + adv;
                          tile_load<64>(T, zb, rr, kcol, vcol); };
                        const LAS float* bp = tab + (h * 15 + (kr - gr + 7)) * 128 + (32 * ch + 4 * hi - cq + 63);
                        const int u0 = 32 * ch + 4 * hi - cs;
                        auto maskf = [&](f32x16& p) {
#pragma unroll
                            for (int r = 0; r < 16; ++r) { const int co = (r & 3) + 8 * (r >> 2);
                                const float bv = bp[co]; p[r] = ((unsigned)(u0 + co) <= 15u) ? bv : NEGBIG; }
                        };
                        attn_tile<64>(o, mrun, lrun, qf, cur, vlds, wsf, maskf, reload, lane, hi);
                    }
                    attn_finish<2>(o, lrun, wsf, lane, hi);
#pragma unroll
                    for (int r = 0; r < 16; ++r) { bf16_t* op = OC + (size_t)(rowb + gr * 64 + c0 + crow(r, hi)) * D + 512 + h * 64 + (lane & 31);
                        op[0] = (bf16_t)f2bf(o[0][r]); op[32] = (bf16_t)f2bf(o[1][r]); }
                }
            }
            {
                int tidm = tid0; asm volatile("" : "+v"(tidm)); const int lane = tidm & 63, hi = lane >> 5;
                LAS unsigned char* vlds = lds + wave * 12288; LAS float* wsf = (LAS float*)(lds + 98304 + wave * 256);
                const char* zb = (const char*)Z;
                for (int wu = gw; wu < NBATCH * 4 * 8 * 16; wu += NGW) {
                    const int rho = wu & 15, sb = (wu >> 4) & 7, hs = (wu >> 7) & 3, b = wu >> 9;
                    const int rowb = b * SEQ; const int qi = lane & 31; const int tq = 512 * sb + rho + 16 * qi;
                    f32x16 o[2]; o[0] = f32x16{}; o[1] = f32x16{};
                    float mrun = NEGBIG, lrun = 0.f;
                    const unsigned qoff0 = (unsigned)(((rowb + tq) * ZW + ZQD + hs * 64 + 8 * hi) * 2);
                    TileRegs<64> cur;
                    { const int kb0 = 512 * sb + rho - 64;
                      unsigned rr[4];
#pragma unroll
                      for (int i = 0; i < 4; ++i) rr[i] = (unsigned)((rowb + min(max(kb0 + 8 * i + (lane >> 3), 0), SEQ - 1)) * ZW * 2);
                      tile_load<64>(cur, zb, rr, (unsigned)((ZKD + hs * 64) * 2), (unsigned)((ZVD + hs * 64) * 2)); }
#pragma unroll 1
                    for (int gi = 0; gi < 3; ++gi) {
                        const int sh = 2 * gi, res = rho & ((1 << sh) - 1), qa = (512 * sb + rho) >> sh, qk = qa + (16 >> sh) * qi, nsub = SEQ >> sh, ntile = (gi == 0) ? 20 : (gi == 1) ? 8 : 5;
                        const int lo_v = max(qk - 64, 0), span = min(qk + 64, nsub - 1) - lo_v;
                        const unsigned kcol = (unsigned)((ZKD + gi * 256 + hs * 64) * 2), vcol = (unsigned)((ZVD + gi * 256 + hs * 64) * 2), rbase = (unsigned)((rowb + res) * ZW * 2);
                        const int sh2 = sh + 2, res2 = rho & ((1 << sh2) - 1), kbn = ((512 * sb + rho) >> sh2) - 64, nsub2 = SEQ >> sh2;
                        bf16x8 qf[4];
#pragma unroll
                        for (int d0 = 0; d0 < 4; ++d0) qf[d0] = *(const bf16x8*)(zb + (size_t)(qoff0 + (unsigned)(gi * 512) + 32u * d0));
                        int kb = qa - 64;
#pragma unroll 1
                        for (int t = 0; t < ntile; ++t, kb += 32) {
                            auto reload = [&](TileRegs<64>& T) { const bool same = (t + 1 < ntile); const int kbx = same ? kb + 32 : kbn, nsx = same ? nsub : nsub2, shx = same ? sh : sh2;
                              const unsigned rbx = same ? rbase : (unsigned)((rowb + res2) * ZW * 2), kcx = same ? kcol : kcol + 512u, vcx = same ? vcol : vcol + 512u; unsigned rr[4];
#pragma unroll
                              for (int i = 0; i < 4; ++i) rr[i] = rbx + __umul24((unsigned)(min(max(kbx + 8 * i + (lane >> 3), 0), nsx - 1) << shx), ZW * 2u);
                              tile_load<64>(T, zb, rr, kcx, vcx); };
                            const int u0 = kb + 4 * hi - lo_v;
                            auto maskf = [&](f32x16& p) {
#pragma unroll
                                for (int r = 0; r < 16; ++r) { const int co = (r & 3) + 8 * (r >> 2); p[r] = ((unsigned)(u0 + co) <= (unsigned)span) ? 0.f : NEGBIG; }
                            };
                            attn_tile<64>(o, mrun, lrun, qf, cur, vlds, wsf, maskf, reload, lane, hi);
                        }
                    }
                    attn_finish<2>(o, lrun, wsf, lane, hi);
#pragma unroll
                    for (int r = 0; r < 16; ++r) { bf16_t* op = OC + (size_t)(rowb + 512 * sb + rho + 16 * crow(r, hi)) * D + 768 + hs * 64 + (lane & 31);
                        op[0] = (bf16_t)f2bf(o[0][r]); op[32] = (bf16_t)f2bf(o[1][r]); }
                }
            }
        }
        SEAM(pb + 2);
        if (IN(pb + 3) && EN(4)) REP(4) {
            WSP(); const float* modl = modp + (size_t)l * NBATCH * 6 * D; (void)modl;
            pg8::StaticOrder S0; S0.init(M, D, G, bx); pg8::Unit u0; pg8::ProjOrder S; S.pm = 0; S.pn = 0; S.rot = bx & 1;
            const bool have = S0.next(0, u0); S.pm = u0.pm; S.pn = u0.pn;
            if (have) { pg8::Gemm g{OC, WPR + (size_t)l * D * D, D, D, D}; EpiProj E{MG, Z + ZG}; pg8::gemm_phase<EpiProj, pg8::ProjOrder>(lds, g, S, E); }
        }
        SEAM(pb + 3);
        if (IN(pb + 4) && EN(5)) {
            WSP(); const float* modl = modp + (size_t)l * NBATCH * 6 * D; (void)modl;
            pg8::Gemm g{MG, WOU + (size_t)l * D * D, D, D, D}; pg8::StaticOrder S; S.init(M, D, G, bx);
            EpiOut E{X, modl + 2 * D};
            pg8::gemm_phase<EpiOut, pg8::StaticOrder>(lds, g, S, E);
        }
        SEAM(pb + 4);
        if (IN(pb + 5) && EN(6)) {
            WSP(); const float* modl = modp + (size_t)l * NBATCH * 6 * D; (void)modl;
            LAS float* rt = (LAS float*)lds;
            LAS unsigned* lcnt = (LAS unsigned*)(lds + MISC_OFF) + 16;
            LAS unsigned* lbase = lcnt + 32;
            { const float* rsrc = rtab + (size_t)l * 36 * D + 4 * lane; const unsigned lds0 = (unsigned)(uintptr_t)lds;
              for (int pc = wave; pc < 144; pc += NWAVES) glds16(rsrc + (pc >> 2) * D + (pc & 3) * 256, (unsigned)__builtin_amdgcn_readfirstlane((int)(lds0 + (pc >> 2) * (RT_LD * 4) + (pc & 3) * 1024)));
              if (tid < 64) lcnt[tid] = 0u;
              if (tid < 36) rt[tid * RT_LD + D] = tid < 4 ? args.rgb[(size_t)l * 4 + tid] : args.reb[(size_t)l * NEXP + tid - 4];
              asm volatile("s_waitcnt vmcnt(0)" ::: "memory");
            }
            __syncthreads();
            const float* gam = args.ffn_g + (size_t)l * D;
            unsigned* cnt = ctl + CW_CNT + l * NEXP * 64;
            int myE0 = 0, myE1 = 0, myP0 = 0, myP1 = 0, myRow = -1; float myW0 = 0.f, myW1 = 0.f; int nrow = 0;
            f32x4 v[4][4], vn[4][4];
            constexpr int RPW = M / (256 * NWAVES); const int rbase = gw * RPW;
            f32x4 ca[4], cb[4];
            { const int b = rbase / SEQ;
#pragma unroll
              for (int j = 0; j < 4; ++j) { const int col = 4 * lane + 256 * j;
                  const f32x4 g4 = *(const f32x4*)(gam + col), sc = *(const f32x4*)(modl + (size_t)b * 6 * D + 4 * D + col), sh = *(const f32x4*)(modl + (size_t)b * 6 * D + 3 * D + col);
                  ca[j] = g4 * (sc + 1.0f); cb[j] = sh; } }
#define T2_LOAD(dst, rb) do { _Pragma("unroll") for (int q = 0; q < 4; ++q) { const int row = min((rb) + q, M - 1); \
                _Pragma("unroll") for (int j = 0; j < 4; ++j) dst[q][j] = bf4(*(const u32x2*)(X + (size_t)row * D + 4 * lane + 256 * j)); } } while (0)
            T2_LOAD(v, rbase);
#pragma unroll 1
            for (int r0 = rbase; r0 < rbase + RPW; r0 += 4) {
                T2_LOAD(vn, min(r0 + 4, M - 4));
#pragma unroll
                for (int q = 0; q < 4; ++q) {
                    const int row = r0 + q;
                    float ss = 0.f;
#pragma unroll
                    for (int j = 0; j < 4; ++j) { ss += (v[q][j][0] * v[q][j][0] + v[q][j][1] * v[q][j][1]) + (v[q][j][2] * v[q][j][2] + v[q][j][3] * v[q][j][3]); }
                    const float rstd = 1.0f / sqrtf(wave_sum_u(ss) * (1.f / D) + NORM_EPS);
#pragma unroll
                    for (int j = 0; j < 4; ++j) { const int col = 4 * lane + 256 * j;
                        v[q][j] = v[q][j] * rstd * ca[j] + cb[j];
                        u32x2 w; w.x = cvt_pk_bf16(v[q][j][0], v[q][j][1]); w.y = cvt_pk_bf16(v[q][j][2], v[q][j][3]);
                        *(u32x2*)(Hn + (size_t)row * D + col) = w; }
                }
                float LG[4][4];
#pragma unroll
                for (int n = 0; n < 4; ++n) { float a0 = 0.f, a1 = 0.f, a2 = 0.f, a3 = 0.f;
#pragma unroll
                    for (int j = 0; j < 4; ++j) { const f32x4 wv = *(const LAS f32x4*)(rt + n * RT_LD + 4 * lane + 256 * j);
                        a0 += (wv[0] * v[0][j][0] + wv[1] * v[0][j][1]) + (wv[2] * v[0][j][2] + wv[3] * v[0][j][3]);
                        a1 += (wv[0] * v[1][j][0] + wv[1] * v[1][j][1]) + (wv[2] * v[1][j][2] + wv[3] * v[1][j][3]);
                        a2 += (wv[0] * v[2][j][0] + wv[1] * v[2][j][1]) + (wv[2] * v[2][j][2] + wv[3] * v[2][j][3]);
                        a3 += (wv[0] * v[3][j][0] + wv[1] * v[3][j][1]) + (wv[2] * v[3][j][2] + wv[3] * v[3][j][3]); }
                    const float bgn = rt[n * RT_LD + D]; LG[0][n] = wave_sum_u(a0) + bgn; LG[1][n] = wave_sum_u(a1) + bgn; LG[2][n] = wave_sum_u(a2) + bgn; LG[3][n] = wave_sum_u(a3) + bgn; }
#pragma unroll
                for (int q = 0; q < 4; ++q) {
                    const int row = r0 + q;
                    int gsel = 0; float gmx = LG[q][0];
#pragma unroll
                    for (int i = 1; i < 4; ++i) if (LG[q][i] > gmx) { gmx = LG[q][i]; gsel = i; }
                    gsel = __builtin_amdgcn_readfirstlane(gsel);
                    float gsum = 0.f;
#pragma unroll
                    for (int i = 0; i < 4; ++i) gsum += __expf(LG[q][i] - gmx);
                    const float pg = 1.0f / gsum;
                    float le[8];
                    const LAS float* rte = rt + (4 + 8 * gsel) * RT_LD + 4 * lane;
#pragma unroll
                    for (int j8 = 0; j8 < 8; ++j8) { float a = 0.f;
#pragma unroll
                        for (int j = 0; j < 4; ++j) { const f32x4 wv = *(const LAS f32x4*)(rte + j8 * RT_LD + 256 * j); a += (wv[0] * v[q][j][0] + wv[1] * v[q][j][1]) + (wv[2] * v[q][j][2] + wv[3] * v[q][j][3]); }
                        le[j8] = wave_sum_u(a) + rte[j8 * RT_LD + D - 4 * lane]; }
                    int e0 = 0; float m0 = le[0];
#pragma unroll
                    for (int j = 1; j < 8; ++j) if (le[j] > m0) { m0 = le[j]; e0 = j; }
                    int e1 = (e0 == 0) ? 1 : 0; float m1 = -3.0e38f;
#pragma unroll
                    for (int j = 0; j < 8; ++j) if (j != e0 && le[j] > m1) { m1 = le[j]; e1 = j; }
                    const float a1 = __expf(m1 - m0), inv = 1.0f / (1.0f + a1);
                    const float w0 = pg * inv, w1 = pg * a1 * inv;
                    const int E0 = gsel * 8 + e0, E1 = gsel * 8 + e1;
                    if (row < M) {
                        unsigned p0 = 0, p1 = 0;
                        if (lane == 0) { p0 = __hip_atomic_fetch_add(lcnt + E0, 1u, __ATOMIC_RELAXED, __HIP_MEMORY_SCOPE_WORKGROUP); p1 = __hip_atomic_fetch_add(lcnt + E1, 1u, __ATOMIC_RELAXED, __HIP_MEMORY_SCOPE_WORKGROUP); }
                        p0 = __builtin_amdgcn_readfirstlane(p0); p1 = __builtin_amdgcn_readfirstlane(p1);
                        if (lane == nrow) { myE0 = E0; myE1 = E1; myP0 = (int)p0; myP1 = (int)p1; myW0 = w0; myW1 = w1; myRow = row; }
                        ++nrow;
                    }
                }
#pragma unroll
                for (int q = 0; q < 4; ++q)
#pragma unroll
                    for (int j = 0; j < 4; ++j) v[q][j] = vn[q][j];
            }
#undef T2_LOAD
            __syncthreads();
            if (tid < NEXP) { const unsigned c = lcnt[tid]; lbase[tid] = c ? __hip_atomic_fetch_add(cnt + tid * 64, c, __ATOMIC_RELAXED, __HIP_MEMORY_SCOPE_AGENT) : 0u; }
            __syncthreads();
            if (myRow >= 0) { const int q0 = myP0 + (int)lbase[myE0], q1 = myP1 + (int)lbase[myE1]; etok[myE0 * 16384 + q0] = myRow; etok[myE1 * 16384 + q1] = myRow;
                              tok_e[2 * myRow] = myE0; tok_e[2 * myRow + 1] = myE1; tok_pos[2 * myRow] = q0; tok_pos[2 * myRow + 1] = q1;
                              tok_w[2 * myRow] = myW0; tok_w[2 * myRow + 1] = myW1; }
            __syncthreads();
        }
        SEAM(pb + 5);
        if (IN(pb + 8) && EN(8)) {
            WSP();
            const unsigned* cnt = ctl + CW_CNT + l * NEXP * 64; unsigned* tcl = ctl + CW_TILE + l * MAXTILES * 16;
            int n1, n3, n4, R;
            int a_pm, a_pn, a_e, a_ts, a_cn, b_pm, b_pn, b_e, b_ts, b_cn, c_pm, c_pn, c_e, c_ts, c_cn;
            int d_pm, d_pn, d_e, d_ts, d_cn, e_pm, e_pn, e_e, e_ts, e_cn, f_pm, f_pn, f_e, f_ts, f_cn, g_pm, g_pn, g_e, g_ts, g_cn;
            {
                const int cv = (lane < NEXP) ? (int)__hip_atomic_load(cnt + lane * 64, __ATOMIC_RELAXED, __HIP_MEMORY_SCOPE_AGENT) : 0;
                const int tl = (cv + 255) >> 8; int tend = 0, ntile = 0;
#pragma unroll
                for (int e = 0; e < NEXP; ++e) { ntile += __builtin_amdgcn_readlane(tl, e); if (lane == e) tend = ntile; }
                const int U = 4 * ntile, nA = min(U, 2 * G), Nf = G - min(U - nA, G), nB = min(nA, 2 * Nf); R = min(U - nA, G);
                auto moe_unit = [&](int v, int& pm, int& pn, int& e, int& ts, int& cn) { const int t = min(v >> 2, ntile - 1); pm = t; pn = v & 3;
                    e = min((int)__builtin_popcountll(__ballot(lane < NEXP && tend <= t)), NEXP - 1); ts = __builtin_amdgcn_readlane(tend - tl, e); cn = max(__builtin_amdgcn_readlane(cv, e), 1); };
                moe_unit(vcu, a_pm, a_pn, a_e, a_ts, a_cn); moe_unit(G + vcu, b_pm, b_pn, b_e, b_ts, b_cn); moe_unit(nA + vcu, c_pm, c_pn, c_e, c_ts, c_cn);
                n1 = (vcu < nA ? 1 : 0) + (G + vcu < nA ? 1 : 0);
                const int v3 = vcu - R, v4 = nB + vcu;
                moe_unit(v3, d_pm, d_pn, d_e, d_ts, d_cn); moe_unit(v3 + Nf, e_pm, e_pn, e_e, e_ts, e_cn); n3 = (vcu >= R) ? (v3 < nB ? 1 : 0) + (v3 + Nf < nB ? 1 : 0) : 0;
                moe_unit(v4, f_pm, f_pn, f_e, f_ts, f_cn); moe_unit(v4 + G, g_pm, g_pn, g_e, g_ts, g_cn); n4 = (v4 < U ? 1 : 0) + (v4 + G < U ? 1 : 0);
            }
#define MOE_M1(n_, p0, p1) do { const pg8::MoeOrder S{(n_), p0##pm, p1##pm, p0##pn, p1##pn, p0##e, p1##e, (size_t)1024 * D * 2, p0##ts, p1##ts, p0##cn, p1##cn, etok, tcl}; \
            pg8::Gemm g{Hn, W13 + (size_t)l * NEXP * 1024 * D, D, D, D};            \
            EpiSwiglu E{HB}; pg8::gemm_phase<EpiSwiglu, pg8::MoeOrder, true, true, true>(lds, g, S, E); } while (0)
#define MOE_M2(n_, p0, p1) do { \
            if (wave == 0) { const int tb_ = (n_) > 1 ? p1##pm : p0##pm; unsigned sp_ = 0; \
                while ((unsigned)__builtin_amdgcn_readfirstlane((int)__hip_atomic_load(tcl + p0##pm * 16, __ATOMIC_RELAXED, __HIP_MEMORY_SCOPE_AGENT)) < 32u && ++sp_ < XB_SPIN_CAP) __builtin_amdgcn_s_sleep(2); \
                while ((unsigned)__builtin_amdgcn_readfirstlane((int)__hip_atomic_load(tcl + tb_ * 16, __ATOMIC_RELAXED, __HIP_MEMORY_SCOPE_AGENT)) < 32u && ++sp_ < XB_SPIN_CAP) __builtin_amdgcn_s_sleep(2); \
                __builtin_amdgcn_fence(__ATOMIC_ACQUIRE, "agent"); asm volatile("s_waitcnt vmcnt(0)" ::: "memory"); }        \
            __syncthreads(); \
            const pg8::MoeOrder S{(n_), p0##pm, p1##pm, p0##pn, p1##pn, p0##e, p1##e, (size_t)D * EH * 2, p0##ts, p1##ts, p0##cn, p1##cn, etok, nullptr}; \
            pg8::Gemm g{HB, W2 + (size_t)l * NEXP * D * EH, EH, EH, EH}; \
            EpiY E{YB}; pg8::gemm_phase<EpiY, pg8::MoeOrder>(lds, g, S, E); } while (0)
            if (n1) MOE_M1(n1, a_, b_);
            if (vcu < R) MOE_M1(1, c_, c_);
            if (n3) MOE_M2(n3, d_, e_);
            if (n4) MOE_M2(n4, f_, g_);
#undef MOE_M1
#undef MOE_M2
        }
        SEAM(pb + 8);
    }
    if (IN(NPHASE - 1) && EN(9)) {
        WSP();
        const float* modprev = modp + (size_t)(DEPTH - 1) * NBATCH * 6 * D;
        constexpr int RPW = M / (256 * NWAVES); const int rbase = gw * RPW, b = rbase / SEQ;
        int slot_v = 0; float w_v = 0.f;
        { const unsigned* cntp = ctl + CW_CNT + (DEPTH - 1) * NEXP * 64;
          const int cv = (lane < NEXP) ? (int)__hip_atomic_load(cntp + lane * 64, __ATOMIC_RELAXED, __HIP_MEMORY_SCOPE_AGENT) : 0;
          const int tl = (cv + 255) >> 8; int tstart = 0, run = 0;
#pragma unroll
          for (int e = 0; e < NEXP; ++e) { if (lane == e) tstart = run; run += __builtin_amdgcn_readlane(tl, e); }
          const int i = min(lane, 2 * RPW - 1);
          const int e = tok_e[2 * rbase + i], pos = tok_pos[2 * rbase + i]; w_v = tok_w[2 * rbase + i];
          slot_v = __builtin_amdgcn_ds_bpermute(4 * e, tstart) * 256 + pos; }
        f32x4 gf[4], fg[4];
#pragma unroll
        for (int j = 0; j < 4; ++j) { const int col = 4 * lane + 256 * j; gf[j] = *(const f32x4*)(modprev + (size_t)b * 6 * D + 5 * D + col); fg[j] = *(const f32x4*)(args.fin_g + col); }
#pragma unroll 1
        for (int r0 = rbase; r0 < rbase + RPW; r0 += 4) {
            u32x2 xr[4][4], y0[4][4], y1[4][4]; float w0[4], w1[4];
#pragma unroll
            for (int q = 0; q < 4; ++q) { const int ix = 2 * (r0 - rbase + q);
                const int s0 = __builtin_amdgcn_readlane(slot_v, ix), s1 = __builtin_amdgcn_readlane(slot_v, ix + 1);
                w0[q] = __builtin_bit_cast(float, __builtin_amdgcn_readlane(__builtin_bit_cast(int, w_v), ix)); w1[q] = __builtin_bit_cast(float, __builtin_amdgcn_readlane(__builtin_bit_cast(int, w_v), ix + 1));
#pragma unroll
                for (int j = 0; j < 4; ++j) { const int col = 4 * lane + 256 * j;
                    xr[q][j] = *(const u32x2*)(X + (size_t)(r0 + q) * D + col); y0[q][j] = *(const u32x2*)(YB + (size_t)s0 * D + col); y1[q][j] = *(const u32x2*)(YB + (size_t)s1 * D + col); } }
#pragma unroll
            for (int q = 0; q < 4; ++q) { const int row = r0 + q;
                f32x4 v[4]; float ss = 0.f;
#pragma unroll
                for (int j = 0; j < 4; ++j) { const f32x4 yy = bf4(y0[q][j]) * w0[q] + bf4(y1[q][j]) * w1[q]; v[j] = bf4(xr[q][j]) + gf[j] * yy;
                    ss += (v[j][0] * v[j][0] + v[j][1] * v[j][1]) + (v[j][2] * v[j][2] + v[j][3] * v[j][3]); }
                const float rstd = 1.0f / sqrtf(wave_sum(ss) * (1.f / D) + NORM_EPS);
#pragma unroll
                for (int j = 0; j < 4; ++j) *(f32x4*)(args.out + (size_t)row * D + 4 * lane + 256 * j) = v[j] * rstd * fg[j];
            }
        }
    }
#undef IN
#undef SEAM
#undef GRID_BAR
}


#ifndef DBG
#define DBG 0
#endif
#if DBG
constexpr size_t WS_REP = WS_END;
__global__ void dbg_scan(const unsigned* buf, size_t nwords, int is_bf16, unsigned long long* rep) {
    unsigned long long nf = 0, ck = 0;
    for (size_t i = (size_t)blockIdx.x * blockDim.x + threadIdx.x; i < nwords; i += (size_t)gridDim.x * blockDim.x) {
        const unsigned w = buf[i]; ck += (unsigned long long)w * (unsigned long long)((i & 1023) + 1);
        if (is_bf16) { if ((w & 0x7f80u) >= (140u << 7)) ++nf; if ((w & 0x7f800000u) >= (140u << 23)) ++nf; }
        else if ((w & 0x7f800000u) >= (140u << 23)) ++nf;
    }
    for (int o = 32; o >= 1; o >>= 1) { nf += __shfl_xor(nf, o); ck += __shfl_xor(ck, o); }
    if ((threadIdx.x & 63) == 0) { if (nf) atomicAdd(rep, nf); atomicAdd(rep + 1, ck); }
}

__global__ void dbg_scan_cols(const unsigned short* buf, int c0, int c1, unsigned long long* rep) {
    unsigned long long nf = 0;
    const int w = c1 - c0;
    for (size_t i = (size_t)blockIdx.x * blockDim.x + threadIdx.x; i < (size_t)M * w; i += (size_t)gridDim.x * blockDim.x) {
        const size_t r = i / w; const int c = c0 + (int)(i % w); const unsigned v = buf[r * D + c];
        if ((v & 0x7f80u) >= (140u << 7)) ++nf; }
    for (int o = 32; o >= 1; o >>= 1) nf += __shfl_xor(nf, o);
    if ((threadIdx.x & 63) == 0 && nf) atomicAdd(rep, nf);
}
__global__ void dbg_encode(const unsigned long long* rep, float* out, size_t n, int nph) {
    int code = 80;
    for (int p = nph - 1; p >= 0; --p) if (rep[(64 + p) * 2 + 1] != rep[p * 2 + 1]) code = 40 + p;
    for (int p = nph - 1; p >= 0; --p) if (rep[p * 2] != 0ull || rep[(64 + p) * 2] != 0ull) code = 1 + p;
    if (code == 80) return;
    const float A = sqrtf((float)code * 0.1f);
    for (size_t i = (size_t)blockIdx.x * blockDim.x + threadIdx.x; i < n; i += (size_t)gridDim.x * blockDim.x) {
        unsigned h = (unsigned)i * 2654435761u; h ^= h >> 15; h *= 2246822519u; h ^= h >> 13;
        out[i] = (h & 1u) ? A : -A; }
}
#endif

extern "C" void kernel_launch(void* const* d_in, const int* in_sizes, int n_in, void* d_out, int out_size, void* d_ws, size_t ws_size, hipStream_t stream) {
    static int grid = 0;
    if (grid == 0) {
        if (n_in != 22 || in_sizes[0] != M * D || out_size != M * D || ws_size < WS_END + (1u << 20)) {
            fprintf(stderr, "kernel_launch: unexpected shapes (n_in %d, in0 %d, out %d, ws %zu, need %zu)\n", n_in, n_in > 0 ? in_sizes[0] : -1, out_size, ws_size, (size_t)WS_END); grid = -1; return; }
        int dev = 0, cus = 0, per_cu = 0;
        if (hipGetDevice(&dev) != hipSuccess || hipDeviceGetAttribute(&cus, hipDeviceAttributeMultiprocessorCount, dev) != hipSuccess) { grid = -1; return; }
        if (hipFuncSetAttribute((const void*)fwd_kernel, hipFuncAttributeMaxDynamicSharedMemorySize, LDS_BYTES) != hipSuccess) { fprintf(stderr, "kernel_launch: hipFuncSetAttribute failed\n"); grid = -1; return; }
        if (hipOccupancyMaxActiveBlocksPerMultiprocessor(&per_cu, (const void*)fwd_kernel, NWAVES * 64, LDS_BYTES) != hipSuccess || per_cu < 1)
            fprintf(stderr, "kernel_launch: occupancy query reports %d\n", per_cu);
        (void)hipGetLastError();
        if (cus != 256) { fprintf(stderr, "kernel_launch: built for 256 CUs (MoE unit deal, T2 row blocks), found %d\n", cus); grid = -1; return; }
        grid = cus;
    }
    if (grid < 0) return;
    if (hipMemsetAsync((char*)d_ws + WS_CTL, 0, CTL_ZERO_BYTES, stream) != hipSuccess) { fprintf(stderr, "kernel_launch: memset failed\n"); return; }
    Args a{};
    a.x = (const float*)d_in[0]; a.c = (const float*)d_in[1]; a.ada_w = (const float*)d_in[2]; a.ada_b = (const float*)d_in[3]; a.mix_g = (const float*)d_in[4]; a.ffn_g = (const float*)d_in[5];
    a.w_in = (const float*)d_in[6]; a.da_lambda = (const float*)d_in[7]; a.da_subln = (const float*)d_in[8]; a.na_rpb = (const float*)d_in[9];
    a.wpa = (const float*)d_in[10]; a.wpn = (const float*)d_in[11]; a.wpd = (const float*)d_in[12]; a.w_out = (const float*)d_in[13];
    a.rgw = (const float*)d_in[14]; a.rgb = (const float*)d_in[15]; a.rew = (const float*)d_in[16]; a.reb = (const float*)d_in[17];
    a.ew1 = (const float*)d_in[18]; a.ew3 = (const float*)d_in[19]; a.ew2 = (const float*)d_in[20]; a.fin_g = (const float*)d_in[21];
    a.out = (float*)d_out; a.ws = (unsigned char*)d_ws;
#if DBG
    {
        unsigned char* ws = (unsigned char*)d_ws;
        unsigned long long* rep = (unsigned long long*)(ws + WS_REP);
        (void)hipMemsetAsync(rep, 0, 2 * 64 * 2 * 8, stream);
        for (int run = 0; run < 2; ++run) {
            (void)hipMemsetAsync((char*)d_ws + WS_CTL, 0, CTL_ZERO_BYTES, stream);
            for (int p = 0; p < NPHASE; ++p) {
                a.ph_lo = p; a.ph_hi = p + 1;
                hipLaunchKernelGGL(fwd_kernel, dim3(grid), dim3(NWAVES * 64), LDS_BYTES, stream, a);
                unsigned long long* r = rep + (size_t)(run * 64 + p) * 2;
#define SCAN(off, bytes, isbf) hipLaunchKernelGGL(dbg_scan, dim3(1024), dim3(256), 0, stream, (const unsigned*)(ws + (off)), (size_t)(bytes) / 4, (isbf), r)
                const int ph = (p == 0) ? -1 : (p == NPHASE - 1) ? 9 : (p - 1) % 9;
                if (ph == -1) { SCAN(WS_MOD, (size_t)DEPTH * NBATCH * 6 * D * 4, 0); SCAN(WS_ROPE, (size_t)SEQ * 64 * 4, 0); SCAN(WS_WIN, WS_END - WS_WIN, 1); }
                else if (ph == 0) { SCAN(WS_X, (size_t)M * D * 4, 0); SCAN(WS_H, (size_t)M * D * 2, 1); }
                else if (ph == 1) { SCAN(WS_Z, (size_t)M * ZW * 2, 1); }
                else if (ph == 2) { SCAN(WS_OCAT, (size_t)M * D * 2, 1); }
                else if (ph == 3) { SCAN(WS_MERGED, (size_t)M * D * 2, 1); }
                else if (ph == 4) { SCAN(WS_X, (size_t)M * D * 4, 0); }
                else if (ph == 5) { SCAN(WS_H, (size_t)M * D * 2, 1); SCAN(WS_ROUTE, (size_t)2 * M * 4, 0); SCAN(WS_ROUTE + (size_t)4 * M * 4, (size_t)2 * M * 4, 0); }
                else if (ph == 9) { hipLaunchKernelGGL(dbg_scan, dim3(1024), dim3(256), 0, stream, (const unsigned*)d_out, (size_t)M * D, 0, r); }
#undef SCAN
            }
        }
        hipLaunchKernelGGL(dbg_encode, dim3(1024), dim3(256), 0, stream, (const unsigned long long*)rep, (float*)d_out, (size_t)M * D, NPHASE);
    }
#elif MK_PER_PHASE
    for (int p = 0; p < NPHASE; ++p) {
        a.ph_lo = p; a.ph_hi = p + 1;
        hipLaunchKernelGGL(fwd_kernel, dim3(grid), dim3(NWAVES * 64), LDS_BYTES, stream, a);
    }
#else
    a.ph_lo = 0; a.ph_hi = NPHASE;
    hipLaunchKernelGGL(fwd_kernel, dim3(grid), dim3(NWAVES * 64), LDS_BYTES, stream, a);
#endif
    const hipError_t le = hipPeekAtLastError();
    if (le != hipSuccess) fprintf(stderr, "kernel_launch: launch failed: %s\n", hipGetErrorName(le));
}
```

```cpp
#include <hip/hip_runtime.h>
#include <cstdio>
#include <cstdint>

#ifndef MK_PER_PHASE
#define MK_PER_PHASE 0
#endif

#define LAS __attribute__((address_space(3)))
#define GAS __attribute__((address_space(1)))
typedef unsigned short bf16_t;
typedef short bf16x8 __attribute__((ext_vector_type(8)));
typedef short s16x4 __attribute__((ext_vector_type(4)));
typedef float f32x4 __attribute__((ext_vector_type(4)));
typedef float f32x2 __attribute__((ext_vector_type(2)));
typedef float f32x16 __attribute__((ext_vector_type(16)));
typedef unsigned u32x4 __attribute__((ext_vector_type(4)));
typedef unsigned u32x2 __attribute__((ext_vector_type(2)));

constexpr int D = 1024, NBATCH = 4, SEQ = 4096, M = NBATCH * SEQ, DEPTH = 4, ZW = 7680;
constexpr int ZQA = 0, ZKA = 512, ZVA = 1024, ZQN = 1536, ZKN = 1792, ZVN = 2048, ZQD = 2304, ZKD = 3072, ZVD = 3840, ZG = 4608;
constexpr int NEXP = 32, EH = 512;
constexpr int MAXTILES = 160, XROWS = MAXTILES * 256;
constexpr float C2 = 0.125f * 1.4426950408889634f;
constexpr float LOG2E = 1.4426950408889634f;
constexpr float NORM_EPS = 1e-6f;
constexpr float NEGBIG = -1e30f;
constexpr float RESCALE_THR = 8.0f;

constexpr size_t MiB = 1u << 20;
constexpr size_t WS_CTL = 0, CTL_ZERO_BYTES = 1 * MiB;
constexpr size_t WS_RT = 1 * MiB;
constexpr size_t WS_MOD = 2 * MiB;
constexpr size_t WS_ROPE = 3 * MiB;
constexpr size_t WS_ROUTE = 4 * MiB;
constexpr size_t WS_X = 8 * MiB;
constexpr size_t WS_H = 72 * MiB;
constexpr size_t WS_OCAT = 104 * MiB;
constexpr size_t WS_MERGED = 136 * MiB;
constexpr size_t WS_Z = 168 * MiB;
constexpr size_t WS_XG = WS_Z;
constexpr size_t WS_HB = WS_Z + 80 * MiB;
constexpr size_t WS_YB = WS_Z + 120 * MiB;
constexpr size_t WS_WIN = 408 * MiB;
constexpr size_t WS_WPROJ = 468 * MiB;
constexpr size_t WS_WOUT = 476 * MiB;
constexpr size_t WS_W13 = 484 * MiB;
constexpr size_t WS_W2 = 740 * MiB;
constexpr size_t WS_END = 868 * MiB;
constexpr int CW_BAR = 4096;
constexpr int CW_CNT = 16384;
constexpr int CW_TILE = 32768;

constexpr int RING_BYTES = 131072;
constexpr int RT_LD = 1028;
constexpr int RT_BYTES = 36 * RT_LD * 4;
constexpr int MISC_OFF = RT_BYTES;
constexpr int LDS_BYTES = MISC_OFF + 512;

__device__ __forceinline__ unsigned f2bf(float f) { unsigned u = __builtin_bit_cast(unsigned, f); return (u + 0x7fffu + ((u >> 16) & 1u)) >> 16; }
__device__ __forceinline__ unsigned pk2(float lo, float hi) { return f2bf(lo) | (f2bf(hi) << 16); }
__device__ __forceinline__ unsigned cvt_pk_bf16(float lo, float hi) { unsigned r; asm("v_cvt_pk_bf16_f32 %0, %1, %2" : "=v"(r) : "v"(lo), "v"(hi)); return r; }
typedef __bf16 bf16x2_t __attribute__((ext_vector_type(2)));
__device__ __forceinline__ unsigned cvtpk_s(float lo, float hi) { f32x2 v = {lo, hi}; bf16x2_t b = __builtin_convertvector(v, bf16x2_t); return __builtin_bit_cast(unsigned, b); }
__device__ __forceinline__ float bflo(unsigned u) { return __builtin_bit_cast(float, u << 16); }
__device__ __forceinline__ float bfhi(unsigned u) { return __builtin_bit_cast(float, u & 0xffff0000u); }
__device__ __forceinline__ f32x4 bf4(u32x2 r) { return (f32x4){bflo(r.x), bfhi(r.x), bflo(r.y), bfhi(r.y)}; }
__device__ __forceinline__ float fexp2(float x) { return __builtin_amdgcn_exp2f(x); }
__device__ __forceinline__ float frcp(float x) { return __builtin_amdgcn_rcpf(x); }
__device__ __forceinline__ void swap32(float& a, float& b) { asm volatile("s_nop 1\n\tv_permlane32_swap_b32 %0, %1\n\ts_nop 1" : "+v"(a), "+v"(b)); }
template <int X> __device__ __forceinline__ float xor_lane(float v) { return __builtin_bit_cast(float, __builtin_amdgcn_ds_swizzle(__builtin_bit_cast(int, v), (X << 10) | 0x1f)); }
__device__ __forceinline__ float half_sum(float v) { v += xor_lane<1>(v); v += xor_lane<2>(v); v += xor_lane<4>(v); v += xor_lane<8>(v); v += xor_lane<16>(v); return v; }
__device__ __forceinline__ float wave_sum(float v) {
    v = half_sum(v);
    float a = v, b = v; swap32(a, b);
    return a + b;
}
template <int CTRL> __device__ __forceinline__ float dpp_f(float v) { return __builtin_bit_cast(float, __builtin_amdgcn_update_dpp(0, __builtin_bit_cast(int, v), CTRL, 0xf, 0xf, false)); }
__device__ __forceinline__ float wave_sum_u(float v) {
    v += dpp_f<0xB1>(v); v += dpp_f<0x4E>(v); v += dpp_f<0x141>(v); v += dpp_f<0x140>(v);
    v += __builtin_bit_cast(float, __builtin_amdgcn_update_dpp(0, __builtin_bit_cast(int, v), 0x142, 0xa, 0xf, false));
    v += __builtin_bit_cast(float, __builtin_amdgcn_update_dpp(0, __builtin_bit_cast(int, v), 0x143, 0xc, 0xf, false));
    float r = __builtin_bit_cast(float, __builtin_amdgcn_readlane(__builtin_bit_cast(int, v), 63));
    asm volatile("" : "+v"(r));
    return r;
}
__device__ __forceinline__ void st16_wt(void* p, u32x4 v) { asm volatile("global_store_dwordx4 %0, %1, off sc1\n\ts_nop 1" :: "v"(p), "v"(v) : "memory"); }
#define LDS_WAIT() asm volatile("s_waitcnt lgkmcnt(0)" ::: "memory")
#define VM_WAIT() asm volatile("s_waitcnt vmcnt(0)" ::: "memory")
#define CBAR() asm volatile("" ::: "memory")

namespace pg8 {
constexpr int BM = 256, BK = 64, HALF = 128, HTB = HALF * BK * 2, STAGE_BYTES = 8 * HTB, NXCD = 8, WGM = 8;
__host__ __device__ __forceinline__ int lds_byte(int r, int c) { const int st = (r >> 4) * 2 + (c >> 5), rr = r & 15, cc = c & 31, ob = rr * 64 + cc * 2; return st * 1024 + (ob ^ (((ob >> 9) & 1) << 5)); }
__host__ __device__ __forceinline__ void stage_rc(int b, int& R, int& C) { const int st = b / 1024, sb = b % 1024, swz = sb ^ (((sb >> 9) & 1) << 5); R = (st >> 1) * 16 + swz / 64; C = (st & 1) * 32 + (swz % 64) / 2; }
__host__ __device__ __forceinline__ int perm32(int rho) { const int n = rho >> 4, i = rho & 15; return 8 * (i >> 2) + 4 * n + (i & 3); }

struct Unit { int pm, pn, e, x0, x1; };
struct Gemm { const bf16_t* A; const bf16_t* Bt; int lda, ldb, K; };

struct StaticOrder {
    int nM, nN, nwg, G, c;
    __device__ void init(int M_, int N_, int G_, int c_) { nM = M_ / BM; nN = N_ / BM; nwg = nM * nN; G = G_; c = c_; }
    __device__ bool next(int i, Unit& u) const {
        const long L = (long)i * G + c; if (L >= nwg) return false;
        int wgid = (int)L; { const int q = nwg / NXCD, r = nwg % NXCD, xcd = wgid % NXCD, off = wgid / NXCD; wgid = (xcd < r ? xcd * (q + 1) : r * (q + 1) + (xcd - r) * q) + off; }
        const int nig = WGM * nN, gid = wgid / nig, fm = gid * WGM, gsz = (nM - fm) < WGM ? (nM - fm) : WGM;
        u.pm = fm + ((wgid % nig) % gsz); u.pn = (wgid % nig) / gsz; u.e = 0; u.x0 = 0; u.x1 = 0; return true;
    }
    __device__ __forceinline__ size_t aoff(const Gemm& g, const Unit& u) const { return (size_t)u.pm * BM * g.lda * 2; }
    __device__ __forceinline__ size_t boff(const Gemm& g, const Unit& u) const { return (size_t)u.pn * BM * g.ldb * 2; }
    __device__ __forceinline__ int ktiles(const Gemm& g, const Unit&) const { return g.K / BK; }
    __device__ __forceinline__ void done(const Unit&, int) const {}
};
struct MoeOrder {
    int n; int pm0, pm1, pn0, pn1, e0, e1; size_t estride;
    int ts0, ts1, cn0, cn1; const int* etok;
    unsigned* tcnt;
    __device__ __forceinline__ void done(const Unit& u, int lane) const {
        if (tcnt) { asm volatile("s_waitcnt vmcnt(0)" ::: "memory"); if (lane == 0) __hip_atomic_fetch_add(tcnt + u.pm * 16, 1u, __ATOMIC_RELAXED, __HIP_MEMORY_SCOPE_AGENT); }
    }
    __device__ bool next(int i, Unit& u) const {
        if (i >= n) return false;
        u.pm = i == 0 ? pm0 : pm1; u.pn = i == 0 ? pn0 : pn1; u.e = i == 0 ? e0 : e1;
        u.x0 = i == 0 ? ts0 : ts1; u.x1 = i == 0 ? cn0 : cn1; return true;
    }
    __device__ __forceinline__ size_t aoff(const Gemm& g, const Unit& u) const { return (size_t)u.pm * BM * g.lda * 2; }
    __device__ __forceinline__ size_t boff(const Gemm& g, const Unit& u) const { return (size_t)u.e * estride + (size_t)u.pn * BM * g.ldb * 2; }
    __device__ __forceinline__ int ktiles(const Gemm& g, const Unit&) const { return g.K / BK; }
    __device__ __forceinline__ int gather_row(const Unit& u, int r) const {
        const int pos = min((u.pm - u.x0) * BM + r, u.x1 - 1);
        return etok[u.e * 16384 + pos];
    }
};
struct ProjOrder {
    int pm, pn, rot;
    __device__ bool next(int i, Unit& u) const { if (i >= 3) return false; int seg = i + rot; seg = seg >= 3 ? seg - 3 : seg; u.pm = pm; u.pn = pn; u.e = seg | ((i == 0) ? 16 : 0); u.x0 = 0; u.x1 = 0; return true; }
    __device__ __forceinline__ int kofs(const Unit& u) const { const int seg = u.e & 15; return seg == 0 ? 0 : (seg == 1 ? 512 : 768); }
    __device__ __forceinline__ size_t aoff(const Gemm& g, const Unit& u) const { return (size_t)u.pm * BM * g.lda * 2 + (size_t)kofs(u) * 2; }
    __device__ __forceinline__ size_t boff(const Gemm& g, const Unit& u) const { return (size_t)u.pn * BM * g.ldb * 2 + (size_t)kofs(u) * 2; }
    __device__ __forceinline__ int ktiles(const Gemm&, const Unit& u) const { return (u.e & 15) == 0 ? 8 : 4; }
    __device__ __forceinline__ void done(const Unit&, int) const {}
};

template <class Epi, class Sched, bool ALIGN_EPI = true, bool SP2 = true, bool GATHER = false>
__device__ __forceinline__ void gemm_phase(LAS unsigned char* lds, const Gemm g, const Sched& S, const Epi& E) {
    int tid_ = threadIdx.x; asm volatile("" : "+v"(tid_));
    const int tid = tid_, wid = __builtin_amdgcn_readfirstlane(tid >> 6), lane = tid & 63, wr = wid >> 2, wc = wid & 3, fr = lane & 15, fq = lane >> 4;
    int nt = S.ktiles(g, Unit{0, 0, 0, 0, 0});
    unsigned voffA[2], voffB[2];
#pragma unroll
    for (int i = 0; i < 2; ++i) { int R, C; stage_rc(tid * 16 + i * 8192, R, C); const int Rb = Epi::PERM ? ((R & ~31) + perm32(R & 31)) : R;
        voffA[i] = (unsigned)(R * g.lda + C) * 2u; voffB[i] = (unsigned)(Rb * g.ldb + C) * 2u; }
    const size_t kstep = (size_t)(BK * 2);
    const size_t hstepA = (size_t)HALF * g.lda * 2, hstepB = (size_t)HALF * g.ldb * 2;
    const unsigned ldsw = (unsigned)wid * 1024u;
    const int aoff = lds_byte(wr * 64 + fr, fq * 8), boff = lds_byte(wc * 32 + fr, fq * 8);
#define PG8_SA(b, h) (((b) * 2 + (h)) * HTB)
#define PG8_SB(b, h) ((4 + (b) * 2 + (h)) * HTB)
#define PG8_STAGE(bufoff, gbase, voff) do { _Pragma("unroll") for (int _i = 0; _i < 2; ++_i) \
        __builtin_amdgcn_global_load_lds((const unsigned*)((const char*)(gbase) + (voff)[_i]), (LAS unsigned*)(lds + (bufoff) + ldsw + _i * 8192), 16, 0, 0); } while (0)
    unsigned vo0[2] = {0u, 0u}, vo1[2] = {0u, 0u}, nvo0[2] = {0u, 0u}, nvo1[2] = {0u, 0u};
#define PG8_GOFF(u_, d0_, d1_) do { _Pragma("unroll") for (int _i = 0; _i < 2; ++_i) { int R_, C_; stage_rc(tid * 16 + _i * 8192, R_, C_); \
        d0_[_i] = (unsigned)(S.gather_row(u_, R_) * g.lda + C_) * 2u; d1_[_i] = (unsigned)(S.gather_row(u_, HALF + R_) * g.lda + C_) * 2u; } } while (0)
#define PG8_STAGEA(bufoff, ptr, h, nx) do { if constexpr (GATHER) { unsigned o_[2]; o_[0] = (nx) ? ((h) ? nvo1[0] : nvo0[0]) : ((h) ? vo1[0] : vo0[0]); o_[1] = (nx) ? ((h) ? nvo1[1] : nvo0[1]) : ((h) ? vo1[1] : vo0[1]); \
        PG8_STAGE(bufoff, ptr, o_); } else { PG8_STAGE(bufoff, (ptr) + ((h) ? hstepA : 0), voffA); } } while (0)
#define PG8_LDA(dst, b, h) do { _Pragma("unroll") for (int m = 0; m < 4; ++m) _Pragma("unroll") for (int k = 0; k < 2; ++k) dst[m][k] = *(const LAS bf16x8*)(lds + PG8_SA(b, h) + aoff + m * 2048 + k * 1024); } while (0)
#define PG8_LDB(dst, b, h) do { _Pragma("unroll") for (int n = 0; n < 2; ++n) _Pragma("unroll") for (int k = 0; k < 2; ++k) dst[n][k] = *(const LAS bf16x8*)(lds + PG8_SB(b, h) + boff + n * 2048 + k * 1024); } while (0)
#define PG8_MMA(ai, bj, At, Bt) do { __builtin_amdgcn_s_setprio(1); _Pragma("unroll") for (int m = 0; m < 4; ++m) _Pragma("unroll") for (int n = 0; n < 2; ++n) _Pragma("unroll") for (int k = 0; k < 2; ++k) \
        acc[ai][bj][m][n] = __builtin_amdgcn_mfma_f32_16x16x32_bf16(Bt[n][k], At[m][k], acc[ai][bj][m][n], 0, 0, 0); __builtin_amdgcn_s_setprio(0); } while (0)
#define PG8_WAIT_V(n) asm volatile("s_waitcnt vmcnt(" #n ")" ::: "memory")
#define PG8_WAIT_L(n) asm volatile("s_waitcnt lgkmcnt(" #n ")" ::: "memory")
#define PG8_BAR __builtin_amdgcn_s_barrier()
#define PG8_SCHED __builtin_amdgcn_sched_barrier(0)
    Unit cur, nxt; int ui = 0;
    if (!S.next(0, cur)) return;
    nt = S.ktiles(g, cur);
    f32x4 acc[2][2][4][2];
#pragma unroll
    for (int a = 0; a < 2; ++a)
#pragma unroll
        for (int b = 0; b < 2; ++b)
#pragma unroll
            for (int m = 0; m < 4; ++m)
#pragma unroll
                for (int n = 0; n < 2; ++n) acc[a][b][m][n] = (f32x4){0.f, 0.f, 0.f, 0.f};
    bf16x8 At[4][2], B0[2][2], B1[2][2];
    const char* cA = (const char*)g.A + (GATHER ? (size_t)0 : S.aoff(g, cur)); const char* cB = (const char*)g.Bt + S.boff(g, cur);
    if constexpr (GATHER) { PG8_GOFF(cur, vo0, vo1); asm volatile("s_waitcnt vmcnt(0)" : "+v"(vo0[0]), "+v"(vo0[1]), "+v"(vo1[0]), "+v"(vo1[1]) :: "memory"); }
    if constexpr (SP2) {
        PG8_STAGE(PG8_SB(0, 0), cB, voffB); PG8_STAGE(PG8_SB(0, 1), cB + hstepB, voffB); PG8_STAGEA(PG8_SA(0, 0), cA, 0, false); PG8_STAGEA(PG8_SA(0, 1), cA, 1, false);
        if (wr == 1) PG8_BAR;
        PG8_WAIT_V(2); PG8_BAR;
        PG8_STAGE(PG8_SB(1, 0), cB + kstep, voffB); PG8_STAGEA(PG8_SA(1, 0), cA + kstep, 0, false); PG8_STAGE(PG8_SB(1, 1), cB + hstepB + kstep, voffB);
        PG8_WAIT_V(6); PG8_BAR;
    } else {
        PG8_STAGE(PG8_SB(0, 0), cB, voffB); PG8_STAGE(PG8_SA(0, 0), cA, voffA); PG8_STAGE(PG8_SB(0, 1), cB + hstepB, voffB); PG8_STAGE(PG8_SA(0, 1), cA + hstepA, voffA);
        if (wr == 1) PG8_BAR;
        PG8_WAIT_V(4); PG8_BAR;
        PG8_STAGE(PG8_SB(1, 0), cB + kstep, voffB); PG8_STAGE(PG8_SA(1, 0), cA + kstep, voffA); PG8_STAGE(PG8_SB(1, 1), cB + hstepB + kstep, voffB);
        PG8_WAIT_V(6); PG8_BAR;
    }
    for (;;) {
        const bool has_next = S.next(ui + 1, nxt);
        const char* nA = (has_next && !GATHER) ? (const char*)g.A + S.aoff(g, nxt) : cA; const char* nB = has_next ? (const char*)g.Bt + S.boff(g, nxt) : cB;
        if constexpr (GATHER) { if (has_next) { PG8_GOFF(nxt, nvo0, nvo1); } else { nvo0[0] = vo0[0]; nvo0[1] = vo0[1]; nvo1[0] = vo1[0]; nvo1[1] = vo1[1]; }
            asm volatile("s_waitcnt vmcnt(0)" : "+v"(nvo0[0]), "+v"(nvo0[1]), "+v"(nvo1[0]), "+v"(nvo1[1]) :: "memory"); }
        for (int t = 0; t < nt; t += 2) {
            const bool last = (t == nt - 2);
            const char* a1 = cA + (size_t)(t + 1) * kstep;
            const char* a2 = last ? nA : cA + (size_t)(t + 2) * kstep; const char* b2 = last ? nB : cB + (size_t)(t + 2) * kstep;
            const char* a3 = a2 + kstep; const char* b3 = b2 + kstep;
            if constexpr (SP2) {
            PG8_LDB(B0, 0, 0); PG8_LDB(B1, 0, 1); PG8_SCHED; PG8_LDA(At, 0, 0); PG8_STAGEA(PG8_SA(1, 1), a1, 1, false);
            PG8_WAIT_V(8); PG8_WAIT_L(0); PG8_BAR; PG8_MMA(0, 0, At, B0); PG8_MMA(0, 1, At, B1); PG8_BAR; PG8_SCHED;
            PG8_LDA(At, 0, 1); PG8_STAGE(PG8_SB(0, 0), b2, voffB); PG8_STAGE(PG8_SB(0, 1), b2 + hstepB, voffB); PG8_STAGEA(PG8_SA(0, 0), a2, 0, last);
            PG8_WAIT_V(8); PG8_WAIT_L(0); PG8_BAR; PG8_MMA(1, 0, At, B0); PG8_MMA(1, 1, At, B1); PG8_BAR; PG8_SCHED;
            PG8_LDB(B0, 1, 0); PG8_LDB(B1, 1, 1); PG8_SCHED; PG8_LDA(At, 1, 0); PG8_STAGEA(PG8_SA(0, 1), a2, 1, last);
            PG8_WAIT_V(8); PG8_WAIT_L(0); PG8_BAR; PG8_MMA(0, 0, At, B0); PG8_MMA(0, 1, At, B1); PG8_BAR; PG8_SCHED;
            PG8_LDA(At, 1, 1); PG8_STAGE(PG8_SB(1, 0), b3, voffB); PG8_STAGE(PG8_SB(1, 1), b3 + hstepB, voffB); PG8_STAGEA(PG8_SA(1, 0), a3, 0, last);
            PG8_WAIT_V(8); PG8_WAIT_L(0); PG8_BAR; PG8_MMA(1, 0, At, B0); PG8_MMA(1, 1, At, B1); PG8_BAR; PG8_SCHED;
            } else {
            PG8_LDB(B0, 0, 0); PG8_SCHED; PG8_LDA(At, 0, 0); PG8_STAGE(PG8_SA(1, 1), a1 + hstepA, voffA);
            PG8_WAIT_L(8); PG8_BAR; PG8_WAIT_L(0); PG8_MMA(0, 0, At, B0); PG8_BAR; PG8_SCHED;
            PG8_LDB(B1, 0, 1); PG8_STAGE(PG8_SB(0, 0), b2, voffB);
            PG8_BAR; PG8_WAIT_L(0); PG8_MMA(0, 1, At, B1); PG8_BAR;
            PG8_LDA(At, 0, 1); PG8_STAGE(PG8_SA(0, 0), a2, voffA);
            PG8_BAR; PG8_WAIT_L(0); PG8_MMA(1, 0, At, B0); PG8_BAR; PG8_SCHED;
            PG8_STAGE(PG8_SB(0, 1), b2 + hstepB, voffB);
            PG8_WAIT_V(6); PG8_BAR; PG8_MMA(1, 1, At, B1); PG8_BAR;
            PG8_LDB(B0, 1, 0); PG8_SCHED; PG8_LDA(At, 1, 0); PG8_STAGE(PG8_SA(0, 1), a2 + hstepA, voffA);
            PG8_WAIT_L(8); PG8_BAR; PG8_WAIT_L(0); PG8_MMA(0, 0, At, B0); PG8_BAR; PG8_SCHED;
            PG8_LDB(B1, 1, 1); PG8_STAGE(PG8_SB(1, 0), b3, voffB);
            PG8_BAR; PG8_WAIT_L(0); PG8_MMA(0, 1, At, B1); PG8_BAR;
            PG8_LDA(At, 1, 1); PG8_STAGE(PG8_SA(1, 0), a3, voffA);
            PG8_BAR; PG8_WAIT_L(0); PG8_MMA(1, 0, At, B0); PG8_BAR; PG8_SCHED;
            PG8_STAGE(PG8_SB(1, 1), b3 + hstepB, voffB);
            PG8_WAIT_V(6); PG8_BAR; PG8_MMA(1, 1, At, B1); PG8_BAR;
            }
        }
        if constexpr (ALIGN_EPI) { if (wr == 0) PG8_BAR; }
        E(acc, cur, wr, wc, fr, fq);
        S.done(cur, lane);
        if (!has_next) break;
#pragma unroll
        for (int a = 0; a < 2; ++a)
#pragma unroll
            for (int b = 0; b < 2; ++b)
#pragma unroll
                for (int m = 0; m < 4; ++m)
#pragma unroll
                    for (int n = 0; n < 2; ++n) acc[a][b][m][n] = (f32x4){0.f, 0.f, 0.f, 0.f};
        cur = nxt; cA = nA; cB = nB; ++ui; nt = S.ktiles(g, cur);
        if constexpr (GATHER) { vo0[0] = nvo0[0]; vo0[1] = nvo0[1]; vo1[0] = nvo1[0]; vo1[1] = nvo1[1]; }
        if constexpr (ALIGN_EPI) { if (wr == 1) PG8_BAR; }
    }
    PG8_WAIT_V(0);
    if constexpr (!ALIGN_EPI) { if (wr == 0) PG8_BAR; }
    PG8_BAR;
#undef PG8_SA
#undef PG8_SB
#undef PG8_STAGE
#undef PG8_LDA
#undef PG8_STAGEA
#undef PG8_GOFF
#undef PG8_LDB
#undef PG8_MMA
#undef PG8_WAIT_V
#undef PG8_WAIT_L
#undef PG8_BAR
#undef PG8_SCHED
}
}

#define XB_TMO      128
#define XB_XCNT(j)  (256  + 64 * (j))
#define XB_XSUB(j)  (1280 + 64 * (j))
#define XB_XGEN(j)  (2304 + 64 * (j))
#define XB_TOP      3328
#define XB_TOPGEN   3392
#define XCD_BAR_WORDS 3456
#define XB_SPIN_CAP (1u << 18)
__device__ __forceinline__ unsigned xb_ld(unsigned* p)              { return __hip_atomic_load(p, __ATOMIC_RELAXED, __HIP_MEMORY_SCOPE_AGENT); }
__device__ __forceinline__ unsigned xb_add(unsigned* p, unsigned v) { return __hip_atomic_fetch_add(p, v, __ATOMIC_RELAXED, __HIP_MEMORY_SCOPE_AGENT); }
__device__ __forceinline__ unsigned xb_xcc_id() { return (unsigned)__builtin_amdgcn_s_getreg((3 << 11) | 20) & 0xFu; }
#define XB_SPIN(cond, bar) do { unsigned _sp = 0; while (cond) { __builtin_amdgcn_s_sleep(1); \
    if ((++_sp & 255u) == 0u) { if (xb_ld(&(bar)[XB_TMO])) break; if (_sp > XB_SPIN_CAP) { atomicAdd(&(bar)[XB_TMO], 1u); break; } } } } while (0)
struct XcdBarrier { unsigned* bar; unsigned x; volatile LAS unsigned* st; };
__device__ __forceinline__ XcdBarrier xcd_barrier_post(unsigned* bar, volatile LAS unsigned* st) {
    XcdBarrier b; b.bar = bar; b.x = xb_xcc_id(); b.st = st;
    if (threadIdx.x == 0) (void)xb_add(&bar[XB_XCNT(b.x)], 1u);
    return b;
}
__device__ __forceinline__ void xcd_barrier_complete(unsigned* bar, unsigned x, unsigned& nloc, unsigned& nx) {
    const unsigned G = gridDim.x * gridDim.y * gridDim.z;
    unsigned sum, cnt, mine, sp = 0u;
    for (;;) {
        sum = 0u; cnt = 0u; mine = 0u;
#pragma unroll
        for (unsigned j = 0; j < 16; ++j) { const unsigned c = xb_ld(&bar[XB_XCNT(j)]); sum += c; cnt += (c > 0u) ? 1u : 0u; mine = (j == x) ? c : mine; }
        if (sum == G) break;
        __builtin_amdgcn_s_sleep(1);
        if ((++sp & 255u) == 0u) { if (xb_ld(&bar[XB_TMO])) break; if (sp > XB_SPIN_CAP) { atomicAdd(&bar[XB_TMO], 1u); break; } }
    }
    nloc = mine > 0u ? mine : 1u; nx = cnt > 0u ? cnt : 1u;
}
__device__ __forceinline__ void xcd_barrier(const XcdBarrier& b) {
    asm volatile("s_waitcnt vmcnt(0)" ::: "memory");
    __syncthreads();
    if (threadIdx.x == 0) {
        unsigned* bar = b.bar;
        __builtin_amdgcn_s_waitcnt(0);
        unsigned nloc = b.st[0], nx = b.st[1];
        if (nloc == 0u) { xcd_barrier_complete(bar, b.x, nloc, nx); b.st[0] = nloc; b.st[1] = nx; }
        const unsigned old = xb_add(&bar[XB_XSUB(b.x)], 1u);
        const unsigned gen = old / nloc;
        if (old + 1u == (gen + 1u) * nloc) {
            __builtin_amdgcn_fence(__ATOMIC_RELEASE, "agent");
            asm volatile("s_waitcnt vmcnt(0)" ::: "memory");
            const unsigned og = xb_add(&bar[XB_TOP], 1u);
            const unsigned tg = og / nx;
            if (og + 1u == (tg + 1u) * nx) xb_add(&bar[XB_TOPGEN], 1u);
            else XB_SPIN(xb_ld(&bar[XB_TOPGEN]) == tg, bar);
            __builtin_amdgcn_fence(__ATOMIC_ACQUIRE, "agent");
            xb_add(&bar[XB_XGEN(b.x)], 1u);
            asm volatile("s_waitcnt vmcnt(0)" ::: "memory");
        } else {
            XB_SPIN(xb_ld(&bar[XB_XGEN(b.x)]) == gen, bar);
            __builtin_amdgcn_fence(__ATOMIC_ACQUIRE, "agent");
            asm volatile("s_waitcnt vmcnt(0)" ::: "memory");
        }
    }
    __syncthreads();
}

struct Args {
    const float* x; const float* c; const float* ada_w; const float* ada_b; const float* mix_g; const float* ffn_g; const float* w_in;
    const float* da_lambda; const float* da_subln; const float* na_rpb; const float* wpa; const float* wpn; const float* wpd; const float* w_out;
    const float* rgw; const float* rgb; const float* rew; const float* reb; const float* ew1; const float* ew3; const float* ew2; const float* fin_g;
    float* out; unsigned char* ws; int ph_lo, ph_hi; int variant, pad;
};

__device__ const double ROPE_INV[32] = {
    1.0, 0.7498942093324559, 0.5623413251903491, 0.4216965034285822, 0.31622776601683794, 0.23713737056616552, 0.1778279410038923, 0.1333521432163324,
    0.1, 0.07498942093324558, 0.05623413251903491, 0.04216965034285822, 0.031622776601683794, 0.023713737056616554, 0.01778279410038923, 0.01333521432163324,
    0.01, 0.007498942093324558, 0.005623413251903491, 0.004216965034285822, 0.0031622776601683794, 0.0023713737056616554, 0.001778279410038923, 0.001333521432163324,
    0.001, 0.0007498942093324559, 0.0005623413251903491, 0.0004216965034285822, 0.00031622776601683794, 0.00023713737056616554, 0.0001778279410038923, 0.0001333521432163324};

__device__ __forceinline__ void sincos_d(double a, float& s, float& c) {
    const double k = __builtin_rint(a * 0.6366197723675814);
    double t = __builtin_fma(-k, 1.5707963267948966, a); t = __builtin_fma(-k, 6.123233995736766e-17, t);
    const double t2 = t * t;
    double sp = -1.0 / 1307674368000.0; sp = sp * t2 + 1.0 / 6227020800.0; sp = sp * t2 - 1.0 / 39916800.0; sp = sp * t2 + 1.0 / 362880.0; sp = sp * t2 - 1.0 / 5040.0; sp = sp * t2 + 1.0 / 120.0; sp = sp * t2 - 1.0 / 6.0; sp = sp * t2 + 1.0; sp *= t;
    double cp = 1.0 / 87178291200.0; cp = cp * t2 - 1.0 / 479001600.0; cp = cp * t2 + 1.0 / 3628800.0; cp = cp * t2 - 1.0 / 40320.0; cp = cp * t2 + 1.0 / 720.0; cp = cp * t2 - 1.0 / 24.0; cp = cp * t2 + 0.5; cp = 1.0 - cp * t2;
    const int q = ((int)k) & 3;
    const double ss = (q == 0) ? sp : (q == 1) ? cp : (q == 2) ? -sp : -cp;
    const double cc = (q == 0) ? cp : (q == 1) ? -sp : (q == 2) ? -cp : sp;
    s = (float)ss; c = (float)cc;
}

__device__ __forceinline__ int dst_row(int mode, int n) {
    if (mode == 1) { const bool rot = (n < 1024) || (n >= ZQD && n < ZVD); if (rot) { const int j = n & 63; return (n & ~63) + ((j & 31) << 1) + (j >> 5); } return n; }
    if (mode == 2) return 256 * (n >> 7) + (n & 127);
    if (mode == 3) return 256 * (n >> 7) + 128 + (n & 127);
    return n;
}
__device__ __forceinline__ void tr_item(const float* W, int N, bf16_t* WT, int ldt, int koff, int mode, LAS float* scr, int item, int lane) {
    const int nblk = N / 32, kb = item / nblk, nb = item % nblk, k0 = 64 * kb, n0 = 32 * nb;
#pragma unroll 8
    for (int i = 0; i < 32; ++i) { const int kk = 2 * i + (lane >> 5); scr[kk * 33 + (lane & 31)] = __builtin_nontemporal_load(&W[(size_t)(k0 + kk) * N + n0 + (lane & 31)]); }
    LDS_WAIT();
    const int c = lane & 7;
#pragma unroll
    for (int j = 0; j < 4; ++j) { const int n = (lane >> 3) + 8 * j; const LAS float* s = scr + (8 * c) * 33 + n;
        float f = 1.0f; if (mode == 1) { const int nn = n0 + n; f = (nn < ZKA || (nn >= ZQN && nn < ZKN) || (nn >= ZQD && nn < ZKD)) ? C2 : (nn >= ZG ? -LOG2E : 1.0f); }
        u32x4 o; o.x = pk2(s[0 * 33] * f, s[1 * 33] * f); o.y = pk2(s[2 * 33] * f, s[3 * 33] * f); o.z = pk2(s[4 * 33] * f, s[5 * 33] * f); o.w = pk2(s[6 * 33] * f, s[7 * 33] * f);
        *(u32x4*)(WT + (size_t)dst_row(mode, n0 + n) * ldt + koff + k0 + 8 * c) = o; }
    LDS_WAIT();
}

__device__ __forceinline__ float max3f(float a, float b, float c) { float r; asm("v_max3_f32 %0, %1, %2, %3" : "=v"(r) : "v"(a), "v"(b), "v"(c)); return r; }
__device__ __forceinline__ int crow(int r, int hi) { return (r & 3) + 8 * (r >> 2) + 4 * hi; }
__device__ __forceinline__ float swapmax(float m) { float a = m, b = m; swap32(a, b); return __builtin_fmaxf(a, b); }
__device__ __forceinline__ float swapsum(float m) { float a = m, b = m; swap32(a, b); return a + b; }
typedef short v4i16_t __attribute__((ext_vector_type(4)));
__device__ __forceinline__ s16x4 vtr(const LAS unsigned char* p) { return __builtin_bit_cast(s16x4, __builtin_amdgcn_ds_read_tr16_b64_v4i16((LAS v4i16_t*)p)); }

template <int DV> struct AttnCfg { static constexpr int ND = DV / 32, NCH = DV / 16, VST = DV * 2 + 64; };

template <int DV> struct TileRegs { u32x4 kr[4]; u32x4 vr[4]; };
template <int DV>
__device__ __forceinline__ void tile_load(TileRegs<DV>& T, const char* zb, const unsigned (&roff)[4], unsigned kcol, unsigned vcol) {
    const unsigned cb = 16u * (threadIdx.x & 7);
#pragma unroll
    for (int i = 0; i < 4; ++i) { T.kr[i] = *(const u32x4*)(zb + (size_t)(roff[i] + kcol + cb)); T.vr[i] = *(const u32x4*)(zb + (size_t)(roff[i] + vcol + cb)); }
}
__device__ __forceinline__ float max16m(const f32x16& p, float m) { float a, b;
    asm("v_max3_f32 %0, %2, %3, %4\n\tv_max3_f32 %1, %5, %6, %7\n\tv_max3_f32 %0, %0, %8, %9\n\tv_max3_f32 %1, %1, %10, %11\n\tv_max3_f32 %0, %0, %12, %13\n\tv_max3_f32 %1, %1, %14, %15\n\t"
        "v_max3_f32 %0, %0, %16, %17\n\tv_max3_f32 %0, %0, %1, %18"
        : "=&v"(a), "=&v"(b) : "v"(p[0]), "v"(p[1]), "v"(p[2]), "v"(p[3]), "v"(p[4]), "v"(p[5]), "v"(p[6]), "v"(p[7]), "v"(p[8]), "v"(p[9]), "v"(p[10]), "v"(p[11]), "v"(p[12]), "v"(p[13]), "v"(p[14]), "v"(p[15]), "v"(m));
    return a; }
template <int DV, class MaskF, class Reload>
__device__ __forceinline__ void attn_tile(f32x16 (&o)[DV / 32], float& m, float& l, const bf16x8 (&qf)[4], TileRegs<DV>& T,
                                          LAS unsigned char* vlds, LAS float* wsf, const MaskF& maskf, const Reload& reload, int lane, int hi) {
    constexpr int ND = AttnCfg<DV>::ND, VST = AttnCfg<DV>::VST, KST = 144;
    static_assert(DV == 64, "gather tiles are 64 wide");
    CBAR();
    { LAS unsigned char* kw = vlds + 6144 + (lane >> 3) * KST + (lane & 7) * 16; LAS unsigned char* vw = vlds + (lane >> 3) * VST + (lane & 7) * 16;
#pragma unroll
      for (int i = 0; i < 4; ++i) { *(LAS u32x4*)(kw + 8 * i * KST) = T.kr[i]; *(LAS u32x4*)(vw + 8 * i * VST) = T.vr[i]; } }
    CBAR();
    reload(T);
    f32x16 p; maskf(p);
    { const LAS unsigned char* kp = vlds + 6144 + (lane & 31) * KST + hi * 16;
#pragma unroll
      for (int d0 = 0; d0 < 4; ++d0) { const bf16x8 kf = *(const LAS bf16x8*)(kp + 32 * d0); p = __builtin_amdgcn_mfma_f32_32x32x16_bf16(kf, qf[d0], p, 0, 0, 0); } }
    asm volatile("s_nop 15\n\ts_nop 7" : "+v"(p));
    float mx = max16m(p, m);
    { float a = mx, b = mx; swap32(a, b); mx = max3f(a, b, m); }
    const float mn = (mx > m + RESCALE_THR) ? mx : m;
    const float alpha = fexp2(m - mn);
    m = mn;
    float rs = 0.f;
#pragma unroll
    for (int r = 0; r < 16; ++r) { p[r] = fexp2(p[r] - mn); rs += p[r]; }
    l = l * alpha + rs;
    if (__any(alpha != 1.0f)) {
        CBAR();
        if (hi == 0) wsf[lane & 31] = alpha;
        CBAR();
#pragma unroll
        for (int g4 = 0; g4 < 4; ++g4) { const f32x4 a4 = *(const LAS f32x4*)(wsf + 8 * g4 + 4 * hi);
#pragma unroll
            for (int d0 = 0; d0 < ND; ++d0) { o[d0][4 * g4 + 0] *= a4[0]; o[d0][4 * g4 + 1] *= a4[1]; o[d0][4 * g4 + 2] *= a4[2]; o[d0][4 * g4 + 3] *= a4[3]; } }
        CBAR();
    }
    CBAR();
    u32x4 pw0, pw1;
    pw0.x = cvtpk_s(p[0], p[1]); pw0.y = cvtpk_s(p[2], p[3]); pw0.z = cvtpk_s(p[4], p[5]); pw0.w = cvtpk_s(p[6], p[7]);
    pw1.x = cvtpk_s(p[8], p[9]); pw1.y = cvtpk_s(p[10], p[11]); pw1.z = cvtpk_s(p[12], p[13]); pw1.w = cvtpk_s(p[14], p[15]);
    const bf16x8 pa0 = __builtin_bit_cast(bf16x8, pw0), pa1 = __builtin_bit_cast(bf16x8, pw1);
    const int li = lane & 15, g16 = lane >> 4;
    const LAS unsigned char* vb = vlds + (4 * hi + (li >> 2)) * VST + (16 * (g16 & 1) + 4 * (li & 3)) * 2;
    s16x4 vlo[2][ND], vhi[2][ND];
#pragma unroll
    for (int s = 0; s < 2; ++s)
#pragma unroll
        for (int d0 = 0; d0 < ND; ++d0) { vlo[s][d0] = vtr(vb + (16 * s) * VST + d0 * 64); vhi[s][d0] = vtr(vb + (16 * s + 8) * VST + d0 * 64); }
    __builtin_amdgcn_sched_barrier(0);
#pragma unroll
    for (int s = 0; s < 2; ++s)
#pragma unroll
        for (int d0 = 0; d0 < ND; ++d0) {
            const bf16x8 vf = (bf16x8){vlo[s][d0][0], vlo[s][d0][1], vlo[s][d0][2], vlo[s][d0][3], vhi[s][d0][0], vhi[s][d0][1], vhi[s][d0][2], vhi[s][d0][3]};
            o[d0] = __builtin_amdgcn_mfma_f32_32x32x16_bf16(s == 0 ? pa0 : pa1, vf, o[d0], 0, 0, 0);
        }
    CBAR();
}
template <int ND>
__device__ __forceinline__ void attn_finish(f32x16 (&o)[ND], float l, LAS float* wsf, int lane, int hi) {
    const float inv = frcp(swapsum(l));
    CBAR();
    if (hi == 0) wsf[lane & 31] = inv;
    CBAR();
#pragma unroll
    for (int g4 = 0; g4 < 4; ++g4) { const f32x4 a4 = *(const LAS f32x4*)(wsf + 8 * g4 + 4 * hi);
#pragma unroll
        for (int d0 = 0; d0 < ND; ++d0) { o[d0][4 * g4 + 0] *= a4[0]; o[d0][4 * g4 + 1] *= a4[1]; o[d0][4 * g4 + 2] *= a4[2]; o[d0][4 * g4 + 3] *= a4[3]; } }
    CBAR();
}

__device__ __forceinline__ void glds16s(const void* sbase, unsigned voff, unsigned lds_dst) { unsigned keep;
    asm volatile("s_mov_b32 %0, m0\n\ts_mov_b32 m0, %2\n\ts_nop 0\n\tglobal_load_lds_dwordx4 %1, %3\n\ts_mov_b32 m0, %0" : "=&s"(keep) : "v"(voff), "s"(lds_dst), "s"(sbase) : "memory"); }
__device__ __forceinline__ void glds16(const void* gsrc, unsigned lds_dst) { unsigned keep;
    asm volatile("s_mov_b32 %0, m0\n\ts_mov_b32 m0, %2\n\ts_nop 0\n\tglobal_load_lds_dwordx4 %1, off\n\ts_mov_b32 m0, %0" : "=&s"(keep) : "v"(gsrc), "s"(lds_dst) : "memory"); }
__device__ __forceinline__ void diff_qk(f32x16& p0, f32x16& p1, const LAS unsigned char* qlds, const LAS unsigned char* kb, int lane, int hi) {
    const int r32 = lane & 31, sw = (r32 >> 1) & 7;
    const LAS unsigned char* kp = kb + r32 * 128;
    p0 = f32x16{}; p1 = f32x16{};
#pragma unroll
    for (int d0 = 0; d0 < 4; ++d0) {
        const bf16x8 q = *(const LAS bf16x8*)(qlds + d0 * 1024 + lane * 16);
        const int po = ((2 * d0 + hi) ^ sw) << 4;
        const bf16x8 k0 = *(const LAS bf16x8*)(kp + po), k1 = *(const LAS bf16x8*)(kp + po + 4096);
        p0 = __builtin_amdgcn_mfma_f32_32x32x16_bf16(k0, q, p0, 0, 0, 0);
        p1 = __builtin_amdgcn_mfma_f32_32x32x16_bf16(k1, q, p1, 0, 0, 0);
    }
}
__device__ __forceinline__ void diff_sm_pv(f32x16 (&o)[4], float& m, float& l, f32x16& p0, f32x16& p1, const LAS unsigned char* vbuf, LAS float* wsf, int lane, int hi) {
    const int r32 = lane & 31;
    float ma = max3f(p0[0], p0[1], p1[0]), mb = max3f(p0[2], p0[3], p1[1]); ma = max3f(ma, p1[2], p1[3]);
#pragma unroll
    for (int r = 4; r < 16; r += 4) { ma = max3f(ma, p0[r], p0[r + 1]); mb = max3f(mb, p0[r + 2], p0[r + 3]); ma = max3f(ma, p1[r], p1[r + 1]); mb = max3f(mb, p1[r + 2], p1[r + 3]); }
    float mx = max3f(ma, mb, m);
    { float a = mx, b = mx; swap32(a, b); mx = max3f(a, b, m); }
    const float mn = (mx > m + RESCALE_THR) ? mx : m;
    const float alpha = fexp2(m - mn);
    m = mn;
    float rs = 0.f;
#pragma unroll
    for (int r = 0; r < 16; ++r) { p0[r] = fexp2(p0[r] - mn); p1[r] = fexp2(p1[r] - mn); rs += p0[r] + p1[r]; }
    l = l * alpha + rs;
    if (__any(alpha != 1.0f)) {
        CBAR();
        if (hi == 0) wsf[r32] = alpha;
        CBAR();
#pragma unroll
        for (int g4 = 0; g4 < 4; ++g4) { const f32x4 a4 = *(const LAS f32x4*)(wsf + 8 * g4 + 4 * hi);
#pragma unroll
            for (int d0 = 0; d0 < 4; ++d0) { o[d0][4 * g4 + 0] *= a4[0]; o[d0][4 * g4 + 1] *= a4[1]; o[d0][4 * g4 + 2] *= a4[2]; o[d0][4 * g4 + 3] *= a4[3]; } }
        CBAR();
    }
    u32x4 pw[4];
#pragma unroll
    for (int i = 0; i < 4; ++i) { pw[0][i] = cvtpk_s(p0[2 * i], p0[2 * i + 1]); pw[1][i] = cvtpk_s(p0[8 + 2 * i], p0[9 + 2 * i]); pw[2][i] = cvtpk_s(p1[2 * i], p1[2 * i + 1]); pw[3][i] = cvtpk_s(p1[8 + 2 * i], p1[9 + 2 * i]); }
    const int li = lane & 15, g16 = lane >> 4;
    const LAS unsigned char* vp = vbuf + hi * 1024 + (li >> 2) * 64 + (16 * (g16 & 1) + 4 * (li & 3)) * 2;
#pragma unroll
    for (int s4 = 0; s4 < 4; ++s4) {
        const bf16x8 pa = __builtin_bit_cast(bf16x8, pw[s4]);
#pragma unroll
        for (int d0 = 0; d0 < 4; ++d0) {
            const s16x4 lo = vtr(vp + s4 * 4096 + d0 * 256), hh = vtr(vp + s4 * 4096 + 2048 + d0 * 256);
            const bf16x8 vf = (bf16x8){lo[0], lo[1], lo[2], lo[3], hh[0], hh[1], hh[2], hh[3]};
            o[d0] = __builtin_amdgcn_mfma_f32_32x32x16_bf16(pa, vf, o[d0], 0, 0, 0);
        }
    }
}

__device__ __forceinline__ void diff_sm(f32x16 (&o)[4], float& m, float& l, f32x16& p0, f32x16& p1, u32x4 (&pw)[4], LAS float* wsf, int lane, int hi) {
    const int r32 = lane & 31;
    float ma = max3f(p0[0], p0[1], p1[0]), mb = max3f(p0[2], p0[3], p1[1]); ma = max3f(ma, p1[2], p1[3]);
#pragma unroll
    for (int r = 4; r < 16; r += 4) { ma = max3f(ma, p0[r], p0[r + 1]); mb = max3f(mb, p0[r + 2], p0[r + 3]); ma = max3f(ma, p1[r], p1[r + 1]); mb = max3f(mb, p1[r + 2], p1[r + 3]); }
    float mx = max3f(ma, mb, m);
    { float a = mx, b = mx; swap32(a, b); mx = max3f(a, b, m); }
    const float mn = (mx > m + RESCALE_THR) ? mx : m;
    const float alpha = fexp2(m - mn);
    m = mn;
    float rs = 0.f;
#pragma unroll
    for (int r = 0; r < 16; ++r) { p0[r] = fexp2(p0[r] - mn); p1[r] = fexp2(p1[r] - mn); rs += p0[r] + p1[r]; }
    l = l * alpha + rs;
    if (__any(alpha != 1.0f)) {
        CBAR();
        if (hi == 0) wsf[r32] = alpha;
        CBAR();
#pragma unroll
        for (int g4 = 0; g4 < 4; ++g4) { const f32x4 a4 = *(const LAS f32x4*)(wsf + 8 * g4 + 4 * hi);
#pragma unroll
            for (int d0 = 0; d0 < 4; ++d0) { o[d0][4 * g4 + 0] *= a4[0]; o[d0][4 * g4 + 1] *= a4[1]; o[d0][4 * g4 + 2] *= a4[2]; o[d0][4 * g4 + 3] *= a4[3]; } }
        CBAR();
    }
#pragma unroll
    for (int i = 0; i < 4; ++i) { pw[0][i] = cvtpk_s(p0[2 * i], p0[2 * i + 1]); pw[1][i] = cvtpk_s(p0[8 + 2 * i], p0[9 + 2 * i]); pw[2][i] = cvtpk_s(p1[2 * i], p1[2 * i + 1]); pw[3][i] = cvtpk_s(p1[8 + 2 * i], p1[9 + 2 * i]); }
}
__device__ __forceinline__ void diff_pv2(f32x16 (&o0)[4], f32x16 (&o1)[4], const u32x4 (&pw0)[4], const u32x4 (&pw1)[4], const LAS unsigned char* vbuf, int lane_, int hi_) {
    int lane = lane_; asm volatile("" : "+v"(lane));
    const int hi = lane >> 5; (void)hi_;
    const int li = lane & 15, g16 = lane >> 4;
    const LAS unsigned char* vp = vbuf + hi * 1024 + (li >> 2) * 64 + (16 * (g16 & 1) + 4 * (li & 3)) * 2;
    __builtin_amdgcn_s_setprio(1);
#pragma unroll
    for (int s4 = 0; s4 < 4; ++s4) {
        const bf16x8 pa0 = __builtin_bit_cast(bf16x8, pw0[s4]), pa1 = __builtin_bit_cast(bf16x8, pw1[s4]);
#pragma unroll
        for (int d0 = 0; d0 < 4; ++d0) {
            const s16x4 lo = vtr(vp + s4 * 4096 + d0 * 256), hh = vtr(vp + s4 * 4096 + 2048 + d0 * 256);
            const bf16x8 vf = (bf16x8){lo[0], lo[1], lo[2], lo[3], hh[0], hh[1], hh[2], hh[3]};
            o0[d0] = __builtin_amdgcn_mfma_f32_32x32x16_bf16(pa0, vf, o0[d0], 0, 0, 0);
            o1[d0] = __builtin_amdgcn_mfma_f32_32x32x16_bf16(pa1, vf, o1[d0], 0, 0, 0);
        }
    }
    __builtin_amdgcn_s_setprio(0);
}
__device__ __forceinline__ void diff_qk_f(f32x16& p0, f32x16& p1, const LAS unsigned char* qlds, const LAS unsigned char* kb, const LAS unsigned char* ap, const LAS unsigned char* bp, int lane_, int hi_) {
    int lane = lane_; asm volatile("" : "+v"(lane));
    const int hi = lane >> 5; (void)hi_;
    const int r32 = lane & 31, sw = (r32 >> 1) & 7;
    const LAS unsigned char* kp = kb + r32 * 128;
    { const bf16x8 a1 = *(const LAS bf16x8*)ap, bm = *(const LAS bf16x8*)bp;
      p0 = __builtin_amdgcn_mfma_f32_32x32x16_bf16(a1, bm, f32x16{}, 0, 0, 0);
      p1 = __builtin_amdgcn_mfma_f32_32x32x16_bf16(a1, bm, f32x16{}, 0, 0, 0); }
#pragma unroll
    for (int d0 = 0; d0 < 4; ++d0) {
        const bf16x8 q = *(const LAS bf16x8*)(qlds + d0 * 1024 + lane * 16);
        const int po = ((2 * d0 + hi) ^ sw) << 4;
        const bf16x8 k0 = *(const LAS bf16x8*)(kp + po), k1 = *(const LAS bf16x8*)(kp + po + 4096);
        p0 = __builtin_amdgcn_mfma_f32_32x32x16_bf16(k0, q, p0, 0, 0, 0);
        p1 = __builtin_amdgcn_mfma_f32_32x32x16_bf16(k1, q, p1, 0, 0, 0);
    }
}
__device__ __forceinline__ void diff_sm_head(f32x16 (&o)[4], float& m, float& l, f32x16& p0, f32x16& p1, LAS float* wsf, LAS unsigned char* bslot, bool first, int lane, int hi) {
    float ma = max3f(p0[0], p0[1], p1[0]), mb = max3f(p0[2], p0[3], p1[1]); ma = max3f(ma, p1[2], p1[3]);
#pragma unroll
    for (int r = 4; r < 16; r += 4) { ma = max3f(ma, p0[r], p0[r + 1]); mb = max3f(mb, p0[r + 2], p0[r + 3]); ma = max3f(ma, p1[r], p1[r + 1]); mb = max3f(mb, p1[r + 2], p1[r + 3]); }
    float mx = __builtin_fmaxf(ma, mb);
    { float a = mx, b = mx; swap32(a, b); mx = __builtin_fmaxf(a, b); }
    const bool up = first || (mx > RESCALE_THR);
    if (__any(up)) {
        const float mnew = up ? __builtin_bit_cast(float, f2bf(m + mx) << 16) : m, delta = mnew - m;
        const float alpha = fexp2(-delta);
        m = mnew; l *= alpha;
        CBAR();
        int l2 = lane; asm volatile("" : "+v"(l2));
        if (hi == 0) { wsf[l2 & 31] = alpha; *(LAS unsigned*)bslot = f2bf(-mnew); }
        CBAR();
#pragma unroll
        for (int g4 = 0; g4 < 4; ++g4) { const f32x4 a4 = *(const LAS f32x4*)(wsf + 8 * g4 + 4 * (l2 >> 5));
#pragma unroll
            for (int d0 = 0; d0 < 4; ++d0) { o[d0][4 * g4 + 0] *= a4[0]; o[d0][4 * g4 + 1] *= a4[1]; o[d0][4 * g4 + 2] *= a4[2]; o[d0][4 * g4 + 3] *= a4[3]; } }
#pragma unroll
        for (int r = 0; r < 16; ++r) { p0[r] -= delta; p1[r] -= delta; }
        CBAR();
    }
}
__device__ __forceinline__ void diff_sm_tail(float& l, f32x16& p0, f32x16& p1, u32x4 (&pw)[4]) {
    float rs = 0.f;
#pragma unroll
    for (int r = 0; r < 16; ++r) { p0[r] = fexp2(p0[r]); p1[r] = fexp2(p1[r]); rs += p0[r] + p1[r]; }
    l += rs;
#pragma unroll
    for (int i = 0; i < 4; ++i) { pw[0][i] = cvtpk_s(p0[2 * i], p0[2 * i + 1]); pw[1][i] = cvtpk_s(p0[8 + 2 * i], p0[9 + 2 * i]); pw[2][i] = cvtpk_s(p1[2 * i], p1[2 * i + 1]); pw[3][i] = cvtpk_s(p1[8 + 2 * i], p1[9 + 2 * i]); }
}
__device__ __forceinline__ void diff_tail_pv2(f32x16 (&o0)[4], f32x16 (&o1)[4], float& l0, float& l1, const f32x16& a0, const f32x16& a1, const f32x16& b0, const f32x16& b1, const LAS unsigned char* vbuf, int lane_) {
    int lane = lane_; asm volatile("" : "+v"(lane));
    const int hi = lane >> 5, li = lane & 15, g16 = lane >> 4;
    const LAS unsigned char* vp = vbuf + hi * 1024 + (li >> 2) * 64 + (16 * (g16 & 1) + 4 * (li & 3)) * 2;
    float rs0 = 0.f, rs1 = 0.f;
    u32x4 pa, pb, pan = {0u, 0u, 0u, 0u}, pbn = {0u, 0u, 0u, 0u};
#define TP_A(st, i) do { const int r_ = ((st) & 1) * 8 + 2 * (i); const float e0_ = fexp2((st) < 2 ? a0[r_] : a1[r_]), e1_ = fexp2((st) < 2 ? a0[r_ + 1] : a1[r_ + 1]); rs0 += e0_; rs0 += e1_; asm volatile("" : "+v"(rs0)); pan[i] = cvtpk_s(e0_, e1_); } while (0)
#define TP_B(st, i) do { const int r_ = ((st) & 1) * 8 + 2 * (i); const float e0_ = fexp2((st) < 2 ? b0[r_] : b1[r_]), e1_ = fexp2((st) < 2 ? b0[r_ + 1] : b1[r_ + 1]); rs1 += e0_; rs1 += e1_; asm volatile("" : "+v"(rs1)); pbn[i] = cvtpk_s(e0_, e1_); } while (0)
#pragma unroll
    for (int i = 0; i < 4; ++i) { TP_A(0, i); TP_B(0, i); }
    pa = pan; pb = pbn;
    s16x4 flo[3], fhh[3];
#define TP_RD(c) do { flo[(c) % 3] = vtr(vp + ((c) >> 2) * 4096 + ((c) & 3) * 256); fhh[(c) % 3] = vtr(vp + ((c) >> 2) * 4096 + 2048 + ((c) & 3) * 256); } while (0)
    TP_RD(0); TP_RD(1);
    __builtin_amdgcn_sched_barrier(0);
#pragma unroll
    for (int c = 0; c < 16; ++c) {
        const int st = c >> 2, d0 = c & 3;
        if (c + 2 < 16) TP_RD(c + 2);
        const bf16x8 vf = (bf16x8){flo[c % 3][0], flo[c % 3][1], flo[c % 3][2], flo[c % 3][3], fhh[c % 3][0], fhh[c % 3][1], fhh[c % 3][2], fhh[c % 3][3]};
        o0[d0] = __builtin_amdgcn_mfma_f32_32x32x16_bf16(__builtin_bit_cast(bf16x8, pa), vf, o0[d0], 0, 0, 0);
        if (st < 3) TP_A(st + 1, d0);
        __builtin_amdgcn_sched_barrier(0);
        o1[d0] = __builtin_amdgcn_mfma_f32_32x32x16_bf16(__builtin_bit_cast(bf16x8, pb), vf, o1[d0], 0, 0, 0);
        if (st < 3) TP_B(st + 1, d0);
        __builtin_amdgcn_sched_barrier(0);
        if (d0 == 3) { pa = pan; pb = pbn; }
    }
#undef TP_A
#undef TP_B
#undef TP_RD
    l0 += rs0; l1 += rs1;
}
__device__ __forceinline__ void hm_step(int k, float& ma, float& mb, const f32x16& p0, const f32x16& p1) {
    if (k == 0) ma = max3f(p0[0], p0[1], p1[0]);
    else if (k == 1) mb = max3f(p0[2], p0[3], p1[1]);
    else if (k == 2) ma = max3f(ma, p1[2], p1[3]);
    else { const int j = (k - 3) >> 2, w = (k - 3) & 3, r = 4 + 4 * j;
        if (w == 0) ma = max3f(ma, p0[r], p0[r + 1]); else if (w == 1) mb = max3f(mb, p0[r + 2], p0[r + 3]); else if (w == 2) ma = max3f(ma, p1[r], p1[r + 1]); else mb = max3f(mb, p1[r + 2], p1[r + 3]); }
}
__device__ __forceinline__ void hm_finish(f32x16 (&o)[4], float& m, float& l, float ma, float mb, f32x16& p0, f32x16& p1, LAS float* wsf, LAS unsigned char* bslot, bool first, int lane) {
    float mx = __builtin_fmaxf(ma, mb);
    { float a = mx, b = mx; swap32(a, b); mx = __builtin_fmaxf(a, b); }
    const bool up = first || (mx > RESCALE_THR);
    if (__any(up)) {
        const float mnew = up ? __builtin_bit_cast(float, f2bf(m + mx) << 16) : m, delta = mnew - m;
        const float alpha = fexp2(-delta);
        m = mnew; l *= alpha;
        CBAR();
        int l2 = lane; asm volatile("" : "+v"(l2));
        if ((l2 >> 5) == 0) { wsf[l2 & 31] = alpha; *(LAS unsigned*)bslot = f2bf(-mnew); }
        CBAR();
#pragma unroll
        for (int g4 = 0; g4 < 4; ++g4) { const f32x4 a4 = *(const LAS f32x4*)(wsf + 8 * g4 + 4 * (l2 >> 5));
#pragma unroll
            for (int d0 = 0; d0 < 4; ++d0) { o[d0][4 * g4 + 0] *= a4[0]; o[d0][4 * g4 + 1] *= a4[1]; o[d0][4 * g4 + 2] *= a4[2]; o[d0][4 * g4 + 3] *= a4[3]; } }
#pragma unroll
        for (int r = 0; r < 16; ++r) { p0[r] -= delta; p1[r] -= delta; }
        CBAR();
    }
}
__device__ __forceinline__ void diffA_step(f32x16 (&o0)[4], f32x16 (&o1)[4], float& m0, float& l0, float& m1, float& l1, const LAS unsigned char* qlds, const LAS unsigned char* kb0, const LAS unsigned char* kb1,
                                           const LAS unsigned char* vbuf, LAS unsigned char* bsel, LAS float* wsf, bool first, int lane_) {
    int lane = lane_; asm volatile("" : "+v"(lane));
    const int hi = lane >> 5;
    f32x16 s0, s1, s2, s3;
    diff_qk_f(s0, s1, qlds, kb0, bsel + 32, bsel, lane, hi);
#define SB() __builtin_amdgcn_sched_barrier(0)
    const int r32 = lane & 31, sw = (r32 >> 1) & 7;
    const LAS unsigned char* kp = kb1 + r32 * 128; const LAS unsigned char* qp = qlds + 4096 + lane * 16;
    float ma = 0.f, mb = 0.f, rs0 = 0.f, rs1 = 0.f;
    u32x4 pa, pb, pan, pbn;
#define TP_A(st, i) do { const int r_ = ((st) & 1) * 8 + 2 * (i); const float e0_ = fexp2((st) < 2 ? s0[r_] : s1[r_]), e1_ = fexp2((st) < 2 ? s0[r_ + 1] : s1[r_ + 1]); rs0 += e0_; rs0 += e1_; asm volatile("" : "+v"(rs0)); pan[i] = cvtpk_s(e0_, e1_); } while (0)
#define TP_B(st, i) do { const int r_ = ((st) & 1) * 8 + 2 * (i); const float e0_ = fexp2((st) < 2 ? s2[r_] : s3[r_]), e1_ = fexp2((st) < 2 ? s2[r_ + 1] : s3[r_ + 1]); rs1 += e0_; rs1 += e1_; asm volatile("" : "+v"(rs1)); pbn[i] = cvtpk_s(e0_, e1_); } while (0)
    {
        const bf16x8 a1 = *(const LAS bf16x8*)(bsel + 32), bm = *(const LAS bf16x8*)(bsel + 16);
        bf16x8 qf[2], k0f, k1f;
#define RD_Q(d0)  qf[(d0) & 1] = *(const LAS bf16x8*)(qp + (d0) * 1024)
#define RD_K0(d0) k0f = *(const LAS bf16x8*)(kp + (((2 * (d0) + hi) ^ sw) << 4))
#define RD_K1(d0) k1f = *(const LAS bf16x8*)(kp + (((2 * (d0) + hi) ^ sw) << 4) + 4096)
        RD_Q(0); RD_K0(0); RD_K1(0); RD_Q(1);
        SB();
        s2 = __builtin_amdgcn_mfma_f32_32x32x16_bf16(a1, bm, f32x16{}, 0, 0, 0);
        asm volatile("s_nop 7" : "+v"(s0), "+v"(s1));
        hm_step(0, ma, mb, s0, s1); hm_step(1, ma, mb, s0, s1);
        SB();
        s3 = __builtin_amdgcn_mfma_f32_32x32x16_bf16(a1, bm, f32x16{}, 0, 0, 0);
        hm_step(2, ma, mb, s0, s1); hm_step(3, ma, mb, s0, s1); hm_step(4, ma, mb, s0, s1);
        SB();
        s2 = __builtin_amdgcn_mfma_f32_32x32x16_bf16(k0f, qf[0], s2, 0, 0, 0);
        RD_K0(1);
        hm_step(5, ma, mb, s0, s1); hm_step(6, ma, mb, s0, s1); hm_step(7, ma, mb, s0, s1);
        SB();
        s3 = __builtin_amdgcn_mfma_f32_32x32x16_bf16(k1f, qf[0], s3, 0, 0, 0);
        RD_K1(1); RD_Q(2);
        hm_step(8, ma, mb, s0, s1); hm_step(9, ma, mb, s0, s1); hm_step(10, ma, mb, s0, s1);
        SB();
        s2 = __builtin_amdgcn_mfma_f32_32x32x16_bf16(k0f, qf[1], s2, 0, 0, 0);
        RD_K0(2);
        hm_step(11, ma, mb, s0, s1); hm_step(12, ma, mb, s0, s1);
        SB();
        s3 = __builtin_amdgcn_mfma_f32_32x32x16_bf16(k1f, qf[1], s3, 0, 0, 0);
        RD_K1(2); RD_Q(3);
        hm_step(13, ma, mb, s0, s1); hm_step(14, ma, mb, s0, s1);
        SB();
        hm_finish(o0, m0, l0, ma, mb, s0, s1, wsf, bsel, first, lane);
        SB();
        s2 = __builtin_amdgcn_mfma_f32_32x32x16_bf16(k0f, qf[0], s2, 0, 0, 0);
        RD_K0(3);
        TP_A(0, 0);
        SB();
        s3 = __builtin_amdgcn_mfma_f32_32x32x16_bf16(k1f, qf[0], s3, 0, 0, 0);
        RD_K1(3);
        TP_A(0, 1);
        SB();
        s2 = __builtin_amdgcn_mfma_f32_32x32x16_bf16(k0f, qf[1], s2, 0, 0, 0);
        TP_A(0, 2);
        SB();
        s3 = __builtin_amdgcn_mfma_f32_32x32x16_bf16(k1f, qf[1], s3, 0, 0, 0);
        TP_A(0, 3);
        SB();
#undef RD_Q
#undef RD_K0
#undef RD_K1
#define QK_RD(x)
#undef QK_RD
    }
    pa = pan;
    asm volatile("s_nop 15\n\ts_nop 7" : "+v"(s2), "+v"(s3));
    ma = 0.f; mb = 0.f;
#pragma unroll
    for (int k = 0; k < 15; ++k) hm_step(k, ma, mb, s2, s3);
    hm_finish(o1, m1, l1, ma, mb, s2, s3, wsf, bsel + 16, first, lane);
#pragma unroll
    for (int i = 0; i < 4; ++i) TP_B(0, i);
    pb = pbn;
    const int li = lane & 15, g16 = lane >> 4;
    const LAS unsigned char* vp = vbuf + hi * 1024 + (li >> 2) * 64 + (16 * (g16 & 1) + 4 * (li & 3)) * 2;
    s16x4 flo[3], fhh[3];
#define TP_RD(c) do { flo[(c) % 3] = vtr(vp + (((c) & 15) >> 2) * 4096 + ((c) & 3) * 256); fhh[(c) % 3] = vtr(vp + (((c) & 15) >> 2) * 4096 + 2048 + ((c) & 3) * 256); } while (0)
#define TP_VF(c) ((bf16x8){flo[(c) % 3][0], flo[(c) % 3][1], flo[(c) % 3][2], flo[(c) % 3][3], fhh[(c) % 3][0], fhh[(c) % 3][1], fhh[(c) % 3][2], fhh[(c) % 3][3]})
    TP_RD(0); TP_RD(1);
    SB();
#pragma unroll
    for (int c = 0; c < 16; ++c) {
        const int st = c >> 2, d0 = c & 3;
        if (c + 2 < 16) TP_RD(c + 2);
        o0[d0] = __builtin_amdgcn_mfma_f32_32x32x16_bf16(__builtin_bit_cast(bf16x8, pa), TP_VF(c), o0[d0], 0, 0, 0);
        if (st < 3) TP_A(st + 1, d0);
        SB();
        o1[d0] = __builtin_amdgcn_mfma_f32_32x32x16_bf16(__builtin_bit_cast(bf16x8, pb), TP_VF(c), o1[d0], 0, 0, 0);
        if (st < 3) TP_B(st + 1, d0);
        SB();
        if (d0 == 3) { pa = pan; pb = pbn; }
    }
#undef TP_A
#undef TP_B
#undef TP_RD
#undef TP_VF
#undef SB
    l0 += rs0; l1 += rs1;
}
struct NoMask { __device__ __forceinline__ void operator()(f32x16&) const {} };

using pg8::Unit;
struct EpiZ {
    static constexpr bool PERM = true;
    bf16_t* Z; const float* ropec; const float* ropes;
    __device__ __forceinline__ void operator()(const f32x4 (&acc)[2][2][4][2], const Unit& u, int wr, int wc, int fr, int fq) const {
        const int pn = u.pn;
        const int type = (pn < 2) ? 0 : (pn < 4) ? 1 : (pn < 6) ? 2 : (pn == 6) ? 3 : (pn < 9) ? 2 : (pn < 12) ? 0 : (pn < 15) ? 1 : (pn < 18) ? 2 : 4;
        const int row0 = u.pm * 256 + wr * 64 + fr, col0 = pn * 256 + wc * 32 + 8 * fq;
        const int j0 = 16 * (wc & 1) + 4 * fq;
#pragma unroll
        for (int ai = 0; ai < 2; ++ai) {
            f32x4 cq[4], sq[4];
#pragma unroll
            for (int m = 0; m < 4; ++m) { const int pos = (row0 + ai * 128 + m * 16) & (SEQ - 1); cq[m] = (f32x4){1.f, 1.f, 1.f, 1.f}; sq[m] = (f32x4){0.f, 0.f, 0.f, 0.f};
                if (type < 2) { cq[m] = *(const f32x4*)(ropec + pos * 32 + j0); sq[m] = *(const f32x4*)(ropes + pos * 32 + j0); } }
#pragma unroll
            for (int m = 0; m < 4; ++m) {
                const int row = row0 + ai * 128 + m * 16;
                const f32x4 c4 = cq[m], s4 = sq[m];
                bf16_t* rowp = Z + (size_t)row * ZW + col0;
#pragma unroll
                for (int bj = 0; bj < 2; ++bj) {
                    f32x4 v0 = acc[ai][bj][m][0], v1 = acc[ai][bj][m][1];
                    if (type < 2) {
                        f32x4 w0, w1;
                        w0[0] = v0[0] * c4[0] - v0[1] * s4[0]; w0[1] = v0[1] * c4[0] + v0[0] * s4[0];
                        w0[2] = v0[2] * c4[1] - v0[3] * s4[1]; w0[3] = v0[3] * c4[1] + v0[2] * s4[1];
                        w1[0] = v1[0] * c4[2] - v1[1] * s4[2]; w1[1] = v1[1] * c4[2] + v1[0] * s4[2];
                        w1[2] = v1[2] * c4[3] - v1[3] * s4[3]; w1[3] = v1[3] * c4[3] + v1[2] * s4[3];
                        v0 = w0; v1 = w1;
                    }
                    if (type == 4) {
#pragma unroll
                        for (int j = 0; j < 4; ++j) { v0[j] = __builtin_fmaxf(frcp(1.f + fexp2(v0[j])), 0.f); v1[j] = __builtin_fmaxf(frcp(1.f + fexp2(v1[j])), 0.f); }
                    }
                    u32x4 w; w.x = cvt_pk_bf16(v0[0], v0[1]); w.y = cvt_pk_bf16(v0[2], v0[3]); w.z = cvt_pk_bf16(v1[0], v1[1]); w.w = cvt_pk_bf16(v1[2], v1[3]);
                    st16_wt(rowp + bj * 128, w);
                }
                CBAR();
            }
        }
    }
};
struct EpiProj {
    static constexpr bool PERM = true;
    bf16_t* Mg; const bf16_t* Zg0;
    __device__ __forceinline__ void operator()(const f32x4 (&acc)[2][2][4][2], const Unit& u, int wr, int wc, int fr, int fq) const {
        const int row0 = u.pm * 256 + wr * 64 + fr, col0 = u.pn * 256 + wc * 32 + 8 * fq;
        const bf16_t* Zg = Zg0 + (u.e & 15) * 1024; const int first = u.e >> 4;
#pragma unroll
        for (int ai = 0; ai < 2; ++ai) {
            u32x4 gq[4][2], oq[4][2];
#pragma unroll
            for (int m = 0; m < 4; ++m)
#pragma unroll
                for (int bj = 0; bj < 2; ++bj) { const int row = row0 + ai * 128 + m * 16, col = col0 + bj * 128;
                    gq[m][bj] = *(const u32x4*)(Zg + (size_t)row * ZW + col);
                    oq[m][bj] = first ? (u32x4){0u, 0u, 0u, 0u} : *(const u32x4*)(Mg + (size_t)row * D + col); }
#pragma unroll
            for (int m = 0; m < 4; ++m)
#pragma unroll
                for (int bj = 0; bj < 2; ++bj) { const int row = row0 + ai * 128 + m * 16, col = col0 + bj * 128;
                    const u32x4 g = gq[m][bj], o = oq[m][bj];
                    const f32x4 v0 = acc[ai][bj][m][0], v1 = acc[ai][bj][m][1];
                    const float r0 = bflo(g.x) * v0[0] + bflo(o.x), r1 = bfhi(g.x) * v0[1] + bfhi(o.x), r2 = bflo(g.y) * v0[2] + bflo(o.y), r3 = bfhi(g.y) * v0[3] + bfhi(o.y);
                    const float r4 = bflo(g.z) * v1[0] + bflo(o.z), r5 = bfhi(g.z) * v1[1] + bfhi(o.z), r6 = bflo(g.w) * v1[2] + bflo(o.w), r7 = bfhi(g.w) * v1[3] + bfhi(o.w);
                    u32x4 w; w.x = cvt_pk_bf16(r0, r1); w.y = cvt_pk_bf16(r2, r3); w.z = cvt_pk_bf16(r4, r5); w.w = cvt_pk_bf16(r6, r7);
                    *(u32x4*)(Mg + (size_t)row * D + col) = w; }
            CBAR();
        }
    }
};
struct EpiOut {
    static constexpr bool PERM = true;
    bf16_t* X; const float* gate;
    __device__ __forceinline__ void operator()(const f32x4 (&acc)[2][2][4][2], const Unit& u, int wr, int wc, int fr, int fq) const {
        const int row0 = u.pm * 256 + wr * 64 + fr, col0 = u.pn * 256 + wc * 32 + 8 * fq;
        const int b = (u.pm * 256) / SEQ;
        f32x4 gv[2][2];
#pragma unroll
        for (int bj = 0; bj < 2; ++bj)
#pragma unroll
            for (int n = 0; n < 2; ++n) gv[bj][n] = *(const f32x4*)(gate + (size_t)b * 6 * D + col0 + bj * 128 + 4 * n);
        u32x4 xq[2][4][2];
#pragma unroll
        for (int ai = 0; ai < 2; ++ai)
#pragma unroll
            for (int m = 0; m < 4; ++m)
#pragma unroll
                for (int bj = 0; bj < 2; ++bj) xq[ai][m][bj] = *(const u32x4*)(X + (size_t)(row0 + ai * 128 + m * 16) * D + col0 + bj * 128);
#pragma unroll
        for (int ai = 0; ai < 2; ++ai) {
#pragma unroll
            for (int m = 0; m < 4; ++m)
#pragma unroll
                for (int bj = 0; bj < 2; ++bj) { const u32x4 o = xq[ai][m][bj];
                    const f32x4 r0 = (f32x4){bflo(o.x), bfhi(o.x), bflo(o.y), bfhi(o.y)} + gv[bj][0] * acc[ai][bj][m][0], r1 = (f32x4){bflo(o.z), bfhi(o.z), bflo(o.w), bfhi(o.w)} + gv[bj][1] * acc[ai][bj][m][1];
                    u32x4 w; w.x = cvt_pk_bf16(r0[0], r0[1]); w.y = cvt_pk_bf16(r0[2], r0[3]); w.z = cvt_pk_bf16(r1[0], r1[1]); w.w = cvt_pk_bf16(r1[2], r1[3]);
                    *(u32x4*)(X + (size_t)(row0 + ai * 128 + m * 16) * D + col0 + bj * 128) = w; }
            CBAR();
        }
    }
};
struct EpiSwiglu {
    static constexpr bool PERM = true;
    bf16_t* H;
    __device__ __forceinline__ void operator()(const f32x4 (&acc)[2][2][4][2], const Unit& u, int wr, int wc, int fr, int fq) const {
        const int row0 = u.pm * 256 + wr * 64 + fr, hc = u.pn * 128 + wc * 32 + 8 * fq;
#pragma unroll
        for (int ai = 0; ai < 2; ++ai)
#pragma unroll
            for (int m = 0; m < 4; ++m) {
                const int row = row0 + ai * 128 + m * 16;
                float h[8];
#pragma unroll
                for (int n = 0; n < 2; ++n) { const f32x4 a = acc[ai][0][m][n], b = acc[ai][1][m][n];
#pragma unroll
                    for (int j = 0; j < 4; ++j) h[4 * n + j] = a[j] * frcp(1.f + fexp2(-a[j] * LOG2E)) * b[j]; }
                u32x4 w; w.x = cvt_pk_bf16(h[0], h[1]); w.y = cvt_pk_bf16(h[2], h[3]); w.z = cvt_pk_bf16(h[4], h[5]); w.w = cvt_pk_bf16(h[6], h[7]);
                st16_wt(H + (size_t)row * EH + hc, w);
            }
    }
};
struct EpiY {
    static constexpr bool PERM = true;
    bf16_t* Y;
    __device__ __forceinline__ void operator()(const f32x4 (&acc)[2][2][4][2], const Unit& u, int wr, int wc, int fr, int fq) const {
        const int row0 = u.pm * 256 + wr * 64 + fr, col0 = u.pn * 256 + wc * 32 + 8 * fq;
#pragma unroll
        for (int ai = 0; ai < 2; ++ai)
#pragma unroll
            for (int m = 0; m < 4; ++m) { bf16_t* rowp = Y + (size_t)(row0 + ai * 128 + m * 16) * D + col0;
#pragma unroll
                for (int bj = 0; bj < 2; ++bj) { const f32x4 v0 = acc[ai][bj][m][0], v1 = acc[ai][bj][m][1];
                    u32x4 w; w.x = cvt_pk_bf16(v0[0], v0[1]); w.y = cvt_pk_bf16(v0[2], v0[3]); w.z = cvt_pk_bf16(v1[0], v1[1]); w.w = cvt_pk_bf16(v1[2], v1[3]);
                    *(u32x4*)(rowp + bj * 128) = w; } }
    }
};

constexpr int NWAVES = 8;
constexpr int NPHASE = 2 + 9 * DEPTH;

__global__ void __launch_bounds__(NWAVES * 64, 2) fwd_kernel(Args args) {
    extern __shared__ __attribute__((aligned(16))) unsigned char lds_raw[];
    LAS unsigned char* lds = (LAS unsigned char*)lds_raw;
    volatile LAS unsigned* MISC = (volatile LAS unsigned*)(lds + MISC_OFF);
    const int tid0 = threadIdx.x;
    const int G = gridDim.x, bx = blockIdx.x;
    const int vcu = (G % 8 == 0) ? (bx % 8) * (G / 8) + bx / 8 : bx;
    const int NGW = G * NWAVES;
#define WSP() size_t wsz_ = 0; asm volatile("" : "+s"(wsz_)); unsigned char* ws = args.ws + wsz_; \
    int tid = tid0; asm volatile("" : "+v"(tid)); const int lane = tid & 63, wave = __builtin_amdgcn_readfirstlane(tid >> 6), hi = lane >> 5, gw = vcu * NWAVES + wave; (void)hi; (void)gw; (void)lane; (void)wave; \
    unsigned* ctl = (unsigned*)(ws + WS_CTL); float* rtab = (float*)(ws + WS_RT); (void)rtab; float* modp = (float*)(ws + WS_MOD); float* ropec = (float*)(ws + WS_ROPE); float* ropes = ropec + SEQ * 32; \
    int* tok_e = (int*)(ws + WS_ROUTE); int* tok_pos = tok_e + 2 * M; float* tok_w = (float*)(tok_pos + 2 * M); int* tok_slot = (int*)(tok_w + 2 * M); int* etok = (int*)(ws + WS_ROUTE + 2 * MiB); \
    bf16_t* X = (bf16_t*)(ws + WS_X); bf16_t* Hn = (bf16_t*)(ws + WS_H); bf16_t* OC = (bf16_t*)(ws + WS_OCAT); bf16_t* MG = (bf16_t*)(ws + WS_MERGED); bf16_t* Z = (bf16_t*)(ws + WS_Z); \
    bf16_t* XG = (bf16_t*)(ws + WS_XG); bf16_t* HB = (bf16_t*)(ws + WS_HB); bf16_t* YB = (bf16_t*)(ws + WS_YB); \
    bf16_t* WIN = (bf16_t*)(ws + WS_WIN); bf16_t* WPR = (bf16_t*)(ws + WS_WPROJ); bf16_t* WOU = (bf16_t*)(ws + WS_WOUT); bf16_t* W13 = (bf16_t*)(ws + WS_W13); bf16_t* W2 = (bf16_t*)(ws + WS_W2); \
    (void)ctl; (void)modp; (void)ropec; (void)ropes; (void)tok_e; (void)tok_pos; (void)tok_w; (void)tok_slot; (void)etok; (void)X; (void)Hn; (void)OC; (void)MG; (void)Z; (void)XG; (void)HB; (void)YB; (void)WIN; (void)WPR; (void)WOU; (void)W13; (void)W2;
    for (int u = tid0; u < 128; u += NWAVES * 64) MISC[u] = 0u;
    __syncthreads();
#if !MK_PER_PHASE
    XcdBarrier bar = xcd_barrier_post((unsigned*)(args.ws + WS_CTL) + CW_BAR, MISC + 8);
#define GRID_BAR() xcd_barrier(bar)
#else
#define GRID_BAR() do {} while (0)
#endif
    const int lo = args.ph_lo, hi_ph = args.ph_hi;
#define IN(k) (lo <= (k) && (k) < hi_ph)
#ifndef EN_MASK
#define EN_MASK 0x3ff
#endif
#define EN(k) ((EN_MASK >> (k)) & 1)
#ifndef DUPK
#define DUPK -1
#endif
#define REP(k) for (int rep_ = 0; rep_ < ((k) == DUPK ? 2 : 1); ++rep_, __syncthreads())
#define SEAM(k) do { if (IN(k) && IN((k) + 1)) GRID_BAR(); } while (0)

    if (IN(0) && EN(0)) REP(0) {
        WSP();
        {
            LAS float* cact = (LAS float*)lds;
            LAS float* part = (LAS float*)(lds + 16384);
            for (int i = tid; i < NBATCH * D; i += NWAVES * 64) { const int b = i / D, k = i % D; const float v = args.c[i]; cact[k * 4 + b] = v / (1.f + __expf(-v)); }
            __syncthreads();
            for (int it = bx; it < DEPTH * 96; it += G) {
                const int l = it / 96, cc = it % 96, col = cc * 64 + lane;
                const float* wp = args.ada_w + (size_t)l * D * 6 * D + col;
                float a0 = 0.f, a1 = 0.f, a2 = 0.f, a3 = 0.f;
#pragma unroll 1
                for (int k0 = 0; k0 < 128; k0 += 32) {
                    float wv[32];
#pragma unroll
                    for (int kk = 0; kk < 32; ++kk) wv[kk] = wp[(size_t)(wave * 128 + k0 + kk) * 6 * D];
#pragma unroll
                    for (int kk = 0; kk < 32; ++kk) { const f32x4 cv = *(const LAS f32x4*)(cact + (wave * 128 + k0 + kk) * 4);
                        a0 += cv[0] * wv[kk]; a1 += cv[1] * wv[kk]; a2 += cv[2] * wv[kk]; a3 += cv[3] * wv[kk]; } }
                part[(wave * 4 + 0) * 64 + lane] = a0; part[(wave * 4 + 1) * 64 + lane] = a1; part[(wave * 4 + 2) * 64 + lane] = a2; part[(wave * 4 + 3) * 64 + lane] = a3;
                __syncthreads();
                if (tid < 256) { const int b = tid >> 6, cl = tid & 63; float s = 0.f;
#pragma unroll
                    for (int w = 0; w < 8; ++w) s += part[(w * 4 + b) * 64 + cl];
                    modp[((size_t)l * NBATCH + b) * 6 * D + cc * 64 + cl] = s + args.ada_b[(size_t)l * 6 * D + cc * 64 + cl]; }
                __syncthreads();
            }
        }
        for (int i = (vcu * NWAVES * 64) + tid; i < SEQ * 32; i += G * NWAVES * 64) { const int pos = i >> 5, j = i & 31; float s, c; sincos_d((double)pos * ROPE_INV[j], s, c); ropec[i] = c; ropes[i] = s; }
        for (int i = (vcu * NWAVES * 64) + tid; i < DEPTH * 36 * D; i += G * NWAVES * 64) { const int k = i & (D - 1), n = (i >> 10) % 36, l2 = i / (36 * D);
            rtab[i] = n < 4 ? args.rgw[((size_t)l2 * D + k) * 4 + n] : args.rew[((size_t)l2 * D + k) * NEXP + (n - 4)]; }
        {
            LAS float* scr = (LAS float*)(lds + wave * 16384);
            constexpr int I_WIN = 16 * 240, I_PA = 8 * 32, I_PN = 4 * 32, I_WO = 16 * 32, I_E = 256, PER_L = I_WIN + I_PA + 2 * I_PN + I_WO + NEXP * 3 * I_E;
            for (int it = gw; it < DEPTH * PER_L; it += NGW) {
                const int l = it / PER_L; int r = it % PER_L;
                if (r < I_WIN) { tr_item(args.w_in + (size_t)l * D * ZW, ZW, WIN + (size_t)l * ZW * D, D, 0, 1, scr, r, lane); continue; } r -= I_WIN;
                if (r < I_PA) { tr_item(args.wpa + (size_t)l * 512 * D, D, WPR + (size_t)l * D * D, D, 0, 0, scr, r, lane); continue; } r -= I_PA;
                if (r < I_PN) { tr_item(args.wpn + (size_t)l * 256 * D, D, WPR + (size_t)l * D * D, D, 512, 0, scr, r, lane); continue; } r -= I_PN;
                if (r < I_PN) { tr_item(args.wpd + (size_t)l * 256 * D, D, WPR + (size_t)l * D * D, D, 768, 0, scr, r, lane); continue; } r -= I_PN;
                if (r < I_WO) { tr_item(args.w_out + (size_t)l * D * D, D, WOU + (size_t)l * D * D, D, 0, 0, scr, r, lane); continue; } r -= I_WO;
                const int e = r / (3 * I_E), q = r % (3 * I_E); const size_t le = (size_t)l * NEXP + e;
                if (q < I_E) tr_item(args.ew1 + le * D * EH, EH, W13 + le * 1024 * D, D, 0, 2, scr, q, lane);
                else if (q < 2 * I_E) tr_item(args.ew3 + le * D * EH, EH, W13 + le * 1024 * D, D, 0, 3, scr, q - I_E, lane);
                else tr_item(args.ew2 + le * EH * D, D, W2 + le * D * EH, EH, 0, 0, scr, q - 2 * I_E, lane);
            }
        }
    }
    SEAM(0);

    for (int l = 0; l < DEPTH; ++l) {
        const int pb = 1 + 9 * l;
        if (IN(pb + 0) && EN(1)) {
            WSP(); const float* modl = modp + (size_t)l * NBATCH * 6 * D; (void)modl;
            const float* gam = args.mix_g + (size_t)l * D;
            const float* modprev = modp + (size_t)(l > 0 ? l - 1 : 0) * NBATCH * 6 * D;
            constexpr int RPW = M / (256 * NWAVES); const int rbase = gw * RPW, b = rbase / SEQ;
            int slot_v = 0; float w_v = 0.f;
            if (l > 0) {
                const unsigned* cntp = ctl + CW_CNT + (l - 1) * NEXP * 64;
                const int cv = (lane < NEXP) ? (int)__hip_atomic_load(cntp + lane * 64, __ATOMIC_RELAXED, __HIP_MEMORY_SCOPE_AGENT) : 0;
                const int tl = (cv + 255) >> 8; int tstart = 0, run = 0;
#pragma unroll
                for (int e = 0; e < NEXP; ++e) { if (lane == e) tstart = run; run += __builtin_amdgcn_readlane(tl, e); }
                const int i = min(lane, 2 * RPW - 1);
                const int e = tok_e[2 * rbase + i], pos = tok_pos[2 * rbase + i]; w_v = tok_w[2 * rbase + i];
                slot_v = __builtin_amdgcn_ds_bpermute(4 * e, tstart) * 256 + pos;
            }
            f32x4 ca[4], cb[4], gf[4];
#pragma unroll
            for (int j = 0; j < 4; ++j) { const int col = 4 * lane + 256 * j;
                const f32x4 g4 = *(const f32x4*)(gam + col), sc = *(const f32x4*)(modl + (size_t)b * 6 * D + 1 * D + col), sh = *(const f32x4*)(modl + (size_t)b * 6 * D + col);
                ca[j] = g4 * (sc + 1.0f); cb[j] = sh; gf[j] = *(const f32x4*)(modprev + (size_t)b * 6 * D + 5 * D + col); }
#pragma unroll 1
            for (int r0 = rbase; r0 < rbase + RPW; r0 += 4) {
                f32x4 v[4][4];
                if (l == 0) {
#pragma unroll
                    for (int q = 0; q < 4; ++q)
#pragma unroll
                        for (int j = 0; j < 4; ++j) v[q][j] = *(const f32x4*)(args.x + (size_t)(r0 + q) * D + 4 * lane + 256 * j);
                } else {
                    u32x2 xr[4][4], y0[4][4], y1[4][4]; float w0[4], w1[4];
#pragma unroll
                    for (int q = 0; q < 4; ++q) { const int ix = 2 * (r0 - rbase + q);
                        const int s0 = __builtin_amdgcn_readlane(slot_v, ix), s1 = __builtin_amdgcn_readlane(slot_v, ix + 1);
                        w0[q] = __builtin_bit_cast(float, __builtin_amdgcn_readlane(__builtin_bit_cast(int, w_v), ix)); w1[q] = __builtin_bit_cast(float, __builtin_amdgcn_readlane(__builtin_bit_cast(int, w_v), ix + 1));
#pragma unroll
                        for (int j = 0; j < 4; ++j) { const int col = 4 * lane + 256 * j;
                            xr[q][j] = *(const u32x2*)(X + (size_t)(r0 + q) * D + col); y0[q][j] = *(const u32x2*)(YB + (size_t)s0 * D + col); y1[q][j] = *(const u32x2*)(YB + (size_t)s1 * D + col); } }
#pragma unroll
                    for (int q = 0; q < 4; ++q)
#pragma unroll
                        for (int j = 0; j < 4; ++j) { const f32x4 yy = bf4(y0[q][j]) * w0[q] + bf4(y1[q][j]) * w1[q]; v[q][j] = bf4(xr[q][j]) + gf[j] * yy; }
                }
#pragma unroll
                for (int q = 0; q < 4; ++q) { const int row = r0 + q;
                    float ss = 0.f;
#pragma unroll
                    for (int j = 0; j < 4; ++j) { u32x2 xw; xw.x = cvt_pk_bf16(v[q][j][0], v[q][j][1]); xw.y = cvt_pk_bf16(v[q][j][2], v[q][j][3]); *(u32x2*)(X + (size_t)row * D + 4 * lane + 256 * j) = xw;
                        ss += (v[q][j][0] * v[q][j][0] + v[q][j][1] * v[q][j][1]) + (v[q][j][2] * v[q][j][2] + v[q][j][3] * v[q][j][3]); }
                    const float rstd = 1.0f / sqrtf(wave_sum(ss) * (1.f / D) + NORM_EPS);
#pragma unroll
                    for (int j = 0; j < 4; ++j) { const int col = 4 * lane + 256 * j;
                        const f32x4 hv = v[q][j] * rstd * ca[j] + cb[j];
                        u32x2 w; w.x = cvt_pk_bf16(hv[0], hv[1]); w.y = cvt_pk_bf16(hv[2], hv[3]);
                        *(u32x2*)(Hn + (size_t)row * D + col) = w; }
                }
            }
        }
        SEAM(pb + 0);
        if (IN(pb + 1) && EN(2)) REP(2) {
            WSP(); const float* modl = modp + (size_t)l * NBATCH * 6 * D; (void)modl;
            pg8::Gemm g{Hn, WIN + (size_t)l * ZW * D, D, D, D}; pg8::StaticOrder S; S.init(M, ZW, G, bx);
            EpiZ E{Z, ropec, ropes};
            pg8::gemm_phase<EpiZ, pg8::StaticOrder>(lds, g, S, E);
        }
        SEAM(pb + 1);
        if (IN(pb + 2) && EN(3)) REP(3) {
            WSP(); const float* modl = modp + (size_t)l * NBATCH * 6 * D; (void)modl;
            {
                int tidm = tid0; asm volatile("" : "+v"(tidm)); const int lane = tidm & 63, hi = lane >> 5;
                LAS unsigned char* vlds = lds + wave * 12288; LAS float* wsf = (LAS float*)(lds + 98304 + wave * 256);
                const float* lp = args.da_lambda + (size_t)l * 4 * 64;
                const float s01 = wave_sum(lp[lane] * lp[64 + lane]), s23 = wave_sum(lp[128 + lane] * lp[192 + lane]);
                const float lam_init = 0.8f - 0.6f * __expf(-0.3f * (float)l);
                const float lam = __expf(s01) - __expf(s23) + lam_init;
                LAS float* wsfA = (LAS float*)(lds + 131072 + wave * 128);
                const unsigned lds0 = (unsigned)(uintptr_t)lds;
                for (int un = vcu; un < NBATCH * 4 * 16; un += G) {
                    const int b = un >> 6, h = (un >> 4) & 3, qb = un & 15;
                    const size_t rowbase = (size_t)b * SEQ; const int q0 = qb * 256 + wave * 32;
                    LAS unsigned char* qlds = lds + 65536 + wave * 8192;
                    { bf16x8 qf[8];
                      const bf16_t* qp = Z + (rowbase + q0 + (lane & 31)) * ZW + ZQA + h * 128 + 8 * hi;
#pragma unroll
                      for (int i = 0; i < 8; ++i) qf[i] = *(const bf16x8*)(qp + 16 * i);
                      asm volatile("s_waitcnt vmcnt(0)" : "+v"(qf[0]), "+v"(qf[1]), "+v"(qf[2]), "+v"(qf[3]), "+v"(qf[4]), "+v"(qf[5]), "+v"(qf[6]), "+v"(qf[7]) :: "memory");
#pragma unroll
                      for (int i = 0; i < 8; ++i) *(LAS bf16x8*)(qlds + i * 1024 + lane * 16) = qf[i]; }
                    f32x16 o0[4], o1[4];
#pragma unroll
                    for (int d0 = 0; d0 < 4; ++d0) { o0[d0] = f32x16{}; o1[d0] = f32x16{}; }
                    float m0 = 0.f, l0 = 0.f, m1 = 0.f, l1 = 0.f;
                    LAS unsigned char* bsel = lds + 132096 + (hi ? 0 : 64 + (wave * 32 + (lane & 31)) * 48);
                    { unsigned z0 = 0u, e0 = hi ? 0u : 0x3F80u; asm volatile("" : "+v"(z0), "+v"(e0));
                      *(LAS u32x4*)bsel = (u32x4){z0, z0, z0, z0}; *(LAS u32x4*)(bsel + 16) = (u32x4){z0, z0, z0, z0}; *(LAS u32x4*)(bsel + 32) = (u32x4){e0, z0, z0, z0}; }
                    const int krow = 8 * wave + (lane >> 3);
                    const unsigned koff = (unsigned)(((rowbase + krow) * ZW + ZKA + h * 128) * 2 + (((lane & 7) ^ ((krow >> 1) & 7)) << 4));
                    const unsigned voff = (unsigned)(((rowbase + 8 * wave + ((lane >> 2) & 3)) * ZW + ZVA + h * 128 + (4 * (lane >> 4) + (lane & 3)) * 8) * 2);
#define DIFF_DMA(t, bo) do { const char* zb_ = (const char*)Z + (size_t)(t) * 64 * ZW * 2; \
        glds16s(zb_, koff, (unsigned)__builtin_amdgcn_readfirstlane((int)(lds0 + ((bo) * 2 + 0) * 8192 + wave * 1024))); \
        glds16s(zb_ + 128, koff, (unsigned)__builtin_amdgcn_readfirstlane((int)(lds0 + ((bo) * 2 + 1) * 8192 + wave * 1024))); \
        glds16s(zb_, voff, (unsigned)__builtin_amdgcn_readfirstlane((int)(lds0 + 32768 + (bo) * 16384 + wave * 2048))); \
        glds16s(zb_ + (size_t)4 * ZW * 2, voff, (unsigned)__builtin_amdgcn_readfirstlane((int)(lds0 + 32768 + (bo) * 16384 + wave * 2048 + 1024))); } while (0)
#define DIFF_SYNC() do { asm volatile("s_waitcnt vmcnt(0) lgkmcnt(0)" ::: "memory"); __builtin_amdgcn_s_barrier(); asm volatile("" ::: "memory"); } while (0)
                    DIFF_DMA(0, 0);
#pragma unroll 1
                    for (int t = 0; t < SEQ / 64; ++t) {
                        const int bo = t & 1;
                        DIFF_SYNC();
                        if (t + 1 < SEQ / 64) DIFF_DMA(t + 1, bo ^ 1);
                        diffA_step(o0, o1, m0, l0, m1, l1, qlds, lds + (bo * 2 + 0) * 8192, lds + (bo * 2 + 1) * 8192, lds + 32768 + bo * 16384, bsel, wsfA, t == 0, lane);
                    }
                    DIFF_SYNC();
#undef DIFF_DMA
#undef DIFF_SYNC
                    int lane_e = lane; asm volatile("" : "+v"(lane_e)); const int hi_e = lane_e >> 5;
                    attn_finish<4>(o0, l0, wsfA, lane_e, hi_e);
                    attn_finish<4>(o1, l1, wsfA, lane_e, hi_e);
                    const float* sg = args.da_subln + (size_t)l * 128;
                    float g4[4];
#pragma unroll
                    for (int d0 = 0; d0 < 4; ++d0) g4[d0] = sg[32 * d0 + (lane_e & 31)] * (1.0f - lam_init);
#pragma unroll
                    for (int r = 0; r < 16; ++r) {
                        float ov[4];
#pragma unroll
                        for (int d0 = 0; d0 < 4; ++d0) ov[d0] = o0[d0][r] - lam * o1[d0][r];
                        float ss = ov[0] * ov[0] + ov[1] * ov[1] + ov[2] * ov[2] + ov[3] * ov[3];
                        ss = half_sum(ss);
                        const float rn = 1.0f / sqrtf(ss * (1.f / 128.f) + NORM_EPS);
                        bf16_t* op = OC + (rowbase + q0 + crow(r, hi_e)) * D + h * 128 + (lane_e & 31);
#pragma unroll
                        for (int d0 = 0; d0 < 4; ++d0) op[32 * d0] = (bf16_t)f2bf(ov[d0] * rn * g4[d0]);
                    }
                }
                asm volatile("s_waitcnt vmcnt(0) lgkmcnt(0)" ::: "memory"); __builtin_amdgcn_s_barrier();
            }
            {
                int tidm = tid0; asm volatile("" : "+v"(tidm)); const int lane = tidm & 63, hi = lane >> 5;
                LAS unsigned char* vlds = lds + wave * 12288; LAS float* wsf = (LAS float*)(lds + 98304 + wave * 256);
                LAS float* tab = (LAS float*)(lds + 100352);
                { const float* rpb = args.na_rpb + (size_t)l * 4 * 15 * 31;
                  for (int i = wave * 64 + lane; i < 4 * 15 * 128; i += NWAVES * 64) { const int j = (i & 127) - 48, hb = i >> 7; tab[i] = (j >= 0 && j <= 30) ? rpb[hb * 31 + j] * LOG2E : 0.f; } }
                asm volatile("s_waitcnt vmcnt(0) lgkmcnt(0)" ::: "memory"); __builtin_amdgcn_s_barrier(); asm volatile("" ::: "memory");
                const char* zb = (const char*)Z;
                for (int wu = gw; wu < NBATCH * 4 * 64 * 2; wu += NGW) {
                    const int half = wu & 1, gr = (wu >> 1) & 63, h = (wu >> 7) & 3, b = wu >> 9;
                    const int rowb = b * SEQ; const int c0 = half * 32, cq = c0 + (lane & 31);
                    const int kr0 = min(max(gr - 4, 0), 56), cs = min(max(cq - 8, 0), 48);
                    bf16x8 qf[4];
                    { const unsigned qoff = (unsigned)(((rowb + gr * 64 + cq) * ZW + ZQN + h * 64 + 8 * hi) * 2);
#pragma unroll
                      for (int d0 = 0; d0 < 4; ++d0) qf[d0] = *(const bf16x8*)(zb + (size_t)(qoff + 32u * d0)); }
                    f32x16 o[2]; o[0] = f32x16{}; o[1] = f32x16{};
                    float mrun = NEGBIG, lrun = 0.f;
                    const unsigned kcol = (unsigned)((ZKN + h * 64) * 2), vcol = (unsigned)((ZVN + h * 64) * 2);
                    unsigned rb0[4];
#pragma unroll
                    for (int i = 0; i < 4; ++i) rb0[i] = (unsigned)((rowb + kr0 * 64 + 8 * i + (lane >> 3)) * ZW * 2);
                    TileRegs<64> cur;
                    tile_load<64>(cur, zb, rb0, kcol, vcol);
#pragma unroll 1
                    for (int t = 0; t < 16; ++t) {
                        const int kr = kr0 + (t >> 1), ch = t & 1;
                        auto reload = [&](TileRegs<64>& T) { const unsigned adv = (unsigned)min(t + 1, 15) * (32u * ZW * 2u); unsigned rr[4];
#pragma unroll
                          for (int i = 0; i < 4; ++i) rr[i] = rb0[i] + adv;
                          tile_load<64>(T, zb, rr, kcol, vcol); };
                        const LAS float* bp = tab + (h * 15 + (kr - gr + 7)) * 128 + (32 * ch + 4 * hi - cq + 63);
                        const int u0 = 32 * ch + 4 * hi - cs;
                        auto maskf = [&](f32x16& p) {
#pragma unroll
                            for (int r = 0; r < 16; ++r) { const int co = (r & 3) + 8 * (r >> 2);
                                const float bv = bp[co]; p[r] = ((unsigned)(u0 + co) <= 15u) ? bv : NEGBIG; }
                        };
                        attn_tile<64>(o, mrun, lrun, qf, cur, vlds, wsf, maskf, reload, lane, hi);
                    }
                    attn_finish<2>(o, lrun, wsf, lane, hi);
#pragma unroll
                    for (int r = 0; r < 16; ++r) { bf16_t* op = OC + (size_t)(rowb + gr * 64 + c0 + crow(r, hi)) * D + 512 + h * 64 + (lane & 31);
                        op[0] = (bf16_t)f2bf(o[0][r]); op[32] = (bf16_t)f2bf(o[1][r]); }
                }
            }
            {
                int tidm = tid0; asm volatile("" : "+v"(tidm)); const int lane = tidm & 63, hi = lane >> 5;
                LAS unsigned char* vlds = lds + wave * 12288; LAS float* wsf = (LAS float*)(lds + 98304 + wave * 256);
                const char* zb = (const char*)Z;
                for (int wu = gw; wu < NBATCH * 4 * 8 * 16; wu += NGW) {
                    const int rho = wu & 15, sb = (wu >> 4) & 7, hs = (wu >> 7) & 3, b = wu >> 9;
                    const int rowb = b * SEQ; const int qi = lane & 31; const int tq = 512 * sb + rho + 16 * qi;
                    f32x16 o[2]; o[0] = f32x16{}; o[1] = f32x16{};
                    float mrun = NEGBIG, lrun = 0.f;
                    const unsigned qoff0 = (unsigned)(((rowb + tq) * ZW + ZQD + hs * 64 + 8 * hi) * 2);
                    TileRegs<64> cur;
                    { const int kb0 = 512 * sb + rho - 64;
                      unsigned rr[4];
#pragma unroll
                      for (int i = 0; i < 4; ++i) rr[i] = (unsigned)((rowb + min(max(kb0 + 8 * i + (lane >> 3), 0), SEQ - 1)) * ZW * 2);
                      tile_load<64>(cur, zb, rr, (unsigned)((ZKD + hs * 64) * 2), (unsigned)((ZVD + hs * 64) * 2)); }
#pragma unroll 1
                    for (int gi = 0; gi < 3; ++gi) {
                        const int sh = 2 * gi, res = rho & ((1 << sh) - 1), qa = (512 * sb + rho) >> sh, qk = qa + (16 >> sh) * qi, nsub = SEQ >> sh, ntile = (gi == 0) ? 20 : (gi == 1) ? 8 : 5;
                        const int lo_v = max(qk - 64, 0), span = min(qk + 64, nsub - 1) - lo_v;
                        const unsigned kcol = (unsigned)((ZKD + gi * 256 + hs * 64) * 2), vcol = (unsigned)((ZVD + gi * 256 + hs * 64) * 2), rbase = (unsigned)((rowb + res) * ZW * 2);
                        const int sh2 = sh + 2, res2 = rho & ((1 << sh2) - 1), kbn = ((512 * sb + rho) >> sh2) - 64, nsub2 = SEQ >> sh2;
                        bf16x8 qf[4];
#pragma unroll
                        for (int d0 = 0; d0 < 4; ++d0) qf[d0] = *(const bf16x8*)(zb + (size_t)(qoff0 + (unsigned)(gi * 512) + 32u * d0));
                        int kb = qa - 64;
#pragma unroll 1
                        for (int t = 0; t < ntile; ++t, kb += 32) {
                            auto reload = [&](TileRegs<64>& T) { const bool same = (t + 1 < ntile); const int kbx = same ? kb + 32 : kbn, nsx = same ? nsub : nsub2, shx = same ? sh : sh2;
                              const unsigned rbx = same ? rbase : (unsigned)((rowb + res2) * ZW * 2), kcx = same ? kcol : kcol + 512u, vcx = same ? vcol : vcol + 512u; unsigned rr[4];
                              if (kbx >= 0 && kbx + 32 <= nsx) {
                                  const unsigned b0 = rbx + __umul24((unsigned)((kbx + (lane >> 3)) << shx), ZW * 2u), inc = (8u << shx) * (ZW * 2u);
#pragma unroll
                                  for (int i = 0; i < 4; ++i) rr[i] = b0 + (unsigned)i * inc;
                              } else {
#pragma unroll
                                  for (int i = 0; i < 4; ++i) rr[i] = rbx + __umul24((unsigned)(min(max(kbx + 8 * i + (lane >> 3), 0), nsx - 1) << shx), ZW * 2u);
                              }
                              tile_load<64>(T, zb, rr, kcx, vcx); };
                            const int u0 = kb + 4 * hi - lo_v;
                            auto maskf = [&](f32x16& p) {
#pragma unroll
                                for (int r = 0; r < 16; ++r) { const int co = (r & 3) + 8 * (r >> 2); p[r] = ((unsigned)(u0 + co) <= (unsigned)span) ? 0.f : NEGBIG; }
                            };
                            attn_tile<64>(o, mrun, lrun, qf, cur, vlds, wsf, maskf, reload, lane, hi);
                        }
                    }
                    attn_finish<2>(o, lrun, wsf, lane, hi);
#pragma unroll
                    for (int r = 0; r < 16; ++r) { bf16_t* op = OC + (size_t)(rowb + 512 * sb + rho + 16 * crow(r, hi)) * D + 768 + hs * 64 + (lane & 31);
                        op[0] = (bf16_t)f2bf(o[0][r]); op[32] = (bf16_t)f2bf(o[1][r]); }
                }
            }
        }
        SEAM(pb + 2);
        if (IN(pb + 3) && EN(4)) REP(4) {
            WSP(); const float* modl = modp + (size_t)l * NBATCH * 6 * D; (void)modl;
            pg8::StaticOrder S0; S0.init(M, D, G, bx); pg8::Unit u0; pg8::ProjOrder S; S.pm = 0; S.pn = 0; S.rot = bx & 1;
            const bool have = S0.next(0, u0); S.pm = u0.pm; S.pn = u0.pn;
            if (have) { pg8::Gemm g{OC, WPR + (size_t)l * D * D, D, D, D}; EpiProj E{MG, Z + ZG}; pg8::gemm_phase<EpiProj, pg8::ProjOrder>(lds, g, S, E); }
        }
        SEAM(pb + 3);
        if (IN(pb + 4) && EN(5)) {
            WSP(); const float* modl = modp + (size_t)l * NBATCH * 6 * D; (void)modl;
            pg8::Gemm g{MG, WOU + (size_t)l * D * D, D, D, D}; pg8::StaticOrder S; S.init(M, D, G, bx);
            EpiOut E{X, modl + 2 * D};
            pg8::gemm_phase<EpiOut, pg8::StaticOrder>(lds, g, S, E);
        }
        SEAM(pb + 4);
        if (IN(pb + 5) && EN(6)) {
            WSP(); const float* modl = modp + (size_t)l * NBATCH * 6 * D; (void)modl;
            LAS float* rt = (LAS float*)lds;
            LAS unsigned* lcnt = (LAS unsigned*)(lds + MISC_OFF) + 16;
            LAS unsigned* lbase = lcnt + 32;
            { const float* rsrc = rtab + (size_t)l * 36 * D + 4 * lane; const unsigned lds0 = (unsigned)(uintptr_t)lds;
              for (int pc = wave; pc < 144; pc += NWAVES) glds16(rsrc + (pc >> 2) * D + (pc & 3) * 256, (unsigned)__builtin_amdgcn_readfirstlane((int)(lds0 + (pc >> 2) * (RT_LD * 4) + (pc & 3) * 1024)));
              if (tid < 64) lcnt[tid] = 0u;
              if (tid < 36) rt[tid * RT_LD + D] = tid < 4 ? args.rgb[(size_t)l * 4 + tid] : args.reb[(size_t)l * NEXP + tid - 4];
              asm volatile("s_waitcnt vmcnt(0)" ::: "memory");
            }
            __syncthreads();
            const float* gam = args.ffn_g + (size_t)l * D;
            unsigned* cnt = ctl + CW_CNT + l * NEXP * 64;
            int myE0 = 0, myE1 = 0, myP0 = 0, myP1 = 0, myRow = -1; float myW0 = 0.f, myW1 = 0.f; int nrow = 0;
            f32x4 v[4][4], vn[4][4];
            constexpr int RPW = M / (256 * NWAVES); const int rbase = gw * RPW;
            f32x4 ca[4], cb[4];
            { const int b = rbase / SEQ;
#pragma unroll
              for (int j = 0; j < 4; ++j) { const int col = 4 * lane + 256 * j;
                  const f32x4 g4 = *(const f32x4*)(gam + col), sc = *(const f32x4*)(modl + (size_t)b * 6 * D + 4 * D + col), sh = *(const f32x4*)(modl + (size_t)b * 6 * D + 3 * D + col);
                  ca[j] = g4 * (sc + 1.0f); cb[j] = sh; } }
#define T2_LOAD(dst, rb) do { _Pragma("unroll") for (int q = 0; q < 4; ++q) { const int row = min((rb) + q, M - 1); \
                _Pragma("unroll") for (int j = 0; j < 4; ++j) dst[q][j] = bf4(*(const u32x2*)(X + (size_t)row * D + 4 * lane + 256 * j)); } } while (0)
            T2_LOAD(v, rbase);
#pragma unroll 1
            for (int r0 = rbase; r0 < rbase + RPW; r0 += 4) {
                T2_LOAD(vn, min(r0 + 4, M - 4));
#pragma unroll
                for (int q = 0; q < 4; ++q) {
                    const int row = r0 + q;
                    float ss = 0.f;
#pragma unroll
                    for (int j = 0; j < 4; ++j) { ss += (v[q][j][0] * v[q][j][0] + v[q][j][1] * v[q][j][1]) + (v[q][j][2] * v[q][j][2] + v[q][j][3] * v[q][j][3]); }
                    const float rstd = 1.0f / sqrtf(wave_sum_u(ss) * (1.f / D) + NORM_EPS);
#pragma unroll
                    for (int j = 0; j < 4; ++j) { const int col = 4 * lane + 256 * j;
                        v[q][j] = v[q][j] * rstd * ca[j] + cb[j];
                        u32x2 w; w.x = cvt_pk_bf16(v[q][j][0], v[q][j][1]); w.y = cvt_pk_bf16(v[q][j][2], v[q][j][3]);
                        *(u32x2*)(Hn + (size_t)row * D + col) = w; }
                }
                float LG[4][4];
#pragma unroll
                for (int n = 0; n < 4; ++n) { float a0 = 0.f, a1 = 0.f, a2 = 0.f, a3 = 0.f;
#pragma unroll
                    for (int j = 0; j < 4; ++j) { const f32x4 wv = *(const LAS f32x4*)(rt + n * RT_LD + 4 * lane + 256 * j);
                        a0 += (wv[0] * v[0][j][0] + wv[1] * v[0][j][1]) + (wv[2] * v[0][j][2] + wv[3] * v[0][j][3]);
                        a1 += (wv[0] * v[1][j][0] + wv[1] * v[1][j][1]) + (wv[2] * v[1][j][2] + wv[3] * v[1][j][3]);
                        a2 += (wv[0] * v[2][j][0] + wv[1] * v[2][j][1]) + (wv[2] * v[2][j][2] + wv[3] * v[2][j][3]);
                        a3 += (wv[0] * v[3][j][0] + wv[1] * v[3][j][1]) + (wv[2] * v[3][j][2] + wv[3] * v[3][j][3]); }
                    const float bgn = rt[n * RT_LD + D]; LG[0][n] = wave_sum_u(a0) + bgn; LG[1][n] = wave_sum_u(a1) + bgn; LG[2][n] = wave_sum_u(a2) + bgn; LG[3][n] = wave_sum_u(a3) + bgn; }
#pragma unroll
                for (int q = 0; q < 4; ++q) {
                    const int row = r0 + q;
                    int gsel = 0; float gmx = LG[q][0];
#pragma unroll
                    for (int i = 1; i < 4; ++i) if (LG[q][i] > gmx) { gmx = LG[q][i]; gsel = i; }
                    gsel = __builtin_amdgcn_readfirstlane(gsel);
                    float gsum = 0.f;
#pragma unroll
                    for (int i = 0; i < 4; ++i) gsum += __expf(LG[q][i] - gmx);
                    const float pg = 1.0f / gsum;
                    float le[8];
                    const LAS float* rte = rt + (4 + 8 * gsel) * RT_LD + 4 * lane;
#pragma unroll
                    for (int j8 = 0; j8 < 8; ++j8) { float a = 0.f;
#pragma unroll
                        for (int j = 0; j < 4; ++j) { const f32x4 wv = *(const LAS f32x4*)(rte + j8 * RT_LD + 256 * j); a += (wv[0] * v[q][j][0] + wv[1] * v[q][j][1]) + (wv[2] * v[q][j][2] + wv[3] * v[q][j][3]); }
                        le[j8] = wave_sum_u(a) + rte[j8 * RT_LD + D - 4 * lane]; }
                    int e0 = 0; float m0 = le[0];
#pragma unroll
                    for (int j = 1; j < 8; ++j) if (le[j] > m0) { m0 = le[j]; e0 = j; }
                    int e1 = (e0 == 0) ? 1 : 0; float m1 = -3.0e38f;
#pragma unroll
                    for (int j = 0; j < 8; ++j) if (j != e0 && le[j] > m1) { m1 = le[j]; e1 = j; }
                    const float a1 = __expf(m1 - m0), inv = 1.0f / (1.0f + a1);
                    const float w0 = pg * inv, w1 = pg * a1 * inv;
                    const int E0 = gsel * 8 + e0, E1 = gsel * 8 + e1;
                    if (row < M) {
                        unsigned p0 = 0, p1 = 0;
                        if (lane == 0) { p0 = __hip_atomic_fetch_add(lcnt + E0, 1u, __ATOMIC_RELAXED, __HIP_MEMORY_SCOPE_WORKGROUP); p1 = __hip_atomic_fetch_add(lcnt + E1, 1u, __ATOMIC_RELAXED, __HIP_MEMORY_SCOPE_WORKGROUP); }
                        p0 = __builtin_amdgcn_readfirstlane(p0); p1 = __builtin_amdgcn_readfirstlane(p1);
                        if (lane == nrow) { myE0 = E0; myE1 = E1; myP0 = (int)p0; myP1 = (int)p1; myW0 = w0; myW1 = w1; myRow = row; }
                        ++nrow;
                    }
                }
#pragma unroll
                for (int q = 0; q < 4; ++q)
#pragma unroll
                    for (int j = 0; j < 4; ++j) v[q][j] = vn[q][j];
            }
#undef T2_LOAD
            __syncthreads();
            if (tid < NEXP) { const unsigned c = lcnt[tid]; lbase[tid] = c ? __hip_atomic_fetch_add(cnt + tid * 64, c, __ATOMIC_RELAXED, __HIP_MEMORY_SCOPE_AGENT) : 0u; }
            __syncthreads();
            if (myRow >= 0) { const int q0 = myP0 + (int)lbase[myE0], q1 = myP1 + (int)lbase[myE1]; etok[myE0 * 16384 + q0] = myRow; etok[myE1 * 16384 + q1] = myRow;
                              tok_e[2 * myRow] = myE0; tok_e[2 * myRow + 1] = myE1; tok_pos[2 * myRow] = q0; tok_pos[2 * myRow + 1] = q1;
                              tok_w[2 * myRow] = myW0; tok_w[2 * myRow + 1] = myW1; }
            __syncthreads();
        }
        SEAM(pb + 5);
        if (IN(pb + 8) && EN(8)) {
            WSP();
            const unsigned* cnt = ctl + CW_CNT + l * NEXP * 64; unsigned* tcl = ctl + CW_TILE + l * MAXTILES * 16;
            int n1, n3, n4, R;
            int a_pm, a_pn, a_e, a_ts, a_cn, b_pm, b_pn, b_e, b_ts, b_cn, c_pm, c_pn, c_e, c_ts, c_cn;
            int d_pm, d_pn, d_e, d_ts, d_cn, e_pm, e_pn, e_e, e_ts, e_cn, f_pm, f_pn, f_e, f_ts, f_cn, g_pm, g_pn, g_e, g_ts, g_cn;
            {
                const int cv = (lane < NEXP) ? (int)__hip_atomic_load(cnt + lane * 64, __ATOMIC_RELAXED, __HIP_MEMORY_SCOPE_AGENT) : 0;
                const int tl = (cv + 255) >> 8; int tend = 0, ntile = 0;
#pragma unroll
                for (int e = 0; e < NEXP; ++e) { ntile += __builtin_amdgcn_readlane(tl, e); if (lane == e) tend = ntile; }
                const int U = 4 * ntile, nA = min(U, 2 * G), Nf = G - min(U - nA, G), nB = min(nA, 2 * Nf); R = min(U - nA, G);
                auto moe_unit = [&](int v, int& pm, int& pn, int& e, int& ts, int& cn) { const int t = min(v >> 2, ntile - 1); pm = t; pn = v & 3;
                    e = min((int)__builtin_popcountll(__ballot(lane < NEXP && tend <= t)), NEXP - 1); ts = __builtin_amdgcn_readlane(tend - tl, e); cn = max(__builtin_amdgcn_readlane(cv, e), 1); };
                moe_unit(vcu, a_pm, a_pn, a_e, a_ts, a_cn); moe_unit(G + vcu, b_pm, b_pn, b_e, b_ts, b_cn); moe_unit(nA + vcu, c_pm, c_pn, c_e, c_ts, c_cn);
                n1 = (vcu < nA ? 1 : 0) + (G + vcu < nA ? 1 : 0);
                const int v3 = vcu - R, v4 = nB + vcu;
                moe_unit(v3, d_pm, d_pn, d_e, d_ts, d_cn); moe_unit(v3 + Nf, e_pm, e_pn, e_e, e_ts, e_cn); n3 = (vcu >= R) ? (v3 < nB ? 1 : 0) + (v3 + Nf < nB ? 1 : 0) : 0;
                moe_unit(v4, f_pm, f_pn, f_e, f_ts, f_cn); moe_unit(v4 + G, g_pm, g_pn, g_e, g_ts, g_cn); n4 = (v4 < U ? 1 : 0) + (v4 + G < U ? 1 : 0);
            }
#define MOE_M1(n_, p0, p1) do { const pg8::MoeOrder S{(n_), p0##pm, p1##pm, p0##pn, p1##pn, p0##e, p1##e, (size_t)1024 * D * 2, p0##ts, p1##ts, p0##cn, p1##cn, etok, tcl}; \
            pg8::Gemm g{Hn, W13 + (size_t)l * NEXP * 1024 * D, D, D, D};            \
            EpiSwiglu E{HB}; pg8::gemm_phase<EpiSwiglu, pg8::MoeOrder, true, true, true>(lds, g, S, E); } while (0)
#define MOE_M2(n_, p0, p1) do { \
            if (wave == 0) { const int tb_ = (n_) > 1 ? p1##pm : p0##pm; unsigned sp_ = 0; \
                while ((unsigned)__builtin_amdgcn_readfirstlane((int)__hip_atomic_load(tcl + p0##pm * 16, __ATOMIC_RELAXED, __HIP_MEMORY_SCOPE_AGENT)) < 32u && ++sp_ < XB_SPIN_CAP) __builtin_amdgcn_s_sleep(2); \
                while ((unsigned)__builtin_amdgcn_readfirstlane((int)__hip_atomic_load(tcl + tb_ * 16, __ATOMIC_RELAXED, __HIP_MEMORY_SCOPE_AGENT)) < 32u && ++sp_ < XB_SPIN_CAP) __builtin_amdgcn_s_sleep(2); \
                __builtin_amdgcn_fence(__ATOMIC_ACQUIRE, "agent"); asm volatile("s_waitcnt vmcnt(0)" ::: "memory"); }        \
            __syncthreads(); \
            const pg8::MoeOrder S{(n_), p0##pm, p1##pm, p0##pn, p1##pn, p0##e, p1##e, (size_t)D * EH * 2, p0##ts, p1##ts, p0##cn, p1##cn, etok, nullptr}; \
            pg8::Gemm g{HB, W2 + (size_t)l * NEXP * D * EH, EH, EH, EH}; \
            EpiY E{YB}; pg8::gemm_phase<EpiY, pg8::MoeOrder>(lds, g, S, E); } while (0)
            if (n1) MOE_M1(n1, a_, b_);
            if (vcu < R) MOE_M1(1, c_, c_);
            if (n3) MOE_M2(n3, d_, e_);
            if (n4) MOE_M2(n4, f_, g_);
#undef MOE_M1
#undef MOE_M2
        }
        SEAM(pb + 8);
    }
    if (IN(NPHASE - 1) && EN(9)) {
        WSP();
        const float* modprev = modp + (size_t)(DEPTH - 1) * NBATCH * 6 * D;
        constexpr int RPW = M / (256 * NWAVES); const int rbase = gw * RPW, b = rbase / SEQ;
        int slot_v = 0; float w_v = 0.f;
        { const unsigned* cntp = ctl + CW_CNT + (DEPTH - 1) * NEXP * 64;
          const int cv = (lane < NEXP) ? (int)__hip_atomic_load(cntp + lane * 64, __ATOMIC_RELAXED, __HIP_MEMORY_SCOPE_AGENT) : 0;
          const int tl = (cv + 255) >> 8; int tstart = 0, run = 0;
#pragma unroll
          for (int e = 0; e < NEXP; ++e) { if (lane == e) tstart = run; run += __builtin_amdgcn_readlane(tl, e); }
          const int i = min(lane, 2 * RPW - 1);
          const int e = tok_e[2 * rbase + i], pos = tok_pos[2 * rbase + i]; w_v = tok_w[2 * rbase + i];
          slot_v = __builtin_amdgcn_ds_bpermute(4 * e, tstart) * 256 + pos; }
        f32x4 gf[4], fg[4];
#pragma unroll
        for (int j = 0; j < 4; ++j) { const int col = 4 * lane + 256 * j; gf[j] = *(const f32x4*)(modprev + (size_t)b * 6 * D + 5 * D + col); fg[j] = *(const f32x4*)(args.fin_g + col); }
#pragma unroll 1
        for (int r0 = rbase; r0 < rbase + RPW; r0 += 4) {
            u32x2 xr[4][4], y0[4][4], y1[4][4]; float w0[4], w1[4];
#pragma unroll
            for (int q = 0; q < 4; ++q) { const int ix = 2 * (r0 - rbase + q);
                const int s0 = __builtin_amdgcn_readlane(slot_v, ix), s1 = __builtin_amdgcn_readlane(slot_v, ix + 1);
                w0[q] = __builtin_bit_cast(float, __builtin_amdgcn_readlane(__builtin_bit_cast(int, w_v), ix)); w1[q] = __builtin_bit_cast(float, __builtin_amdgcn_readlane(__builtin_bit_cast(int, w_v), ix + 1));
#pragma unroll
                for (int j = 0; j < 4; ++j) { const int col = 4 * lane + 256 * j;
                    xr[q][j] = *(const u32x2*)(X + (size_t)(r0 + q) * D + col); y0[q][j] = *(const u32x2*)(YB + (size_t)s0 * D + col); y1[q][j] = *(const u32x2*)(YB + (size_t)s1 * D + col); } }
#pragma unroll
            for (int q = 0; q < 4; ++q) { const int row = r0 + q;
                f32x4 v[4]; float ss = 0.f;
#pragma unroll
                for (int j = 0; j < 4; ++j) { const f32x4 yy = bf4(y0[q][j]) * w0[q] + bf4(y1[q][j]) * w1[q]; v[j] = bf4(xr[q][j]) + gf[j] * yy;
                    ss += (v[j][0] * v[j][0] + v[j][1] * v[j][1]) + (v[j][2] * v[j][2] + v[j][3] * v[j][3]); }
                const float rstd = 1.0f / sqrtf(wave_sum(ss) * (1.f / D) + NORM_EPS);
#pragma unroll
                for (int j = 0; j < 4; ++j) *(f32x4*)(args.out + (size_t)row * D + 4 * lane + 256 * j) = v[j] * rstd * fg[j];
            }
        }
    }
#undef IN
#undef SEAM
#undef GRID_BAR
}


#ifndef DBG
#define DBG 0
#endif
#if DBG
constexpr size_t WS_REP = WS_END;
__global__ void dbg_scan(const unsigned* buf, size_t nwords, int is_bf16, unsigned long long* rep) {
    unsigned long long nf = 0, ck = 0;
    for (size_t i = (size_t)blockIdx.x * blockDim.x + threadIdx.x; i < nwords; i += (size_t)gridDim.x * blockDim.x) {
        const unsigned w = buf[i]; ck += (unsigned long long)w * (unsigned long long)((i & 1023) + 1);
        if (is_bf16) { if ((w & 0x7f80u) >= (140u << 7)) ++nf; if ((w & 0x7f800000u) >= (140u << 23)) ++nf; }
        else if ((w & 0x7f800000u) >= (140u << 23)) ++nf;
    }
    for (int o = 32; o >= 1; o >>= 1) { nf += __shfl_xor(nf, o); ck += __shfl_xor(ck, o); }
    if ((threadIdx.x & 63) == 0) { if (nf) atomicAdd(rep, nf); atomicAdd(rep + 1, ck); }
}

__global__ void dbg_scan_cols(const unsigned short* buf, int c0, int c1, unsigned long long* rep) {
    unsigned long long nf = 0;
    const int w = c1 - c0;
    for (size_t i = (size_t)blockIdx.x * blockDim.x + threadIdx.x; i < (size_t)M * w; i += (size_t)gridDim.x * blockDim.x) {
        const size_t r = i / w; const int c = c0 + (int)(i % w); const unsigned v = buf[r * D + c];
        if ((v & 0x7f80u) >= (140u << 7)) ++nf; }
    for (int o = 32; o >= 1; o >>= 1) nf += __shfl_xor(nf, o);
    if ((threadIdx.x & 63) == 0 && nf) atomicAdd(rep, nf);
}
__global__ void dbg_encode(const unsigned long long* rep, float* out, size_t n, int nph) {
    int code = 80;
    for (int p = nph - 1; p >= 0; --p) if (rep[(64 + p) * 2 + 1] != rep[p * 2 + 1]) code = 40 + p;
    for (int p = nph - 1; p >= 0; --p) if (rep[p * 2] != 0ull || rep[(64 + p) * 2] != 0ull) code = 1 + p;
    if (code == 80) return;
    const float A = sqrtf((float)code * 0.1f);
    for (size_t i = (size_t)blockIdx.x * blockDim.x + threadIdx.x; i < n; i += (size_t)gridDim.x * blockDim.x) {
        unsigned h = (unsigned)i * 2654435761u; h ^= h >> 15; h *= 2246822519u; h ^= h >> 13;
        out[i] = (h & 1u) ? A : -A; }
}
#endif

extern "C" void kernel_launch(void* const* d_in, const int* in_sizes, int n_in, void* d_out, int out_size, void* d_ws, size_t ws_size, hipStream_t stream) {
    static int grid = 0;
    if (grid == 0) {
        if (n_in != 22 || in_sizes[0] != M * D || out_size != M * D || ws_size < WS_END + (1u << 20)) {
            fprintf(stderr, "kernel_launch: unexpected shapes (n_in %d, in0 %d, out %d, ws %zu, need %zu)\n", n_in, n_in > 0 ? in_sizes[0] : -1, out_size, ws_size, (size_t)WS_END); grid = -1; return; }
        int dev = 0, cus = 0, per_cu = 0;
        if (hipGetDevice(&dev) != hipSuccess || hipDeviceGetAttribute(&cus, hipDeviceAttributeMultiprocessorCount, dev) != hipSuccess) { grid = -1; return; }
        if (hipFuncSetAttribute((const void*)fwd_kernel, hipFuncAttributeMaxDynamicSharedMemorySize, LDS_BYTES) != hipSuccess) { fprintf(stderr, "kernel_launch: hipFuncSetAttribute failed\n"); grid = -1; return; }
        if (hipOccupancyMaxActiveBlocksPerMultiprocessor(&per_cu, (const void*)fwd_kernel, NWAVES * 64, LDS_BYTES) != hipSuccess || per_cu < 1)
            fprintf(stderr, "kernel_launch: occupancy query reports %d\n", per_cu);
        (void)hipGetLastError();
        if (cus != 256) { fprintf(stderr, "kernel_launch: built for 256 CUs (MoE unit deal, T2 row blocks), found %d\n", cus); grid = -1; return; }
        grid = cus;
    }
    if (grid < 0) return;
    if (hipMemsetAsync((char*)d_ws + WS_CTL, 0, CTL_ZERO_BYTES, stream) != hipSuccess) { fprintf(stderr, "kernel_launch: memset failed\n"); return; }
    Args a{};
    a.x = (const float*)d_in[0]; a.c = (const float*)d_in[1]; a.ada_w = (const float*)d_in[2]; a.ada_b = (const float*)d_in[3]; a.mix_g = (const float*)d_in[4]; a.ffn_g = (const float*)d_in[5];
    a.w_in = (const float*)d_in[6]; a.da_lambda = (const float*)d_in[7]; a.da_subln = (const float*)d_in[8]; a.na_rpb = (const float*)d_in[9];
    a.wpa = (const float*)d_in[10]; a.wpn = (const float*)d_in[11]; a.wpd = (const float*)d_in[12]; a.w_out = (const float*)d_in[13];
    a.rgw = (const float*)d_in[14]; a.rgb = (const float*)d_in[15]; a.rew = (const float*)d_in[16]; a.reb = (const float*)d_in[17];
    a.ew1 = (const float*)d_in[18]; a.ew3 = (const float*)d_in[19]; a.ew2 = (const float*)d_in[20]; a.fin_g = (const float*)d_in[21];
    a.out = (float*)d_out; a.ws = (unsigned char*)d_ws;
#if DBG
    {
        unsigned char* ws = (unsigned char*)d_ws;
        unsigned long long* rep = (unsigned long long*)(ws + WS_REP);
        (void)hipMemsetAsync(rep, 0, 2 * 64 * 2 * 8, stream);
        for (int run = 0; run < 2; ++run) {
            (void)hipMemsetAsync((char*)d_ws + WS_CTL, 0, CTL_ZERO_BYTES, stream);
            for (int p = 0; p < NPHASE; ++p) {
                a.ph_lo = p; a.ph_hi = p + 1;
                hipLaunchKernelGGL(fwd_kernel, dim3(grid), dim3(NWAVES * 64), LDS_BYTES, stream, a);
                unsigned long long* r = rep + (size_t)(run * 64 + p) * 2;
#define SCAN(off, bytes, isbf) hipLaunchKernelGGL(dbg_scan, dim3(1024), dim3(256), 0, stream, (const unsigned*)(ws + (off)), (size_t)(bytes) / 4, (isbf), r)
                const int ph = (p == 0) ? -1 : (p == NPHASE - 1) ? 9 : (p - 1) % 9;
                if (ph == -1) { SCAN(WS_MOD, (size_t)DEPTH * NBATCH * 6 * D * 4, 0); SCAN(WS_ROPE, (size_t)SEQ * 64 * 4, 0); SCAN(WS_WIN, WS_END - WS_WIN, 1); }
                else if (ph == 0) { SCAN(WS_X, (size_t)M * D * 4, 0); SCAN(WS_H, (size_t)M * D * 2, 1); }
                else if (ph == 1) { SCAN(WS_Z, (size_t)M * ZW * 2, 1); }
                else if (ph == 2) { SCAN(WS_OCAT, (size_t)M * D * 2, 1); }
                else if (ph == 3) { SCAN(WS_MERGED, (size_t)M * D * 2, 1); }
                else if (ph == 4) { SCAN(WS_X, (size_t)M * D * 4, 0); }
                else if (ph == 5) { SCAN(WS_H, (size_t)M * D * 2, 1); SCAN(WS_ROUTE, (size_t)2 * M * 4, 0); SCAN(WS_ROUTE + (size_t)4 * M * 4, (size_t)2 * M * 4, 0); }
                else if (ph == 9) { hipLaunchKernelGGL(dbg_scan, dim3(1024), dim3(256), 0, stream, (const unsigned*)d_out, (size_t)M * D, 0, r); }
#undef SCAN
            }
        }
        hipLaunchKernelGGL(dbg_encode, dim3(1024), dim3(256), 0, stream, (const unsigned long long*)rep, (float*)d_out, (size_t)M * D, NPHASE);
    }
#elif MK_PER_PHASE
    for (int p = 0; p < NPHASE; ++p) {
        a.ph_lo = p; a.ph_hi = p + 1;
        hipLaunchKernelGGL(fwd_kernel, dim3(grid), dim3(NWAVES * 64), LDS_BYTES, stream, a);
    }
#else
    a.ph_lo = 0; a.ph_hi = NPHASE;
    hipLaunchKernelGGL(fwd_kernel, dim3(grid), dim3(NWAVES * 64), LDS_BYTES, stream, a);
#endif
    const hipError_t le = hipPeekAtLastError();
    if (le != hipSuccess) fprintf(stderr, "kernel_launch: launch failed: %s\n", hipGetErrorName(le));
}
```

```cpp
#include <hip/hip_runtime.h>
#include <cstdio>
#include <cstdint>

#ifndef MK_PER_PHASE
#define MK_PER_PHASE 0
#endif

#define LAS __attribute__((address_space(3)))
#define GAS __attribute__((address_space(1)))
typedef unsigned short bf16_t;
typedef short bf16x8 __attribute__((ext_vector_type(8)));
typedef short s16x4 __attribute__((ext_vector_type(4)));
typedef float f32x4 __attribute__((ext_vector_type(4)));
typedef float f32x2 __attribute__((ext_vector_type(2)));
typedef float f32x16 __attribute__((ext_vector_type(16)));
typedef unsigned u32x4 __attribute__((ext_vector_type(4)));
typedef unsigned u32x2 __attribute__((ext_vector_type(2)));

constexpr int D = 1024, NBATCH = 4, SEQ = 4096, M = NBATCH * SEQ, DEPTH = 4, ZW = 7680;
constexpr int ZQA = 0, ZKA = 512, ZVA = 1024, ZQN = 1536, ZKN = 1792, ZVN = 2048, ZQD = 2304, ZKD = 3072, ZVD = 3840, ZG = 4608;
constexpr int NEXP = 32, EH = 512;
constexpr int MAXTILES = 160, XROWS = MAXTILES * 256;
constexpr float C2 = 0.125f * 1.4426950408889634f;
constexpr float LOG2E = 1.4426950408889634f;
constexpr float NORM_EPS = 1e-6f;
constexpr float NEGBIG = -1e30f;
constexpr float RESCALE_THR = 8.0f;

constexpr size_t MiB = 1u << 20;
constexpr size_t WS_CTL = 0, CTL_ZERO_BYTES = 1 * MiB;
constexpr size_t WS_RT = 1 * MiB;
constexpr size_t WS_MOD = 2 * MiB;
constexpr size_t WS_ROPE = 3 * MiB;
constexpr size_t WS_ROUTE = 4 * MiB;
constexpr size_t WS_X = 8 * MiB;
constexpr size_t WS_H = 72 * MiB;
constexpr size_t WS_OCAT = 104 * MiB;
constexpr size_t WS_MERGED = 136 * MiB;
constexpr size_t WS_Z = 168 * MiB;
constexpr size_t WS_XG = WS_Z;
constexpr size_t WS_HB = WS_Z + 80 * MiB;
constexpr size_t WS_YB = WS_Z + 120 * MiB;
constexpr size_t WS_WIN = 408 * MiB;
constexpr size_t WS_WPROJ = 468 * MiB;
constexpr size_t WS_WOUT = 476 * MiB;
constexpr size_t WS_W13 = 484 * MiB;
constexpr size_t WS_W2 = 740 * MiB;
constexpr size_t WS_END = 868 * MiB;
constexpr int CW_BAR = 4096;
constexpr int CW_CNT = 16384;
constexpr int CW_TILE = 32768;

constexpr int RING_BYTES = 131072;
constexpr int RT_LD = 1028;
constexpr int RT_BYTES = 36 * RT_LD * 4;
constexpr int MISC_OFF = RT_BYTES;
constexpr int LDS_BYTES = MISC_OFF + 512;

__device__ __forceinline__ unsigned f2bf(float f) { unsigned u = __builtin_bit_cast(unsigned, f); return (u + 0x7fffu + ((u >> 16) & 1u)) >> 16; }
__device__ __forceinline__ unsigned pk2(float lo, float hi) { return f2bf(lo) | (f2bf(hi) << 16); }
__device__ __forceinline__ unsigned cvt_pk_bf16(float lo, float hi) { unsigned r; asm("v_cvt_pk_bf16_f32 %0, %1, %2" : "=v"(r) : "v"(lo), "v"(hi)); return r; }
typedef __bf16 bf16x2_t __attribute__((ext_vector_type(2)));
__device__ __forceinline__ unsigned cvtpk_s(float lo, float hi) { f32x2 v = {lo, hi}; bf16x2_t b = __builtin_convertvector(v, bf16x2_t); return __builtin_bit_cast(unsigned, b); }
__device__ __forceinline__ float bflo(unsigned u) { return __builtin_bit_cast(float, u << 16); }
__device__ __forceinline__ float bfhi(unsigned u) { return __builtin_bit_cast(float, u & 0xffff0000u); }
__device__ __forceinline__ f32x4 bf4(u32x2 r) { return (f32x4){bflo(r.x), bfhi(r.x), bflo(r.y), bfhi(r.y)}; }
__device__ __forceinline__ float fexp2(float x) { return __builtin_amdgcn_exp2f(x); }
__device__ __forceinline__ float frcp(float x) { return __builtin_amdgcn_rcpf(x); }
__device__ __forceinline__ void swap32(float& a, float& b) { asm volatile("s_nop 1\n\tv_permlane32_swap_b32 %0, %1\n\ts_nop 1" : "+v"(a), "+v"(b)); }
template <int X> __device__ __forceinline__ float xor_lane(float v) { return __builtin_bit_cast(float, __builtin_amdgcn_ds_swizzle(__builtin_bit_cast(int, v), (X << 10) | 0x1f)); }
__device__ __forceinline__ float half_sum(float v) { v += xor_lane<1>(v); v += xor_lane<2>(v); v += xor_lane<4>(v); v += xor_lane<8>(v); v += xor_lane<16>(v); return v; }
__device__ __forceinline__ float wave_sum(float v) {
    v = half_sum(v);
    float a = v, b = v; swap32(a, b);
    return a + b;
}
template <int CTRL> __device__ __forceinline__ float dpp_f(float v) { return __builtin_bit_cast(float, __builtin_amdgcn_update_dpp(0, __builtin_bit_cast(int, v), CTRL, 0xf, 0xf, false)); }
__device__ __forceinline__ float wave_sum_u(float v) {
    v += dpp_f<0xB1>(v); v += dpp_f<0x4E>(v); v += dpp_f<0x141>(v); v += dpp_f<0x140>(v);
    v += __builtin_bit_cast(float, __builtin_amdgcn_update_dpp(0, __builtin_bit_cast(int, v), 0x142, 0xa, 0xf, false));
    v += __builtin_bit_cast(float, __builtin_amdgcn_update_dpp(0, __builtin_bit_cast(int, v), 0x143, 0xc, 0xf, false));
    float r = __builtin_bit_cast(float, __builtin_amdgcn_readlane(__builtin_bit_cast(int, v), 63));
    asm volatile("" : "+v"(r));
    return r;
}
__device__ __forceinline__ void wave_sum4_u(float& a, float& b, float& c, float& d) {
    unsigned s0, s1, s2, s3;
#define WS4_STEP(ctl) "v_add_f32_dpp %0, %0, %0 " ctl "\n\tv_add_f32_dpp %1, %1, %1 " ctl "\n\tv_add_f32_dpp %2, %2, %2 " ctl "\n\tv_add_f32_dpp %3, %3, %3 " ctl "\n\t"
    asm volatile("s_nop 1\n\t"
        WS4_STEP("quad_perm:[1,0,3,2] row_mask:0xf bank_mask:0xf") WS4_STEP("quad_perm:[2,3,0,1] row_mask:0xf bank_mask:0xf") WS4_STEP("row_half_mirror row_mask:0xf bank_mask:0xf")
        WS4_STEP("row_mirror row_mask:0xf bank_mask:0xf") WS4_STEP("row_bcast:15 row_mask:0xa bank_mask:0xf") WS4_STEP("row_bcast:31 row_mask:0xc bank_mask:0xf")
        "v_readlane_b32 %4, %0, 63\n\tv_readlane_b32 %5, %1, 63\n\tv_readlane_b32 %6, %2, 63\n\tv_readlane_b32 %7, %3, 63\n\t"
        "v_mov_b32 %0, %4\n\tv_mov_b32 %1, %5\n\tv_mov_b32 %2, %6\n\tv_mov_b32 %3, %7"
        : "+v"(a), "+v"(b), "+v"(c), "+v"(d), "=&s"(s0), "=&s"(s1), "=&s"(s2), "=&s"(s3));
#undef WS4_STEP
}
__device__ __forceinline__ void st16_wt(void* p, u32x4 v) { asm volatile("global_store_dwordx4 %0, %1, off sc1\n\ts_nop 1" :: "v"(p), "v"(v) : "memory"); }
#define LDS_WAIT() asm volatile("s_waitcnt lgkmcnt(0)" ::: "memory")
#define VM_WAIT() asm volatile("s_waitcnt vmcnt(0)" ::: "memory")
#define CBAR() asm volatile("" ::: "memory")

namespace pg8 {
constexpr int BM = 256, BK = 64, HALF = 128, HTB = HALF * BK * 2, STAGE_BYTES = 8 * HTB, NXCD = 8, WGM = 8;
__host__ __device__ __forceinline__ int lds_byte(int r, int c) { const int st = (r >> 4) * 2 + (c >> 5), rr = r & 15, cc = c & 31, ob = rr * 64 + cc * 2; return st * 1024 + (ob ^ (((ob >> 9) & 1) << 5)); }
__host__ __device__ __forceinline__ void stage_rc(int b, int& R, int& C) { const int st = b / 1024, sb = b % 1024, swz = sb ^ (((sb >> 9) & 1) << 5); R = (st >> 1) * 16 + swz / 64; C = (st & 1) * 32 + (swz % 64) / 2; }
__host__ __device__ __forceinline__ int perm32(int rho) { const int n = rho >> 4, i = rho & 15; return 8 * (i >> 2) + 4 * n + (i & 3); }

struct Unit { int pm, pn, e, x0, x1; };
struct Gemm { const bf16_t* A; const bf16_t* Bt; int lda, ldb, K; };

struct StaticOrder {
    int nM, nN, nwg, G, c;
    __device__ void init(int M_, int N_, int G_, int c_) { nM = M_ / BM; nN = N_ / BM; nwg = nM * nN; G = G_; c = c_; }
    __device__ bool next(int i, Unit& u) const {
        const long L = (long)i * G + c; if (L >= nwg) return false;
        int wgid = (int)L; { const int q = nwg / NXCD, r = nwg % NXCD, xcd = wgid % NXCD, off = wgid / NXCD; wgid = (xcd < r ? xcd * (q + 1) : r * (q + 1) + (xcd - r) * q) + off; }
        const int nig = WGM * nN, gid = wgid / nig, fm = gid * WGM, gsz = (nM - fm) < WGM ? (nM - fm) : WGM;
        u.pm = fm + ((wgid % nig) % gsz); u.pn = (wgid % nig) / gsz; u.e = 0; u.x0 = 0; u.x1 = 0; return true;
    }
    __device__ __forceinline__ size_t aoff(const Gemm& g, const Unit& u) const { return (size_t)u.pm * BM * g.lda * 2; }
    __device__ __forceinline__ size_t boff(const Gemm& g, const Unit& u) const { return (size_t)u.pn * BM * g.ldb * 2; }
    __device__ __forceinline__ int ktiles(const Gemm& g, const Unit&) const { return g.K / BK; }
    __device__ __forceinline__ void done(const Unit&, int) const {}
};
struct MoeOrder {
    int n; int pm0, pm1, pn0, pn1, e0, e1; size_t estride;
    int ts0, ts1, cn0, cn1; const int* etok;
    unsigned* tcnt;
    __device__ __forceinline__ void done(const Unit& u, int lane) const {
        if (tcnt) { asm volatile("s_waitcnt vmcnt(0)" ::: "memory"); if (lane == 0) __hip_atomic_fetch_add(tcnt + u.pm * 16, 1u, __ATOMIC_RELAXED, __HIP_MEMORY_SCOPE_AGENT); }
    }
    __device__ bool next(int i, Unit& u) const {
        if (i >= n) return false;
        u.pm = i == 0 ? pm0 : pm1; u.pn = i == 0 ? pn0 : pn1; u.e = i == 0 ? e0 : e1;
        u.x0 = i == 0 ? ts0 : ts1; u.x1 = i == 0 ? cn0 : cn1; return true;
    }
    __device__ __forceinline__ size_t aoff(const Gemm& g, const Unit& u) const { return (size_t)u.pm * BM * g.lda * 2; }
    __device__ __forceinline__ size_t boff(const Gemm& g, const Unit& u) const { return (size_t)u.e * estride + (size_t)u.pn * BM * g.ldb * 2; }
    __device__ __forceinline__ int ktiles(const Gemm& g, const Unit&) const { return g.K / BK; }
    __device__ __forceinline__ int gather_row(const Unit& u, int r) const {
        const int pos = min((u.pm - u.x0) * BM + r, u.x1 - 1);
        return etok[u.e * 16384 + pos];
    }
};
struct ProjOrder {
    int pm, pn, rot;
    __device__ bool next(int i, Unit& u) const { if (i >= 3) return false; int seg = i + rot; seg = seg >= 3 ? seg - 3 : seg; u.pm = pm; u.pn = pn; u.e = seg | ((i == 0) ? 16 : 0); u.x0 = 0; u.x1 = 0; return true; }
    __device__ __forceinline__ int kofs(const Unit& u) const { const int seg = u.e & 15; return seg == 0 ? 0 : (seg == 1 ? 512 : 768); }
    __device__ __forceinline__ size_t aoff(const Gemm& g, const Unit& u) const { return (size_t)u.pm * BM * g.lda * 2 + (size_t)kofs(u) * 2; }
    __device__ __forceinline__ size_t boff(const Gemm& g, const Unit& u) const { return (size_t)u.pn * BM * g.ldb * 2 + (size_t)kofs(u) * 2; }
    __device__ __forceinline__ int ktiles(const Gemm&, const Unit& u) const { return (u.e & 15) == 0 ? 8 : 4; }
    __device__ __forceinline__ void done(const Unit&, int) const {}
};

template <class Epi, class Sched, bool ALIGN_EPI = true, bool SP2 = true, bool GATHER = false>
__device__ __forceinline__ void gemm_phase(LAS unsigned char* lds, const Gemm g, const Sched& S, const Epi& E) {
    int tid_ = threadIdx.x; asm volatile("" : "+v"(tid_));
    const int tid = tid_, wid = __builtin_amdgcn_readfirstlane(tid >> 6), lane = tid & 63, wr = wid >> 2, wc = wid & 3, fr = lane & 15, fq = lane >> 4;
    int nt = S.ktiles(g, Unit{0, 0, 0, 0, 0});
    unsigned voffA[2], voffB[2];
#pragma unroll
    for (int i = 0; i < 2; ++i) { int R, C; stage_rc(tid * 16 + i * 8192, R, C); const int Rb = Epi::PERM ? ((R & ~31) + perm32(R & 31)) : R;
        voffA[i] = (unsigned)(R * g.lda + C) * 2u; voffB[i] = (unsigned)(Rb * g.ldb + C) * 2u; }
    const size_t kstep = (size_t)(BK * 2);
    const size_t hstepA = (size_t)HALF * g.lda * 2, hstepB = (size_t)HALF * g.ldb * 2;
    const unsigned ldsw = (unsigned)wid * 1024u;
    const int aoff = lds_byte(wr * 64 + fr, fq * 8), boff = lds_byte(wc * 32 + fr, fq * 8);
#define PG8_SA(b, h) (((b) * 2 + (h)) * HTB)
#define PG8_SB(b, h) ((4 + (b) * 2 + (h)) * HTB)
#define PG8_STAGE(bufoff, gbase, voff) do { _Pragma("unroll") for (int _i = 0; _i < 2; ++_i) \
        __builtin_amdgcn_global_load_lds((const unsigned*)((const char*)(gbase) + (voff)[_i]), (LAS unsigned*)(lds + (bufoff) + ldsw + _i * 8192), 16, 0, 0); } while (0)
    unsigned vo0[2] = {0u, 0u}, vo1[2] = {0u, 0u}, nvo0[2] = {0u, 0u}, nvo1[2] = {0u, 0u};
#define PG8_GOFF(u_, d0_, d1_) do { _Pragma("unroll") for (int _i = 0; _i < 2; ++_i) { int R_, C_; stage_rc(tid * 16 + _i * 8192, R_, C_); \
        d0_[_i] = (unsigned)(S.gather_row(u_, R_) * g.lda + C_) * 2u; d1_[_i] = (unsigned)(S.gather_row(u_, HALF + R_) * g.lda + C_) * 2u; } } while (0)
#define PG8_STAGEA(bufoff, ptr, h, nx) do { if constexpr (GATHER) { unsigned o_[2]; o_[0] = (nx) ? ((h) ? nvo1[0] : nvo0[0]) : ((h) ? vo1[0] : vo0[0]); o_[1] = (nx) ? ((h) ? nvo1[1] : nvo0[1]) : ((h) ? vo1[1] : vo0[1]); \
        PG8_STAGE(bufoff, ptr, o_); } else { PG8_STAGE(bufoff, (ptr) + ((h) ? hstepA : 0), voffA); } } while (0)
#define PG8_LDA(dst, b, h) do { _Pragma("unroll") for (int m = 0; m < 4; ++m) _Pragma("unroll") for (int k = 0; k < 2; ++k) dst[m][k] = *(const LAS bf16x8*)(lds + PG8_SA(b, h) + aoff + m * 2048 + k * 1024); } while (0)
#define PG8_LDB(dst, b, h) do { _Pragma("unroll") for (int n = 0; n < 2; ++n) _Pragma("unroll") for (int k = 0; k < 2; ++k) dst[n][k] = *(const LAS bf16x8*)(lds + PG8_SB(b, h) + boff + n * 2048 + k * 1024); } while (0)
#define PG8_MMA(ai, bj, At, Bt) do { __builtin_amdgcn_s_setprio(1); _Pragma("unroll") for (int m = 0; m < 4; ++m) _Pragma("unroll") for (int n = 0; n < 2; ++n) _Pragma("unroll") for (int k = 0; k < 2; ++k) \
        acc[ai][bj][m][n] = __builtin_amdgcn_mfma_f32_16x16x32_bf16(Bt[n][k], At[m][k], acc[ai][bj][m][n], 0, 0, 0); __builtin_amdgcn_s_setprio(0); } while (0)
#define PG8_WAIT_V(n) asm volatile("s_waitcnt vmcnt(" #n ")" ::: "memory")
#define PG8_WAIT_L(n) asm volatile("s_waitcnt lgkmcnt(" #n ")" ::: "memory")
#define PG8_BAR __builtin_amdgcn_s_barrier()
#define PG8_SCHED __builtin_amdgcn_sched_barrier(0)
    Unit cur, nxt; int ui = 0;
    if (!S.next(0, cur)) return;
    nt = S.ktiles(g, cur);
    f32x4 acc[2][2][4][2];
#pragma unroll
    for (int a = 0; a < 2; ++a)
#pragma unroll
        for (int b = 0; b < 2; ++b)
#pragma unroll
            for (int m = 0; m < 4; ++m)
#pragma unroll
                for (int n = 0; n < 2; ++n) acc[a][b][m][n] = (f32x4){0.f, 0.f, 0.f, 0.f};
    bf16x8 At[4][2], B0[2][2], B1[2][2];
    const char* cA = (const char*)g.A + (GATHER ? (size_t)0 : S.aoff(g, cur)); const char* cB = (const char*)g.Bt + S.boff(g, cur);
    if constexpr (GATHER) { PG8_GOFF(cur, vo0, vo1); asm volatile("s_waitcnt vmcnt(0)" : "+v"(vo0[0]), "+v"(vo0[1]), "+v"(vo1[0]), "+v"(vo1[1]) :: "memory"); }
    if constexpr (SP2) {
        PG8_STAGE(PG8_SB(0, 0), cB, voffB); PG8_STAGE(PG8_SB(0, 1), cB + hstepB, voffB); PG8_STAGEA(PG8_SA(0, 0), cA, 0, false); PG8_STAGEA(PG8_SA(0, 1), cA, 1, false);
        if (wr == 1) PG8_BAR;
        PG8_WAIT_V(2); PG8_BAR;
        PG8_STAGE(PG8_SB(1, 0), cB + kstep, voffB); PG8_STAGEA(PG8_SA(1, 0), cA + kstep, 0, false); PG8_STAGE(PG8_SB(1, 1), cB + hstepB + kstep, voffB);
        PG8_WAIT_V(6); PG8_BAR;
    } else {
        PG8_STAGE(PG8_SB(0, 0), cB, voffB); PG8_STAGE(PG8_SA(0, 0), cA, voffA); PG8_STAGE(PG8_SB(0, 1), cB + hstepB, voffB); PG8_STAGE(PG8_SA(0, 1), cA + hstepA, voffA);
        if (wr == 1) PG8_BAR;
        PG8_WAIT_V(4); PG8_BAR;
        PG8_STAGE(PG8_SB(1, 0), cB + kstep, voffB); PG8_STAGE(PG8_SA(1, 0), cA + kstep, voffA); PG8_STAGE(PG8_SB(1, 1), cB + hstepB + kstep, voffB);
        PG8_WAIT_V(6); PG8_BAR;
    }
    for (;;) {
        const bool has_next = S.next(ui + 1, nxt);
        const char* nA = (has_next && !GATHER) ? (const char*)g.A + S.aoff(g, nxt) : cA; const char* nB = has_next ? (const char*)g.Bt + S.boff(g, nxt) : cB;
        if constexpr (GATHER) { if (has_next) { PG8_GOFF(nxt, nvo0, nvo1); } else { nvo0[0] = vo0[0]; nvo0[1] = vo0[1]; nvo1[0] = vo1[0]; nvo1[1] = vo1[1]; }
            asm volatile("s_waitcnt vmcnt(0)" : "+v"(nvo0[0]), "+v"(nvo0[1]), "+v"(nvo1[0]), "+v"(nvo1[1]) :: "memory"); }
        for (int t = 0; t < nt; t += 2) {
            const bool last = (t == nt - 2);
            const char* a1 = cA + (size_t)(t + 1) * kstep;
            const char* a2 = last ? nA : cA + (size_t)(t + 2) * kstep; const char* b2 = last ? nB : cB + (size_t)(t + 2) * kstep;
            const char* a3 = a2 + kstep; const char* b3 = b2 + kstep;
            if constexpr (SP2) {
            PG8_LDB(B0, 0, 0); PG8_LDB(B1, 0, 1); PG8_SCHED; PG8_LDA(At, 0, 0); PG8_STAGEA(PG8_SA(1, 1), a1, 1, false);
            PG8_WAIT_V(8); PG8_WAIT_L(0); PG8_BAR; PG8_MMA(0, 0, At, B0); PG8_MMA(0, 1, At, B1); PG8_BAR; PG8_SCHED;
            PG8_LDA(At, 0, 1); PG8_STAGE(PG8_SB(0, 0), b2, voffB); PG8_STAGE(PG8_SB(0, 1), b2 + hstepB, voffB); PG8_STAGEA(PG8_SA(0, 0), a2, 0, last);
            PG8_WAIT_V(8); PG8_WAIT_L(0); PG8_BAR; PG8_MMA(1, 0, At, B0); PG8_MMA(1, 1, At, B1); PG8_BAR; PG8_SCHED;
            PG8_LDB(B0, 1, 0); PG8_LDB(B1, 1, 1); PG8_SCHED; PG8_LDA(At, 1, 0); PG8_STAGEA(PG8_SA(0, 1), a2, 1, last);
            PG8_WAIT_V(8); PG8_WAIT_L(0); PG8_BAR; PG8_MMA(0, 0, At, B0); PG8_MMA(0, 1, At, B1); PG8_BAR; PG8_SCHED;
            PG8_LDA(At, 1, 1); PG8_STAGE(PG8_SB(1, 0), b3, voffB); PG8_STAGE(PG8_SB(1, 1), b3 + hstepB, voffB); PG8_STAGEA(PG8_SA(1, 0), a3, 0, last);
            PG8_WAIT_V(8); PG8_WAIT_L(0); PG8_BAR; PG8_MMA(1, 0, At, B0); PG8_MMA(1, 1, At, B1); PG8_BAR; PG8_SCHED;
            } else {
            PG8_LDB(B0, 0, 0); PG8_SCHED; PG8_LDA(At, 0, 0); PG8_STAGE(PG8_SA(1, 1), a1 + hstepA, voffA);
            PG8_WAIT_L(8); PG8_BAR; PG8_WAIT_L(0); PG8_MMA(0, 0, At, B0); PG8_BAR; PG8_SCHED;
            PG8_LDB(B1, 0, 1); PG8_STAGE(PG8_SB(0, 0), b2, voffB);
            PG8_BAR; PG8_WAIT_L(0); PG8_MMA(0, 1, At, B1); PG8_BAR;
            PG8_LDA(At, 0, 1); PG8_STAGE(PG8_SA(0, 0), a2, voffA);
            PG8_BAR; PG8_WAIT_L(0); PG8_MMA(1, 0, At, B0); PG8_BAR; PG8_SCHED;
            PG8_STAGE(PG8_SB(0, 1), b2 + hstepB, voffB);
            PG8_WAIT_V(6); PG8_BAR; PG8_MMA(1, 1, At, B1); PG8_BAR;
            PG8_LDB(B0, 1, 0); PG8_SCHED; PG8_LDA(At, 1, 0); PG8_STAGE(PG8_SA(0, 1), a2 + hstepA, voffA);
            PG8_WAIT_L(8); PG8_BAR; PG8_WAIT_L(0); PG8_MMA(0, 0, At, B0); PG8_BAR; PG8_SCHED;
            PG8_LDB(B1, 1, 1); PG8_STAGE(PG8_SB(1, 0), b3, voffB);
            PG8_BAR; PG8_WAIT_L(0); PG8_MMA(0, 1, At, B1); PG8_BAR;
            PG8_LDA(At, 1, 1); PG8_STAGE(PG8_SA(1, 0), a3, voffA);
            PG8_BAR; PG8_WAIT_L(0); PG8_MMA(1, 0, At, B0); PG8_BAR; PG8_SCHED;
            PG8_STAGE(PG8_SB(1, 1), b3 + hstepB, voffB);
            PG8_WAIT_V(6); PG8_BAR; PG8_MMA(1, 1, At, B1); PG8_BAR;
            }
        }
        if constexpr (ALIGN_EPI) { if (wr == 0) PG8_BAR; }
        E(acc, cur, wr, wc, fr, fq);
        S.done(cur, lane);
        if (!has_next) break;
#pragma unroll
        for (int a = 0; a < 2; ++a)
#pragma unroll
            for (int b = 0; b < 2; ++b)
#pragma unroll
                for (int m = 0; m < 4; ++m)
#pragma unroll
                    for (int n = 0; n < 2; ++n) acc[a][b][m][n] = (f32x4){0.f, 0.f, 0.f, 0.f};
        cur = nxt; cA = nA; cB = nB; ++ui; nt = S.ktiles(g, cur);
        if constexpr (GATHER) { vo0[0] = nvo0[0]; vo0[1] = nvo0[1]; vo1[0] = nvo1[0]; vo1[1] = nvo1[1]; }
        if constexpr (ALIGN_EPI) { if (wr == 1) PG8_BAR; }
    }
    PG8_WAIT_V(0);
    if constexpr (!ALIGN_EPI) { if (wr == 0) PG8_BAR; }
    PG8_BAR;
#undef PG8_SA
#undef PG8_SB
#undef PG8_STAGE
#undef PG8_LDA
#undef PG8_STAGEA
#undef PG8_GOFF
#undef PG8_LDB
#undef PG8_MMA
#undef PG8_WAIT_V
#undef PG8_WAIT_L
#undef PG8_BAR
#undef PG8_SCHED
}
}

#define XB_TMO      128
#define XB_XCNT(j)  (256  + 64 * (j))
#define XB_XSUB(j)  (1280 + 64 * (j))
#define XB_XGEN(j)  (2304 + 64 * (j))
#define XB_TOP      3328
#define XB_TOPGEN   3392
#define XCD_BAR_WORDS 3456
#define XB_SPIN_CAP (1u << 18)
__device__ __forceinline__ unsigned xb_ld(unsigned* p)              { return __hip_atomic_load(p, __ATOMIC_RELAXED, __HIP_MEMORY_SCOPE_AGENT); }
__device__ __forceinline__ unsigned xb_add(unsigned* p, unsigned v) { return __hip_atomic_fetch_add(p, v, __ATOMIC_RELAXED, __HIP_MEMORY_SCOPE_AGENT); }
__device__ __forceinline__ unsigned xb_xcc_id() { return (unsigned)__builtin_amdgcn_s_getreg((3 << 11) | 20) & 0xFu; }
#define XB_SPIN(cond, bar) do { unsigned _sp = 0; while (cond) { __builtin_amdgcn_s_sleep(1); \
    if ((++_sp & 255u) == 0u) { if (xb_ld(&(bar)[XB_TMO])) break; if (_sp > XB_SPIN_CAP) { atomicAdd(&(bar)[XB_TMO], 1u); break; } } } } while (0)
struct XcdBarrier { unsigned* bar; unsigned x; volatile LAS unsigned* st; };
__device__ __forceinline__ XcdBarrier xcd_barrier_post(unsigned* bar, volatile LAS unsigned* st) {
    XcdBarrier b; b.bar = bar; b.x = xb_xcc_id(); b.st = st;
    if (threadIdx.x == 0) (void)xb_add(&bar[XB_XCNT(b.x)], 1u);
    return b;
}
__device__ __forceinline__ void xcd_barrier_complete(unsigned* bar, unsigned x, unsigned& nloc, unsigned& nx) {
    const unsigned G = gridDim.x * gridDim.y * gridDim.z;
    unsigned sum, cnt, mine, sp = 0u;
    for (;;) {
        sum = 0u; cnt = 0u; mine = 0u;
#pragma unroll
        for (unsigned j = 0; j < 16; ++j) { const unsigned c = xb_ld(&bar[XB_XCNT(j)]); sum += c; cnt += (c > 0u) ? 1u : 0u; mine = (j == x) ? c : mine; }
        if (sum == G) break;
        __builtin_amdgcn_s_sleep(1);
        if ((++sp & 255u) == 0u) { if (xb_ld(&bar[XB_TMO])) break; if (sp > XB_SPIN_CAP) { atomicAdd(&bar[XB_TMO], 1u); break; } }
    }
    nloc = mine > 0u ? mine : 1u; nx = cnt > 0u ? cnt : 1u;
}
__device__ __forceinline__ void xcd_barrier(const XcdBarrier& b) {
    asm volatile("s_waitcnt vmcnt(0)" ::: "memory");
    __syncthreads();
    if (threadIdx.x == 0) {
        unsigned* bar = b.bar;
        __builtin_amdgcn_s_waitcnt(0);
        unsigned nloc = b.st[0], nx = b.st[1];
        if (nloc == 0u) { xcd_barrier_complete(bar, b.x, nloc, nx); b.st[0] = nloc; b.st[1] = nx; }
        const unsigned old = xb_add(&bar[XB_XSUB(b.x)], 1u);
        const unsigned gen = old / nloc;
        if (old + 1u == (gen + 1u) * nloc) {
            __builtin_amdgcn_fence(__ATOMIC_RELEASE, "agent");
            asm volatile("s_waitcnt vmcnt(0)" ::: "memory");
            const unsigned og = xb_add(&bar[XB_TOP], 1u);
            const unsigned tg = og / nx;
            if (og + 1u == (tg + 1u) * nx) xb_add(&bar[XB_TOPGEN], 1u);
            else XB_SPIN(xb_ld(&bar[XB_TOPGEN]) == tg, bar);
            __builtin_amdgcn_fence(__ATOMIC_ACQUIRE, "agent");
            xb_add(&bar[XB_XGEN(b.x)], 1u);
            asm volatile("s_waitcnt vmcnt(0)" ::: "memory");
        } else {
            XB_SPIN(xb_ld(&bar[XB_XGEN(b.x)]) == gen, bar);
            __builtin_amdgcn_fence(__ATOMIC_ACQUIRE, "agent");
            asm volatile("s_waitcnt vmcnt(0)" ::: "memory");
        }
    }
    __syncthreads();
}

struct Args {
    const float* x; const float* c; const float* ada_w; const float* ada_b; const float* mix_g; const float* ffn_g; const float* w_in;
    const float* da_lambda; const float* da_subln; const float* na_rpb; const float* wpa; const float* wpn; const float* wpd; const float* w_out;
    const float* rgw; const float* rgb; const float* rew; const float* reb; const float* ew1; const float* ew3; const float* ew2; const float* fin_g;
    float* out; unsigned char* ws; int ph_lo, ph_hi; int variant, pad;
};

__device__ const double ROPE_INV[32] = {
    1.0, 0.7498942093324559, 0.5623413251903491, 0.4216965034285822, 0.31622776601683794, 0.23713737056616552, 0.1778279410038923, 0.1333521432163324,
    0.1, 0.07498942093324558, 0.05623413251903491, 0.04216965034285822, 0.031622776601683794, 0.023713737056616554, 0.01778279410038923, 0.01333521432163324,
    0.01, 0.007498942093324558, 0.005623413251903491, 0.004216965034285822, 0.0031622776601683794, 0.0023713737056616554, 0.001778279410038923, 0.001333521432163324,
    0.001, 0.0007498942093324559, 0.0005623413251903491, 0.0004216965034285822, 0.00031622776601683794, 0.00023713737056616554, 0.0001778279410038923, 0.0001333521432163324};

__device__ __forceinline__ void sincos_d(double a, float& s, float& c) {
    const double k = __builtin_rint(a * 0.6366197723675814);
    double t = __builtin_fma(-k, 1.5707963267948966, a); t = __builtin_fma(-k, 6.123233995736766e-17, t);
    const double t2 = t * t;
    double sp = -1.0 / 1307674368000.0; sp = sp * t2 + 1.0 / 6227020800.0; sp = sp * t2 - 1.0 / 39916800.0; sp = sp * t2 + 1.0 / 362880.0; sp = sp * t2 - 1.0 / 5040.0; sp = sp * t2 + 1.0 / 120.0; sp = sp * t2 - 1.0 / 6.0; sp = sp * t2 + 1.0; sp *= t;
    double cp = 1.0 / 87178291200.0; cp = cp * t2 - 1.0 / 479001600.0; cp = cp * t2 + 1.0 / 3628800.0; cp = cp * t2 - 1.0 / 40320.0; cp = cp * t2 + 1.0 / 720.0; cp = cp * t2 - 1.0 / 24.0; cp = cp * t2 + 0.5; cp = 1.0 - cp * t2;
    const int q = ((int)k) & 3;
    const double ss = (q == 0) ? sp : (q == 1) ? cp : (q == 2) ? -sp : -cp;
    const double cc = (q == 0) ? cp : (q == 1) ? -sp : (q == 2) ? -cp : sp;
    s = (float)ss; c = (float)cc;
}

__device__ __forceinline__ int dst_row(int mode, int n) {
    if (mode == 1) { const bool rot = (n < 1024) || (n >= ZQD && n < ZVD); if (rot) { const int j = n & 63; return (n & ~63) + ((j & 31) << 1) + (j >> 5); } return n; }
    if (mode == 2) return 256 * (n >> 7) + (n & 127);
    if (mode == 3) return 256 * (n >> 7) + 128 + (n & 127);
    return n;
}
__device__ __forceinline__ void tr_item(const float* W, int N, bf16_t* WT, int ldt, int koff, int mode, LAS float* scr, int item, int lane) {
    const int nblk = N / 32, kb = item / nblk, nb = item % nblk, k0 = 64 * kb, n0 = 32 * nb;
#pragma unroll 8
    for (int i = 0; i < 32; ++i) { const int kk = 2 * i + (lane >> 5); scr[kk * 33 + (lane & 31)] = __builtin_nontemporal_load(&W[(size_t)(k0 + kk) * N + n0 + (lane & 31)]); }
    LDS_WAIT();
    const int c = lane & 7;
#pragma unroll
    for (int j = 0; j < 4; ++j) { const int n = (lane >> 3) + 8 * j; const LAS float* s = scr + (8 * c) * 33 + n;
        float f = 1.0f; if (mode == 1) { const int nn = n0 + n; f = (nn < ZKA || (nn >= ZQN && nn < ZKN) || (nn >= ZQD && nn < ZKD)) ? C2 : (nn >= ZG ? -LOG2E : 1.0f); }
        u32x4 o; o.x = cvt_pk_bf16(s[0 * 33] * f, s[1 * 33] * f); o.y = cvt_pk_bf16(s[2 * 33] * f, s[3 * 33] * f); o.z = cvt_pk_bf16(s[4 * 33] * f, s[5 * 33] * f); o.w = cvt_pk_bf16(s[6 * 33] * f, s[7 * 33] * f);
        *(u32x4*)(WT + (size_t)dst_row(mode, n0 + n) * ldt + koff + k0 + 8 * c) = o; }
    LDS_WAIT();
}

__device__ __forceinline__ float max3f(float a, float b, float c) { float r; asm("v_max3_f32 %0, %1, %2, %3" : "=v"(r) : "v"(a), "v"(b), "v"(c)); return r; }
__device__ __forceinline__ int crow(int r, int hi) { return (r & 3) + 8 * (r >> 2) + 4 * hi; }
__device__ __forceinline__ float swapmax(float m) { float a = m, b = m; swap32(a, b); return __builtin_fmaxf(a, b); }
__device__ __forceinline__ float swapsum(float m) { float a = m, b = m; swap32(a, b); return a + b; }
typedef short v4i16_t __attribute__((ext_vector_type(4)));
__device__ __forceinline__ s16x4 vtr(const LAS unsigned char* p) { return __builtin_bit_cast(s16x4, __builtin_amdgcn_ds_read_tr16_b64_v4i16((LAS v4i16_t*)p)); }

template <int DV> struct AttnCfg { static constexpr int ND = DV / 32, NCH = DV / 16, VST = DV * 2 + 64; };

template <int DV> struct TileRegs { u32x4 kr[4]; u32x4 vr[4]; };
template <int DV>
__device__ __forceinline__ void tile_load(TileRegs<DV>& T, const char* zb, const unsigned (&roff)[4], unsigned kcol, unsigned vcol) {
    const unsigned cb = 16u * (threadIdx.x & 7);
#pragma unroll
    for (int i = 0; i < 4; ++i) { T.kr[i] = *(const u32x4*)(zb + (size_t)(roff[i] + kcol + cb)); T.vr[i] = *(const u32x4*)(zb + (size_t)(roff[i] + vcol + cb)); }
}
__device__ __forceinline__ float max16m(const f32x16& p, float m) { float a, b;
    asm("v_max3_f32 %0, %2, %3, %4\n\tv_max3_f32 %1, %5, %6, %7\n\tv_max3_f32 %0, %0, %8, %9\n\tv_max3_f32 %1, %1, %10, %11\n\tv_max3_f32 %0, %0, %12, %13\n\tv_max3_f32 %1, %1, %14, %15\n\t"
        "v_max3_f32 %0, %0, %16, %17\n\tv_max3_f32 %0, %0, %1, %18"
        : "=&v"(a), "=&v"(b) : "v"(p[0]), "v"(p[1]), "v"(p[2]), "v"(p[3]), "v"(p[4]), "v"(p[5]), "v"(p[6]), "v"(p[7]), "v"(p[8]), "v"(p[9]), "v"(p[10]), "v"(p[11]), "v"(p[12]), "v"(p[13]), "v"(p[14]), "v"(p[15]), "v"(m));
    return a; }
template <int DV, class MaskF, class Reload>
__device__ __forceinline__ void attn_tile(f32x16 (&o)[DV / 32], float& m, float& l, const bf16x8 (&qf)[4], TileRegs<DV>& T,
                                          LAS unsigned char* vlds, LAS float* wsf, const MaskF& maskf, const Reload& reload, int lane, int hi) {
    constexpr int ND = AttnCfg<DV>::ND, VST = AttnCfg<DV>::VST, KST = 144;
    static_assert(DV == 64, "gather tiles are 64 wide");
    CBAR();
    { LAS unsigned char* kw = vlds + 6144 + (lane >> 3) * KST + (lane & 7) * 16; LAS unsigned char* vw = vlds + (lane >> 3) * VST + (lane & 7) * 16;
#pragma unroll
      for (int i = 0; i < 4; ++i) { *(LAS u32x4*)(kw + 8 * i * KST) = T.kr[i]; *(LAS u32x4*)(vw + 8 * i * VST) = T.vr[i]; } }
    CBAR();
    reload(T);
    f32x16 p; maskf(p);
    { const LAS unsigned char* kp = vlds + 6144 + (lane & 31) * KST + hi * 16;
#pragma unroll
      for (int d0 = 0; d0 < 4; ++d0) { const bf16x8 kf = *(const LAS bf16x8*)(kp + 32 * d0); p = __builtin_amdgcn_mfma_f32_32x32x16_bf16(kf, qf[d0], p, 0, 0, 0); } }
    asm volatile("s_nop 15\n\ts_nop 7" : "+v"(p));
    float mx = max16m(p, m);
    { float a = mx, b = mx; swap32(a, b); mx = max3f(a, b, m); }
    const float mn = (mx > m + RESCALE_THR) ? mx : m;
    const float alpha = fexp2(m - mn);
    m = mn;
    float rs = 0.f;
#pragma unroll
    for (int r = 0; r < 16; ++r) { p[r] = fexp2(p[r] - mn); rs += p[r]; }
    l = l * alpha + rs;
    if (__any(alpha != 1.0f)) {
        CBAR();
        if (hi == 0) wsf[lane & 31] = alpha;
        CBAR();
#pragma unroll
        for (int g4 = 0; g4 < 4; ++g4) { const f32x4 a4 = *(const LAS f32x4*)(wsf + 8 * g4 + 4 * hi);
#pragma unroll
            for (int d0 = 0; d0 < ND; ++d0) { o[d0][4 * g4 + 0] *= a4[0]; o[d0][4 * g4 + 1] *= a4[1]; o[d0][4 * g4 + 2] *= a4[2]; o[d0][4 * g4 + 3] *= a4[3]; } }
        CBAR();
    }
    CBAR();
    u32x4 pw0, pw1;
    pw0.x = cvtpk_s(p[0], p[1]); pw0.y = cvtpk_s(p[2], p[3]); pw0.z = cvtpk_s(p[4], p[5]); pw0.w = cvtpk_s(p[6], p[7]);
    pw1.x = cvtpk_s(p[8], p[9]); pw1.y = cvtpk_s(p[10], p[11]); pw1.z = cvtpk_s(p[12], p[13]); pw1.w = cvtpk_s(p[14], p[15]);
    const bf16x8 pa0 = __builtin_bit_cast(bf16x8, pw0), pa1 = __builtin_bit_cast(bf16x8, pw1);
    const int li = lane & 15, g16 = lane >> 4;
    const LAS unsigned char* vb = vlds + (4 * hi + (li >> 2)) * VST + (16 * (g16 & 1) + 4 * (li & 3)) * 2;
    s16x4 vlo[2][ND], vhi[2][ND];
#pragma unroll
    for (int s = 0; s < 2; ++s)
#pragma unroll
        for (int d0 = 0; d0 < ND; ++d0) { vlo[s][d0] = vtr(vb + (16 * s) * VST + d0 * 64); vhi[s][d0] = vtr(vb + (16 * s + 8) * VST + d0 * 64); }
    __builtin_amdgcn_sched_barrier(0);
#pragma unroll
    for (int s = 0; s < 2; ++s)
#pragma unroll
        for (int d0 = 0; d0 < ND; ++d0) {
            const bf16x8 vf = (bf16x8){vlo[s][d0][0], vlo[s][d0][1], vlo[s][d0][2], vlo[s][d0][3], vhi[s][d0][0], vhi[s][d0][1], vhi[s][d0][2], vhi[s][d0][3]};
            o[d0] = __builtin_amdgcn_mfma_f32_32x32x16_bf16(s == 0 ? pa0 : pa1, vf, o[d0], 0, 0, 0);
        }
    CBAR();
}
template <int ND>
__device__ __forceinline__ void attn_finish(f32x16 (&o)[ND], float l, LAS float* wsf, int lane, int hi) {
    const float inv = frcp(swapsum(l));
    CBAR();
    if (hi == 0) wsf[lane & 31] = inv;
    CBAR();
#pragma unroll
    for (int g4 = 0; g4 < 4; ++g4) { const f32x4 a4 = *(const LAS f32x4*)(wsf + 8 * g4 + 4 * hi);
#pragma unroll
        for (int d0 = 0; d0 < ND; ++d0) { o[d0][4 * g4 + 0] *= a4[0]; o[d0][4 * g4 + 1] *= a4[1]; o[d0][4 * g4 + 2] *= a4[2]; o[d0][4 * g4 + 3] *= a4[3]; } }
    CBAR();
}

__device__ __forceinline__ void glds16s(const void* sbase, unsigned voff, unsigned lds_dst) { unsigned keep;
    asm volatile("s_mov_b32 %0, m0\n\ts_mov_b32 m0, %2\n\ts_nop 0\n\tglobal_load_lds_dwordx4 %1, %3\n\ts_mov_b32 m0, %0" : "=&s"(keep) : "v"(voff), "s"(lds_dst), "s"(sbase) : "memory"); }
__device__ __forceinline__ void glds16(const void* gsrc, unsigned lds_dst) { unsigned keep;
    asm volatile("s_mov_b32 %0, m0\n\ts_mov_b32 m0, %2\n\ts_nop 0\n\tglobal_load_lds_dwordx4 %1, off\n\ts_mov_b32 m0, %0" : "=&s"(keep) : "v"(gsrc), "s"(lds_dst) : "memory"); }
__device__ __forceinline__ void diff_qk(f32x16& p0, f32x16& p1, const LAS unsigned char* qlds, const LAS unsigned char* kb, int lane, int hi) {
    const int r32 = lane & 31, sw = (r32 >> 1) & 7;
    const LAS unsigned char* kp = kb + r32 * 128;
    p0 = f32x16{}; p1 = f32x16{};
#pragma unroll
    for (int d0 = 0; d0 < 4; ++d0) {
        const bf16x8 q = *(const LAS bf16x8*)(qlds + d0 * 1024 + lane * 16);
        const int po = ((2 * d0 + hi) ^ sw) << 4;
        const bf16x8 k0 = *(const LAS bf16x8*)(kp + po), k1 = *(const LAS bf16x8*)(kp + po + 4096);
        p0 = __builtin_amdgcn_mfma_f32_32x32x16_bf16(k0, q, p0, 0, 0, 0);
        p1 = __builtin_amdgcn_mfma_f32_32x32x16_bf16(k1, q, p1, 0, 0, 0);
    }
}
__device__ __forceinline__ void diff_sm_pv(f32x16 (&o)[4], float& m, float& l, f32x16& p0, f32x16& p1, const LAS unsigned char* vbuf, LAS float* wsf, int lane, int hi) {
    const int r32 = lane & 31;
    float ma = max3f(p0[0], p0[1], p1[0]), mb = max3f(p0[2], p0[3], p1[1]); ma = max3f(ma, p1[2], p1[3]);
#pragma unroll
    for (int r = 4; r < 16; r += 4) { ma = max3f(ma, p0[r], p0[r + 1]); mb = max3f(mb, p0[r + 2], p0[r + 3]); ma = max3f(ma, p1[r], p1[r + 1]); mb = max3f(mb, p1[r + 2], p1[r + 3]); }
    float mx = max3f(ma, mb, m);
    { float a = mx, b = mx; swap32(a, b); mx = max3f(a, b, m); }
    const float mn = (mx > m + RESCALE_THR) ? mx : m;
    const float alpha = fexp2(m - mn);
    m = mn;
    float rs = 0.f;
#pragma unroll
    for (int r = 0; r < 16; ++r) { p0[r] = fexp2(p0[r] - mn); p1[r] = fexp2(p1[r] - mn); rs += p0[r] + p1[r]; }
    l = l * alpha + rs;
    if (__any(alpha != 1.0f)) {
        CBAR();
        if (hi == 0) wsf[r32] = alpha;
        CBAR();
#pragma unroll
        for (int g4 = 0; g4 < 4; ++g4) { const f32x4 a4 = *(const LAS f32x4*)(wsf + 8 * g4 + 4 * hi);
#pragma unroll
            for (int d0 = 0; d0 < 4; ++d0) { o[d0][4 * g4 + 0] *= a4[0]; o[d0][4 * g4 + 1] *= a4[1]; o[d0][4 * g4 + 2] *= a4[2]; o[d0][4 * g4 + 3] *= a4[3]; } }
        CBAR();
    }
    u32x4 pw[4];
#pragma unroll
    for (int i = 0; i < 4; ++i) { pw[0][i] = cvtpk_s(p0[2 * i], p0[2 * i + 1]); pw[1][i] = cvtpk_s(p0[8 + 2 * i], p0[9 + 2 * i]); pw[2][i] = cvtpk_s(p1[2 * i], p1[2 * i + 1]); pw[3][i] = cvtpk_s(p1[8 + 2 * i], p1[9 + 2 * i]); }
    const int li = lane & 15, g16 = lane >> 4;
    const LAS unsigned char* vp = vbuf + hi * 1024 + (li >> 2) * 64 + (16 * (g16 & 1) + 4 * (li & 3)) * 2;
#pragma unroll
    for (int s4 = 0; s4 < 4; ++s4) {
        const bf16x8 pa = __builtin_bit_cast(bf16x8, pw[s4]);
#pragma unroll
        for (int d0 = 0; d0 < 4; ++d0) {
            const s16x4 lo = vtr(vp + s4 * 4096 + d0 * 256), hh = vtr(vp + s4 * 4096 + 2048 + d0 * 256);
            const bf16x8 vf = (bf16x8){lo[0], lo[1], lo[2], lo[3], hh[0], hh[1], hh[2], hh[3]};
            o[d0] = __builtin_amdgcn_mfma_f32_32x32x16_bf16(pa, vf, o[d0], 0, 0, 0);
        }
    }
}

__device__ __forceinline__ void diff_sm(f32x16 (&o)[4], float& m, float& l, f32x16& p0, f32x16& p1, u32x4 (&pw)[4], LAS float* wsf, int lane, int hi) {
    const int r32 = lane & 31;
    float ma = max3f(p0[0], p0[1], p1[0]), mb = max3f(p0[2], p0[3], p1[1]); ma = max3f(ma, p1[2], p1[3]);
#pragma unroll
    for (int r = 4; r < 16; r += 4) { ma = max3f(ma, p0[r], p0[r + 1]); mb = max3f(mb, p0[r + 2], p0[r + 3]); ma = max3f(ma, p1[r], p1[r + 1]); mb = max3f(mb, p1[r + 2], p1[r + 3]); }
    float mx = max3f(ma, mb, m);
    { float a = mx, b = mx; swap32(a, b); mx = max3f(a, b, m); }
    const float mn = (mx > m + RESCALE_THR) ? mx : m;
    const float alpha = fexp2(m - mn);
    m = mn;
    float rs = 0.f;
#pragma unroll
    for (int r = 0; r < 16; ++r) { p0[r] = fexp2(p0[r] - mn); p1[r] = fexp2(p1[r] - mn); rs += p0[r] + p1[r]; }
    l = l * alpha + rs;
    if (__any(alpha != 1.0f)) {
        CBAR();
        if (hi == 0) wsf[r32] = alpha;
        CBAR();
#pragma unroll
        for (int g4 = 0; g4 < 4; ++g4) { const f32x4 a4 = *(const LAS f32x4*)(wsf + 8 * g4 + 4 * hi);
#pragma unroll
            for (int d0 = 0; d0 < 4; ++d0) { o[d0][4 * g4 + 0] *= a4[0]; o[d0][4 * g4 + 1] *= a4[1]; o[d0][4 * g4 + 2] *= a4[2]; o[d0][4 * g4 + 3] *= a4[3]; } }
        CBAR();
    }
#pragma unroll
    for (int i = 0; i < 4; ++i) { pw[0][i] = cvtpk_s(p0[2 * i], p0[2 * i + 1]); pw[1][i] = cvtpk_s(p0[8 + 2 * i], p0[9 + 2 * i]); pw[2][i] = cvtpk_s(p1[2 * i], p1[2 * i + 1]); pw[3][i] = cvtpk_s(p1[8 + 2 * i], p1[9 + 2 * i]); }
}
__device__ __forceinline__ void diff_pv2(f32x16 (&o0)[4], f32x16 (&o1)[4], const u32x4 (&pw0)[4], const u32x4 (&pw1)[4], const LAS unsigned char* vbuf, int lane_, int hi_) {
    int lane = lane_; asm volatile("" : "+v"(lane));
    const int hi = lane >> 5; (void)hi_;
    const int li = lane & 15, g16 = lane >> 4;
    const LAS unsigned char* vp = vbuf + hi * 1024 + (li >> 2) * 64 + (16 * (g16 & 1) + 4 * (li & 3)) * 2;
    __builtin_amdgcn_s_setprio(1);
#pragma unroll
    for (int s4 = 0; s4 < 4; ++s4) {
        const bf16x8 pa0 = __builtin_bit_cast(bf16x8, pw0[s4]), pa1 = __builtin_bit_cast(bf16x8, pw1[s4]);
#pragma unroll
        for (int d0 = 0; d0 < 4; ++d0) {
            const s16x4 lo = vtr(vp + s4 * 4096 + d0 * 256), hh = vtr(vp + s4 * 4096 + 2048 + d0 * 256);
            const bf16x8 vf = (bf16x8){lo[0], lo[1], lo[2], lo[3], hh[0], hh[1], hh[2], hh[3]};
            o0[d0] = __builtin_amdgcn_mfma_f32_32x32x16_bf16(pa0, vf, o0[d0], 0, 0, 0);
            o1[d0] = __builtin_amdgcn_mfma_f32_32x32x16_bf16(pa1, vf, o1[d0], 0, 0, 0);
        }
    }
    __builtin_amdgcn_s_setprio(0);
}
__device__ __forceinline__ void diff_qk_f(f32x16& p0, f32x16& p1, const LAS unsigned char* qlds, const LAS unsigned char* kb, const LAS unsigned char* ap, const LAS unsigned char* bp, int lane_, int hi_) {
    int lane = lane_; asm volatile("" : "+v"(lane));
    const int hi = lane >> 5; (void)hi_;
    const int r32 = lane & 31, sw = (r32 >> 1) & 7;
    const LAS unsigned char* kp = kb + r32 * 128;
    { const bf16x8 a1 = *(const LAS bf16x8*)ap, bm = *(const LAS bf16x8*)bp;
      p0 = __builtin_amdgcn_mfma_f32_32x32x16_bf16(a1, bm, f32x16{}, 0, 0, 0);
      p1 = __builtin_amdgcn_mfma_f32_32x32x16_bf16(a1, bm, f32x16{}, 0, 0, 0); }
#pragma unroll
    for (int d0 = 0; d0 < 4; ++d0) {
        const bf16x8 q = *(const LAS bf16x8*)(qlds + d0 * 1024 + lane * 16);
        const int po = ((2 * d0 + hi) ^ sw) << 4;
        const bf16x8 k0 = *(const LAS bf16x8*)(kp + po), k1 = *(const LAS bf16x8*)(kp + po + 4096);
        p0 = __builtin_amdgcn_mfma_f32_32x32x16_bf16(k0, q, p0, 0, 0, 0);
        p1 = __builtin_amdgcn_mfma_f32_32x32x16_bf16(k1, q, p1, 0, 0, 0);
    }
}
__device__ __forceinline__ void diff_sm_head(f32x16 (&o)[4], float& m, float& l, f32x16& p0, f32x16& p1, LAS float* wsf, LAS unsigned char* bslot, bool first, int lane, int hi) {
    float ma = max3f(p0[0], p0[1], p1[0]), mb = max3f(p0[2], p0[3], p1[1]); ma = max3f(ma, p1[2], p1[3]);
#pragma unroll
    for (int r = 4; r < 16; r += 4) { ma = max3f(ma, p0[r], p0[r + 1]); mb = max3f(mb, p0[r + 2], p0[r + 3]); ma = max3f(ma, p1[r], p1[r + 1]); mb = max3f(mb, p1[r + 2], p1[r + 3]); }
    float mx = __builtin_fmaxf(ma, mb);
    { float a = mx, b = mx; swap32(a, b); mx = __builtin_fmaxf(a, b); }
    const bool up = first || (mx > RESCALE_THR);
    if (__any(up)) {
        const float mnew = up ? __builtin_bit_cast(float, f2bf(m + mx) << 16) : m, delta = mnew - m;
        const float alpha = fexp2(-delta);
        m = mnew; l *= alpha;
        CBAR();
        int l2 = lane; asm volatile("" : "+v"(l2));
        if (hi == 0) { wsf[l2 & 31] = alpha; *(LAS unsigned*)bslot = f2bf(-mnew); }
        CBAR();
#pragma unroll
        for (int g4 = 0; g4 < 4; ++g4) { const f32x4 a4 = *(const LAS f32x4*)(wsf + 8 * g4 + 4 * (l2 >> 5));
#pragma unroll
            for (int d0 = 0; d0 < 4; ++d0) { o[d0][4 * g4 + 0] *= a4[0]; o[d0][4 * g4 + 1] *= a4[1]; o[d0][4 * g4 + 2] *= a4[2]; o[d0][4 * g4 + 3] *= a4[3]; } }
#pragma unroll
        for (int r = 0; r < 16; ++r) { p0[r] -= delta; p1[r] -= delta; }
        CBAR();
    }
}
__device__ __forceinline__ void diff_sm_tail(float& l, f32x16& p0, f32x16& p1, u32x4 (&pw)[4]) {
    float rs = 0.f;
#pragma unroll
    for (int r = 0; r < 16; ++r) { p0[r] = fexp2(p0[r]); p1[r] = fexp2(p1[r]); rs += p0[r] + p1[r]; }
    l += rs;
#pragma unroll
    for (int i = 0; i < 4; ++i) { pw[0][i] = cvtpk_s(p0[2 * i], p0[2 * i + 1]); pw[1][i] = cvtpk_s(p0[8 + 2 * i], p0[9 + 2 * i]); pw[2][i] = cvtpk_s(p1[2 * i], p1[2 * i + 1]); pw[3][i] = cvtpk_s(p1[8 + 2 * i], p1[9 + 2 * i]); }
}
__device__ __forceinline__ void diff_tail_pv2(f32x16 (&o0)[4], f32x16 (&o1)[4], float& l0, float& l1, const f32x16& a0, const f32x16& a1, const f32x16& b0, const f32x16& b1, const LAS unsigned char* vbuf, int lane_) {
    int lane = lane_; asm volatile("" : "+v"(lane));
    const int hi = lane >> 5, li = lane & 15, g16 = lane >> 4;
    const LAS unsigned char* vp = vbuf + hi * 1024 + (li >> 2) * 64 + (16 * (g16 & 1) + 4 * (li & 3)) * 2;
    float rs0 = 0.f, rs1 = 0.f;
    u32x4 pa, pb, pan = {0u, 0u, 0u, 0u}, pbn = {0u, 0u, 0u, 0u};
#define TP_A(st, i) do { const int r_ = ((st) & 1) * 8 + 2 * (i); const float e0_ = fexp2((st) < 2 ? a0[r_] : a1[r_]), e1_ = fexp2((st) < 2 ? a0[r_ + 1] : a1[r_ + 1]); rs0 += e0_; rs0 += e1_; asm volatile("" : "+v"(rs0)); pan[i] = cvtpk_s(e0_, e1_); } while (0)
#define TP_B(st, i) do { const int r_ = ((st) & 1) * 8 + 2 * (i); const float e0_ = fexp2((st) < 2 ? b0[r_] : b1[r_]), e1_ = fexp2((st) < 2 ? b0[r_ + 1] : b1[r_ + 1]); rs1 += e0_; rs1 += e1_; asm volatile("" : "+v"(rs1)); pbn[i] = cvtpk_s(e0_, e1_); } while (0)
#pragma unroll
    for (int i = 0; i < 4; ++i) { TP_A(0, i); TP_B(0, i); }
    pa = pan; pb = pbn;
    s16x4 flo[3], fhh[3];
#define TP_RD(c) do { flo[(c) % 3] = vtr(vp + ((c) >> 2) * 4096 + ((c) & 3) * 256); fhh[(c) % 3] = vtr(vp + ((c) >> 2) * 4096 + 2048 + ((c) & 3) * 256); } while (0)
    TP_RD(0); TP_RD(1);
    __builtin_amdgcn_sched_barrier(0);
#pragma unroll
    for (int c = 0; c < 16; ++c) {
        const int st = c >> 2, d0 = c & 3;
        if (c + 2 < 16) TP_RD(c + 2);
        const bf16x8 vf = (bf16x8){flo[c % 3][0], flo[c % 3][1], flo[c % 3][2], flo[c % 3][3], fhh[c % 3][0], fhh[c % 3][1], fhh[c % 3][2], fhh[c % 3][3]};
        o0[d0] = __builtin_amdgcn_mfma_f32_32x32x16_bf16(__builtin_bit_cast(bf16x8, pa), vf, o0[d0], 0, 0, 0);
        if (st < 3) TP_A(st + 1, d0);
        __builtin_amdgcn_sched_barrier(0);
        o1[d0] = __builtin_amdgcn_mfma_f32_32x32x16_bf16(__builtin_bit_cast(bf16x8, pb), vf, o1[d0], 0, 0, 0);
        if (st < 3) TP_B(st + 1, d0);
        __builtin_amdgcn_sched_barrier(0);
        if (d0 == 3) { pa = pan; pb = pbn; }
    }
#undef TP_A
#undef TP_B
#undef TP_RD
    l0 += rs0; l1 += rs1;
}
__device__ __forceinline__ void hm_step(int k, float& ma, float& mb, const f32x16& p0, const f32x16& p1) {
    if (k == 0) ma = max3f(p0[0], p0[1], p1[0]);
    else if (k == 1) mb = max3f(p0[2], p0[3], p1[1]);
    else if (k == 2) ma = max3f(ma, p1[2], p1[3]);
    else { const int j = (k - 3) >> 2, w = (k - 3) & 3, r = 4 + 4 * j;
        if (w == 0) ma = max3f(ma, p0[r], p0[r + 1]); else if (w == 1) mb = max3f(mb, p0[r + 2], p0[r + 3]); else if (w == 2) ma = max3f(ma, p1[r], p1[r + 1]); else mb = max3f(mb, p1[r + 2], p1[r + 3]); }
}
__device__ __forceinline__ void hm_finish(f32x16 (&o)[4], float& m, float& l, float ma, float mb, f32x16& p0, f32x16& p1, LAS float* wsf, LAS unsigned char* bslot, bool first, int lane) {
    float mx = __builtin_fmaxf(ma, mb);
    { float a = mx, b = mx; swap32(a, b); mx = __builtin_fmaxf(a, b); }
    const bool up = first || (mx > RESCALE_THR);
    if (__any(up)) {
        const float mnew = up ? __builtin_bit_cast(float, f2bf(m + mx) << 16) : m, delta = mnew - m;
        const float alpha = fexp2(-delta);
        m = mnew; l *= alpha;
        CBAR();
        int l2 = lane; asm volatile("" : "+v"(l2));
        if ((l2 >> 5) == 0) { wsf[l2 & 31] = alpha; *(LAS unsigned*)bslot = f2bf(-mnew); }
        CBAR();
#pragma unroll
        for (int g4 = 0; g4 < 4; ++g4) { const f32x4 a4 = *(const LAS f32x4*)(wsf + 8 * g4 + 4 * (l2 >> 5));
#pragma unroll
            for (int d0 = 0; d0 < 4; ++d0) { o[d0][4 * g4 + 0] *= a4[0]; o[d0][4 * g4 + 1] *= a4[1]; o[d0][4 * g4 + 2] *= a4[2]; o[d0][4 * g4 + 3] *= a4[3]; } }
#pragma unroll
        for (int r = 0; r < 16; ++r) { p0[r] -= delta; p1[r] -= delta; }
        CBAR();
    }
}
__device__ __forceinline__ void diffA_step(f32x16 (&o0)[4], f32x16 (&o1)[4], float& m0, float& l0, float& m1, float& l1, const LAS unsigned char* qlds, const LAS unsigned char* kb0, const LAS unsigned char* kb1,
                                           const LAS unsigned char* vbuf, LAS unsigned char* bsel, LAS float* wsf, bool first, int lane_) {
    int lane = lane_; asm volatile("" : "+v"(lane));
    const int hi = lane >> 5;
    f32x16 s0, s1, s2, s3;
    diff_qk_f(s0, s1, qlds, kb0, bsel + 32, bsel, lane, hi);
#define SB() __builtin_amdgcn_sched_barrier(0)
    const int r32 = lane & 31, sw = (r32 >> 1) & 7;
    const LAS unsigned char* kp = kb1 + r32 * 128; const LAS unsigned char* qp = qlds + 4096 + lane * 16;
    float ma = 0.f, mb = 0.f, rs0 = 0.f, rs1 = 0.f;
    u32x4 pa, pb, pan, pbn;
#define TP_A(st, i) do { const int r_ = ((st) & 1) * 8 + 2 * (i); const float e0_ = fexp2((st) < 2 ? s0[r_] : s1[r_]), e1_ = fexp2((st) < 2 ? s0[r_ + 1] : s1[r_ + 1]); rs0 += e0_; rs0 += e1_; asm volatile("" : "+v"(rs0)); pan[i] = cvtpk_s(e0_, e1_); } while (0)
#define TP_B(st, i) do { const int r_ = ((st) & 1) * 8 + 2 * (i); const float e0_ = fexp2((st) < 2 ? s2[r_] : s3[r_]), e1_ = fexp2((st) < 2 ? s2[r_ + 1] : s3[r_ + 1]); rs1 += e0_; rs1 += e1_; asm volatile("" : "+v"(rs1)); pbn[i] = cvtpk_s(e0_, e1_); } while (0)
    {
        const bf16x8 a1 = *(const LAS bf16x8*)(bsel + 32), bm = *(const LAS bf16x8*)(bsel + 16);
        bf16x8 qf[2], k0f, k1f;
#define RD_Q(d0)  qf[(d0) & 1] = *(const LAS bf16x8*)(qp + (d0) * 1024)
#define RD_K0(d0) k0f = *(const LAS bf16x8*)(kp + (((2 * (d0) + hi) ^ sw) << 4))
#define RD_K1(d0) k1f = *(const LAS bf16x8*)(kp + (((2 * (d0) + hi) ^ sw) << 4) + 4096)
        RD_Q(0); RD_K0(0); RD_K1(0); RD_Q(1);
        SB();
        s2 = __builtin_amdgcn_mfma_f32_32x32x16_bf16(a1, bm, f32x16{}, 0, 0, 0);
        asm volatile("s_nop 7" : "+v"(s0), "+v"(s1));
        hm_step(0, ma, mb, s0, s1); hm_step(1, ma, mb, s0, s1);
        SB();
        s3 = __builtin_amdgcn_mfma_f32_32x32x16_bf16(a1, bm, f32x16{}, 0, 0, 0);
        hm_step(2, ma, mb, s0, s1); hm_step(3, ma, mb, s0, s1); hm_step(4, ma, mb, s0, s1);
        SB();
        s2 = __builtin_amdgcn_mfma_f32_32x32x16_bf16(k0f, qf[0], s2, 0, 0, 0);
        RD_K0(1);
        hm_step(5, ma, mb, s0, s1); hm_step(6, ma, mb, s0, s1); hm_step(7, ma, mb, s0, s1);
        SB();
        s3 = __builtin_amdgcn_mfma_f32_32x32x16_bf16(k1f, qf[0], s3, 0, 0, 0);
        RD_K1(1); RD_Q(2);
        hm_step(8, ma, mb, s0, s1); hm_step(9, ma, mb, s0, s1); hm_step(10, ma, mb, s0, s1);
        SB();
        s2 = __builtin_amdgcn_mfma_f32_32x32x16_bf16(k0f, qf[1], s2, 0, 0, 0);
        RD_K0(2);
        hm_step(11, ma, mb, s0, s1); hm_step(12, ma, mb, s0, s1);
        SB();
        s3 = __builtin_amdgcn_mfma_f32_32x32x16_bf16(k1f, qf[1], s3, 0, 0, 0);
        RD_K1(2); RD_Q(3);
        hm_step(13, ma, mb, s0, s1); hm_step(14, ma, mb, s0, s1);
        SB();
        hm_finish(o0, m0, l0, ma, mb, s0, s1, wsf, bsel, first, lane);
        SB();
        s2 = __builtin_amdgcn_mfma_f32_32x32x16_bf16(k0f, qf[0], s2, 0, 0, 0);
        RD_K0(3);
        TP_A(0, 0);
        SB();
        s3 = __builtin_amdgcn_mfma_f32_32x32x16_bf16(k1f, qf[0], s3, 0, 0, 0);
        RD_K1(3);
        TP_A(0, 1);
        SB();
        s2 = __builtin_amdgcn_mfma_f32_32x32x16_bf16(k0f, qf[1], s2, 0, 0, 0);
        TP_A(0, 2);
        SB();
        s3 = __builtin_amdgcn_mfma_f32_32x32x16_bf16(k1f, qf[1], s3, 0, 0, 0);
        TP_A(0, 3);
        SB();
#undef RD_Q
#undef RD_K0
#undef RD_K1
#define QK_RD(x)
#undef QK_RD
    }
    pa = pan;
    asm volatile("s_nop 15\n\ts_nop 7" : "+v"(s2), "+v"(s3));
    ma = 0.f; mb = 0.f;
#pragma unroll
    for (int k = 0; k < 15; ++k) hm_step(k, ma, mb, s2, s3);
    hm_finish(o1, m1, l1, ma, mb, s2, s3, wsf, bsel + 16, first, lane);
#pragma unroll
    for (int i = 0; i < 4; ++i) TP_B(0, i);
    pb = pbn;
    const int li = lane & 15, g16 = lane >> 4;
    const LAS unsigned char* vp = vbuf + hi * 1024 + (li >> 2) * 64 + (16 * (g16 & 1) + 4 * (li & 3)) * 2;
    s16x4 flo[3], fhh[3];
#define TP_RD(c) do { flo[(c) % 3] = vtr(vp + (((c) & 15) >> 2) * 4096 + ((c) & 3) * 256); fhh[(c) % 3] = vtr(vp + (((c) & 15) >> 2) * 4096 + 2048 + ((c) & 3) * 256); } while (0)
#define TP_VF(c) ((bf16x8){flo[(c) % 3][0], flo[(c) % 3][1], flo[(c) % 3][2], flo[(c) % 3][3], fhh[(c) % 3][0], fhh[(c) % 3][1], fhh[(c) % 3][2], fhh[(c) % 3][3]})
    TP_RD(0); TP_RD(1);
    SB();
#pragma unroll
    for (int c = 0; c < 16; ++c) {
        const int st = c >> 2, d0 = c & 3;
        if (c + 2 < 16) TP_RD(c + 2);
        o0[d0] = __builtin_amdgcn_mfma_f32_32x32x16_bf16(__builtin_bit_cast(bf16x8, pa), TP_VF(c), o0[d0], 0, 0, 0);
        if (st < 3) TP_A(st + 1, d0);
        SB();
        o1[d0] = __builtin_amdgcn_mfma_f32_32x32x16_bf16(__builtin_bit_cast(bf16x8, pb), TP_VF(c), o1[d0], 0, 0, 0);
        if (st < 3) TP_B(st + 1, d0);
        SB();
        if (d0 == 3) { pa = pan; pb = pbn; }
    }
#undef TP_A
#undef TP_B
#undef TP_RD
#undef TP_VF
#undef SB
    l0 += rs0; l1 += rs1;
}
struct NoMask { __device__ __forceinline__ void operator()(f32x16&) const {} };

using pg8::Unit;
struct EpiZ {
    static constexpr bool PERM = true;
    bf16_t* Z; const float* ropec; const float* ropes;
    __device__ __forceinline__ void operator()(const f32x4 (&acc)[2][2][4][2], const Unit& u, int wr, int wc, int fr, int fq) const {
        const int pn = u.pn;
        const int type = (pn < 2) ? 0 : (pn < 4) ? 1 : (pn < 6) ? 2 : (pn == 6) ? 3 : (pn < 9) ? 2 : (pn < 12) ? 0 : (pn < 15) ? 1 : (pn < 18) ? 2 : 4;
        const int row0 = u.pm * 256 + wr * 64 + fr, col0 = pn * 256 + wc * 32 + 8 * fq;
        const int j0 = 16 * (wc & 1) + 4 * fq;
#pragma unroll
        for (int ai = 0; ai < 2; ++ai) {
            f32x4 cq[4], sq[4];
#pragma unroll
            for (int m = 0; m < 4; ++m) { const int pos = (row0 + ai * 128 + m * 16) & (SEQ - 1); cq[m] = (f32x4){1.f, 1.f, 1.f, 1.f}; sq[m] = (f32x4){0.f, 0.f, 0.f, 0.f};
                if (type < 2) { cq[m] = *(const f32x4*)(ropec + pos * 32 + j0); sq[m] = *(const f32x4*)(ropes + pos * 32 + j0); } }
#pragma unroll
            for (int m = 0; m < 4; ++m) {
                const int row = row0 + ai * 128 + m * 16;
                const f32x4 c4 = cq[m], s4 = sq[m];
                bf16_t* rowp = Z + (size_t)row * ZW + col0;
#pragma unroll
                for (int bj = 0; bj < 2; ++bj) {
                    f32x4 v0 = acc[ai][bj][m][0], v1 = acc[ai][bj][m][1];
                    if (type < 2) {
                        f32x4 w0, w1;
                        w0[0] = v0[0] * c4[0] - v0[1] * s4[0]; w0[1] = v0[1] * c4[0] + v0[0] * s4[0];
                        w0[2] = v0[2] * c4[1] - v0[3] * s4[1]; w0[3] = v0[3] * c4[1] + v0[2] * s4[1];
                        w1[0] = v1[0] * c4[2] - v1[1] * s4[2]; w1[1] = v1[1] * c4[2] + v1[0] * s4[2];
                        w1[2] = v1[2] * c4[3] - v1[3] * s4[3]; w1[3] = v1[3] * c4[3] + v1[2] * s4[3];
                        v0 = w0; v1 = w1;
                    }
                    if (type == 4) {
#pragma unroll
                        for (int j = 0; j < 4; ++j) { v0[j] = __builtin_fmaxf(frcp(1.f + fexp2(v0[j])), 0.f); v1[j] = __builtin_fmaxf(frcp(1.f + fexp2(v1[j])), 0.f); }
                    }
                    u32x4 w; w.x = cvt_pk_bf16(v0[0], v0[1]); w.y = cvt_pk_bf16(v0[2], v0[3]); w.z = cvt_pk_bf16(v1[0], v1[1]); w.w = cvt_pk_bf16(v1[2], v1[3]);
                    st16_wt(rowp + bj * 128, w);
                }
                CBAR();
            }
        }
    }
};
struct EpiProj {
    static constexpr bool PERM = true;
    bf16_t* Mg; const bf16_t* Zg0;
    __device__ __forceinline__ void operator()(const f32x4 (&acc)[2][2][4][2], const Unit& u, int wr, int wc, int fr, int fq) const {
        const int row0 = u.pm * 256 + wr * 64 + fr, col0 = u.pn * 256 + wc * 32 + 8 * fq;
        const bf16_t* Zg = Zg0 + (u.e & 15) * 1024; const int first = u.e >> 4;
#pragma unroll
        for (int ai = 0; ai < 2; ++ai) {
            u32x4 gq[4][2], oq[4][2];
#pragma unroll
            for (int m = 0; m < 4; ++m)
#pragma unroll
                for (int bj = 0; bj < 2; ++bj) { const int row = row0 + ai * 128 + m * 16, col = col0 + bj * 128;
                    gq[m][bj] = *(const u32x4*)(Zg + (size_t)row * ZW + col);
                    oq[m][bj] = first ? (u32x4){0u, 0u, 0u, 0u} : *(const u32x4*)(Mg + (size_t)row * D + col); }
#pragma unroll
            for (int m = 0; m < 4; ++m)
#pragma unroll
                for (int bj = 0; bj < 2; ++bj) { const int row = row0 + ai * 128 + m * 16, col = col0 + bj * 128;
                    const u32x4 g = gq[m][bj], o = oq[m][bj];
                    const f32x4 v0 = acc[ai][bj][m][0], v1 = acc[ai][bj][m][1];
                    const float r0 = bflo(g.x) * v0[0] + bflo(o.x), r1 = bfhi(g.x) * v0[1] + bfhi(o.x), r2 = bflo(g.y) * v0[2] + bflo(o.y), r3 = bfhi(g.y) * v0[3] + bfhi(o.y);
                    const float r4 = bflo(g.z) * v1[0] + bflo(o.z), r5 = bfhi(g.z) * v1[1] + bfhi(o.z), r6 = bflo(g.w) * v1[2] + bflo(o.w), r7 = bfhi(g.w) * v1[3] + bfhi(o.w);
                    u32x4 w; w.x = cvt_pk_bf16(r0, r1); w.y = cvt_pk_bf16(r2, r3); w.z = cvt_pk_bf16(r4, r5); w.w = cvt_pk_bf16(r6, r7);
                    *(u32x4*)(Mg + (size_t)row * D + col) = w; }
            CBAR();
        }
    }
};
struct EpiOut {
    static constexpr bool PERM = true;
    bf16_t* X; const float* gate;
    __device__ __forceinline__ void operator()(const f32x4 (&acc)[2][2][4][2], const Unit& u, int wr, int wc, int fr, int fq) const {
        const int row0 = u.pm * 256 + wr * 64 + fr, col0 = u.pn * 256 + wc * 32 + 8 * fq;
        const int b = (u.pm * 256) / SEQ;
        f32x4 gv[2][2];
#pragma unroll
        for (int bj = 0; bj < 2; ++bj)
#pragma unroll
            for (int n = 0; n < 2; ++n) gv[bj][n] = *(const f32x4*)(gate + (size_t)b * 6 * D + col0 + bj * 128 + 4 * n);
        u32x4 xq[2][4][2];
#pragma unroll
        for (int ai = 0; ai < 2; ++ai)
#pragma unroll
            for (int m = 0; m < 4; ++m)
#pragma unroll
                for (int bj = 0; bj < 2; ++bj) xq[ai][m][bj] = *(const u32x4*)(X + (size_t)(row0 + ai * 128 + m * 16) * D + col0 + bj * 128);
#pragma unroll
        for (int ai = 0; ai < 2; ++ai) {
#pragma unroll
            for (int m = 0; m < 4; ++m)
#pragma unroll
                for (int bj = 0; bj < 2; ++bj) { const u32x4 o = xq[ai][m][bj];
                    const f32x4 r0 = (f32x4){bflo(o.x), bfhi(o.x), bflo(o.y), bfhi(o.y)} + gv[bj][0] * acc[ai][bj][m][0], r1 = (f32x4){bflo(o.z), bfhi(o.z), bflo(o.w), bfhi(o.w)} + gv[bj][1] * acc[ai][bj][m][1];
                    u32x4 w; w.x = cvt_pk_bf16(r0[0], r0[1]); w.y = cvt_pk_bf16(r0[2], r0[3]); w.z = cvt_pk_bf16(r1[0], r1[1]); w.w = cvt_pk_bf16(r1[2], r1[3]);
                    *(u32x4*)(X + (size_t)(row0 + ai * 128 + m * 16) * D + col0 + bj * 128) = w; }
            CBAR();
        }
    }
};
struct EpiSwiglu {
    static constexpr bool PERM = true;
    bf16_t* H;
    __device__ __forceinline__ void operator()(const f32x4 (&acc)[2][2][4][2], const Unit& u, int wr, int wc, int fr, int fq) const {
        const int row0 = u.pm * 256 + wr * 64 + fr, hc = u.pn * 128 + wc * 32 + 8 * fq;
#pragma unroll
        for (int ai = 0; ai < 2; ++ai)
#pragma unroll
            for (int m = 0; m < 4; ++m) {
                const int row = row0 + ai * 128 + m * 16;
                float h[8];
#pragma unroll
                for (int n = 0; n < 2; ++n) { const f32x4 a = acc[ai][0][m][n], b = acc[ai][1][m][n];
#pragma unroll
                    for (int j = 0; j < 4; ++j) h[4 * n + j] = a[j] * frcp(1.f + fexp2(-a[j] * LOG2E)) * b[j]; }
                u32x4 w; w.x = cvt_pk_bf16(h[0], h[1]); w.y = cvt_pk_bf16(h[2], h[3]); w.z = cvt_pk_bf16(h[4], h[5]); w.w = cvt_pk_bf16(h[6], h[7]);
                st16_wt(H + (size_t)row * EH + hc, w);
            }
    }
};
struct EpiY {
    static constexpr bool PERM = true;
    bf16_t* Y;
    __device__ __forceinline__ void operator()(const f32x4 (&acc)[2][2][4][2], const Unit& u, int wr, int wc, int fr, int fq) const {
        const int row0 = u.pm * 256 + wr * 64 + fr, col0 = u.pn * 256 + wc * 32 + 8 * fq;
#pragma unroll
        for (int ai = 0; ai < 2; ++ai)
#pragma unroll
            for (int m = 0; m < 4; ++m) { bf16_t* rowp = Y + (size_t)(row0 + ai * 128 + m * 16) * D + col0;
#pragma unroll
                for (int bj = 0; bj < 2; ++bj) { const f32x4 v0 = acc[ai][bj][m][0], v1 = acc[ai][bj][m][1];
                    u32x4 w; w.x = cvt_pk_bf16(v0[0], v0[1]); w.y = cvt_pk_bf16(v0[2], v0[3]); w.z = cvt_pk_bf16(v1[0], v1[1]); w.w = cvt_pk_bf16(v1[2], v1[3]);
                    *(u32x4*)(rowp + bj * 128) = w; } }
    }
};

constexpr int NWAVES = 8;
constexpr int NPHASE = 2 + 9 * DEPTH;

__global__ void __launch_bounds__(NWAVES * 64, 2) fwd_kernel(Args args) {
    extern __shared__ __attribute__((aligned(16))) unsigned char lds_raw[];
    LAS unsigned char* lds = (LAS unsigned char*)lds_raw;
    volatile LAS unsigned* MISC = (volatile LAS unsigned*)(lds + MISC_OFF);
    const int tid0 = threadIdx.x;
    const int G = gridDim.x, bx = blockIdx.x;
    const int vcu = (G % 8 == 0) ? (bx % 8) * (G / 8) + bx / 8 : bx;
    const int NGW = G * NWAVES;
#define WSP() size_t wsz_ = 0; asm volatile("" : "+s"(wsz_)); unsigned char* ws = args.ws + wsz_; \
    int tid = tid0; asm volatile("" : "+v"(tid)); const int lane = tid & 63, wave = __builtin_amdgcn_readfirstlane(tid >> 6), hi = lane >> 5, gw = vcu * NWAVES + wave; (void)hi; (void)gw; (void)lane; (void)wave; \
    unsigned* ctl = (unsigned*)(ws + WS_CTL); float* rtab = (float*)(ws + WS_RT); (void)rtab; float* modp = (float*)(ws + WS_MOD); float* ropec = (float*)(ws + WS_ROPE); float* ropes = ropec + SEQ * 32; \
    int* tok_e = (int*)(ws + WS_ROUTE); int* tok_pos = tok_e + 2 * M; float* tok_w = (float*)(tok_pos + 2 * M); int* tok_slot = (int*)(tok_w + 2 * M); int* etok = (int*)(ws + WS_ROUTE + 2 * MiB); \
    bf16_t* X = (bf16_t*)(ws + WS_X); bf16_t* Hn = (bf16_t*)(ws + WS_H); bf16_t* OC = (bf16_t*)(ws + WS_OCAT); bf16_t* MG = (bf16_t*)(ws + WS_MERGED); bf16_t* Z = (bf16_t*)(ws + WS_Z); \
    bf16_t* XG = (bf16_t*)(ws + WS_XG); bf16_t* HB = (bf16_t*)(ws + WS_HB); bf16_t* YB = (bf16_t*)(ws + WS_YB); \
    bf16_t* WIN = (bf16_t*)(ws + WS_WIN); bf16_t* WPR = (bf16_t*)(ws + WS_WPROJ); bf16_t* WOU = (bf16_t*)(ws + WS_WOUT); bf16_t* W13 = (bf16_t*)(ws + WS_W13); bf16_t* W2 = (bf16_t*)(ws + WS_W2); \
    (void)ctl; (void)modp; (void)ropec; (void)ropes; (void)tok_e; (void)tok_pos; (void)tok_w; (void)tok_slot; (void)etok; (void)X; (void)Hn; (void)OC; (void)MG; (void)Z; (void)XG; (void)HB; (void)YB; (void)WIN; (void)WPR; (void)WOU; (void)W13; (void)W2;
    for (int u = tid0; u < 128; u += NWAVES * 64) MISC[u] = 0u;
    __syncthreads();
#if !MK_PER_PHASE
    XcdBarrier bar = xcd_barrier_post((unsigned*)(args.ws + WS_CTL) + CW_BAR, MISC + 8);
#define GRID_BAR() xcd_barrier(bar)
#else
#define GRID_BAR() do {} while (0)
#endif
    const int lo = args.ph_lo, hi_ph = args.ph_hi;
#define IN(k) (lo <= (k) && (k) < hi_ph)
#ifndef EN_MASK
#define EN_MASK 0x3ff
#endif
#define EN(k) ((EN_MASK >> (k)) & 1)
#ifndef DUPK
#define DUPK -1
#endif
#define REP(k) for (int rep_ = 0; rep_ < ((k) == DUPK ? 2 : 1); ++rep_, __syncthreads())
#define SEAM(k) do { if (IN(k) && IN((k) + 1)) GRID_BAR(); } while (0)

    if (IN(0) && EN(0)) REP(0) {
        WSP();
        {
            LAS float* cact = (LAS float*)lds;
            LAS float* part = (LAS float*)(lds + 16384);
            for (int i = tid; i < NBATCH * D; i += NWAVES * 64) { const int b = i / D, k = i % D; const float v = args.c[i]; cact[k * 4 + b] = v / (1.f + __expf(-v)); }
            __syncthreads();
            for (int it = bx; it < DEPTH * 96; it += G) {
                const int l = it / 96, cc = it % 96, col = cc * 64 + lane;
                const float* wp = args.ada_w + (size_t)l * D * 6 * D + col;
                float a0 = 0.f, a1 = 0.f, a2 = 0.f, a3 = 0.f;
#pragma unroll 1
                for (int k0 = 0; k0 < 128; k0 += 32) {
                    float wv[32];
#pragma unroll
                    for (int kk = 0; kk < 32; ++kk) wv[kk] = wp[(size_t)(wave * 128 + k0 + kk) * 6 * D];
#pragma unroll
                    for (int kk = 0; kk < 32; ++kk) { const f32x4 cv = *(const LAS f32x4*)(cact + (wave * 128 + k0 + kk) * 4);
                        a0 += cv[0] * wv[kk]; a1 += cv[1] * wv[kk]; a2 += cv[2] * wv[kk]; a3 += cv[3] * wv[kk]; } }
                part[(wave * 4 + 0) * 64 + lane] = a0; part[(wave * 4 + 1) * 64 + lane] = a1; part[(wave * 4 + 2) * 64 + lane] = a2; part[(wave * 4 + 3) * 64 + lane] = a3;
                __syncthreads();
                if (tid < 256) { const int b = tid >> 6, cl = tid & 63; float s = 0.f;
#pragma unroll
                    for (int w = 0; w < 8; ++w) s += part[(w * 4 + b) * 64 + cl];
                    modp[((size_t)l * NBATCH + b) * 6 * D + cc * 64 + cl] = s + args.ada_b[(size_t)l * 6 * D + cc * 64 + cl]; }
                __syncthreads();
            }
        }
        for (int i = (vcu * NWAVES * 64) + tid; i < SEQ * 32; i += G * NWAVES * 64) { const int pos = i >> 5, j = i & 31; float s, c; sincos_d((double)pos * ROPE_INV[j], s, c); ropec[i] = c; ropes[i] = s; }
        for (int i = (vcu * NWAVES * 64) + tid; i < DEPTH * 36 * D; i += G * NWAVES * 64) { const int k = i & (D - 1), n = (i >> 10) % 36, l2 = i / (36 * D);
            rtab[i] = n < 4 ? args.rgw[((size_t)l2 * D + k) * 4 + n] : args.rew[((size_t)l2 * D + k) * NEXP + (n - 4)]; }
        {
            LAS float* scr = (LAS float*)(lds + wave * 16384);
            constexpr int I_WIN = 16 * 240, I_PA = 8 * 32, I_PN = 4 * 32, I_WO = 16 * 32, I_E = 256, PER_L = I_WIN + I_PA + 2 * I_PN + I_WO + NEXP * 3 * I_E;
            for (int it = gw; it < DEPTH * PER_L; it += NGW) {
                const int l = it / PER_L; int r = it % PER_L;
                if (r < I_WIN) { tr_item(args.w_in + (size_t)l * D * ZW, ZW, WIN + (size_t)l * ZW * D, D, 0, 1, scr, r, lane); continue; } r -= I_WIN;
                if (r < I_PA) { tr_item(args.wpa + (size_t)l * 512 * D, D, WPR + (size_t)l * D * D, D, 0, 0, scr, r, lane); continue; } r -= I_PA;
                if (r < I_PN) { tr_item(args.wpn + (size_t)l * 256 * D, D, WPR + (size_t)l * D * D, D, 512, 0, scr, r, lane); continue; } r -= I_PN;
                if (r < I_PN) { tr_item(args.wpd + (size_t)l * 256 * D, D, WPR + (size_t)l * D * D, D, 768, 0, scr, r, lane); continue; } r -= I_PN;
                if (r < I_WO) { tr_item(args.w_out + (size_t)l * D * D, D, WOU + (size_t)l * D * D, D, 0, 0, scr, r, lane); continue; } r -= I_WO;
                const int e = r / (3 * I_E), q = r % (3 * I_E); const size_t le = (size_t)l * NEXP + e;
                if (q < I_E) tr_item(args.ew1 + le * D * EH, EH, W13 + le * 1024 * D, D, 0, 2, scr, q, lane);
                else if (q < 2 * I_E) tr_item(args.ew3 + le * D * EH, EH, W13 + le * 1024 * D, D, 0, 3, scr, q - I_E, lane);
                else tr_item(args.ew2 + le * EH * D, D, W2 + le * D * EH, EH, 0, 0, scr, q - 2 * I_E, lane);
            }
        }
    }
    SEAM(0);

    for (int l = 0; l < DEPTH; ++l) {
        const int pb = 1 + 9 * l;
        if (IN(pb + 0) && EN(1)) {
            WSP(); const float* modl = modp + (size_t)l * NBATCH * 6 * D; (void)modl;
            const float* gam = args.mix_g + (size_t)l * D;
            const float* modprev = modp + (size_t)(l > 0 ? l - 1 : 0) * NBATCH * 6 * D;
            constexpr int RPW = M / (256 * NWAVES); const int rbase = gw * RPW, b = rbase / SEQ;
            int slot_v = 0; float w_v = 0.f;
            if (l > 0) {
                const unsigned* cntp = ctl + CW_CNT + (l - 1) * NEXP * 64;
                const int cv = (lane < NEXP) ? (int)__hip_atomic_load(cntp + lane * 64, __ATOMIC_RELAXED, __HIP_MEMORY_SCOPE_AGENT) : 0;
                const int tl = (cv + 255) >> 8; int tstart = 0, run = 0;
#pragma unroll
                for (int e = 0; e < NEXP; ++e) { if (lane == e) tstart = run; run += __builtin_amdgcn_readlane(tl, e); }
                const int i = min(lane, 2 * RPW - 1);
                const int e = tok_e[2 * rbase + i], pos = tok_pos[2 * rbase + i]; w_v = tok_w[2 * rbase + i];
                slot_v = __builtin_amdgcn_ds_bpermute(4 * e, tstart) * 256 + pos;
            }
            f32x4 ca[4], cb[4], gf[4];
#pragma unroll
            for (int j = 0; j < 4; ++j) { const int col = 4 * lane + 256 * j;
                const f32x4 g4 = *(const f32x4*)(gam + col), sc = *(const f32x4*)(modl + (size_t)b * 6 * D + 1 * D + col), sh = *(const f32x4*)(modl + (size_t)b * 6 * D + col);
                ca[j] = g4 * (sc + 1.0f); cb[j] = sh; gf[j] = *(const f32x4*)(modprev + (size_t)b * 6 * D + 5 * D + col); }
#pragma unroll 1
            for (int r0 = rbase; r0 < rbase + RPW; r0 += 4) {
                f32x4 v[4][4];
                if (l == 0) {
#pragma unroll
                    for (int q = 0; q < 4; ++q)
#pragma unroll
                        for (int j = 0; j < 4; ++j) v[q][j] = *(const f32x4*)(args.x + (size_t)(r0 + q) * D + 4 * lane + 256 * j);
                } else {
                    u32x2 xr[4][4], y0[4][4], y1[4][4]; float w0[4], w1[4];
#pragma unroll
                    for (int q = 0; q < 4; ++q) { const int ix = 2 * (r0 - rbase + q);
                        const int s0 = __builtin_amdgcn_readlane(slot_v, ix), s1 = __builtin_amdgcn_readlane(slot_v, ix + 1);
                        w0[q] = __builtin_bit_cast(float, __builtin_amdgcn_readlane(__builtin_bit_cast(int, w_v), ix)); w1[q] = __builtin_bit_cast(float, __builtin_amdgcn_readlane(__builtin_bit_cast(int, w_v), ix + 1));
#pragma unroll
                        for (int j = 0; j < 4; ++j) { const int col = 4 * lane + 256 * j;
                            xr[q][j] = *(const u32x2*)(X + (size_t)(r0 + q) * D + col); y0[q][j] = *(const u32x2*)(YB + (size_t)s0 * D + col); y1[q][j] = *(const u32x2*)(YB + (size_t)s1 * D + col); } }
#pragma unroll
                    for (int q = 0; q < 4; ++q)
#pragma unroll
                        for (int j = 0; j < 4; ++j) { const f32x4 yy = bf4(y0[q][j]) * w0[q] + bf4(y1[q][j]) * w1[q]; v[q][j] = bf4(xr[q][j]) + gf[j] * yy; }
                }
#pragma unroll
                for (int q = 0; q < 4; ++q) { const int row = r0 + q;
                    float ss = 0.f;
#pragma unroll
                    for (int j = 0; j < 4; ++j) { u32x2 xw; xw.x = cvt_pk_bf16(v[q][j][0], v[q][j][1]); xw.y = cvt_pk_bf16(v[q][j][2], v[q][j][3]); *(u32x2*)(X + (size_t)row * D + 4 * lane + 256 * j) = xw;
                        ss += (v[q][j][0] * v[q][j][0] + v[q][j][1] * v[q][j][1]) + (v[q][j][2] * v[q][j][2] + v[q][j][3] * v[q][j][3]); }
                    const float rstd = 1.0f / sqrtf(wave_sum(ss) * (1.f / D) + NORM_EPS);
#pragma unroll
                    for (int j = 0; j < 4; ++j) { const int col = 4 * lane + 256 * j;
                        const f32x4 hv = v[q][j] * rstd * ca[j] + cb[j];
                        u32x2 w; w.x = cvt_pk_bf16(hv[0], hv[1]); w.y = cvt_pk_bf16(hv[2], hv[3]);
                        *(u32x2*)(Hn + (size_t)row * D + col) = w; }
                }
            }
        }
        SEAM(pb + 0);
        if (IN(pb + 1) && EN(2)) REP(2) {
            WSP(); const float* modl = modp + (size_t)l * NBATCH * 6 * D; (void)modl;
            pg8::Gemm g{Hn, WIN + (size_t)l * ZW * D, D, D, D}; pg8::StaticOrder S; S.init(M, ZW, G, bx);
            EpiZ E{Z, ropec, ropes};
            pg8::gemm_phase<EpiZ, pg8::StaticOrder>(lds, g, S, E);
        }
        SEAM(pb + 1);
        if (IN(pb + 2) && EN(3)) REP(3) {
            WSP(); const float* modl = modp + (size_t)l * NBATCH * 6 * D; (void)modl;
            {
                int tidm = tid0; asm volatile("" : "+v"(tidm)); const int lane = tidm & 63, hi = lane >> 5;
                LAS unsigned char* vlds = lds + wave * 12288; LAS float* wsf = (LAS float*)(lds + 98304 + wave * 256);
                const float* lp = args.da_lambda + (size_t)l * 4 * 64;
                const float s01 = wave_sum(lp[lane] * lp[64 + lane]), s23 = wave_sum(lp[128 + lane] * lp[192 + lane]);
                const float lam_init = 0.8f - 0.6f * __expf(-0.3f * (float)l);
                const float lam = __expf(s01) - __expf(s23) + lam_init;
                LAS float* wsfA = (LAS float*)(lds + 131072 + wave * 128);
                const unsigned lds0 = (unsigned)(uintptr_t)lds;
                for (int un = vcu; un < NBATCH * 4 * 16; un += G) {
                    const int b = un >> 6, h = (un >> 4) & 3, qb = un & 15;
                    const size_t rowbase = (size_t)b * SEQ; const int q0 = qb * 256 + wave * 32;
                    LAS unsigned char* qlds = lds + 65536 + wave * 8192;
                    { bf16x8 qf[8];
                      const bf16_t* qp = Z + (rowbase + q0 + (lane & 31)) * ZW + ZQA + h * 128 + 8 * hi;
#pragma unroll
                      for (int i = 0; i < 8; ++i) qf[i] = *(const bf16x8*)(qp + 16 * i);
                      asm volatile("s_waitcnt vmcnt(0)" : "+v"(qf[0]), "+v"(qf[1]), "+v"(qf[2]), "+v"(qf[3]), "+v"(qf[4]), "+v"(qf[5]), "+v"(qf[6]), "+v"(qf[7]) :: "memory");
#pragma unroll
                      for (int i = 0; i < 8; ++i) *(LAS bf16x8*)(qlds + i * 1024 + lane * 16) = qf[i]; }
                    f32x16 o0[4], o1[4];
#pragma unroll
                    for (int d0 = 0; d0 < 4; ++d0) { o0[d0] = f32x16{}; o1[d0] = f32x16{}; }
                    float m0 = 0.f, l0 = 0.f, m1 = 0.f, l1 = 0.f;
                    LAS unsigned char* bsel = lds + 132096 + (hi ? 0 : 64 + (wave * 32 + (lane & 31)) * 48);
                    { unsigned z0 = 0u, e0 = hi ? 0u : 0x3F80u; asm volatile("" : "+v"(z0), "+v"(e0));
                      *(LAS u32x4*)bsel = (u32x4){z0, z0, z0, z0}; *(LAS u32x4*)(bsel + 16) = (u32x4){z0, z0, z0, z0}; *(LAS u32x4*)(bsel + 32) = (u32x4){e0, z0, z0, z0}; }
                    const int krow = 8 * wave + (lane >> 3);
                    const unsigned koff = (unsigned)(((rowbase + krow) * ZW + ZKA + h * 128) * 2 + (((lane & 7) ^ ((krow >> 1) & 7)) << 4));
                    const unsigned voff = (unsigned)(((rowbase + 8 * wave + ((lane >> 2) & 3)) * ZW + ZVA + h * 128 + (4 * (lane >> 4) + (lane & 3)) * 8) * 2);
#define DIFF_DMA(t, bo) do { const char* zb_ = (const char*)Z + (size_t)(t) * 64 * ZW * 2; \
        glds16s(zb_, koff, (unsigned)__builtin_amdgcn_readfirstlane((int)(lds0 + ((bo) * 2 + 0) * 8192 + wave * 1024))); \
        glds16s(zb_ + 128, koff, (unsigned)__builtin_amdgcn_readfirstlane((int)(lds0 + ((bo) * 2 + 1) * 8192 + wave * 1024))); \
        glds16s(zb_, voff, (unsigned)__builtin_amdgcn_readfirstlane((int)(lds0 + 32768 + (bo) * 16384 + wave * 2048))); \
        glds16s(zb_ + (size_t)4 * ZW * 2, voff, (unsigned)__builtin_amdgcn_readfirstlane((int)(lds0 + 32768 + (bo) * 16384 + wave * 2048 + 1024))); } while (0)
#define DIFF_SYNC() do { asm volatile("s_waitcnt vmcnt(0) lgkmcnt(0)" ::: "memory"); __builtin_amdgcn_s_barrier(); asm volatile("" ::: "memory"); } while (0)
                    DIFF_DMA(0, 0);
#pragma unroll 1
                    for (int t = 0; t < SEQ / 64; ++t) {
                        const int bo = t & 1;
                        DIFF_SYNC();
                        if (t + 1 < SEQ / 64) DIFF_DMA(t + 1, bo ^ 1);
                        diffA_step(o0, o1, m0, l0, m1, l1, qlds, lds + (bo * 2 + 0) * 8192, lds + (bo * 2 + 1) * 8192, lds + 32768 + bo * 16384, bsel, wsfA, t == 0, lane);
                    }
                    DIFF_SYNC();
#undef DIFF_DMA
#undef DIFF_SYNC
                    int lane_e = lane; asm volatile("" : "+v"(lane_e)); const int hi_e = lane_e >> 5;
                    attn_finish<4>(o0, l0, wsfA, lane_e, hi_e);
                    attn_finish<4>(o1, l1, wsfA, lane_e, hi_e);
                    const float* sg = args.da_subln + (size_t)l * 128;
                    float g4[4];
#pragma unroll
                    for (int d0 = 0; d0 < 4; ++d0) g4[d0] = sg[32 * d0 + (lane_e & 31)] * (1.0f - lam_init);
#pragma unroll
                    for (int r = 0; r < 16; ++r) {
                        float ov[4];
#pragma unroll
                        for (int d0 = 0; d0 < 4; ++d0) ov[d0] = o0[d0][r] - lam * o1[d0][r];
                        float ss = ov[0] * ov[0] + ov[1] * ov[1] + ov[2] * ov[2] + ov[3] * ov[3];
                        ss = half_sum(ss);
                        const float rn = 1.0f / sqrtf(ss * (1.f / 128.f) + NORM_EPS);
                        bf16_t* op = OC + (rowbase + q0 + crow(r, hi_e)) * D + h * 128 + (lane_e & 31);
#pragma unroll
                        for (int d0 = 0; d0 < 4; ++d0) op[32 * d0] = (bf16_t)f2bf(ov[d0] * rn * g4[d0]);
                    }
                }
                asm volatile("s_waitcnt vmcnt(0) lgkmcnt(0)" ::: "memory"); __builtin_amdgcn_s_barrier();
            }
            {
                int tidm = tid0; asm volatile("" : "+v"(tidm)); const int lane = tidm & 63, hi = lane >> 5;
                LAS unsigned char* vlds = lds + wave * 12288; LAS float* wsf = (LAS float*)(lds + 98304 + wave * 256);
                LAS float* tab = (LAS float*)(lds + 100352);
                { const float* rpb = args.na_rpb + (size_t)l * 4 * 15 * 31;
                  for (int i = wave * 64 + lane; i < 4 * 15 * 128; i += NWAVES * 64) { const int j = (i & 127) - 48, hb = i >> 7; tab[i] = (j >= 0 && j <= 30) ? rpb[hb * 31 + j] * LOG2E : 0.f; } }
                asm volatile("s_waitcnt vmcnt(0) lgkmcnt(0)" ::: "memory"); __builtin_amdgcn_s_barrier(); asm volatile("" ::: "memory");
                const char* zb = (const char*)Z;
                for (int wu = gw; wu < NBATCH * 4 * 64 * 2; wu += NGW) {
                    const int half = wu & 1, gr = (wu >> 1) & 63, h = (wu >> 7) & 3, b = wu >> 9;
                    const int rowb = b * SEQ; const int c0 = half * 32, cq = c0 + (lane & 31);
                    const int kr0 = min(max(gr - 4, 0), 56), cs = min(max(cq - 8, 0), 48);
                    bf16x8 qf[4];
                    { const unsigned qoff = (unsigned)(((rowb + gr * 64 + cq) * ZW + ZQN + h * 64 + 8 * hi) * 2);
#pragma unroll
                      for (int d0 = 0; d0 < 4; ++d0) qf[d0] = *(const bf16x8*)(zb + (size_t)(qoff + 32u * d0)); }
                    f32x16 o[2]; o[0] = f32x16{}; o[1] = f32x16{};
                    float mrun = NEGBIG, lrun = 0.f;
                    const unsigned kcol = (unsigned)((ZKN + h * 64) * 2), vcol = (unsigned)((ZVN + h * 64) * 2);
                    unsigned rb0[4];
#pragma unroll
                    for (int i = 0; i < 4; ++i) rb0[i] = (unsigned)((rowb + (kr0 + (i >> 1)) * 64 + 16 * half + 8 * (i & 1) + (lane >> 3)) * ZW * 2);
                    TileRegs<64> cur;
                    tile_load<64>(cur, zb, rb0, kcol, vcol);
#pragma unroll 1
                    for (int t = 0, rp = 0, cc = 0; t < 12; ++t) {
                        const int kr = kr0 + 2 * rp, chunk = half + cc;
                        const int cn = (cc == 2) ? 0 : cc + 1, rn = (cc == 2) ? rp + 1 : rp;
                        auto reload = [&](TileRegs<64>& T) { const unsigned adv = (unsigned)((t + 1 < 12) ? (2 * rn * 64 + 16 * cn) : (2 * rp * 64 + 16 * cc)) * (ZW * 2u); unsigned rr[4];
#pragma unroll
                          for (int i = 0; i < 4; ++i) rr[i] = rb0[i] + adv;
                          tile_load<64>(T, zb, rr, kcol, vcol); };
                        const LAS float* bp = tab + (h * 15 + (kr - gr + 7)) * 128 + (16 * chunk + 4 * hi - cq + 63);
                        const int u0 = 16 * chunk + 4 * hi - cs;
                        auto maskf = [&](f32x16& p) {
#pragma unroll
                            for (int r = 0; r < 16; ++r) { const int co = (r & 3) + 8 * (r >> 2);
                                const float bv = bp[(co >> 4) * 128 + (co & 15)]; p[r] = ((unsigned)(u0 + (co & 15)) <= 15u) ? bv : NEGBIG; }
                        };
                        attn_tile<64>(o, mrun, lrun, qf, cur, vlds, wsf, maskf, reload, lane, hi);
                        cc = cn; rp = rn;
                    }
                    attn_finish<2>(o, lrun, wsf, lane, hi);
#pragma unroll
                    for (int r = 0; r < 16; ++r) { bf16_t* op = OC + (size_t)(rowb + gr * 64 + c0 + crow(r, hi)) * D + 512 + h * 64 + (lane & 31);
                        op[0] = (bf16_t)f2bf(o[0][r]); op[32] = (bf16_t)f2bf(o[1][r]); }
                }
            }
            {
                int tidm = tid0; asm volatile("" : "+v"(tidm)); const int lane = tidm & 63, hi = lane >> 5;
                LAS unsigned char* vlds = lds + wave * 12288; LAS float* wsf = (LAS float*)(lds + 98304 + wave * 256);
                const char* zb = (const char*)Z;
                for (int wu = gw; wu < NBATCH * 4 * 8 * 16; wu += NGW) {
                    const int rho = wu & 15, sb = (wu >> 4) & 7, hs = (wu >> 7) & 3, b = wu >> 9;
                    const int rowb = b * SEQ; const int qi = lane & 31; const int tq = 512 * sb + rho + 16 * qi;
                    f32x16 o[2]; o[0] = f32x16{}; o[1] = f32x16{};
                    float mrun = NEGBIG, lrun = 0.f;
                    const unsigned qoff0 = (unsigned)(((rowb + tq) * ZW + ZQD + hs * 64 + 8 * hi) * 2);
                    TileRegs<64> cur;
                    { const int kb0 = 512 * sb + rho - 64;
                      unsigned rr[4];
#pragma unroll
                      for (int i = 0; i < 4; ++i) rr[i] = (unsigned)((rowb + min(max(kb0 + 8 * i + (lane >> 3), 0), SEQ - 1)) * ZW * 2);
                      tile_load<64>(cur, zb, rr, (unsigned)((ZKD + hs * 64) * 2), (unsigned)((ZVD + hs * 64) * 2)); }
#pragma unroll 1
                    for (int gi = 0; gi < 3; ++gi) {
                        const int sh = 2 * gi, res = rho & ((1 << sh) - 1), qa = (512 * sb + rho) >> sh, qk = qa + (16 >> sh) * qi, nsub = SEQ >> sh, ntile = (gi == 0) ? 20 : (gi == 1) ? 8 : 5;
                        const int lo_v = max(qk - 64, 0), span = min(qk + 64, nsub - 1) - lo_v;
                        const unsigned kcol = (unsigned)((ZKD + gi * 256 + hs * 64) * 2), vcol = (unsigned)((ZVD + gi * 256 + hs * 64) * 2), rbase = (unsigned)((rowb + res) * ZW * 2);
                        const int sh2 = sh + 2, res2 = rho & ((1 << sh2) - 1), kbn = ((512 * sb + rho) >> sh2) - 64, nsub2 = SEQ >> sh2;
                        bf16x8 qf[4];
#pragma unroll
                        for (int d0 = 0; d0 < 4; ++d0) qf[d0] = *(const bf16x8*)(zb + (size_t)(qoff0 + (unsigned)(gi * 512) + 32u * d0));
                        int kb = qa - 64;
#pragma unroll 1
                        for (int t = 0; t < ntile; ++t, kb += 32) {
                            auto reload = [&](TileRegs<64>& T) { const bool same = (t + 1 < ntile); const int kbx = same ? kb + 32 : kbn, nsx = same ? nsub : nsub2, shx = same ? sh : sh2;
                              const unsigned rbx = same ? rbase : (unsigned)((rowb + res2) * ZW * 2), kcx = same ? kcol : kcol + 512u, vcx = same ? vcol : vcol + 512u; unsigned rr[4];
                              if (kbx >= 0 && kbx + 32 <= nsx) {
                                  const unsigned b0 = rbx + __umul24((unsigned)((kbx + (lane >> 3)) << shx), ZW * 2u), inc = (8u << shx) * (ZW * 2u);
#pragma unroll
                                  for (int i = 0; i < 4; ++i) rr[i] = b0 + (unsigned)i * inc;
                              } else {
#pragma unroll
                                  for (int i = 0; i < 4; ++i) rr[i] = rbx + __umul24((unsigned)(min(max(kbx + 8 * i + (lane >> 3), 0), nsx - 1) << shx), ZW * 2u);
                              }
                              tile_load<64>(T, zb, rr, kcx, vcx); };
                            const int u0 = kb + 4 * hi - lo_v;
                            auto maskf = [&](f32x16& p) {
#pragma unroll
                                for (int r = 0; r < 16; ++r) { const int co = (r & 3) + 8 * (r >> 2); p[r] = ((unsigned)(u0 + co) <= (unsigned)span) ? 0.f : NEGBIG; }
                            };
                            attn_tile<64>(o, mrun, lrun, qf, cur, vlds, wsf, maskf, reload, lane, hi);
                        }
                    }
                    attn_finish<2>(o, lrun, wsf, lane, hi);
#pragma unroll
                    for (int r = 0; r < 16; ++r) { bf16_t* op = OC + (size_t)(rowb + 512 * sb + rho + 16 * crow(r, hi)) * D + 768 + hs * 64 + (lane & 31);
                        op[0] = (bf16_t)f2bf(o[0][r]); op[32] = (bf16_t)f2bf(o[1][r]); }
                }
            }
        }
        SEAM(pb + 2);
        if (IN(pb + 3) && EN(4)) REP(4) {
            WSP(); const float* modl = modp + (size_t)l * NBATCH * 6 * D; (void)modl;
            pg8::StaticOrder S0; S0.init(M, D, G, bx); pg8::Unit u0; pg8::ProjOrder S; S.pm = 0; S.pn = 0; S.rot = bx & 1;
            const bool have = S0.next(0, u0); S.pm = u0.pm; S.pn = u0.pn;
            if (have) { pg8::Gemm g{OC, WPR + (size_t)l * D * D, D, D, D}; EpiProj E{MG, Z + ZG}; pg8::gemm_phase<EpiProj, pg8::ProjOrder>(lds, g, S, E); }
        }
        SEAM(pb + 3);
        if (IN(pb + 4) && EN(5)) {
            WSP(); const float* modl = modp + (size_t)l * NBATCH * 6 * D; (void)modl;
            pg8::Gemm g{MG, WOU + (size_t)l * D * D, D, D, D}; pg8::StaticOrder S; S.init(M, D, G, bx);
            EpiOut E{X, modl + 2 * D};
            pg8::gemm_phase<EpiOut, pg8::StaticOrder>(lds, g, S, E);
        }
        SEAM(pb + 4);
        if (IN(pb + 5) && EN(6)) {
            WSP(); const float* modl = modp + (size_t)l * NBATCH * 6 * D; (void)modl;
            LAS float* rt = (LAS float*)lds;
            LAS unsigned* lcnt = (LAS unsigned*)(lds + MISC_OFF) + 16;
            LAS unsigned* lbase = lcnt + 32;
            { const float* rsrc = rtab + (size_t)l * 36 * D + 4 * lane; const unsigned lds0 = (unsigned)(uintptr_t)lds;
              for (int pc = wave; pc < 144; pc += NWAVES) glds16(rsrc + (pc >> 2) * D + (pc & 3) * 256, (unsigned)__builtin_amdgcn_readfirstlane((int)(lds0 + (pc >> 2) * (RT_LD * 4) + (pc & 3) * 1024)));
              if (tid < 64) lcnt[tid] = 0u;
              if (tid < 36) rt[tid * RT_LD + D] = tid < 4 ? args.rgb[(size_t)l * 4 + tid] : args.reb[(size_t)l * NEXP + tid - 4];
              asm volatile("s_waitcnt vmcnt(0)" ::: "memory");
            }
            __syncthreads();
            const float* gam = args.ffn_g + (size_t)l * D;
            unsigned* cnt = ctl + CW_CNT + l * NEXP * 64;
            int myE0 = 0, myE1 = 0, myP0 = 0, myP1 = 0, myRow = -1; float myW0 = 0.f, myW1 = 0.f; int nrow = 0;
            f32x4 v[4][4], vn[4][4];
            constexpr int RPW = M / (256 * NWAVES); const int rbase = gw * RPW;
            f32x4 ca[4], cb[4];
            { const int b = rbase / SEQ;
#pragma unroll
              for (int j = 0; j < 4; ++j) { const int col = 4 * lane + 256 * j;
                  const f32x4 g4 = *(const f32x4*)(gam + col), sc = *(const f32x4*)(modl + (size_t)b * 6 * D + 4 * D + col), sh = *(const f32x4*)(modl + (size_t)b * 6 * D + 3 * D + col);
                  ca[j] = g4 * (sc + 1.0f); cb[j] = sh; } }
#define T2_LOAD(dst, rb) do { _Pragma("unroll") for (int q = 0; q < 4; ++q) { const int row = min((rb) + q, M - 1); \
                _Pragma("unroll") for (int j = 0; j < 4; ++j) dst[q][j] = bf4(*(const u32x2*)(X + (size_t)row * D + 4 * lane + 256 * j)); } } while (0)
            T2_LOAD(v, rbase);
#pragma unroll 1
            for (int r0 = rbase; r0 < rbase + RPW; r0 += 4) {
                T2_LOAD(vn, min(r0 + 4, M - 4));
                float ssq[4];
#pragma unroll
                for (int q = 0; q < 4; ++q) { f32x2 s2 = {0.f, 0.f};
#pragma unroll
                    for (int j = 0; j < 4; ++j) { const f32x2 lo = {v[q][j][0], v[q][j][1]}, hi2 = {v[q][j][2], v[q][j][3]}; s2 = lo * lo + s2; s2 = hi2 * hi2 + s2; }
                    ssq[q] = s2[0] + s2[1]; }
                wave_sum4_u(ssq[0], ssq[1], ssq[2], ssq[3]);
#pragma unroll
                for (int q = 0; q < 4; ++q) {
                    const int row = r0 + q;
                    const float rstd = 1.0f / sqrtf(ssq[q] * (1.f / D) + NORM_EPS);
#pragma unroll
                    for (int j = 0; j < 4; ++j) { const int col = 4 * lane + 256 * j;
                        v[q][j] = v[q][j] * rstd * ca[j] + cb[j];
                        u32x2 w; w.x = cvt_pk_bf16(v[q][j][0], v[q][j][1]); w.y = cvt_pk_bf16(v[q][j][2], v[q][j][3]);
                        *(u32x2*)(Hn + (size_t)row * D + col) = w; }
                }
                float LG[4][4];
#pragma unroll
                for (int n = 0; n < 4; ++n) { f32x2 c0 = {0.f, 0.f}, c1 = c0, c2 = c0, c3 = c0;
#pragma unroll
                    for (int j = 0; j < 4; ++j) { const f32x4 wv = *(const LAS f32x4*)(rt + n * RT_LD + 4 * lane + 256 * j); const f32x2 wl = {wv[0], wv[1]}, wh = {wv[2], wv[3]};
                        c0 = wl * (f32x2){v[0][j][0], v[0][j][1]} + c0; c0 = wh * (f32x2){v[0][j][2], v[0][j][3]} + c0;
                        c1 = wl * (f32x2){v[1][j][0], v[1][j][1]} + c1; c1 = wh * (f32x2){v[1][j][2], v[1][j][3]} + c1;
                        c2 = wl * (f32x2){v[2][j][0], v[2][j][1]} + c2; c2 = wh * (f32x2){v[2][j][2], v[2][j][3]} + c2;
                        c3 = wl * (f32x2){v[3][j][0], v[3][j][1]} + c3; c3 = wh * (f32x2){v[3][j][2], v[3][j][3]} + c3; }
                    float a0 = c0[0] + c0[1], a1 = c1[0] + c1[1], a2 = c2[0] + c2[1], a3 = c3[0] + c3[1];
                    wave_sum4_u(a0, a1, a2, a3);
                    const float bgn = rt[n * RT_LD + D]; LG[0][n] = a0 + bgn; LG[1][n] = a1 + bgn; LG[2][n] = a2 + bgn; LG[3][n] = a3 + bgn; }
#pragma unroll
                for (int q = 0; q < 4; ++q) {
                    const int row = r0 + q;
                    int gsel = 0; float gmx = LG[q][0];
#pragma unroll
                    for (int i = 1; i < 4; ++i) if (LG[q][i] > gmx) { gmx = LG[q][i]; gsel = i; }
                    gsel = __builtin_amdgcn_readfirstlane(gsel);
                    float gsum = 0.f;
#pragma unroll
                    for (int i = 0; i < 4; ++i) gsum += __expf(LG[q][i] - gmx);
                    const float pg = 1.0f / gsum;
                    float le[8];
                    const LAS float* rte = rt + (4 + 8 * gsel) * RT_LD + 4 * lane;
#pragma unroll
                    for (int j8 = 0; j8 < 8; ++j8) { f32x2 c = {0.f, 0.f};
#pragma unroll
                        for (int j = 0; j < 4; ++j) { const f32x4 wv = *(const LAS f32x4*)(rte + j8 * RT_LD + 256 * j);
                            c = (f32x2){wv[0], wv[1]} * (f32x2){v[q][j][0], v[q][j][1]} + c; c = (f32x2){wv[2], wv[3]} * (f32x2){v[q][j][2], v[q][j][3]} + c; }
                        le[j8] = c[0] + c[1]; }
                    wave_sum4_u(le[0], le[1], le[2], le[3]); wave_sum4_u(le[4], le[5], le[6], le[7]);
#pragma unroll
                    for (int j8 = 0; j8 < 8; ++j8) le[j8] += rte[j8 * RT_LD + D - 4 * lane];
                    int e0 = 0; float m0 = le[0];
#pragma unroll
                    for (int j = 1; j < 8; ++j) if (le[j] > m0) { m0 = le[j]; e0 = j; }
                    int e1 = (e0 == 0) ? 1 : 0; float m1 = -3.0e38f;
#pragma unroll
                    for (int j = 0; j < 8; ++j) if (j != e0 && le[j] > m1) { m1 = le[j]; e1 = j; }
                    const float a1 = __expf(m1 - m0), inv = 1.0f / (1.0f + a1);
                    const float w0 = pg * inv, w1 = pg * a1 * inv;
                    const int E0 = gsel * 8 + e0, E1 = gsel * 8 + e1;
                    if (row < M) {
                        unsigned p0 = 0, p1 = 0;
                        if (lane == 0) { p0 = __hip_atomic_fetch_add(lcnt + E0, 1u, __ATOMIC_RELAXED, __HIP_MEMORY_SCOPE_WORKGROUP); p1 = __hip_atomic_fetch_add(lcnt + E1, 1u, __ATOMIC_RELAXED, __HIP_MEMORY_SCOPE_WORKGROUP); }
                        p0 = __builtin_amdgcn_readfirstlane(p0); p1 = __builtin_amdgcn_readfirstlane(p1);
                        if (lane == nrow) { myE0 = E0; myE1 = E1; myP0 = (int)p0; myP1 = (int)p1; myW0 = w0; myW1 = w1; myRow = row; }
                        ++nrow;
                    }
                }
#pragma unroll
                for (int q = 0; q < 4; ++q)
#pragma unroll
                    for (int j = 0; j < 4; ++j) v[q][j] = vn[q][j];
            }
#undef T2_LOAD
            __syncthreads();
            if (tid < NEXP) { const unsigned c = lcnt[tid]; lbase[tid] = c ? __hip_atomic_fetch_add(cnt + tid * 64, c, __ATOMIC_RELAXED, __HIP_MEMORY_SCOPE_AGENT) : 0u; }
            __syncthreads();
            if (myRow >= 0) { const int q0 = myP0 + (int)lbase[myE0], q1 = myP1 + (int)lbase[myE1]; etok[myE0 * 16384 + q0] = myRow; etok[myE1 * 16384 + q1] = myRow;
                              tok_e[2 * myRow] = myE0; tok_e[2 * myRow + 1] = myE1; tok_pos[2 * myRow] = q0; tok_pos[2 * myRow + 1] = q1;
                              tok_w[2 * myRow] = myW0; tok_w[2 * myRow + 1] = myW1; }
            __syncthreads();
        }
        SEAM(pb + 5);
        if (IN(pb + 8) && EN(8)) {
            WSP();
            const unsigned* cnt = ctl + CW_CNT + l * NEXP * 64; unsigned* tcl = ctl + CW_TILE + l * MAXTILES * 16;
            int n1, n3, n4, R;
            int a_pm, a_pn, a_e, a_ts, a_cn, b_pm, b_pn, b_e, b_ts, b_cn, c_pm, c_pn, c_e, c_ts, c_cn;
            int d_pm, d_pn, d_e, d_ts, d_cn, e_pm, e_pn, e_e, e_ts, e_cn, f_pm, f_pn, f_e, f_ts, f_cn, g_pm, g_pn, g_e, g_ts, g_cn;
            {
                const int cv = (lane < NEXP) ? (int)__hip_atomic_load(cnt + lane * 64, __ATOMIC_RELAXED, __HIP_MEMORY_SCOPE_AGENT) : 0;
                const int tl = (cv + 255) >> 8; int tend = 0, ntile = 0;
#pragma unroll
                for (int e = 0; e < NEXP; ++e) { ntile += __builtin_amdgcn_readlane(tl, e); if (lane == e) tend = ntile; }
                const int U = 4 * ntile, nA = min(U, 2 * G), Nf = G - min(U - nA, G), nB = min(nA, 2 * Nf); R = min(U - nA, G);
                auto moe_unit = [&](int v, int& pm, int& pn, int& e, int& ts, int& cn) { const int t = min(v >> 2, ntile - 1); pm = t; pn = v & 3;
                    e = min((int)__builtin_popcountll(__ballot(lane < NEXP && tend <= t)), NEXP - 1); ts = __builtin_amdgcn_readlane(tend - tl, e); cn = max(__builtin_amdgcn_readlane(cv, e), 1); };
                moe_unit(vcu, a_pm, a_pn, a_e, a_ts, a_cn); moe_unit(G + vcu, b_pm, b_pn, b_e, b_ts, b_cn); moe_unit(nA + vcu, c_pm, c_pn, c_e, c_ts, c_cn);
                n1 = (vcu < nA ? 1 : 0) + (G + vcu < nA ? 1 : 0);
                const int v3 = vcu - R, v4 = nB + vcu;
                moe_unit(v3, d_pm, d_pn, d_e, d_ts, d_cn); moe_unit(v3 + Nf, e_pm, e_pn, e_e, e_ts, e_cn); n3 = (vcu >= R) ? (v3 < nB ? 1 : 0) + (v3 + Nf < nB ? 1 : 0) : 0;
                moe_unit(v4, f_pm, f_pn, f_e, f_ts, f_cn); moe_unit(v4 + G, g_pm, g_pn, g_e, g_ts, g_cn); n4 = (v4 < U ? 1 : 0) + (v4 + G < U ? 1 : 0);
            }
#define MOE_M1(n_, p0, p1) do { const pg8::MoeOrder S{(n_), p0##pm, p1##pm, p0##pn, p1##pn, p0##e, p1##e, (size_t)1024 * D * 2, p0##ts, p1##ts, p0##cn, p1##cn, etok, tcl}; \
            pg8::Gemm g{Hn, W13 + (size_t)l * NEXP * 1024 * D, D, D, D};            \
            EpiSwiglu E{HB}; pg8::gemm_phase<EpiSwiglu, pg8::MoeOrder, true, true, true>(lds, g, S, E); } while (0)
#define MOE_M2(n_, p0, p1) do { \
            if (wave == 0) { const int tb_ = (n_) > 1 ? p1##pm : p0##pm; unsigned sp_ = 0; \
                while ((unsigned)__builtin_amdgcn_readfirstlane((int)__hip_atomic_load(tcl + p0##pm * 16, __ATOMIC_RELAXED, __HIP_MEMORY_SCOPE_AGENT)) < 32u && ++sp_ < XB_SPIN_CAP) __builtin_amdgcn_s_sleep(2); \
                while ((unsigned)__builtin_amdgcn_readfirstlane((int)__hip_atomic_load(tcl + tb_ * 16, __ATOMIC_RELAXED, __HIP_MEMORY_SCOPE_AGENT)) < 32u && ++sp_ < XB_SPIN_CAP) __builtin_amdgcn_s_sleep(2); \
                __builtin_amdgcn_fence(__ATOMIC_ACQUIRE, "agent"); asm volatile("s_waitcnt vmcnt(0)" ::: "memory"); }        \
            __syncthreads(); \
            const pg8::MoeOrder S{(n_), p0##pm, p1##pm, p0##pn, p1##pn, p0##e, p1##e, (size_t)D * EH * 2, p0##ts, p1##ts, p0##cn, p1##cn, etok, nullptr}; \
            pg8::Gemm g{HB, W2 + (size_t)l * NEXP * D * EH, EH, EH, EH}; \
            EpiY E{YB}; pg8::gemm_phase<EpiY, pg8::MoeOrder>(lds, g, S, E); } while (0)
            if (n1) MOE_M1(n1, a_, b_);
            if (vcu < R) MOE_M1(1, c_, c_);
            if (n3) MOE_M2(n3, d_, e_);
            if (n4) MOE_M2(n4, f_, g_);
#undef MOE_M1
#undef MOE_M2
        }
        SEAM(pb + 8);
    }
    if (IN(NPHASE - 1) && EN(9)) {
        WSP();
        const float* modprev = modp + (size_t)(DEPTH - 1) * NBATCH * 6 * D;
        constexpr int RPW = M / (256 * NWAVES); const int rbase = gw * RPW, b = rbase / SEQ;
        int slot_v = 0; float w_v = 0.f;
        { const unsigned* cntp = ctl + CW_CNT + (DEPTH - 1) * NEXP * 64;
          const int cv = (lane < NEXP) ? (int)__hip_atomic_load(cntp + lane * 64, __ATOMIC_RELAXED, __HIP_MEMORY_SCOPE_AGENT) : 0;
          const int tl = (cv + 255) >> 8; int tstart = 0, run = 0;
#pragma unroll
          for (int e = 0; e < NEXP; ++e) { if (lane == e) tstart = run; run += __builtin_amdgcn_readlane(tl, e); }
          const int i = min(lane, 2 * RPW - 1);
          const int e = tok_e[2 * rbase + i], pos = tok_pos[2 * rbase + i]; w_v = tok_w[2 * rbase + i];
          slot_v = __builtin_amdgcn_ds_bpermute(4 * e, tstart) * 256 + pos; }
        f32x4 gf[4], fg[4];
#pragma unroll
        for (int j = 0; j < 4; ++j) { const int col = 4 * lane + 256 * j; gf[j] = *(const f32x4*)(modprev + (size_t)b * 6 * D + 5 * D + col); fg[j] = *(const f32x4*)(args.fin_g + col); }
#pragma unroll 1
        for (int r0 = rbase; r0 < rbase + RPW; r0 += 4) {
            u32x2 xr[4][4], y0[4][4], y1[4][4]; float w0[4], w1[4];
#pragma unroll
            for (int q = 0; q < 4; ++q) { const int ix = 2 * (r0 - rbase + q);
                const int s0 = __builtin_amdgcn_readlane(slot_v, ix), s1 = __builtin_amdgcn_readlane(slot_v, ix + 1);
                w0[q] = __builtin_bit_cast(float, __builtin_amdgcn_readlane(__builtin_bit_cast(int, w_v), ix)); w1[q] = __builtin_bit_cast(float, __builtin_amdgcn_readlane(__builtin_bit_cast(int, w_v), ix + 1));
#pragma unroll
                for (int j = 0; j < 4; ++j) { const int col = 4 * lane + 256 * j;
                    xr[q][j] = *(const u32x2*)(X + (size_t)(r0 + q) * D + col); y0[q][j] = *(const u32x2*)(YB + (size_t)s0 * D + col); y1[q][j] = *(const u32x2*)(YB + (size_t)s1 * D + col); } }
#pragma unroll
            for (int q = 0; q < 4; ++q) { const int row = r0 + q;
                f32x4 v[4]; float ss = 0.f;
#pragma unroll
                for (int j = 0; j < 4; ++j) { const f32x4 yy = bf4(y0[q][j]) * w0[q] + bf4(y1[q][j]) * w1[q]; v[j] = bf4(xr[q][j]) + gf[j] * yy;
                    ss += (v[j][0] * v[j][0] + v[j][1] * v[j][1]) + (v[j][2] * v[j][2] + v[j][3] * v[j][3]); }
                const float rstd = 1.0f / sqrtf(wave_sum(ss) * (1.f / D) + NORM_EPS);
#pragma unroll
                for (int j = 0; j < 4; ++j) *(f32x4*)(args.out + (size_t)row * D + 4 * lane + 256 * j) = v[j] * rstd * fg[j];
            }
        }
    }
#undef IN
#undef SEAM
#undef GRID_BAR
}


#ifndef DBG
#define DBG 0
#endif
#if DBG
constexpr size_t WS_REP = WS_END;
__global__ void dbg_scan(const unsigned* buf, size_t nwords, int is_bf16, unsigned long long* rep) {
    unsigned long long nf = 0, ck = 0;
    for (size_t i = (size_t)blockIdx.x * blockDim.x + threadIdx.x; i < nwords; i += (size_t)gridDim.x * blockDim.x) {
        const unsigned w = buf[i]; ck += (unsigned long long)w * (unsigned long long)((i & 1023) + 1);
        if (is_bf16) { if ((w & 0x7f80u) >= (140u << 7)) ++nf; if ((w & 0x7f800000u) >= (140u << 23)) ++nf; }
        else if ((w & 0x7f800000u) >= (140u << 23)) ++nf;
    }
    for (int o = 32; o >= 1; o >>= 1) { nf += __shfl_xor(nf, o); ck += __shfl_xor(ck, o); }
    if ((threadIdx.x & 63) == 0) { if (nf) atomicAdd(rep, nf); atomicAdd(rep + 1, ck); }
}

__global__ void dbg_scan_cols(const unsigned short* buf, int c0, int c1, unsigned long long* rep) {
    unsigned long long nf = 0;
    const int w = c1 - c0;
    for (size_t i = (size_t)blockIdx.x * blockDim.x + threadIdx.x; i < (size_t)M * w; i += (size_t)gridDim.x * blockDim.x) {
        const size_t r = i / w; const int c = c0 + (int)(i % w); const unsigned v = buf[r * D + c];
        if ((v & 0x7f80u) >= (140u << 7)) ++nf; }
    for (int o = 32; o >= 1; o >>= 1) nf += __shfl_xor(nf, o);
    if ((threadIdx.x & 63) == 0 && nf) atomicAdd(rep, nf);
}
__global__ void dbg_encode(const unsigned long long* rep, float* out, size_t n, int nph) {
    int code = 80;
    for (int p = nph - 1; p >= 0; --p) if (rep[(64 + p) * 2 + 1] != rep[p * 2 + 1]) code = 40 + p;
    for (int p = nph - 1; p >= 0; --p) if (rep[p * 2] != 0ull || rep[(64 + p) * 2] != 0ull) code = 1 + p;
    if (code == 80) return;
    const float A = sqrtf((float)code * 0.1f);
    for (size_t i = (size_t)blockIdx.x * blockDim.x + threadIdx.x; i < n; i += (size_t)gridDim.x * blockDim.x) {
        unsigned h = (unsigned)i * 2654435761u; h ^= h >> 15; h *= 2246822519u; h ^= h >> 13;
        out[i] = (h & 1u) ? A : -A; }
}
#endif

extern "C" void kernel_launch(void* const* d_in, const int* in_sizes, int n_in, void* d_out, int out_size, void* d_ws, size_t ws_size, hipStream_t stream) {
    static int grid = 0;
    if (grid == 0) {
        if (n_in != 22 || in_sizes[0] != M * D || out_size != M * D || ws_size < WS_END + (1u << 20)) {
            fprintf(stderr, "kernel_launch: unexpected shapes (n_in %d, in0 %d, out %d, ws %zu, need %zu)\n", n_in, n_in > 0 ? in_sizes[0] : -1, out_size, ws_size, (size_t)WS_END); grid = -1; return; }
        int dev = 0, cus = 0, per_cu = 0;
        if (hipGetDevice(&dev) != hipSuccess || hipDeviceGetAttribute(&cus, hipDeviceAttributeMultiprocessorCount, dev) != hipSuccess) { grid = -1; return; }
        if (hipFuncSetAttribute((const void*)fwd_kernel, hipFuncAttributeMaxDynamicSharedMemorySize, LDS_BYTES) != hipSuccess) { fprintf(stderr, "kernel_launch: hipFuncSetAttribute failed\n"); grid = -1; return; }
        if (hipOccupancyMaxActiveBlocksPerMultiprocessor(&per_cu, (const void*)fwd_kernel, NWAVES * 64, LDS_BYTES) != hipSuccess || per_cu < 1)
            fprintf(stderr, "kernel_launch: occupancy query reports %d\n", per_cu);
        (void)hipGetLastError();
        if (cus != 256) { fprintf(stderr, "kernel_launch: built for 256 CUs (MoE unit deal, T2 row blocks), found %d\n", cus); grid = -1; return; }
        grid = cus;
    }
    if (grid < 0) return;
    if (hipMemsetAsync((char*)d_ws + WS_CTL, 0, CTL_ZERO_BYTES, stream) != hipSuccess) { fprintf(stderr, "kernel_launch: memset failed\n"); return; }
    Args a{};
    a.x = (const float*)d_in[0]; a.c = (const float*)d_in[1]; a.ada_w = (const float*)d_in[2]; a.ada_b = (const float*)d_in[3]; a.mix_g = (const float*)d_in[4]; a.ffn_g = (const float*)d_in[5];
    a.w_in = (const float*)d_in[6]; a.da_lambda = (const float*)d_in[7]; a.da_subln = (const float*)d_in[8]; a.na_rpb = (const float*)d_in[9];
    a.wpa = (const float*)d_in[10]; a.wpn = (const float*)d_in[11]; a.wpd = (const float*)d_in[12]; a.w_out = (const float*)d_in[13];
    a.rgw = (const float*)d_in[14]; a.rgb = (const float*)d_in[15]; a.rew = (const float*)d_in[16]; a.reb = (const float*)d_in[17];
    a.ew1 = (const float*)d_in[18]; a.ew3 = (const float*)d_in[19]; a.ew2 = (const float*)d_in[20]; a.fin_g = (const float*)d_in[21];
    a.out = (float*)d_out; a.ws = (unsigned char*)d_ws;
#if DBG
    {
        unsigned char* ws = (unsigned char*)d_ws;
        unsigned long long* rep = (unsigned long long*)(ws + WS_REP);
        (void)hipMemsetAsync(rep, 0, 2 * 64 * 2 * 8, stream);
        for (int run = 0; run < 2; ++run) {
            (void)hipMemsetAsync((char*)d_ws + WS_CTL, 0, CTL_ZERO_BYTES, stream);
            for (int p = 0; p < NPHASE; ++p) {
                a.ph_lo = p; a.ph_hi = p + 1;
                hipLaunchKernelGGL(fwd_kernel, dim3(grid), dim3(NWAVES * 64), LDS_BYTES, stream, a);
                unsigned long long* r = rep + (size_t)(run * 64 + p) * 2;
#define SCAN(off, bytes, isbf) hipLaunchKernelGGL(dbg_scan, dim3(1024), dim3(256), 0, stream, (const unsigned*)(ws + (off)), (size_t)(bytes) / 4, (isbf), r)
                const int ph = (p == 0) ? -1 : (p == NPHASE - 1) ? 9 : (p - 1) % 9;
                if (ph == -1) { SCAN(WS_MOD, (size_t)DEPTH * NBATCH * 6 * D * 4, 0); SCAN(WS_ROPE, (size_t)SEQ * 64 * 4, 0); SCAN(WS_WIN, WS_END - WS_WIN, 1); }
                else if (ph == 0) { SCAN(WS_X, (size_t)M * D * 4, 0); SCAN(WS_H, (size_t)M * D * 2, 1); }
                else if (ph == 1) { SCAN(WS_Z, (size_t)M * ZW * 2, 1); }
                else if (ph == 2) { SCAN(WS_OCAT, (size_t)M * D * 2, 1); }
                else if (ph == 3) { SCAN(WS_MERGED, (size_t)M * D * 2, 1); }
                else if (ph == 4) { SCAN(WS_X, (size_t)M * D * 4, 0); }
                else if (ph == 5) { SCAN(WS_H, (size_t)M * D * 2, 1); SCAN(WS_ROUTE, (size_t)2 * M * 4, 0); SCAN(WS_ROUTE + (size_t)4 * M * 4, (size_t)2 * M * 4, 0); }
                else if (ph == 9) { hipLaunchKernelGGL(dbg_scan, dim3(1024), dim3(256), 0, stream, (const unsigned*)d_out, (size_t)M * D, 0, r); }
#undef SCAN
            }
        }
        hipLaunchKernelGGL(dbg_encode, dim3(1024), dim3(256), 0, stream, (const unsigned long long*)rep, (float*)d_out, (size_t)M * D, NPHASE);
    }
#elif MK_PER_PHASE
    for (int p = 0; p < NPHASE; ++p) {
        a.ph_lo = p; a.ph_hi = p + 1;
        hipLaunchKernelGGL(fwd_kernel, dim3(grid), dim3(NWAVES * 64), LDS_BYTES, stream, a);
    }
#else
    a.ph_lo = 0; a.ph_hi = NPHASE;
    hipLaunchKernelGGL(fwd_kernel, dim3(grid), dim3(NWAVES * 64), LDS_BYTES, stream, a);
#endif
    const hipError_t le = hipPeekAtLastError();
    if (le != hipSuccess) fprintf(stderr, "kernel_launch: launch failed: %s\n", hipGetErrorName(le));
}
```

```cpp
#include <hip/hip_runtime.h>
#include <cstdio>
#include <cstdint>

#ifndef MK_PER_PHASE
#define MK_PER_PHASE 0
#endif

#define LAS __attribute__((address_space(3)))
#define GAS __attribute__((address_space(1)))
typedef unsigned short bf16_t;
typedef short bf16x8 __attribute__((ext_vector_type(8)));
typedef short s16x4 __attribute__((ext_vector_type(4)));
typedef float f32x4 __attribute__((ext_vector_type(4)));
typedef float f32x2 __attribute__((ext_vector_type(2)));
typedef float f32x16 __attribute__((ext_vector_type(16)));
typedef unsigned u32x4 __attribute__((ext_vector_type(4)));
typedef unsigned u32x2 __attribute__((ext_vector_type(2)));

constexpr int D = 1024, NBATCH = 4, SEQ = 4096, M = NBATCH * SEQ, DEPTH = 4, ZW = 7680;
constexpr int ZQA = 0, ZKA = 512, ZVA = 1024, ZQN = 1536, ZKN = 1792, ZVN = 2048, ZQD = 2304, ZKD = 3072, ZVD = 3840, ZG = 4608;
constexpr int NEXP = 32, EH = 512;
constexpr int MAXTILES = 160, XROWS = MAXTILES * 256;
constexpr float C2 = 0.125f * 1.4426950408889634f;
constexpr float LOG2E = 1.4426950408889634f;
constexpr float NORM_EPS = 1e-6f;
constexpr float NEGBIG = -1e30f;
constexpr float RESCALE_THR = 8.0f;

constexpr size_t MiB = 1u << 20;
constexpr size_t WS_CTL = 0, CTL_ZERO_BYTES = 1 * MiB;
constexpr size_t WS_RT = 1 * MiB;
constexpr size_t WS_MOD = 2 * MiB;
constexpr size_t WS_ROPE = 3 * MiB;
constexpr size_t WS_ROUTE = 4 * MiB;
constexpr size_t WS_X = 8 * MiB;
constexpr size_t WS_H = 72 * MiB;
constexpr size_t WS_OCAT = 104 * MiB;
constexpr size_t WS_MERGED = 136 * MiB;
constexpr size_t WS_Z = 168 * MiB;
constexpr size_t WS_XG = WS_Z;
constexpr size_t WS_HB = WS_Z + 80 * MiB;
constexpr size_t WS_YB = WS_Z + 120 * MiB;
constexpr size_t WS_WIN = 408 * MiB;
constexpr size_t WS_WPROJ = 468 * MiB;
constexpr size_t WS_WOUT = 476 * MiB;
constexpr size_t WS_W13 = 484 * MiB;
constexpr size_t WS_W2 = 740 * MiB;
constexpr size_t WS_END = 868 * MiB;
constexpr int CW_BAR = 4096;
constexpr int CW_CNT = 16384;
constexpr int CW_TILE = 32768;

constexpr int RING_BYTES = 131072;
constexpr int RT_LD = 1028;
constexpr int RT_BYTES = 36 * RT_LD * 4;
constexpr int MISC_OFF = RT_BYTES;
constexpr int LDS_BYTES = MISC_OFF + 512;

__device__ __forceinline__ unsigned f2bf(float f) { unsigned u = __builtin_bit_cast(unsigned, f); return (u + 0x7fffu + ((u >> 16) & 1u)) >> 16; }
__device__ __forceinline__ unsigned pk2(float lo, float hi) { return f2bf(lo) | (f2bf(hi) << 16); }
__device__ __forceinline__ unsigned cvt_pk_bf16(float lo, float hi) { unsigned r; asm("v_cvt_pk_bf16_f32 %0, %1, %2" : "=v"(r) : "v"(lo), "v"(hi)); return r; }
typedef __bf16 bf16x2_t __attribute__((ext_vector_type(2)));
__device__ __forceinline__ unsigned cvtpk_s(float lo, float hi) { f32x2 v = {lo, hi}; bf16x2_t b = __builtin_convertvector(v, bf16x2_t); return __builtin_bit_cast(unsigned, b); }
__device__ __forceinline__ float bflo(unsigned u) { return __builtin_bit_cast(float, u << 16); }
__device__ __forceinline__ float bfhi(unsigned u) { return __builtin_bit_cast(float, u & 0xffff0000u); }
__device__ __forceinline__ f32x4 bf4(u32x2 r) { return (f32x4){bflo(r.x), bfhi(r.x), bflo(r.y), bfhi(r.y)}; }
__device__ __forceinline__ float fexp2(float x) { return __builtin_amdgcn_exp2f(x); }
__device__ __forceinline__ float frcp(float x) { return __builtin_amdgcn_rcpf(x); }
__device__ __forceinline__ void swap32(float& a, float& b) { asm volatile("s_nop 1\n\tv_permlane32_swap_b32 %0, %1\n\ts_nop 1" : "+v"(a), "+v"(b)); }
template <int X> __device__ __forceinline__ float xor_lane(float v) { return __builtin_bit_cast(float, __builtin_amdgcn_ds_swizzle(__builtin_bit_cast(int, v), (X << 10) | 0x1f)); }
__device__ __forceinline__ float half_sum(float v) { v += xor_lane<1>(v); v += xor_lane<2>(v); v += xor_lane<4>(v); v += xor_lane<8>(v); v += xor_lane<16>(v); return v; }
__device__ __forceinline__ float wave_sum(float v) {
    v = half_sum(v);
    float a = v, b = v; swap32(a, b);
    return a + b;
}
template <int CTRL> __device__ __forceinline__ float dpp_f(float v) { return __builtin_bit_cast(float, __builtin_amdgcn_update_dpp(0, __builtin_bit_cast(int, v), CTRL, 0xf, 0xf, false)); }
__device__ __forceinline__ float wave_sum_u(float v) {
    v += dpp_f<0xB1>(v); v += dpp_f<0x4E>(v); v += dpp_f<0x141>(v); v += dpp_f<0x140>(v);
    v += __builtin_bit_cast(float, __builtin_amdgcn_update_dpp(0, __builtin_bit_cast(int, v), 0x142, 0xa, 0xf, false));
    v += __builtin_bit_cast(float, __builtin_amdgcn_update_dpp(0, __builtin_bit_cast(int, v), 0x143, 0xc, 0xf, false));
    float r = __builtin_bit_cast(float, __builtin_amdgcn_readlane(__builtin_bit_cast(int, v), 63));
    asm volatile("" : "+v"(r));
    return r;
}
__device__ __forceinline__ void wave_sum4_u(float& a, float& b, float& c, float& d) {
    unsigned s0, s1, s2, s3;
#define WS4_STEP(ctl) "v_add_f32_dpp %0, %0, %0 " ctl "\n\tv_add_f32_dpp %1, %1, %1 " ctl "\n\tv_add_f32_dpp %2, %2, %2 " ctl "\n\tv_add_f32_dpp %3, %3, %3 " ctl "\n\t"
    asm volatile("s_nop 1\n\t"
        WS4_STEP("quad_perm:[1,0,3,2] row_mask:0xf bank_mask:0xf") WS4_STEP("quad_perm:[2,3,0,1] row_mask:0xf bank_mask:0xf") WS4_STEP("row_half_mirror row_mask:0xf bank_mask:0xf")
        WS4_STEP("row_mirror row_mask:0xf bank_mask:0xf") WS4_STEP("row_bcast:15 row_mask:0xa bank_mask:0xf") WS4_STEP("row_bcast:31 row_mask:0xc bank_mask:0xf")
        "v_readlane_b32 %4, %0, 63\n\tv_readlane_b32 %5, %1, 63\n\tv_readlane_b32 %6, %2, 63\n\tv_readlane_b32 %7, %3, 63\n\t"
        "v_mov_b32 %0, %4\n\tv_mov_b32 %1, %5\n\tv_mov_b32 %2, %6\n\tv_mov_b32 %3, %7"
        : "+v"(a), "+v"(b), "+v"(c), "+v"(d), "=&s"(s0), "=&s"(s1), "=&s"(s2), "=&s"(s3));
#undef WS4_STEP
}
__device__ __forceinline__ void st16_wt(void* p, u32x4 v) { asm volatile("global_store_dwordx4 %0, %1, off sc1\n\ts_nop 1" :: "v"(p), "v"(v) : "memory"); }
#define LDS_WAIT() asm volatile("s_waitcnt lgkmcnt(0)" ::: "memory")
#define VM_WAIT() asm volatile("s_waitcnt vmcnt(0)" ::: "memory")
#define CBAR() asm volatile("" ::: "memory")

namespace pg8 {
constexpr int BM = 256, BK = 64, HALF = 128, HTB = HALF * BK * 2, STAGE_BYTES = 8 * HTB, NXCD = 8, WGM = 8;
__host__ __device__ __forceinline__ int lds_byte(int r, int c) { const int st = (r >> 4) * 2 + (c >> 5), rr = r & 15, cc = c & 31, ob = rr * 64 + cc * 2; return st * 1024 + (ob ^ (((ob >> 9) & 1) << 5)); }
__host__ __device__ __forceinline__ void stage_rc(int b, int& R, int& C) { const int st = b / 1024, sb = b % 1024, swz = sb ^ (((sb >> 9) & 1) << 5); R = (st >> 1) * 16 + swz / 64; C = (st & 1) * 32 + (swz % 64) / 2; }
__host__ __device__ __forceinline__ int perm32(int rho) { const int n = rho >> 4, i = rho & 15; return 8 * (i >> 2) + 4 * n + (i & 3); }

struct Unit { int pm, pn, e, x0, x1; };
struct Gemm { const bf16_t* A; const bf16_t* Bt; int lda, ldb, K; };

struct StaticOrder {
    int nM, nN, nwg, G, c;
    __device__ void init(int M_, int N_, int G_, int c_) { nM = M_ / BM; nN = N_ / BM; nwg = nM * nN; G = G_; c = c_; }
    __device__ bool next(int i, Unit& u) const {
        const long L = (long)i * G + c; if (L >= nwg) return false;
        int wgid = (int)L; { const int q = nwg / NXCD, r = nwg % NXCD, xcd = wgid % NXCD, off = wgid / NXCD; wgid = (xcd < r ? xcd * (q + 1) : r * (q + 1) + (xcd - r) * q) + off; }
        const int nig = WGM * nN, gid = wgid / nig, fm = gid * WGM, gsz = (nM - fm) < WGM ? (nM - fm) : WGM;
        u.pm = fm + ((wgid % nig) % gsz); u.pn = (wgid % nig) / gsz; u.e = 0; u.x0 = 0; u.x1 = 0; return true;
    }
    __device__ __forceinline__ size_t aoff(const Gemm& g, const Unit& u) const { return (size_t)u.pm * BM * g.lda * 2; }
    __device__ __forceinline__ size_t boff(const Gemm& g, const Unit& u) const { return (size_t)u.pn * BM * g.ldb * 2; }
    __device__ __forceinline__ int ktiles(const Gemm& g, const Unit&) const { return g.K / BK; }
    __device__ __forceinline__ void done(const Unit&, int) const {}
};
struct MoeOrder {
    int n; int pm0, pm1, pn0, pn1, e0, e1; size_t estride;
    int ts0, ts1, cn0, cn1; const int* etok;
    unsigned* tcnt;
    __device__ __forceinline__ void done(const Unit& u, int lane) const {
        if (tcnt) { asm volatile("s_waitcnt vmcnt(0)" ::: "memory"); if (lane == 0) __hip_atomic_fetch_add(tcnt + u.pm * 16, 1u, __ATOMIC_RELAXED, __HIP_MEMORY_SCOPE_AGENT); }
    }
    __device__ bool next(int i, Unit& u) const {
        if (i >= n) return false;
        u.pm = i == 0 ? pm0 : pm1; u.pn = i == 0 ? pn0 : pn1; u.e = i == 0 ? e0 : e1;
        u.x0 = i == 0 ? ts0 : ts1; u.x1 = i == 0 ? cn0 : cn1; return true;
    }
    __device__ __forceinline__ size_t aoff(const Gemm& g, const Unit& u) const { return (size_t)u.pm * BM * g.lda * 2; }
    __device__ __forceinline__ size_t boff(const Gemm& g, const Unit& u) const { return (size_t)u.e * estride + (size_t)u.pn * BM * g.ldb * 2; }
    __device__ __forceinline__ int ktiles(const Gemm& g, const Unit&) const { return g.K / BK; }
    __device__ __forceinline__ int gather_row(const Unit& u, int r) const {
        const int pos = min((u.pm - u.x0) * BM + r, u.x1 - 1);
        return etok[u.e * 16384 + pos];
    }
};
struct ProjOrder {
    int pm, pn, rot;
    __device__ bool next(int i, Unit& u) const { if (i >= 3) return false; int seg = i + rot; seg = seg >= 3 ? seg - 3 : seg; u.pm = pm; u.pn = pn; u.e = seg | ((i == 0) ? 16 : 0); u.x0 = 0; u.x1 = 0; return true; }
    __device__ __forceinline__ int kofs(const Unit& u) const { const int seg = u.e & 15; return seg == 0 ? 0 : (seg == 1 ? 512 : 768); }
    __device__ __forceinline__ size_t aoff(const Gemm& g, const Unit& u) const { return (size_t)u.pm * BM * g.lda * 2 + (size_t)kofs(u) * 2; }
    __device__ __forceinline__ size_t boff(const Gemm& g, const Unit& u) const { return (size_t)u.pn * BM * g.ldb * 2 + (size_t)kofs(u) * 2; }
    __device__ __forceinline__ int ktiles(const Gemm&, const Unit& u) const { return (u.e & 15) == 0 ? 8 : 4; }
    __device__ __forceinline__ void done(const Unit&, int) const {}
};

template <class Epi, class Sched, bool ALIGN_EPI = true, bool SP2 = true, bool GATHER = false>
__device__ __forceinline__ void gemm_phase(LAS unsigned char* lds, const Gemm g, const Sched& S, const Epi& E) {
    int tid_ = threadIdx.x; asm volatile("" : "+v"(tid_));
    const int tid = tid_, wid = __builtin_amdgcn_readfirstlane(tid >> 6), lane = tid & 63, wr = wid >> 2, wc = wid & 3, fr = lane & 15, fq = lane >> 4;
    int nt = S.ktiles(g, Unit{0, 0, 0, 0, 0});
    unsigned voffA[2], voffB[2];
#pragma unroll
    for (int i = 0; i < 2; ++i) { int R, C; stage_rc(tid * 16 + i * 8192, R, C); const int Rb = Epi::PERM ? ((R & ~31) + perm32(R & 31)) : R;
        voffA[i] = (unsigned)(R * g.lda + C) * 2u; voffB[i] = (unsigned)(Rb * g.ldb + C) * 2u; }
    const size_t kstep = (size_t)(BK * 2);
    const size_t hstepA = (size_t)HALF * g.lda * 2, hstepB = (size_t)HALF * g.ldb * 2;
    const unsigned ldsw = (unsigned)wid * 1024u;
    const int aoff = lds_byte(wr * 64 + fr, fq * 8), boff = lds_byte(wc * 32 + fr, fq * 8);
#define PG8_SA(b, h) (((b) * 2 + (h)) * HTB)
#define PG8_SB(b, h) ((4 + (b) * 2 + (h)) * HTB)
#define PG8_STAGE(bufoff, gbase, voff) do { _Pragma("unroll") for (int _i = 0; _i < 2; ++_i) \
        __builtin_amdgcn_global_load_lds((const unsigned*)((const char*)(gbase) + (voff)[_i]), (LAS unsigned*)(lds + (bufoff) + ldsw + _i * 8192), 16, 0, 0); } while (0)
    unsigned vo0[2] = {0u, 0u}, vo1[2] = {0u, 0u}, nvo0[2] = {0u, 0u}, nvo1[2] = {0u, 0u};
#define PG8_GOFF(u_, d0_, d1_) do { _Pragma("unroll") for (int _i = 0; _i < 2; ++_i) { int R_, C_; stage_rc(tid * 16 + _i * 8192, R_, C_); \
        d0_[_i] = (unsigned)(S.gather_row(u_, R_) * g.lda + C_) * 2u; d1_[_i] = (unsigned)(S.gather_row(u_, HALF + R_) * g.lda + C_) * 2u; } } while (0)
#define PG8_STAGEA(bufoff, ptr, h, nx) do { if constexpr (GATHER) { unsigned o_[2]; o_[0] = (nx) ? ((h) ? nvo1[0] : nvo0[0]) : ((h) ? vo1[0] : vo0[0]); o_[1] = (nx) ? ((h) ? nvo1[1] : nvo0[1]) : ((h) ? vo1[1] : vo0[1]); \
        PG8_STAGE(bufoff, ptr, o_); } else { PG8_STAGE(bufoff, (ptr) + ((h) ? hstepA : 0), voffA); } } while (0)
#define PG8_LDA(dst, b, h) do { _Pragma("unroll") for (int m = 0; m < 4; ++m) _Pragma("unroll") for (int k = 0; k < 2; ++k) dst[m][k] = *(const LAS bf16x8*)(lds + PG8_SA(b, h) + aoff + m * 2048 + k * 1024); } while (0)
#define PG8_LDB(dst, b, h) do { _Pragma("unroll") for (int n = 0; n < 2; ++n) _Pragma("unroll") for (int k = 0; k < 2; ++k) dst[n][k] = *(const LAS bf16x8*)(lds + PG8_SB(b, h) + boff + n * 2048 + k * 1024); } while (0)
#define PG8_MMA(ai, bj, At, Bt) do { __builtin_amdgcn_s_setprio(1); _Pragma("unroll") for (int m = 0; m < 4; ++m) _Pragma("unroll") for (int n = 0; n < 2; ++n) _Pragma("unroll") for (int k = 0; k < 2; ++k) \
        acc[ai][bj][m][n] = __builtin_amdgcn_mfma_f32_16x16x32_bf16(Bt[n][k], At[m][k], acc[ai][bj][m][n], 0, 0, 0); __builtin_amdgcn_s_setprio(0); } while (0)
#define PG8_WAIT_V(n) asm volatile("s_waitcnt vmcnt(" #n ")" ::: "memory")
#define PG8_WAIT_L(n) asm volatile("s_waitcnt lgkmcnt(" #n ")" ::: "memory")
#define PG8_BAR __builtin_amdgcn_s_barrier()
#define PG8_SCHED __builtin_amdgcn_sched_barrier(0)
    Unit cur, nxt; int ui = 0;
    if (!S.next(0, cur)) return;
    nt = S.ktiles(g, cur);
    f32x4 acc[2][2][4][2];
#pragma unroll
    for (int a = 0; a < 2; ++a)
#pragma unroll
        for (int b = 0; b < 2; ++b)
#pragma unroll
            for (int m = 0; m < 4; ++m)
#pragma unroll
                for (int n = 0; n < 2; ++n) acc[a][b][m][n] = (f32x4){0.f, 0.f, 0.f, 0.f};
    bf16x8 At[4][2], B0[2][2], B1[2][2];
    const char* cA = (const char*)g.A + (GATHER ? (size_t)0 : S.aoff(g, cur)); const char* cB = (const char*)g.Bt + S.boff(g, cur);
    if constexpr (GATHER) { PG8_GOFF(cur, vo0, vo1); asm volatile("s_waitcnt vmcnt(0)" : "+v"(vo0[0]), "+v"(vo0[1]), "+v"(vo1[0]), "+v"(vo1[1]) :: "memory"); }
    if constexpr (SP2) {
        PG8_STAGE(PG8_SB(0, 0), cB, voffB); PG8_STAGE(PG8_SB(0, 1), cB + hstepB, voffB); PG8_STAGEA(PG8_SA(0, 0), cA, 0, false); PG8_STAGEA(PG8_SA(0, 1), cA, 1, false);
        if (wr == 1) PG8_BAR;
        PG8_WAIT_V(2); PG8_BAR;
        PG8_STAGE(PG8_SB(1, 0), cB + kstep, voffB); PG8_STAGEA(PG8_SA(1, 0), cA + kstep, 0, false); PG8_STAGE(PG8_SB(1, 1), cB + hstepB + kstep, voffB);
        PG8_WAIT_V(6); PG8_BAR;
    } else {
        PG8_STAGE(PG8_SB(0, 0), cB, voffB); PG8_STAGE(PG8_SA(0, 0), cA, voffA); PG8_STAGE(PG8_SB(0, 1), cB + hstepB, voffB); PG8_STAGE(PG8_SA(0, 1), cA + hstepA, voffA);
        if (wr == 1) PG8_BAR;
        PG8_WAIT_V(4); PG8_BAR;
        PG8_STAGE(PG8_SB(1, 0), cB + kstep, voffB); PG8_STAGE(PG8_SA(1, 0), cA + kstep, voffA); PG8_STAGE(PG8_SB(1, 1), cB + hstepB + kstep, voffB);
        PG8_WAIT_V(6); PG8_BAR;
    }
    for (;;) {
        const bool has_next = S.next(ui + 1, nxt);
        const char* nA = (has_next && !GATHER) ? (const char*)g.A + S.aoff(g, nxt) : cA; const char* nB = has_next ? (const char*)g.Bt + S.boff(g, nxt) : cB;
        if constexpr (GATHER) { if (has_next) { PG8_GOFF(nxt, nvo0, nvo1); } else { nvo0[0] = vo0[0]; nvo0[1] = vo0[1]; nvo1[0] = vo1[0]; nvo1[1] = vo1[1]; }
            asm volatile("s_waitcnt vmcnt(0)" : "+v"(nvo0[0]), "+v"(nvo0[1]), "+v"(nvo1[0]), "+v"(nvo1[1]) :: "memory"); }
        for (int t = 0; t < nt; t += 2) {
            const bool last = (t == nt - 2);
            const char* a1 = cA + (size_t)(t + 1) * kstep;
            const char* a2 = last ? nA : cA + (size_t)(t + 2) * kstep; const char* b2 = last ? nB : cB + (size_t)(t + 2) * kstep;
            const char* a3 = a2 + kstep; const char* b3 = b2 + kstep;
            if constexpr (SP2) {
            PG8_LDB(B0, 0, 0); PG8_LDB(B1, 0, 1); PG8_SCHED; PG8_LDA(At, 0, 0); PG8_STAGEA(PG8_SA(1, 1), a1, 1, false);
            PG8_WAIT_V(8); PG8_WAIT_L(0); PG8_BAR; PG8_MMA(0, 0, At, B0); PG8_MMA(0, 1, At, B1); PG8_BAR; PG8_SCHED;
            PG8_LDA(At, 0, 1); PG8_STAGE(PG8_SB(0, 0), b2, voffB); PG8_STAGE(PG8_SB(0, 1), b2 + hstepB, voffB); PG8_STAGEA(PG8_SA(0, 0), a2, 0, last);
            PG8_WAIT_V(8); PG8_WAIT_L(0); PG8_BAR; PG8_MMA(1, 0, At, B0); PG8_MMA(1, 1, At, B1); PG8_BAR; PG8_SCHED;
            PG8_LDB(B0, 1, 0); PG8_LDB(B1, 1, 1); PG8_SCHED; PG8_LDA(At, 1, 0); PG8_STAGEA(PG8_SA(0, 1), a2, 1, last);
            PG8_WAIT_V(8); PG8_WAIT_L(0); PG8_BAR; PG8_MMA(0, 0, At, B0); PG8_MMA(0, 1, At, B1); PG8_BAR; PG8_SCHED;
            PG8_LDA(At, 1, 1); PG8_STAGE(PG8_SB(1, 0), b3, voffB); PG8_STAGE(PG8_SB(1, 1), b3 + hstepB, voffB); PG8_STAGEA(PG8_SA(1, 0), a3, 0, last);
            PG8_WAIT_V(8); PG8_WAIT_L(0); PG8_BAR; PG8_MMA(1, 0, At, B0); PG8_MMA(1, 1, At, B1); PG8_BAR; PG8_SCHED;
            } else {
            PG8_LDB(B0, 0, 0); PG8_SCHED; PG8_LDA(At, 0, 0); PG8_STAGE(PG8_SA(1, 1), a1 + hstepA, voffA);
            PG8_WAIT_L(8); PG8_BAR; PG8_WAIT_L(0); PG8_MMA(0, 0, At, B0); PG8_BAR; PG8_SCHED;
            PG8_LDB(B1, 0, 1); PG8_STAGE(PG8_SB(0, 0), b2, voffB);
            PG8_BAR; PG8_WAIT_L(0); PG8_MMA(0, 1, At, B1); PG8_BAR;
            PG8_LDA(At, 0, 1); PG8_STAGE(PG8_SA(0, 0), a2, voffA);
            PG8_BAR; PG8_WAIT_L(0); PG8_MMA(1, 0, At, B0); PG8_BAR; PG8_SCHED;
            PG8_STAGE(PG8_SB(0, 1), b2 + hstepB, voffB);
            PG8_WAIT_V(6); PG8_BAR; PG8_MMA(1, 1, At, B1); PG8_BAR;
            PG8_LDB(B0, 1, 0); PG8_SCHED; PG8_LDA(At, 1, 0); PG8_STAGE(PG8_SA(0, 1), a2 + hstepA, voffA);
            PG8_WAIT_L(8); PG8_BAR; PG8_WAIT_L(0); PG8_MMA(0, 0, At, B0); PG8_BAR; PG8_SCHED;
            PG8_LDB(B1, 1, 1); PG8_STAGE(PG8_SB(1, 0), b3, voffB);
            PG8_BAR; PG8_WAIT_L(0); PG8_MMA(0, 1, At, B1); PG8_BAR;
            PG8_LDA(At, 1, 1); PG8_STAGE(PG8_SA(1, 0), a3, voffA);
            PG8_BAR; PG8_WAIT_L(0); PG8_MMA(1, 0, At, B0); PG8_BAR; PG8_SCHED;
            PG8_STAGE(PG8_SB(1, 1), b3 + hstepB, voffB);
            PG8_WAIT_V(6); PG8_BAR; PG8_MMA(1, 1, At, B1); PG8_BAR;
            }
        }
        if constexpr (ALIGN_EPI) { if (wr == 0) PG8_BAR; }
        E(acc, cur, wr, wc, fr, fq);
        S.done(cur, lane);
        if (!has_next) break;
#pragma unroll
        for (int a = 0; a < 2; ++a)
#pragma unroll
            for (int b = 0; b < 2; ++b)
#pragma unroll
                for (int m = 0; m < 4; ++m)
#pragma unroll
                    for (int n = 0; n < 2; ++n) acc[a][b][m][n] = (f32x4){0.f, 0.f, 0.f, 0.f};
        cur = nxt; cA = nA; cB = nB; ++ui; nt = S.ktiles(g, cur);
        if constexpr (GATHER) { vo0[0] = nvo0[0]; vo0[1] = nvo0[1]; vo1[0] = nvo1[0]; vo1[1] = nvo1[1]; }
        if constexpr (ALIGN_EPI) { if (wr == 1) PG8_BAR; }
    }
    PG8_WAIT_V(0);
    if constexpr (!ALIGN_EPI) { if (wr == 0) PG8_BAR; }
    PG8_BAR;
#undef PG8_SA
#undef PG8_SB
#undef PG8_STAGE
#undef PG8_LDA
#undef PG8_STAGEA
#undef PG8_GOFF
#undef PG8_LDB
#undef PG8_MMA
#undef PG8_WAIT_V
#undef PG8_WAIT_L
#undef PG8_BAR
#undef PG8_SCHED
}
}

#define XB_TMO      128
#define XB_XCNT(j)  (256  + 64 * (j))
#define XB_XSUB(j)  (1280 + 64 * (j))
#define XB_XGEN(j)  (2304 + 64 * (j))
#define XB_TOP      3328
#define XB_TOPGEN   3392
#define XCD_BAR_WORDS 3456
#define XB_SPIN_CAP (1u << 18)
__device__ __forceinline__ unsigned xb_ld(unsigned* p)              { return __hip_atomic_load(p, __ATOMIC_RELAXED, __HIP_MEMORY_SCOPE_AGENT); }
__device__ __forceinline__ unsigned xb_add(unsigned* p, unsigned v) { return __hip_atomic_fetch_add(p, v, __ATOMIC_RELAXED, __HIP_MEMORY_SCOPE_AGENT); }
__device__ __forceinline__ unsigned xb_xcc_id() { return (unsigned)__builtin_amdgcn_s_getreg((3 << 11) | 20) & 0xFu; }
#define XB_SPIN(cond, bar) do { unsigned _sp = 0; while (cond) { __builtin_amdgcn_s_sleep(1); \
    if ((++_sp & 255u) == 0u) { if (xb_ld(&(bar)[XB_TMO])) break; if (_sp > XB_SPIN_CAP) { atomicAdd(&(bar)[XB_TMO], 1u); break; } } } } while (0)
struct XcdBarrier { unsigned* bar; unsigned x; volatile LAS unsigned* st; };
__device__ __forceinline__ XcdBarrier xcd_barrier_post(unsigned* bar, volatile LAS unsigned* st) {
    XcdBarrier b; b.bar = bar; b.x = xb_xcc_id(); b.st = st;
    if (threadIdx.x == 0) (void)xb_add(&bar[XB_XCNT(b.x)], 1u);
    return b;
}
__device__ __forceinline__ void xcd_barrier_complete(unsigned* bar, unsigned x, unsigned& nloc, unsigned& nx) {
    const unsigned G = gridDim.x * gridDim.y * gridDim.z;
    unsigned sum, cnt, mine, sp = 0u;
    for (;;) {
        sum = 0u; cnt = 0u; mine = 0u;
#pragma unroll
        for (unsigned j = 0; j < 16; ++j) { const unsigned c = xb_ld(&bar[XB_XCNT(j)]); sum += c; cnt += (c > 0u) ? 1u : 0u; mine = (j == x) ? c : mine; }
        if (sum == G) break;
        __builtin_amdgcn_s_sleep(1);
        if ((++sp & 255u) == 0u) { if (xb_ld(&bar[XB_TMO])) break; if (sp > XB_SPIN_CAP) { atomicAdd(&bar[XB_TMO], 1u); break; } }
    }
    nloc = mine > 0u ? mine : 1u; nx = cnt > 0u ? cnt : 1u;
}
__device__ __forceinline__ void xcd_barrier(const XcdBarrier& b) {
    asm volatile("s_waitcnt vmcnt(0)" ::: "memory");
    __syncthreads();
    if (threadIdx.x == 0) {
        unsigned* bar = b.bar;
        __builtin_amdgcn_s_waitcnt(0);
        unsigned nloc = b.st[0], nx = b.st[1];
        if (nloc == 0u) { xcd_barrier_complete(bar, b.x, nloc, nx); b.st[0] = nloc; b.st[1] = nx; }
        const unsigned old = xb_add(&bar[XB_XSUB(b.x)], 1u);
        const unsigned gen = old / nloc;
        if (old + 1u == (gen + 1u) * nloc) {
            __builtin_amdgcn_fence(__ATOMIC_RELEASE, "agent");
            asm volatile("s_waitcnt vmcnt(0)" ::: "memory");
            const unsigned og = xb_add(&bar[XB_TOP], 1u);
            const unsigned tg = og / nx;
            if (og + 1u == (tg + 1u) * nx) xb_add(&bar[XB_TOPGEN], 1u);
            else XB_SPIN(xb_ld(&bar[XB_TOPGEN]) == tg, bar);
            __builtin_amdgcn_fence(__ATOMIC_ACQUIRE, "agent");
            xb_add(&bar[XB_XGEN(b.x)], 1u);
            asm volatile("s_waitcnt vmcnt(0)" ::: "memory");
        } else {
            XB_SPIN(xb_ld(&bar[XB_XGEN(b.x)]) == gen, bar);
            __builtin_amdgcn_fence(__ATOMIC_ACQUIRE, "agent");
            asm volatile("s_waitcnt vmcnt(0)" ::: "memory");
        }
    }
    __syncthreads();
}

struct Args {
    const float* x; const float* c; const float* ada_w; const float* ada_b; const float* mix_g; const float* ffn_g; const float* w_in;
    const float* da_lambda; const float* da_subln; const float* na_rpb; const float* wpa; const float* wpn; const float* wpd; const float* w_out;
    const float* rgw; const float* rgb; const float* rew; const float* reb; const float* ew1; const float* ew3; const float* ew2; const float* fin_g;
    float* out; unsigned char* ws; int ph_lo, ph_hi; int variant, pad;
};

__device__ const double ROPE_INV[32] = {
    1.0, 0.7498942093324559, 0.5623413251903491, 0.4216965034285822, 0.31622776601683794, 0.23713737056616552, 0.1778279410038923, 0.1333521432163324,
    0.1, 0.07498942093324558, 0.05623413251903491, 0.04216965034285822, 0.031622776601683794, 0.023713737056616554, 0.01778279410038923, 0.01333521432163324,
    0.01, 0.007498942093324558, 0.005623413251903491, 0.004216965034285822, 0.0031622776601683794, 0.0023713737056616554, 0.001778279410038923, 0.001333521432163324,
    0.001, 0.0007498942093324559, 0.0005623413251903491, 0.0004216965034285822, 0.00031622776601683794, 0.00023713737056616554, 0.0001778279410038923, 0.0001333521432163324};

__device__ __forceinline__ void sincos_d(double a, float& s, float& c) {
    const double k = __builtin_rint(a * 0.6366197723675814);
    double t = __builtin_fma(-k, 1.5707963267948966, a); t = __builtin_fma(-k, 6.123233995736766e-17, t);
    const double t2 = t * t;
    double sp = -1.0 / 1307674368000.0; sp = sp * t2 + 1.0 / 6227020800.0; sp = sp * t2 - 1.0 / 39916800.0; sp = sp * t2 + 1.0 / 362880.0; sp = sp * t2 - 1.0 / 5040.0; sp = sp * t2 + 1.0 / 120.0; sp = sp * t2 - 1.0 / 6.0; sp = sp * t2 + 1.0; sp *= t;
    double cp = 1.0 / 87178291200.0; cp = cp * t2 - 1.0 / 479001600.0; cp = cp * t2 + 1.0 / 3628800.0; cp = cp * t2 - 1.0 / 40320.0; cp = cp * t2 + 1.0 / 720.0; cp = cp * t2 - 1.0 / 24.0; cp = cp * t2 + 0.5; cp = 1.0 - cp * t2;
    const int q = ((int)k) & 3;
    const double ss = (q == 0) ? sp : (q == 1) ? cp : (q == 2) ? -sp : -cp;
    const double cc = (q == 0) ? cp : (q == 1) ? -sp : (q == 2) ? -cp : sp;
    s = (float)ss; c = (float)cc;
}

__device__ __forceinline__ int dst_row(int mode, int n) {
    if (mode == 1) { const bool rot = (n < 1024) || (n >= ZQD && n < ZVD); if (rot) { const int j = n & 63; return (n & ~63) + ((j & 31) << 1) + (j >> 5); } return n; }
    if (mode == 2) return 256 * (n >> 7) + (n & 127);
    if (mode == 3) return 256 * (n >> 7) + 128 + (n & 127);
    return n;
}
__device__ __forceinline__ void tr_item(const float* W, int N, bf16_t* WT, int ldt, int koff, int mode, LAS float* scr, int item, int lane) {
    const int nblk = N / 32, kb = item / nblk, nb = item % nblk, k0 = 64 * kb, n0 = 32 * nb;
#pragma unroll 8
    for (int i = 0; i < 32; ++i) { const int kk = 2 * i + (lane >> 5); scr[kk * 33 + (lane & 31)] = __builtin_nontemporal_load(&W[(size_t)(k0 + kk) * N + n0 + (lane & 31)]); }
    LDS_WAIT();
    const int c = lane & 7;
#pragma unroll
    for (int j = 0; j < 4; ++j) { const int n = (lane >> 3) + 8 * j; const LAS float* s = scr + (8 * c) * 33 + n;
        float f = 1.0f; if (mode == 1) { const int nn = n0 + n; f = (nn < ZKA || (nn >= ZQN && nn < ZKN) || (nn >= ZQD && nn < ZKD)) ? C2 : (nn >= ZG ? -LOG2E : 1.0f); }
        u32x4 o; o.x = cvt_pk_bf16(s[0 * 33] * f, s[1 * 33] * f); o.y = cvt_pk_bf16(s[2 * 33] * f, s[3 * 33] * f); o.z = cvt_pk_bf16(s[4 * 33] * f, s[5 * 33] * f); o.w = cvt_pk_bf16(s[6 * 33] * f, s[7 * 33] * f);
        *(u32x4*)(WT + (size_t)dst_row(mode, n0 + n) * ldt + koff + k0 + 8 * c) = o; }
    LDS_WAIT();
}

__device__ __forceinline__ float max3f(float a, float b, float c) { float r; asm("v_max3_f32 %0, %1, %2, %3" : "=v"(r) : "v"(a), "v"(b), "v"(c)); return r; }
__device__ __forceinline__ int crow(int r, int hi) { return (r & 3) + 8 * (r >> 2) + 4 * hi; }
__device__ __forceinline__ float swapmax(float m) { float a = m, b = m; swap32(a, b); return __builtin_fmaxf(a, b); }
__device__ __forceinline__ float swapsum(float m) { float a = m, b = m; swap32(a, b); return a + b; }
typedef short v4i16_t __attribute__((ext_vector_type(4)));
__device__ __forceinline__ s16x4 vtr(const LAS unsigned char* p) { return __builtin_bit_cast(s16x4, __builtin_amdgcn_ds_read_tr16_b64_v4i16((LAS v4i16_t*)p)); }

template <int DV> struct AttnCfg { static constexpr int ND = DV / 32, NCH = DV / 16, VST = DV * 2 + 64; };

template <int DV> struct TileRegs { u32x4 kr[4]; u32x4 vr[4]; };
template <int DV>
__device__ __forceinline__ void tile_load(TileRegs<DV>& T, const char* zb, const unsigned (&roff)[4], unsigned kcol, unsigned vcol) {
    const unsigned cb = 16u * (threadIdx.x & 7);
#pragma unroll
    for (int i = 0; i < 4; ++i) { T.kr[i] = *(const u32x4*)(zb + (size_t)(roff[i] + kcol + cb)); T.vr[i] = *(const u32x4*)(zb + (size_t)(roff[i] + vcol + cb)); }
}
__device__ __forceinline__ float max16m(const f32x16& p, float m) { float a, b;
    asm("v_max3_f32 %0, %2, %3, %4\n\tv_max3_f32 %1, %5, %6, %7\n\tv_max3_f32 %0, %0, %8, %9\n\tv_max3_f32 %1, %1, %10, %11\n\tv_max3_f32 %0, %0, %12, %13\n\tv_max3_f32 %1, %1, %14, %15\n\t"
        "v_max3_f32 %0, %0, %16, %17\n\tv_max3_f32 %0, %0, %1, %18"
        : "=&v"(a), "=&v"(b) : "v"(p[0]), "v"(p[1]), "v"(p[2]), "v"(p[3]), "v"(p[4]), "v"(p[5]), "v"(p[6]), "v"(p[7]), "v"(p[8]), "v"(p[9]), "v"(p[10]), "v"(p[11]), "v"(p[12]), "v"(p[13]), "v"(p[14]), "v"(p[15]), "v"(m));
    return a; }
template <int DV, class MaskF, class Reload>
__device__ __forceinline__ void attn_tile(f32x16 (&o)[DV / 32], float& m, float& l, const bf16x8 (&qf)[4], TileRegs<DV>& T,
                                          LAS unsigned char* vlds, LAS float* wsf, const MaskF& maskf, const Reload& reload, int lane, int hi) {
    constexpr int ND = AttnCfg<DV>::ND, VST = AttnCfg<DV>::VST, KST = 144;
    static_assert(DV == 64, "gather tiles are 64 wide");
    CBAR();
    { LAS unsigned char* kw = vlds + 6144 + (lane >> 3) * KST + (lane & 7) * 16; LAS unsigned char* vw = vlds + (lane >> 3) * VST + (lane & 7) * 16;
#pragma unroll
      for (int i = 0; i < 4; ++i) { *(LAS u32x4*)(kw + 8 * i * KST) = T.kr[i]; *(LAS u32x4*)(vw + 8 * i * VST) = T.vr[i]; } }
    CBAR();
    reload(T);
    f32x16 p; maskf(p);
    { const LAS unsigned char* kp = vlds + 6144 + (lane & 31) * KST + hi * 16;
#pragma unroll
      for (int d0 = 0; d0 < 4; ++d0) { const bf16x8 kf = *(const LAS bf16x8*)(kp + 32 * d0); p = __builtin_amdgcn_mfma_f32_32x32x16_bf16(kf, qf[d0], p, 0, 0, 0); } }
    asm volatile("s_nop 15\n\ts_nop 7" : "+v"(p));
    float mx = max16m(p, m);
    { float a = mx, b = mx; swap32(a, b); mx = max3f(a, b, m); }
    const float mn = (mx > m + RESCALE_THR) ? mx : m;
    const float alpha = fexp2(m - mn);
    m = mn;
    float rs = 0.f;
#pragma unroll
    for (int r = 0; r < 16; ++r) { p[r] = fexp2(p[r] - mn); rs += p[r]; }
    l = l * alpha + rs;
    if (__any(alpha != 1.0f)) {
        CBAR();
        if (hi == 0) wsf[lane & 31] = alpha;
        CBAR();
#pragma unroll
        for (int g4 = 0; g4 < 4; ++g4) { const f32x4 a4 = *(const LAS f32x4*)(wsf + 8 * g4 + 4 * hi);
#pragma unroll
            for (int d0 = 0; d0 < ND; ++d0) { o[d0][4 * g4 + 0] *= a4[0]; o[d0][4 * g4 + 1] *= a4[1]; o[d0][4 * g4 + 2] *= a4[2]; o[d0][4 * g4 + 3] *= a4[3]; } }
        CBAR();
    }
    CBAR();
    u32x4 pw0, pw1;
    pw0.x = cvtpk_s(p[0], p[1]); pw0.y = cvtpk_s(p[2], p[3]); pw0.z = cvtpk_s(p[4], p[5]); pw0.w = cvtpk_s(p[6], p[7]);
    pw1.x = cvtpk_s(p[8], p[9]); pw1.y = cvtpk_s(p[10], p[11]); pw1.z = cvtpk_s(p[12], p[13]); pw1.w = cvtpk_s(p[14], p[15]);
    const bf16x8 pa0 = __builtin_bit_cast(bf16x8, pw0), pa1 = __builtin_bit_cast(bf16x8, pw1);
    const int li = lane & 15, g16 = lane >> 4;
    const LAS unsigned char* vb = vlds + (4 * hi + (li >> 2)) * VST + (16 * (g16 & 1) + 4 * (li & 3)) * 2;
    s16x4 vlo[2][ND], vhi[2][ND];
#pragma unroll
    for (int s = 0; s < 2; ++s)
#pragma unroll
        for (int d0 = 0; d0 < ND; ++d0) { vlo[s][d0] = vtr(vb + (16 * s) * VST + d0 * 64); vhi[s][d0] = vtr(vb + (16 * s + 8) * VST + d0 * 64); }
    __builtin_amdgcn_sched_barrier(0);
#pragma unroll
    for (int s = 0; s < 2; ++s)
#pragma unroll
        for (int d0 = 0; d0 < ND; ++d0) {
            const bf16x8 vf = (bf16x8){vlo[s][d0][0], vlo[s][d0][1], vlo[s][d0][2], vlo[s][d0][3], vhi[s][d0][0], vhi[s][d0][1], vhi[s][d0][2], vhi[s][d0][3]};
            o[d0] = __builtin_amdgcn_mfma_f32_32x32x16_bf16(s == 0 ? pa0 : pa1, vf, o[d0], 0, 0, 0);
        }
    CBAR();
}
template <int ND>
__device__ __forceinline__ void attn_finish(f32x16 (&o)[ND], float l, LAS float* wsf, int lane, int hi) {
    const float inv = frcp(swapsum(l));
    CBAR();
    if (hi == 0) wsf[lane & 31] = inv;
    CBAR();
#pragma unroll
    for (int g4 = 0; g4 < 4; ++g4) { const f32x4 a4 = *(const LAS f32x4*)(wsf + 8 * g4 + 4 * hi);
#pragma unroll
        for (int d0 = 0; d0 < ND; ++d0) { o[d0][4 * g4 + 0] *= a4[0]; o[d0][4 * g4 + 1] *= a4[1]; o[d0][4 * g4 + 2] *= a4[2]; o[d0][4 * g4 + 3] *= a4[3]; } }
    CBAR();
}

__device__ __forceinline__ void glds16s(const void* sbase, unsigned voff, unsigned lds_dst) { unsigned keep;
    asm volatile("s_mov_b32 %0, m0\n\ts_mov_b32 m0, %2\n\ts_nop 0\n\tglobal_load_lds_dwordx4 %1, %3\n\ts_mov_b32 m0, %0" : "=&s"(keep) : "v"(voff), "s"(lds_dst), "s"(sbase) : "memory"); }
__device__ __forceinline__ void glds16(const void* gsrc, unsigned lds_dst) { unsigned keep;
    asm volatile("s_mov_b32 %0, m0\n\ts_mov_b32 m0, %2\n\ts_nop 0\n\tglobal_load_lds_dwordx4 %1, off\n\ts_mov_b32 m0, %0" : "=&s"(keep) : "v"(gsrc), "s"(lds_dst) : "memory"); }
__device__ __forceinline__ void diff_qk(f32x16& p0, f32x16& p1, const LAS unsigned char* qlds, const LAS unsigned char* kb, int lane, int hi) {
    const int r32 = lane & 31, sw = (r32 >> 1) & 7;
    const LAS unsigned char* kp = kb + r32 * 128;
    p0 = f32x16{}; p1 = f32x16{};
#pragma unroll
    for (int d0 = 0; d0 < 4; ++d0) {
        const bf16x8 q = *(const LAS bf16x8*)(qlds + d0 * 1024 + lane * 16);
        const int po = ((2 * d0 + hi) ^ sw) << 4;
        const bf16x8 k0 = *(const LAS bf16x8*)(kp + po), k1 = *(const LAS bf16x8*)(kp + po + 4096);
        p0 = __builtin_amdgcn_mfma_f32_32x32x16_bf16(k0, q, p0, 0, 0, 0);
        p1 = __builtin_amdgcn_mfma_f32_32x32x16_bf16(k1, q, p1, 0, 0, 0);
    }
}
__device__ __forceinline__ void diff_sm_pv(f32x16 (&o)[4], float& m, float& l, f32x16& p0, f32x16& p1, const LAS unsigned char* vbuf, LAS float* wsf, int lane, int hi) {
    const int r32 = lane & 31;
    float ma = max3f(p0[0], p0[1], p1[0]), mb = max3f(p0[2], p0[3], p1[1]); ma = max3f(ma, p1[2], p1[3]);
#pragma unroll
    for (int r = 4; r < 16; r += 4) { ma = max3f(ma, p0[r], p0[r + 1]); mb = max3f(mb, p0[r + 2], p0[r + 3]); ma = max3f(ma, p1[r], p1[r + 1]); mb = max3f(mb, p1[r + 2], p1[r + 3]); }
    float mx = max3f(ma, mb, m);
    { float a = mx, b = mx; swap32(a, b); mx = max3f(a, b, m); }
    const float mn = (mx > m + RESCALE_THR) ? mx : m;
    const float alpha = fexp2(m - mn);
    m = mn;
    float rs = 0.f;
#pragma unroll
    for (int r = 0; r < 16; ++r) { p0[r] = fexp2(p0[r] - mn); p1[r] = fexp2(p1[r] - mn); rs += p0[r] + p1[r]; }
    l = l * alpha + rs;
    if (__any(alpha != 1.0f)) {
        CBAR();
        if (hi == 0) wsf[r32] = alpha;
        CBAR();
#pragma unroll
        for (int g4 = 0; g4 < 4; ++g4) { const f32x4 a4 = *(const LAS f32x4*)(wsf + 8 * g4 + 4 * hi);
#pragma unroll
            for (int d0 = 0; d0 < 4; ++d0) { o[d0][4 * g4 + 0] *= a4[0]; o[d0][4 * g4 + 1] *= a4[1]; o[d0][4 * g4 + 2] *= a4[2]; o[d0][4 * g4 + 3] *= a4[3]; } }
        CBAR();
    }
    u32x4 pw[4];
#pragma unroll
    for (int i = 0; i < 4; ++i) { pw[0][i] = cvtpk_s(p0[2 * i], p0[2 * i + 1]); pw[1][i] = cvtpk_s(p0[8 + 2 * i], p0[9 + 2 * i]); pw[2][i] = cvtpk_s(p1[2 * i], p1[2 * i + 1]); pw[3][i] = cvtpk_s(p1[8 + 2 * i], p1[9 + 2 * i]); }
    const int li = lane & 15, g16 = lane >> 4;
    const LAS unsigned char* vp = vbuf + hi * 1024 + (li >> 2) * 64 + (16 * (g16 & 1) + 4 * (li & 3)) * 2;
#pragma unroll
    for (int s4 = 0; s4 < 4; ++s4) {
        const bf16x8 pa = __builtin_bit_cast(bf16x8, pw[s4]);
#pragma unroll
        for (int d0 = 0; d0 < 4; ++d0) {
            const s16x4 lo = vtr(vp + s4 * 4096 + d0 * 256), hh = vtr(vp + s4 * 4096 + 2048 + d0 * 256);
            const bf16x8 vf = (bf16x8){lo[0], lo[1], lo[2], lo[3], hh[0], hh[1], hh[2], hh[3]};
            o[d0] = __builtin_amdgcn_mfma_f32_32x32x16_bf16(pa, vf, o[d0], 0, 0, 0);
        }
    }
}

__device__ __forceinline__ void diff_sm(f32x16 (&o)[4], float& m, float& l, f32x16& p0, f32x16& p1, u32x4 (&pw)[4], LAS float* wsf, int lane, int hi) {
    const int r32 = lane & 31;
    float ma = max3f(p0[0], p0[1], p1[0]), mb = max3f(p0[2], p0[3], p1[1]); ma = max3f(ma, p1[2], p1[3]);
#pragma unroll
    for (int r = 4; r < 16; r += 4) { ma = max3f(ma, p0[r], p0[r + 1]); mb = max3f(mb, p0[r + 2], p0[r + 3]); ma = max3f(ma, p1[r], p1[r + 1]); mb = max3f(mb, p1[r + 2], p1[r + 3]); }
    float mx = max3f(ma, mb, m);
    { float a = mx, b = mx; swap32(a, b); mx = max3f(a, b, m); }
    const float mn = (mx > m + RESCALE_THR) ? mx : m;
    const float alpha = fexp2(m - mn);
    m = mn;
    float rs = 0.f;
#pragma unroll
    for (int r = 0; r < 16; ++r) { p0[r] = fexp2(p0[r] - mn); p1[r] = fexp2(p1[r] - mn); rs += p0[r] + p1[r]; }
    l = l * alpha + rs;
    if (__any(alpha != 1.0f)) {
        CBAR();
        if (hi == 0) wsf[r32] = alpha;
        CBAR();
#pragma unroll
        for (int g4 = 0; g4 < 4; ++g4) { const f32x4 a4 = *(const LAS f32x4*)(wsf + 8 * g4 + 4 * hi);
#pragma unroll
            for (int d0 = 0; d0 < 4; ++d0) { o[d0][4 * g4 + 0] *= a4[0]; o[d0][4 * g4 + 1] *= a4[1]; o[d0][4 * g4 + 2] *= a4[2]; o[d0][4 * g4 + 3] *= a4[3]; } }
        CBAR();
    }
#pragma unroll
    for (int i = 0; i < 4; ++i) { pw[0][i] = cvtpk_s(p0[2 * i], p0[2 * i + 1]); pw[1][i] = cvtpk_s(p0[8 + 2 * i], p0[9 + 2 * i]); pw[2][i] = cvtpk_s(p1[2 * i], p1[2 * i + 1]); pw[3][i] = cvtpk_s(p1[8 + 2 * i], p1[9 + 2 * i]); }
}
__device__ __forceinline__ void diff_pv2(f32x16 (&o0)[4], f32x16 (&o1)[4], const u32x4 (&pw0)[4], const u32x4 (&pw1)[4], const LAS unsigned char* vbuf, int lane_, int hi_) {
    int lane = lane_; asm volatile("" : "+v"(lane));
    const int hi = lane >> 5; (void)hi_;
    const int li = lane & 15, g16 = lane >> 4;
    const LAS unsigned char* vp = vbuf + hi * 1024 + (li >> 2) * 64 + (16 * (g16 & 1) + 4 * (li & 3)) * 2;
    __builtin_amdgcn_s_setprio(1);
#pragma unroll
    for (int s4 = 0; s4 < 4; ++s4) {
        const bf16x8 pa0 = __builtin_bit_cast(bf16x8, pw0[s4]), pa1 = __builtin_bit_cast(bf16x8, pw1[s4]);
#pragma unroll
        for (int d0 = 0; d0 < 4; ++d0) {
            const s16x4 lo = vtr(vp + s4 * 4096 + d0 * 256), hh = vtr(vp + s4 * 4096 + 2048 + d0 * 256);
            const bf16x8 vf = (bf16x8){lo[0], lo[1], lo[2], lo[3], hh[0], hh[1], hh[2], hh[3]};
            o0[d0] = __builtin_amdgcn_mfma_f32_32x32x16_bf16(pa0, vf, o0[d0], 0, 0, 0);
            o1[d0] = __builtin_amdgcn_mfma_f32_32x32x16_bf16(pa1, vf, o1[d0], 0, 0, 0);
        }
    }
    __builtin_amdgcn_s_setprio(0);
}
__device__ __forceinline__ void diff_qk_f(f32x16& p0, f32x16& p1, const LAS unsigned char* qlds, const LAS unsigned char* kb, const LAS unsigned char* ap, const LAS unsigned char* bp, int lane_, int hi_) {
    int lane = lane_; asm volatile("" : "+v"(lane));
    const int hi = lane >> 5; (void)hi_;
    const int r32 = lane & 31, sw = (r32 >> 1) & 7;
    const LAS unsigned char* kp = kb + r32 * 128;
    { const bf16x8 a1 = *(const LAS bf16x8*)ap, bm = *(const LAS bf16x8*)bp;
      p0 = __builtin_amdgcn_mfma_f32_32x32x16_bf16(a1, bm, f32x16{}, 0, 0, 0);
      p1 = __builtin_amdgcn_mfma_f32_32x32x16_bf16(a1, bm, f32x16{}, 0, 0, 0); }
#pragma unroll
    for (int d0 = 0; d0 < 4; ++d0) {
        const bf16x8 q = *(const LAS bf16x8*)(qlds + d0 * 1024 + lane * 16);
        const int po = ((2 * d0 + hi) ^ sw) << 4;
        const bf16x8 k0 = *(const LAS bf16x8*)(kp + po), k1 = *(const LAS bf16x8*)(kp + po + 4096);
        p0 = __builtin_amdgcn_mfma_f32_32x32x16_bf16(k0, q, p0, 0, 0, 0);
        p1 = __builtin_amdgcn_mfma_f32_32x32x16_bf16(k1, q, p1, 0, 0, 0);
    }
}
__device__ __forceinline__ void diff_sm_head(f32x16 (&o)[4], float& m, float& l, f32x16& p0, f32x16& p1, LAS float* wsf, LAS unsigned char* bslot, bool first, int lane, int hi) {
    float ma = max3f(p0[0], p0[1], p1[0]), mb = max3f(p0[2], p0[3], p1[1]); ma = max3f(ma, p1[2], p1[3]);
#pragma unroll
    for (int r = 4; r < 16; r += 4) { ma = max3f(ma, p0[r], p0[r + 1]); mb = max3f(mb, p0[r + 2], p0[r + 3]); ma = max3f(ma, p1[r], p1[r + 1]); mb = max3f(mb, p1[r + 2], p1[r + 3]); }
    float mx = __builtin_fmaxf(ma, mb);
    { float a = mx, b = mx; swap32(a, b); mx = __builtin_fmaxf(a, b); }
    const bool up = first || (mx > RESCALE_THR);
    if (__any(up)) {
        const float mnew = up ? __builtin_bit_cast(float, f2bf(m + mx) << 16) : m, delta = mnew - m;
        const float alpha = fexp2(-delta);
        m = mnew; l *= alpha;
        CBAR();
        int l2 = lane; asm volatile("" : "+v"(l2));
        if (hi == 0) { wsf[l2 & 31] = alpha; *(LAS unsigned*)bslot = f2bf(-mnew); }
        CBAR();
#pragma unroll
        for (int g4 = 0; g4 < 4; ++g4) { const f32x4 a4 = *(const LAS f32x4*)(wsf + 8 * g4 + 4 * (l2 >> 5));
#pragma unroll
            for (int d0 = 0; d0 < 4; ++d0) { o[d0][4 * g4 + 0] *= a4[0]; o[d0][4 * g4 + 1] *= a4[1]; o[d0][4 * g4 + 2] *= a4[2]; o[d0][4 * g4 + 3] *= a4[3]; } }
#pragma unroll
        for (int r = 0; r < 16; ++r) { p0[r] -= delta; p1[r] -= delta; }
        CBAR();
    }
}
__device__ __forceinline__ void diff_sm_tail(float& l, f32x16& p0, f32x16& p1, u32x4 (&pw)[4]) {
    float rs = 0.f;
#pragma unroll
    for (int r = 0; r < 16; ++r) { p0[r] = fexp2(p0[r]); p1[r] = fexp2(p1[r]); rs += p0[r] + p1[r]; }
    l += rs;
#pragma unroll
    for (int i = 0; i < 4; ++i) { pw[0][i] = cvtpk_s(p0[2 * i], p0[2 * i + 1]); pw[1][i] = cvtpk_s(p0[8 + 2 * i], p0[9 + 2 * i]); pw[2][i] = cvtpk_s(p1[2 * i], p1[2 * i + 1]); pw[3][i] = cvtpk_s(p1[8 + 2 * i], p1[9 + 2 * i]); }
}
__device__ __forceinline__ void diff_tail_pv2(f32x16 (&o0)[4], f32x16 (&o1)[4], float& l0, float& l1, const f32x16& a0, const f32x16& a1, const f32x16& b0, const f32x16& b1, const LAS unsigned char* vbuf, int lane_) {
    int lane = lane_; asm volatile("" : "+v"(lane));
    const int hi = lane >> 5, li = lane & 15, g16 = lane >> 4;
    const LAS unsigned char* vp = vbuf + hi * 1024 + (li >> 2) * 64 + (16 * (g16 & 1) + 4 * (li & 3)) * 2;
    float rs0 = 0.f, rs1 = 0.f;
    u32x4 pa, pb, pan = {0u, 0u, 0u, 0u}, pbn = {0u, 0u, 0u, 0u};
#define TP_A(st, i) do { const int r_ = ((st) & 1) * 8 + 2 * (i); const float e0_ = fexp2((st) < 2 ? a0[r_] : a1[r_]), e1_ = fexp2((st) < 2 ? a0[r_ + 1] : a1[r_ + 1]); rs0 += e0_; rs0 += e1_; asm volatile("" : "+v"(rs0)); pan[i] = cvtpk_s(e0_, e1_); } while (0)
#define TP_B(st, i) do { const int r_ = ((st) & 1) * 8 + 2 * (i); const float e0_ = fexp2((st) < 2 ? b0[r_] : b1[r_]), e1_ = fexp2((st) < 2 ? b0[r_ + 1] : b1[r_ + 1]); rs1 += e0_; rs1 += e1_; asm volatile("" : "+v"(rs1)); pbn[i] = cvtpk_s(e0_, e1_); } while (0)
#pragma unroll
    for (int i = 0; i < 4; ++i) { TP_A(0, i); TP_B(0, i); }
    pa = pan; pb = pbn;
    s16x4 flo[3], fhh[3];
#define TP_RD(c) do { flo[(c) % 3] = vtr(vp + ((c) >> 2) * 4096 + ((c) & 3) * 256); fhh[(c) % 3] = vtr(vp + ((c) >> 2) * 4096 + 2048 + ((c) & 3) * 256); } while (0)
    TP_RD(0); TP_RD(1);
    __builtin_amdgcn_sched_barrier(0);
#pragma unroll
    for (int c = 0; c < 16; ++c) {
        const int st = c >> 2, d0 = c & 3;
        if (c + 2 < 16) TP_RD(c + 2);
        const bf16x8 vf = (bf16x8){flo[c % 3][0], flo[c % 3][1], flo[c % 3][2], flo[c % 3][3], fhh[c % 3][0], fhh[c % 3][1], fhh[c % 3][2], fhh[c % 3][3]};
        o0[d0] = __builtin_amdgcn_mfma_f32_32x32x16_bf16(__builtin_bit_cast(bf16x8, pa), vf, o0[d0], 0, 0, 0);
        if (st < 3) TP_A(st + 1, d0);
        __builtin_amdgcn_sched_barrier(0);
        o1[d0] = __builtin_amdgcn_mfma_f32_32x32x16_bf16(__builtin_bit_cast(bf16x8, pb), vf, o1[d0], 0, 0, 0);
        if (st < 3) TP_B(st + 1, d0);
        __builtin_amdgcn_sched_barrier(0);
        if (d0 == 3) { pa = pan; pb = pbn; }
    }
#undef TP_A
#undef TP_B
#undef TP_RD
    l0 += rs0; l1 += rs1;
}
__device__ __forceinline__ void hm_step(int k, float& ma, float& mb, const f32x16& p0, const f32x16& p1) {
    if (k == 0) ma = max3f(p0[0], p0[1], p1[0]);
    else if (k == 1) mb = max3f(p0[2], p0[3], p1[1]);
    else if (k == 2) ma = max3f(ma, p1[2], p1[3]);
    else { const int j = (k - 3) >> 2, w = (k - 3) & 3, r = 4 + 4 * j;
        if (w == 0) ma = max3f(ma, p0[r], p0[r + 1]); else if (w == 1) mb = max3f(mb, p0[r + 2], p0[r + 3]); else if (w == 2) ma = max3f(ma, p1[r], p1[r + 1]); else mb = max3f(mb, p1[r + 2], p1[r + 3]); }
}
__device__ __forceinline__ void hm_finish(f32x16 (&o)[4], float& m, float& l, float ma, float mb, f32x16& p0, f32x16& p1, LAS float* wsf, LAS unsigned char* bslot, bool first, int lane) {
    float mx = __builtin_fmaxf(ma, mb);
    { float a = mx, b = mx; swap32(a, b); mx = __builtin_fmaxf(a, b); }
    const bool up = first || (mx > RESCALE_THR);
    if (__any(up)) {
        const float mnew = up ? __builtin_bit_cast(float, f2bf(m + mx) << 16) : m, delta = mnew - m;
        const float alpha = fexp2(-delta);
        m = mnew; l *= alpha;
        CBAR();
        int l2 = lane; asm volatile("" : "+v"(l2));
        if ((l2 >> 5) == 0) { wsf[l2 & 31] = alpha; *(LAS unsigned*)bslot = f2bf(-mnew); }
        CBAR();
#pragma unroll
        for (int g4 = 0; g4 < 4; ++g4) { const f32x4 a4 = *(const LAS f32x4*)(wsf + 8 * g4 + 4 * (l2 >> 5));
#pragma unroll
            for (int d0 = 0; d0 < 4; ++d0) { o[d0][4 * g4 + 0] *= a4[0]; o[d0][4 * g4 + 1] *= a4[1]; o[d0][4 * g4 + 2] *= a4[2]; o[d0][4 * g4 + 3] *= a4[3]; } }
#pragma unroll
        for (int r = 0; r < 16; ++r) { p0[r] -= delta; p1[r] -= delta; }
        CBAR();
    }
}
__device__ __forceinline__ void diffA_step(f32x16 (&o0)[4], f32x16 (&o1)[4], float& m0, float& l0, float& m1, float& l1, const LAS unsigned char* qlds, const LAS unsigned char* kb0, const LAS unsigned char* kb1,
                                           const LAS unsigned char* vbuf, LAS unsigned char* bsel, LAS float* wsf, bool first, int lane_) {
    int lane = lane_; asm volatile("" : "+v"(lane));
    const int hi = lane >> 5;
    f32x16 s0, s1, s2, s3;
    diff_qk_f(s0, s1, qlds, kb0, bsel + 32, bsel, lane, hi);
#define SB() __builtin_amdgcn_sched_barrier(0)
    const int r32 = lane & 31, sw = (r32 >> 1) & 7;
    const LAS unsigned char* kp = kb1 + r32 * 128; const LAS unsigned char* qp = qlds + 4096 + lane * 16;
    float ma = 0.f, mb = 0.f, rs0 = 0.f, rs1 = 0.f;
    u32x4 pa, pb, pan, pbn;
#define TP_A(st, i) do { const int r_ = ((st) & 1) * 8 + 2 * (i); const float e0_ = fexp2((st) < 2 ? s0[r_] : s1[r_]), e1_ = fexp2((st) < 2 ? s0[r_ + 1] : s1[r_ + 1]); rs0 += e0_; rs0 += e1_; asm volatile("" : "+v"(rs0)); pan[i] = cvtpk_s(e0_, e1_); } while (0)
#define TP_B(st, i) do { const int r_ = ((st) & 1) * 8 + 2 * (i); const float e0_ = fexp2((st) < 2 ? s2[r_] : s3[r_]), e1_ = fexp2((st) < 2 ? s2[r_ + 1] : s3[r_ + 1]); rs1 += e0_; rs1 += e1_; asm volatile("" : "+v"(rs1)); pbn[i] = cvtpk_s(e0_, e1_); } while (0)
    {
        const bf16x8 a1 = *(const LAS bf16x8*)(bsel + 32), bm = *(const LAS bf16x8*)(bsel + 16);
        bf16x8 qf[2], k0f, k1f;
#define RD_Q(d0)  qf[(d0) & 1] = *(const LAS bf16x8*)(qp + (d0) * 1024)
#define RD_K0(d0) k0f = *(const LAS bf16x8*)(kp + (((2 * (d0) + hi) ^ sw) << 4))
#define RD_K1(d0) k1f = *(const LAS bf16x8*)(kp + (((2 * (d0) + hi) ^ sw) << 4) + 4096)
        RD_Q(0); RD_K0(0); RD_K1(0); RD_Q(1);
        SB();
        s2 = __builtin_amdgcn_mfma_f32_32x32x16_bf16(a1, bm, f32x16{}, 0, 0, 0);
        asm volatile("s_nop 7" : "+v"(s0), "+v"(s1));
        hm_step(0, ma, mb, s0, s1); hm_step(1, ma, mb, s0, s1);
        SB();
        s3 = __builtin_amdgcn_mfma_f32_32x32x16_bf16(a1, bm, f32x16{}, 0, 0, 0);
        hm_step(2, ma, mb, s0, s1); hm_step(3, ma, mb, s0, s1); hm_step(4, ma, mb, s0, s1);
        SB();
        s2 = __builtin_amdgcn_mfma_f32_32x32x16_bf16(k0f, qf[0], s2, 0, 0, 0);
        RD_K0(1);
        hm_step(5, ma, mb, s0, s1); hm_step(6, ma, mb, s0, s1); hm_step(7, ma, mb, s0, s1);
        SB();
        s3 = __builtin_amdgcn_mfma_f32_32x32x16_bf16(k1f, qf[0], s3, 0, 0, 0);
        RD_K1(1); RD_Q(2);
        hm_step(8, ma, mb, s0, s1); hm_step(9, ma, mb, s0, s1); hm_step(10, ma, mb, s0, s1);
        SB();
        s2 = __builtin_amdgcn_mfma_f32_32x32x16_bf16(k0f, qf[1], s2, 0, 0, 0);
        RD_K0(2);
        hm_step(11, ma, mb, s0, s1); hm_step(12, ma, mb, s0, s1);
        SB();
        s3 = __builtin_amdgcn_mfma_f32_32x32x16_bf16(k1f, qf[1], s3, 0, 0, 0);
        RD_K1(2); RD_Q(3);
        hm_step(13, ma, mb, s0, s1); hm_step(14, ma, mb, s0, s1);
        SB();
        hm_finish(o0, m0, l0, ma, mb, s0, s1, wsf, bsel, first, lane);
        SB();
        s2 = __builtin_amdgcn_mfma_f32_32x32x16_bf16(k0f, qf[0], s2, 0, 0, 0);
        RD_K0(3);
        TP_A(0, 0);
        SB();
        s3 = __builtin_amdgcn_mfma_f32_32x32x16_bf16(k1f, qf[0], s3, 0, 0, 0);
        RD_K1(3);
        TP_A(0, 1);
        SB();
        s2 = __builtin_amdgcn_mfma_f32_32x32x16_bf16(k0f, qf[1], s2, 0, 0, 0);
        TP_A(0, 2);
        SB();
        s3 = __builtin_amdgcn_mfma_f32_32x32x16_bf16(k1f, qf[1], s3, 0, 0, 0);
        TP_A(0, 3);
        SB();
#undef RD_Q
#undef RD_K0
#undef RD_K1
#define QK_RD(x)
#undef QK_RD
    }
    pa = pan;
    asm volatile("s_nop 15\n\ts_nop 7" : "+v"(s2), "+v"(s3));
    ma = 0.f; mb = 0.f;
#pragma unroll
    for (int k = 0; k < 15; ++k) hm_step(k, ma, mb, s2, s3);
    hm_finish(o1, m1, l1, ma, mb, s2, s3, wsf, bsel + 16, first, lane);
#pragma unroll
    for (int i = 0; i < 4; ++i) TP_B(0, i);
    pb = pbn;
    const int li = lane & 15, g16 = lane >> 4;
    const LAS unsigned char* vp = vbuf + hi * 1024 + (li >> 2) * 64 + (16 * (g16 & 1) + 4 * (li & 3)) * 2;
    s16x4 flo[3], fhh[3];
#define TP_RD(c) do { flo[(c) % 3] = vtr(vp + (((c) & 15) >> 2) * 4096 + ((c) & 3) * 256); fhh[(c) % 3] = vtr(vp + (((c) & 15) >> 2) * 4096 + 2048 + ((c) & 3) * 256); } while (0)
#define TP_VF(c) ((bf16x8){flo[(c) % 3][0], flo[(c) % 3][1], flo[(c) % 3][2], flo[(c) % 3][3], fhh[(c) % 3][0], fhh[(c) % 3][1], fhh[(c) % 3][2], fhh[(c) % 3][3]})
    TP_RD(0); TP_RD(1);
    SB();
#pragma unroll
    for (int c = 0; c < 16; ++c) {
        const int st = c >> 2, d0 = c & 3;
        if (c + 2 < 16) TP_RD(c + 2);
        o0[d0] = __builtin_amdgcn_mfma_f32_32x32x16_bf16(__builtin_bit_cast(bf16x8, pa), TP_VF(c), o0[d0], 0, 0, 0);
        if (st < 3) TP_A(st + 1, d0);
        SB();
        o1[d0] = __builtin_amdgcn_mfma_f32_32x32x16_bf16(__builtin_bit_cast(bf16x8, pb), TP_VF(c), o1[d0], 0, 0, 0);
        if (st < 3) TP_B(st + 1, d0);
        SB();
        if (d0 == 3) { pa = pan; pb = pbn; }
    }
#undef TP_A
#undef TP_B
#undef TP_RD
#undef TP_VF
#undef SB
    l0 += rs0; l1 += rs1;
}
struct NoMask { __device__ __forceinline__ void operator()(f32x16&) const {} };

using pg8::Unit;
struct EpiZ {
    static constexpr bool PERM = true;
    bf16_t* Z; const float* ropec; const float* ropes;
    __device__ __forceinline__ void operator()(const f32x4 (&acc)[2][2][4][2], const Unit& u, int wr, int wc, int fr, int fq) const {
        const int pn = u.pn;
        const int type = (pn < 2) ? 0 : (pn < 4) ? 1 : (pn < 6) ? 2 : (pn == 6) ? 3 : (pn < 9) ? 2 : (pn < 12) ? 0 : (pn < 15) ? 1 : (pn < 18) ? 2 : 4;
        const int row0 = u.pm * 256 + wr * 64 + fr, col0 = pn * 256 + wc * 32 + 8 * fq;
        const int j0 = 16 * (wc & 1) + 4 * fq;
#pragma unroll
        for (int ai = 0; ai < 2; ++ai) {
            f32x4 cq[4], sq[4];
#pragma unroll
            for (int m = 0; m < 4; ++m) { const int pos = (row0 + ai * 128 + m * 16) & (SEQ - 1); cq[m] = (f32x4){1.f, 1.f, 1.f, 1.f}; sq[m] = (f32x4){0.f, 0.f, 0.f, 0.f};
                if (type < 2) { cq[m] = *(const f32x4*)(ropec + pos * 32 + j0); sq[m] = *(const f32x4*)(ropes + pos * 32 + j0); } }
#pragma unroll
            for (int m = 0; m < 4; ++m) {
                const int row = row0 + ai * 128 + m * 16;
                const f32x4 c4 = cq[m], s4 = sq[m];
                bf16_t* rowp = Z + (size_t)row * ZW + col0;
#pragma unroll
                for (int bj = 0; bj < 2; ++bj) {
                    f32x4 v0 = acc[ai][bj][m][0], v1 = acc[ai][bj][m][1];
                    if (type < 2) {
                        f32x4 w0, w1;
                        w0[0] = v0[0] * c4[0] - v0[1] * s4[0]; w0[1] = v0[1] * c4[0] + v0[0] * s4[0];
                        w0[2] = v0[2] * c4[1] - v0[3] * s4[1]; w0[3] = v0[3] * c4[1] + v0[2] * s4[1];
                        w1[0] = v1[0] * c4[2] - v1[1] * s4[2]; w1[1] = v1[1] * c4[2] + v1[0] * s4[2];
                        w1[2] = v1[2] * c4[3] - v1[3] * s4[3]; w1[3] = v1[3] * c4[3] + v1[2] * s4[3];
                        v0 = w0; v1 = w1;
                    }
                    if (type == 4) {
#pragma unroll
                        for (int j = 0; j < 4; ++j) { v0[j] = __builtin_fmaxf(frcp(1.f + fexp2(v0[j])), 0.f); v1[j] = __builtin_fmaxf(frcp(1.f + fexp2(v1[j])), 0.f); }
                    }
                    u32x4 w; w.x = cvt_pk_bf16(v0[0], v0[1]); w.y = cvt_pk_bf16(v0[2], v0[3]); w.z = cvt_pk_bf16(v1[0], v1[1]); w.w = cvt_pk_bf16(v1[2], v1[3]);
                    st16_wt(rowp + bj * 128, w);
                }
                CBAR();
            }
        }
    }
};
struct EpiProj {
    static constexpr bool PERM = true;
    bf16_t* Mg; const bf16_t* Zg0;
    __device__ __forceinline__ void operator()(const f32x4 (&acc)[2][2][4][2], const Unit& u, int wr, int wc, int fr, int fq) const {
        const int row0 = u.pm * 256 + wr * 64 + fr, col0 = u.pn * 256 + wc * 32 + 8 * fq;
        const bf16_t* Zg = Zg0 + (u.e & 15) * 1024; const int first = u.e >> 4;
#pragma unroll
        for (int ai = 0; ai < 2; ++ai) {
            u32x4 gq[4][2], oq[4][2];
#pragma unroll
            for (int m = 0; m < 4; ++m)
#pragma unroll
                for (int bj = 0; bj < 2; ++bj) { const int row = row0 + ai * 128 + m * 16, col = col0 + bj * 128;
                    gq[m][bj] = *(const u32x4*)(Zg + (size_t)row * ZW + col);
                    oq[m][bj] = first ? (u32x4){0u, 0u, 0u, 0u} : *(const u32x4*)(Mg + (size_t)row * D + col); }
#pragma unroll
            for (int m = 0; m < 4; ++m)
#pragma unroll
                for (int bj = 0; bj < 2; ++bj) { const int row = row0 + ai * 128 + m * 16, col = col0 + bj * 128;
                    const u32x4 g = gq[m][bj], o = oq[m][bj];
                    const f32x4 v0 = acc[ai][bj][m][0], v1 = acc[ai][bj][m][1];
                    const float r0 = bflo(g.x) * v0[0] + bflo(o.x), r1 = bfhi(g.x) * v0[1] + bfhi(o.x), r2 = bflo(g.y) * v0[2] + bflo(o.y), r3 = bfhi(g.y) * v0[3] + bfhi(o.y);
                    const float r4 = bflo(g.z) * v1[0] + bflo(o.z), r5 = bfhi(g.z) * v1[1] + bfhi(o.z), r6 = bflo(g.w) * v1[2] + bflo(o.w), r7 = bfhi(g.w) * v1[3] + bfhi(o.w);
                    u32x4 w; w.x = cvt_pk_bf16(r0, r1); w.y = cvt_pk_bf16(r2, r3); w.z = cvt_pk_bf16(r4, r5); w.w = cvt_pk_bf16(r6, r7);
                    *(u32x4*)(Mg + (size_t)row * D + col) = w; }
            CBAR();
        }
    }
};
struct EpiOut {
    static constexpr bool PERM = true;
    bf16_t* X; const float* gate;
    __device__ __forceinline__ void operator()(const f32x4 (&acc)[2][2][4][2], const Unit& u, int wr, int wc, int fr, int fq) const {
        const int row0 = u.pm * 256 + wr * 64 + fr, col0 = u.pn * 256 + wc * 32 + 8 * fq;
        const int b = (u.pm * 256) / SEQ;
        f32x4 gv[2][2];
#pragma unroll
        for (int bj = 0; bj < 2; ++bj)
#pragma unroll
            for (int n = 0; n < 2; ++n) gv[bj][n] = *(const f32x4*)(gate + (size_t)b * 6 * D + col0 + bj * 128 + 4 * n);
        u32x4 xq[2][4][2];
#pragma unroll
        for (int ai = 0; ai < 2; ++ai)
#pragma unroll
            for (int m = 0; m < 4; ++m)
#pragma unroll
                for (int bj = 0; bj < 2; ++bj) xq[ai][m][bj] = *(const u32x4*)(X + (size_t)(row0 + ai * 128 + m * 16) * D + col0 + bj * 128);
#pragma unroll
        for (int ai = 0; ai < 2; ++ai) {
#pragma unroll
            for (int m = 0; m < 4; ++m)
#pragma unroll
                for (int bj = 0; bj < 2; ++bj) { const u32x4 o = xq[ai][m][bj];
                    const f32x4 r0 = (f32x4){bflo(o.x), bfhi(o.x), bflo(o.y), bfhi(o.y)} + gv[bj][0] * acc[ai][bj][m][0], r1 = (f32x4){bflo(o.z), bfhi(o.z), bflo(o.w), bfhi(o.w)} + gv[bj][1] * acc[ai][bj][m][1];
                    u32x4 w; w.x = cvt_pk_bf16(r0[0], r0[1]); w.y = cvt_pk_bf16(r0[2], r0[3]); w.z = cvt_pk_bf16(r1[0], r1[1]); w.w = cvt_pk_bf16(r1[2], r1[3]);
                    *(u32x4*)(X + (size_t)(row0 + ai * 128 + m * 16) * D + col0 + bj * 128) = w; }
            CBAR();
        }
    }
};
struct EpiSwiglu {
    static constexpr bool PERM = true;
    bf16_t* H;
    __device__ __forceinline__ void operator()(const f32x4 (&acc)[2][2][4][2], const Unit& u, int wr, int wc, int fr, int fq) const {
        const int row0 = u.pm * 256 + wr * 64 + fr, hc = u.pn * 128 + wc * 32 + 8 * fq;
#pragma unroll
        for (int ai = 0; ai < 2; ++ai)
#pragma unroll
            for (int m = 0; m < 4; ++m) {
                const int row = row0 + ai * 128 + m * 16;
                float h[8];
#pragma unroll
                for (int n = 0; n < 2; ++n) { const f32x4 a = acc[ai][0][m][n], b = acc[ai][1][m][n];
#pragma unroll
                    for (int j = 0; j < 4; ++j) h[4 * n + j] = a[j] * frcp(1.f + fexp2(-a[j] * LOG2E)) * b[j]; }
                u32x4 w; w.x = cvt_pk_bf16(h[0], h[1]); w.y = cvt_pk_bf16(h[2], h[3]); w.z = cvt_pk_bf16(h[4], h[5]); w.w = cvt_pk_bf16(h[6], h[7]);
                st16_wt(H + (size_t)row * EH + hc, w);
            }
    }
};
struct EpiY {
    static constexpr bool PERM = true;
    bf16_t* Y;
    __device__ __forceinline__ void operator()(const f32x4 (&acc)[2][2][4][2], const Unit& u, int wr, int wc, int fr, int fq) const {
        const int row0 = u.pm * 256 + wr * 64 + fr, col0 = u.pn * 256 + wc * 32 + 8 * fq;
#pragma unroll
        for (int ai = 0; ai < 2; ++ai)
#pragma unroll
            for (int m = 0; m < 4; ++m) { bf16_t* rowp = Y + (size_t)(row0 + ai * 128 + m * 16) * D + col0;
#pragma unroll
                for (int bj = 0; bj < 2; ++bj) { const f32x4 v0 = acc[ai][bj][m][0], v1 = acc[ai][bj][m][1];
                    u32x4 w; w.x = cvt_pk_bf16(v0[0], v0[1]); w.y = cvt_pk_bf16(v0[2], v0[3]); w.z = cvt_pk_bf16(v1[0], v1[1]); w.w = cvt_pk_bf16(v1[2], v1[3]);
                    *(u32x4*)(rowp + bj * 128) = w; } }
    }
};

constexpr int NWAVES = 8;
constexpr int NPHASE = 2 + 9 * DEPTH;

__global__ void __launch_bounds__(NWAVES * 64, 2) fwd_kernel(Args args) {
    extern __shared__ __attribute__((aligned(16))) unsigned char lds_raw[];
    LAS unsigned char* lds = (LAS unsigned char*)lds_raw;
    volatile LAS unsigned* MISC = (volatile LAS unsigned*)(lds + MISC_OFF);
    const int tid0 = threadIdx.x;
    const int G = gridDim.x, bx = blockIdx.x;
    const int vcu = (G % 8 == 0) ? (bx % 8) * (G / 8) + bx / 8 : bx;
    const int NGW = G * NWAVES;
#define WSP() size_t wsz_ = 0; asm volatile("" : "+s"(wsz_)); unsigned char* ws = args.ws + wsz_; \
    int tid = tid0; asm volatile("" : "+v"(tid)); const int lane = tid & 63, wave = __builtin_amdgcn_readfirstlane(tid >> 6), hi = lane >> 5, gw = vcu * NWAVES + wave; (void)hi; (void)gw; (void)lane; (void)wave; \
    unsigned* ctl = (unsigned*)(ws + WS_CTL); float* rtab = (float*)(ws + WS_RT); (void)rtab; float* modp = (float*)(ws + WS_MOD); float* ropec = (float*)(ws + WS_ROPE); float* ropes = ropec + SEQ * 32; \
    int* tok_e = (int*)(ws + WS_ROUTE); int* tok_pos = tok_e + 2 * M; float* tok_w = (float*)(tok_pos + 2 * M); int* tok_slot = (int*)(tok_w + 2 * M); int* etok = (int*)(ws + WS_ROUTE + 2 * MiB); \
    bf16_t* X = (bf16_t*)(ws + WS_X); bf16_t* Hn = (bf16_t*)(ws + WS_H); bf16_t* OC = (bf16_t*)(ws + WS_OCAT); bf16_t* MG = (bf16_t*)(ws + WS_MERGED); bf16_t* Z = (bf16_t*)(ws + WS_Z); \
    bf16_t* XG = (bf16_t*)(ws + WS_XG); bf16_t* HB = (bf16_t*)(ws + WS_HB); bf16_t* YB = (bf16_t*)(ws + WS_YB); \
    bf16_t* WIN = (bf16_t*)(ws + WS_WIN); bf16_t* WPR = (bf16_t*)(ws + WS_WPROJ); bf16_t* WOU = (bf16_t*)(ws + WS_WOUT); bf16_t* W13 = (bf16_t*)(ws + WS_W13); bf16_t* W2 = (bf16_t*)(ws + WS_W2); \
    (void)ctl; (void)modp; (void)ropec; (void)ropes; (void)tok_e; (void)tok_pos; (void)tok_w; (void)tok_slot; (void)etok; (void)X; (void)Hn; (void)OC; (void)MG; (void)Z; (void)XG; (void)HB; (void)YB; (void)WIN; (void)WPR; (void)WOU; (void)W13; (void)W2;
    for (int u = tid0; u < 128; u += NWAVES * 64) MISC[u] = 0u;
    __syncthreads();
#if !MK_PER_PHASE
    XcdBarrier bar = xcd_barrier_post((unsigned*)(args.ws + WS_CTL) + CW_BAR, MISC + 8);
#define GRID_BAR() xcd_barrier(bar)
#else
#define GRID_BAR() do {} while (0)
#endif
    const int lo = args.ph_lo, hi_ph = args.ph_hi;
#define IN(k) (lo <= (k) && (k) < hi_ph)
#ifndef EN_MASK
#define EN_MASK 0x3ff
#endif
#define EN(k) ((EN_MASK >> (k)) & 1)
#ifndef DUPK
#define DUPK -1
#endif
#define REP(k) for (int rep_ = 0; rep_ < ((k) == DUPK ? 2 : 1); ++rep_, __syncthreads())
#define SEAM(k) do { if (IN(k) && IN((k) + 1)) GRID_BAR(); } while (0)

    if (IN(0) && EN(0)) REP(0) {
        WSP();
        {
            LAS float* cact = (LAS float*)lds;
            LAS float* part = (LAS float*)(lds + 16384);
            for (int i = tid; i < NBATCH * D; i += NWAVES * 64) { const int b = i / D, k = i % D; const float v = args.c[i]; cact[k * 4 + b] = v / (1.f + __expf(-v)); }
            __syncthreads();
            for (int it = bx; it < DEPTH * 96; it += G) {
                const int l = it / 96, cc = it % 96, col = cc * 64 + lane;
                const float* wp = args.ada_w + (size_t)l * D * 6 * D + col;
                float a0 = 0.f, a1 = 0.f, a2 = 0.f, a3 = 0.f;
#pragma unroll 1
                for (int k0 = 0; k0 < 128; k0 += 32) {
                    float wv[32];
#pragma unroll
                    for (int kk = 0; kk < 32; ++kk) wv[kk] = wp[(size_t)(wave * 128 + k0 + kk) * 6 * D];
#pragma unroll
                    for (int kk = 0; kk < 32; ++kk) { const f32x4 cv = *(const LAS f32x4*)(cact + (wave * 128 + k0 + kk) * 4);
                        a0 += cv[0] * wv[kk]; a1 += cv[1] * wv[kk]; a2 += cv[2] * wv[kk]; a3 += cv[3] * wv[kk]; } }
                part[(wave * 4 + 0) * 64 + lane] = a0; part[(wave * 4 + 1) * 64 + lane] = a1; part[(wave * 4 + 2) * 64 + lane] = a2; part[(wave * 4 + 3) * 64 + lane] = a3;
                __syncthreads();
                if (tid < 256) { const int b = tid >> 6, cl = tid & 63; float s = 0.f;
#pragma unroll
                    for (int w = 0; w < 8; ++w) s += part[(w * 4 + b) * 64 + cl];
                    modp[((size_t)l * NBATCH + b) * 6 * D + cc * 64 + cl] = s + args.ada_b[(size_t)l * 6 * D + cc * 64 + cl]; }
                __syncthreads();
            }
        }
        for (int i = (vcu * NWAVES * 64) + tid; i < SEQ * 32; i += G * NWAVES * 64) { const int pos = i >> 5, j = i & 31; float s, c; sincos_d((double)pos * ROPE_INV[j], s, c); ropec[i] = c; ropes[i] = s; }
        for (int i = (vcu * NWAVES * 64) + tid; i < DEPTH * 36 * D; i += G * NWAVES * 64) { const int k = i & (D - 1), n = (i >> 10) % 36, l2 = i / (36 * D);
            rtab[i] = n < 4 ? args.rgw[((size_t)l2 * D + k) * 4 + n] : args.rew[((size_t)l2 * D + k) * NEXP + (n - 4)]; }
        {
            LAS float* scr = (LAS float*)(lds + wave * 16384);
            constexpr int I_WIN = 16 * 240, I_PA = 8 * 32, I_PN = 4 * 32, I_WO = 16 * 32, I_E = 256, PER_L = I_WIN + I_PA + 2 * I_PN + I_WO + NEXP * 3 * I_E;
            for (int it = gw; it < DEPTH * PER_L; it += NGW) {
                const int l = it / PER_L; int r = it % PER_L;
                if (r < I_WIN) { tr_item(args.w_in + (size_t)l * D * ZW, ZW, WIN + (size_t)l * ZW * D, D, 0, 1, scr, r, lane); continue; } r -= I_WIN;
                if (r < I_PA) { tr_item(args.wpa + (size_t)l * 512 * D, D, WPR + (size_t)l * D * D, D, 0, 0, scr, r, lane); continue; } r -= I_PA;
                if (r < I_PN) { tr_item(args.wpn + (size_t)l * 256 * D, D, WPR + (size_t)l * D * D, D, 512, 0, scr, r, lane); continue; } r -= I_PN;
                if (r < I_PN) { tr_item(args.wpd + (size_t)l * 256 * D, D, WPR + (size_t)l * D * D, D, 768, 0, scr, r, lane); continue; } r -= I_PN;
                if (r < I_WO) { tr_item(args.w_out + (size_t)l * D * D, D, WOU + (size_t)l * D * D, D, 0, 0, scr, r, lane); continue; } r -= I_WO;
                const int e = r / (3 * I_E), q = r % (3 * I_E); const size_t le = (size_t)l * NEXP + e;
                if (q < I_E) tr_item(args.ew1 + le * D * EH, EH, W13 + le * 1024 * D, D, 0, 2, scr, q, lane);
                else if (q < 2 * I_E) tr_item(args.ew3 + le * D * EH, EH, W13 + le * 1024 * D, D, 0, 3, scr, q - I_E, lane);
                else tr_item(args.ew2 + le * EH * D, D, W2 + le * D * EH, EH, 0, 0, scr, q - 2 * I_E, lane);
            }
        }
    }
    SEAM(0);

    for (int l = 0; l < DEPTH; ++l) {
        const int pb = 1 + 9 * l;
        if (IN(pb + 0) && EN(1)) {
            WSP(); const float* modl = modp + (size_t)l * NBATCH * 6 * D; (void)modl;
            const float* gam = args.mix_g + (size_t)l * D;
            const float* modprev = modp + (size_t)(l > 0 ? l - 1 : 0) * NBATCH * 6 * D;
            constexpr int RPW = M / (256 * NWAVES); const int rbase = gw * RPW, b = rbase / SEQ;
            int slot_v = 0; float w_v = 0.f;
            if (l > 0) {
                const unsigned* cntp = ctl + CW_CNT + (l - 1) * NEXP * 64;
                const int cv = (lane < NEXP) ? (int)__hip_atomic_load(cntp + lane * 64, __ATOMIC_RELAXED, __HIP_MEMORY_SCOPE_AGENT) : 0;
                const int tl = (cv + 255) >> 8; int tstart = 0, run = 0;
#pragma unroll
                for (int e = 0; e < NEXP; ++e) { if (lane == e) tstart = run; run += __builtin_amdgcn_readlane(tl, e); }
                const int i = min(lane, 2 * RPW - 1);
                const int e = tok_e[2 * rbase + i], pos = tok_pos[2 * rbase + i]; w_v = tok_w[2 * rbase + i];
                slot_v = __builtin_amdgcn_ds_bpermute(4 * e, tstart) * 256 + pos;
            }
            f32x4 ca[4], cb[4], gf[4];
#pragma unroll
            for (int j = 0; j < 4; ++j) { const int col = 4 * lane + 256 * j;
                const f32x4 g4 = *(const f32x4*)(gam + col), sc = *(const f32x4*)(modl + (size_t)b * 6 * D + 1 * D + col), sh = *(const f32x4*)(modl + (size_t)b * 6 * D + col);
                ca[j] = g4 * (sc + 1.0f); cb[j] = sh; gf[j] = *(const f32x4*)(modprev + (size_t)b * 6 * D + 5 * D + col); }
#pragma unroll 1
            for (int r0 = rbase; r0 < rbase + RPW; r0 += 4) {
                f32x4 v[4][4];
                if (l == 0) {
#pragma unroll
                    for (int q = 0; q < 4; ++q)
#pragma unroll
                        for (int j = 0; j < 4; ++j) v[q][j] = *(const f32x4*)(args.x + (size_t)(r0 + q) * D + 4 * lane + 256 * j);
                } else {
                    u32x2 xr[4][4], y0[4][4], y1[4][4]; float w0[4], w1[4];
#pragma unroll
                    for (int q = 0; q < 4; ++q) { const int ix = 2 * (r0 - rbase + q);
                        const int s0 = __builtin_amdgcn_readlane(slot_v, ix), s1 = __builtin_amdgcn_readlane(slot_v, ix + 1);
                        w0[q] = __builtin_bit_cast(float, __builtin_amdgcn_readlane(__builtin_bit_cast(int, w_v), ix)); w1[q] = __builtin_bit_cast(float, __builtin_amdgcn_readlane(__builtin_bit_cast(int, w_v), ix + 1));
#pragma unroll
                        for (int j = 0; j < 4; ++j) { const int col = 4 * lane + 256 * j;
                            xr[q][j] = *(const u32x2*)(X + (size_t)(r0 + q) * D + col); y0[q][j] = *(const u32x2*)(YB + (size_t)s0 * D + col); y1[q][j] = *(const u32x2*)(YB + (size_t)s1 * D + col); } }
#pragma unroll
                    for (int q = 0; q < 4; ++q)
#pragma unroll
                        for (int j = 0; j < 4; ++j) { const f32x4 yy = bf4(y0[q][j]) * w0[q] + bf4(y1[q][j]) * w1[q]; v[q][j] = bf4(xr[q][j]) + gf[j] * yy; }
                }
#pragma unroll
                for (int q = 0; q < 4; ++q) { const int row = r0 + q;
                    float ss = 0.f;
#pragma unroll
                    for (int j = 0; j < 4; ++j) { u32x2 xw; xw.x = cvt_pk_bf16(v[q][j][0], v[q][j][1]); xw.y = cvt_pk_bf16(v[q][j][2], v[q][j][3]); *(u32x2*)(X + (size_t)row * D + 4 * lane + 256 * j) = xw;
                        ss += (v[q][j][0] * v[q][j][0] + v[q][j][1] * v[q][j][1]) + (v[q][j][2] * v[q][j][2] + v[q][j][3] * v[q][j][3]); }
                    const float rstd = 1.0f / sqrtf(wave_sum(ss) * (1.f / D) + NORM_EPS);
#pragma unroll
                    for (int j = 0; j < 4; ++j) { const int col = 4 * lane + 256 * j;
                        const f32x4 hv = v[q][j] * rstd * ca[j] + cb[j];
                        u32x2 w; w.x = cvt_pk_bf16(hv[0], hv[1]); w.y = cvt_pk_bf16(hv[2], hv[3]);
                        *(u32x2*)(Hn + (size_t)row * D + col) = w; }
                }
            }
        }
        SEAM(pb + 0);
        if (IN(pb + 1) && EN(2)) REP(2) {
            WSP(); const float* modl = modp + (size_t)l * NBATCH * 6 * D; (void)modl;
            pg8::Gemm g{Hn, WIN + (size_t)l * ZW * D, D, D, D}; pg8::StaticOrder S; S.init(M, ZW, G, bx);
            EpiZ E{Z, ropec, ropes};
            pg8::gemm_phase<EpiZ, pg8::StaticOrder>(lds, g, S, E);
        }
        SEAM(pb + 1);
        if (IN(pb + 2) && EN(3)) REP(3) {
            WSP(); const float* modl = modp + (size_t)l * NBATCH * 6 * D; (void)modl;
            {
                int tidm = tid0; asm volatile("" : "+v"(tidm)); const int lane = tidm & 63, hi = lane >> 5;
                LAS unsigned char* vlds = lds + wave * 12288; LAS float* wsf = (LAS float*)(lds + 98304 + wave * 256);
                const float* lp = args.da_lambda + (size_t)l * 4 * 64;
                const float s01 = wave_sum(lp[lane] * lp[64 + lane]), s23 = wave_sum(lp[128 + lane] * lp[192 + lane]);
                const float lam_init = 0.8f - 0.6f * __expf(-0.3f * (float)l);
                const float lam = __expf(s01) - __expf(s23) + lam_init;
                LAS float* wsfA = (LAS float*)(lds + 131072 + wave * 128);
                const unsigned lds0 = (unsigned)(uintptr_t)lds;
                for (int un = vcu; un < NBATCH * 4 * 16; un += G) {
                    const int b = un >> 6, h = (un >> 4) & 3, qb = un & 15;
                    const size_t rowbase = (size_t)b * SEQ; const int q0 = qb * 256 + wave * 32;
                    LAS unsigned char* qlds = lds + 65536 + wave * 8192;
                    { bf16x8 qf[8];
                      const bf16_t* qp = Z + (rowbase + q0 + (lane & 31)) * ZW + ZQA + h * 128 + 8 * hi;
#pragma unroll
                      for (int i = 0; i < 8; ++i) qf[i] = *(const bf16x8*)(qp + 16 * i);
                      asm volatile("s_waitcnt vmcnt(0)" : "+v"(qf[0]), "+v"(qf[1]), "+v"(qf[2]), "+v"(qf[3]), "+v"(qf[4]), "+v"(qf[5]), "+v"(qf[6]), "+v"(qf[7]) :: "memory");
#pragma unroll
                      for (int i = 0; i < 8; ++i) *(LAS bf16x8*)(qlds + i * 1024 + lane * 16) = qf[i]; }
                    f32x16 o0[4], o1[4];
#pragma unroll
                    for (int d0 = 0; d0 < 4; ++d0) { o0[d0] = f32x16{}; o1[d0] = f32x16{}; }
                    float m0 = 0.f, l0 = 0.f, m1 = 0.f, l1 = 0.f;
                    LAS unsigned char* bsel = lds + 132096 + (hi ? 0 : 64 + (wave * 32 + (lane & 31)) * 48);
                    { unsigned z0 = 0u, e0 = hi ? 0u : 0x3F80u; asm volatile("" : "+v"(z0), "+v"(e0));
                      *(LAS u32x4*)bsel = (u32x4){z0, z0, z0, z0}; *(LAS u32x4*)(bsel + 16) = (u32x4){z0, z0, z0, z0}; *(LAS u32x4*)(bsel + 32) = (u32x4){e0, z0, z0, z0}; }
                    const int krow = 8 * wave + (lane >> 3);
                    const unsigned koff = (unsigned)(((rowbase + krow) * ZW + ZKA + h * 128) * 2 + (((lane & 7) ^ ((krow >> 1) & 7)) << 4));
                    const unsigned voff = (unsigned)(((rowbase + 8 * wave + ((lane >> 2) & 3)) * ZW + ZVA + h * 128 + (4 * (lane >> 4) + (lane & 3)) * 8) * 2);
#define DIFF_DMA(t, bo) do { const char* zb_ = (const char*)Z + (size_t)(t) * 64 * ZW * 2; \
        glds16s(zb_, koff, (unsigned)__builtin_amdgcn_readfirstlane((int)(lds0 + ((bo) * 2 + 0) * 8192 + wave * 1024))); \
        glds16s(zb_ + 128, koff, (unsigned)__builtin_amdgcn_readfirstlane((int)(lds0 + ((bo) * 2 + 1) * 8192 + wave * 1024))); \
        glds16s(zb_, voff, (unsigned)__builtin_amdgcn_readfirstlane((int)(lds0 + 32768 + (bo) * 16384 + wave * 2048))); \
        glds16s(zb_ + (size_t)4 * ZW * 2, voff, (unsigned)__builtin_amdgcn_readfirstlane((int)(lds0 + 32768 + (bo) * 16384 + wave * 2048 + 1024))); } while (0)
#define DIFF_SYNC() do { asm volatile("s_waitcnt vmcnt(0) lgkmcnt(0)" ::: "memory"); __builtin_amdgcn_s_barrier(); asm volatile("" ::: "memory"); } while (0)
                    DIFF_DMA(0, 0);
#pragma unroll 1
                    for (int t = 0; t < SEQ / 64; ++t) {
                        const int bo = t & 1;
                        DIFF_SYNC();
                        if (t + 1 < SEQ / 64) DIFF_DMA(t + 1, bo ^ 1);
                        diffA_step(o0, o1, m0, l0, m1, l1, qlds, lds + (bo * 2 + 0) * 8192, lds + (bo * 2 + 1) * 8192, lds + 32768 + bo * 16384, bsel, wsfA, t == 0, lane);
                    }
                    DIFF_SYNC();
#undef DIFF_DMA
#undef DIFF_SYNC
                    int lane_e = lane; asm volatile("" : "+v"(lane_e)); const int hi_e = lane_e >> 5;
                    attn_finish<4>(o0, l0, wsfA, lane_e, hi_e);
                    attn_finish<4>(o1, l1, wsfA, lane_e, hi_e);
                    const float* sg = args.da_subln + (size_t)l * 128;
                    float g4[4];
#pragma unroll
                    for (int d0 = 0; d0 < 4; ++d0) g4[d0] = sg[32 * d0 + (lane_e & 31)] * (1.0f - lam_init);
#pragma unroll
                    for (int r0 = 0; r0 < 16; r0 += 4) {
                        float ov[4][4], ss[4], tt[4];
#pragma unroll
                        for (int k = 0; k < 4; ++k) {
#pragma unroll
                            for (int d0 = 0; d0 < 4; ++d0) ov[k][d0] = o0[d0][r0 + k] - lam * o1[d0][r0 + k];
                            ss[k] = ov[k][0] * ov[k][0] + ov[k][1] * ov[k][1] + ov[k][2] * ov[k][2] + ov[k][3] * ov[k][3]; }
#pragma unroll
                        for (int k = 0; k < 4; ++k) ss[k] += dpp_f<0xB1>(ss[k]);
#pragma unroll
                        for (int k = 0; k < 4; ++k) ss[k] += dpp_f<0x4E>(ss[k]);
#pragma unroll
                        for (int k = 0; k < 4; ++k) ss[k] += dpp_f<0x141>(ss[k]);
#pragma unroll
                        for (int k = 0; k < 4; ++k) ss[k] += dpp_f<0x140>(ss[k]);
#pragma unroll
                        for (int k = 0; k < 4; ++k) tt[k] = xor_lane<16>(ss[k]);
#pragma unroll
                        for (int k = 0; k < 4; ++k) { const int r = r0 + k;
                            const float rn = __builtin_amdgcn_rsqf((ss[k] + tt[k]) * (1.f / 128.f) + NORM_EPS);
                            bf16_t* op = OC + (rowbase + q0 + crow(r, hi_e)) * D + h * 128 + (lane_e & 31);
#pragma unroll
                            for (int d0 = 0; d0 < 4; ++d0) { const float ovn = ov[k][d0] * rn * g4[d0]; op[32 * d0] = (bf16_t)(cvt_pk_bf16(ovn, ovn) & 0xffffu); } }
                    }
                }
                asm volatile("s_waitcnt vmcnt(0) lgkmcnt(0)" ::: "memory"); __builtin_amdgcn_s_barrier();
            }
            {
                int tidm = tid0; asm volatile("" : "+v"(tidm)); const int lane = tidm & 63, hi = lane >> 5;
                LAS unsigned char* vlds = lds + wave * 12288; LAS float* wsf = (LAS float*)(lds + 98304 + wave * 256);
                LAS float* tab = (LAS float*)(lds + 100352);
                { const float* rpb = args.na_rpb + (size_t)l * 4 * 15 * 31;
                  for (int i = wave * 64 + lane; i < 4 * 15 * 128; i += NWAVES * 64) { const int j = (i & 127) - 48, hb = i >> 7; tab[i] = (j >= 0 && j <= 30) ? rpb[hb * 31 + j] * LOG2E : 0.f; } }
                asm volatile("s_waitcnt vmcnt(0) lgkmcnt(0)" ::: "memory"); __builtin_amdgcn_s_barrier(); asm volatile("" ::: "memory");
                const char* zb = (const char*)Z;
                for (int wu = gw; wu < NBATCH * 4 * 64 * 2; wu += NGW) {
                    const int half = wu & 1, gr = (wu >> 1) & 63, h = (wu >> 7) & 3, b = wu >> 9;
                    const int rowb = b * SEQ; const int c0 = half * 32, cq = c0 + (lane & 31);
                    const int kr0 = min(max(gr - 4, 0), 56), cs = min(max(cq - 8, 0), 48);
                    bf16x8 qf[4];
                    { const unsigned qoff = (unsigned)(((rowb + gr * 64 + cq) * ZW + ZQN + h * 64 + 8 * hi) * 2);
#pragma unroll
                      for (int d0 = 0; d0 < 4; ++d0) qf[d0] = *(const bf16x8*)(zb + (size_t)(qoff + 32u * d0)); }
                    f32x16 o[2]; o[0] = f32x16{}; o[1] = f32x16{};
                    float mrun = NEGBIG, lrun = 0.f;
                    const unsigned kcol = (unsigned)((ZKN + h * 64) * 2), vcol = (unsigned)((ZVN + h * 64) * 2);
                    unsigned rb0[4];
#pragma unroll
                    for (int i = 0; i < 4; ++i) rb0[i] = (unsigned)((rowb + (kr0 + (i >> 1)) * 64 + 16 * half + 8 * (i & 1) + (lane >> 3)) * ZW * 2);
                    TileRegs<64> cur;
                    tile_load<64>(cur, zb, rb0, kcol, vcol);
#pragma unroll 1
                    for (int t = 0, rp = 0, cc = 0; t < 12; ++t) {
                        const int kr = kr0 + 2 * rp, chunk = half + cc;
                        const int cn = (cc == 2) ? 0 : cc + 1, rn = (cc == 2) ? rp + 1 : rp;
                        auto reload = [&](TileRegs<64>& T) { const unsigned adv = (unsigned)((t + 1 < 12) ? (2 * rn * 64 + 16 * cn) : (2 * rp * 64 + 16 * cc)) * (ZW * 2u); unsigned rr[4];
#pragma unroll
                          for (int i = 0; i < 4; ++i) rr[i] = rb0[i] + adv;
                          tile_load<64>(T, zb, rr, kcol, vcol); };
                        const LAS float* bp = tab + (h * 15 + (kr - gr + 7)) * 128 + (16 * chunk + 4 * hi - cq + 63);
                        const int u0 = 16 * chunk + 4 * hi - cs;
                        auto maskf = [&](f32x16& p) {
#pragma unroll
                            for (int r = 0; r < 16; ++r) { const int co = (r & 3) + 8 * (r >> 2);
                                const float bv = bp[(co >> 4) * 128 + (co & 15)]; p[r] = ((unsigned)(u0 + (co & 15)) <= 15u) ? bv : NEGBIG; }
                        };
                        attn_tile<64>(o, mrun, lrun, qf, cur, vlds, wsf, maskf, reload, lane, hi);
                        cc = cn; rp = rn;
                    }
                    attn_finish<2>(o, lrun, wsf, lane, hi);
#pragma unroll
                    for (int r = 0; r < 16; ++r) { bf16_t* op = OC + (size_t)(rowb + gr * 64 + c0 + crow(r, hi)) * D + 512 + h * 64 + (lane & 31);
                        const unsigned w = cvt_pk_bf16(o[0][r], o[1][r]); op[0] = (bf16_t)(w & 0xffffu); op[32] = (bf16_t)(w >> 16); }
                }
            }
            {
                int tidm = tid0; asm volatile("" : "+v"(tidm)); const int lane = tidm & 63, hi = lane >> 5;
                LAS unsigned char* vlds = lds + wave * 12288; LAS float* wsf = (LAS float*)(lds + 98304 + wave * 256);
                const char* zb = (const char*)Z;
                for (int wu = gw; wu < NBATCH * 4 * 8 * 16; wu += NGW) {
                    const int rho = wu & 15, sb = (wu >> 4) & 7, hs = (wu >> 7) & 3, b = wu >> 9;
                    const int rowb = b * SEQ; const int qi = lane & 31; const int tq = 512 * sb + rho + 16 * qi;
                    f32x16 o[2]; o[0] = f32x16{}; o[1] = f32x16{};
                    float mrun = NEGBIG, lrun = 0.f;
                    const unsigned qoff0 = (unsigned)(((rowb + tq) * ZW + ZQD + hs * 64 + 8 * hi) * 2);
                    TileRegs<64> cur;
                    { const int kb0 = 512 * sb + rho - 64;
                      unsigned rr[4];
#pragma unroll
                      for (int i = 0; i < 4; ++i) rr[i] = (unsigned)((rowb + min(max(kb0 + 8 * i + (lane >> 3), 0), SEQ - 1)) * ZW * 2);
                      tile_load<64>(cur, zb, rr, (unsigned)((ZKD + hs * 64) * 2), (unsigned)((ZVD + hs * 64) * 2)); }
#pragma unroll 1
                    for (int gi = 0; gi < 3; ++gi) {
                        const int sh = 2 * gi, res = rho & ((1 << sh) - 1), qa = (512 * sb + rho) >> sh, qk = qa + (16 >> sh) * qi, nsub = SEQ >> sh, ntile = (gi == 0) ? 20 : (gi == 1) ? 8 : 5;
                        const int lo_v = max(qk - 64, 0), span = min(qk + 64, nsub - 1) - lo_v;
                        const unsigned kcol = (unsigned)((ZKD + gi * 256 + hs * 64) * 2), vcol = (unsigned)((ZVD + gi * 256 + hs * 64) * 2), rbase = (unsigned)((rowb + res) * ZW * 2);
                        const int sh2 = sh + 2, res2 = rho & ((1 << sh2) - 1), kbn = ((512 * sb + rho) >> sh2) - 64, nsub2 = SEQ >> sh2;
                        bf16x8 qf[4];
#pragma unroll
                        for (int d0 = 0; d0 < 4; ++d0) qf[d0] = *(const bf16x8*)(zb + (size_t)(qoff0 + (unsigned)(gi * 512) + 32u * d0));
                        int kb = qa - 64;
#pragma unroll 1
                        for (int t = 0; t < ntile; ++t, kb += 32) {
                            auto reload = [&](TileRegs<64>& T) { const bool same = (t + 1 < ntile); const int kbx = same ? kb + 32 : kbn, nsx = same ? nsub : nsub2, shx = same ? sh : sh2;
                              const unsigned rbx = same ? rbase : (unsigned)((rowb + res2) * ZW * 2), kcx = same ? kcol : kcol + 512u, vcx = same ? vcol : vcol + 512u; unsigned rr[4];
                              if (kbx >= 0 && kbx + 32 <= nsx) {
                                  const unsigned b0 = rbx + __umul24((unsigned)((kbx + (lane >> 3)) << shx), ZW * 2u), inc = (8u << shx) * (ZW * 2u);
#pragma unroll
                                  for (int i = 0; i < 4; ++i) rr[i] = b0 + (unsigned)i * inc;
                              } else {
#pragma unroll
                                  for (int i = 0; i < 4; ++i) rr[i] = rbx + __umul24((unsigned)(min(max(kbx + 8 * i + (lane >> 3), 0), nsx - 1) << shx), ZW * 2u);
                              }
                              tile_load<64>(T, zb, rr, kcx, vcx); };
                            const int u0 = kb + 4 * hi - lo_v;
                            auto maskf = [&](f32x16& p) {
#pragma unroll
                                for (int r = 0; r < 16; ++r) { const int co = (r & 3) + 8 * (r >> 2); p[r] = ((unsigned)(u0 + co) <= (unsigned)span) ? 0.f : NEGBIG; }
                            };
                            attn_tile<64>(o, mrun, lrun, qf, cur, vlds, wsf, maskf, reload, lane, hi);
                        }
                    }
                    attn_finish<2>(o, lrun, wsf, lane, hi);
#pragma unroll
                    for (int r = 0; r < 16; ++r) { bf16_t* op = OC + (size_t)(rowb + 512 * sb + rho + 16 * crow(r, hi)) * D + 768 + hs * 64 + (lane & 31);
                        const unsigned w = cvt_pk_bf16(o[0][r], o[1][r]); op[0] = (bf16_t)(w & 0xffffu); op[32] = (bf16_t)(w >> 16); }
                }
            }
        }
        SEAM(pb + 2);
        if (IN(pb + 3) && EN(4)) REP(4) {
            WSP(); const float* modl = modp + (size_t)l * NBATCH * 6 * D; (void)modl;
            pg8::StaticOrder S0; S0.init(M, D, G, bx); pg8::Unit u0; pg8::ProjOrder S; S.pm = 0; S.pn = 0; S.rot = bx & 1;
            const bool have = S0.next(0, u0); S.pm = u0.pm; S.pn = u0.pn;
            if (have) { pg8::Gemm g{OC, WPR + (size_t)l * D * D, D, D, D}; EpiProj E{MG, Z + ZG}; pg8::gemm_phase<EpiProj, pg8::ProjOrder>(lds, g, S, E); }
        }
        SEAM(pb + 3);
        if (IN(pb + 4) && EN(5)) {
            WSP(); const float* modl = modp + (size_t)l * NBATCH * 6 * D; (void)modl;
            pg8::Gemm g{MG, WOU + (size_t)l * D * D, D, D, D}; pg8::StaticOrder S; S.init(M, D, G, bx);
            EpiOut E{X, modl + 2 * D};
            pg8::gemm_phase<EpiOut, pg8::StaticOrder>(lds, g, S, E);
        }
        SEAM(pb + 4);
        if (IN(pb + 5) && EN(6)) {
            WSP(); const float* modl = modp + (size_t)l * NBATCH * 6 * D; (void)modl;
            LAS float* rt = (LAS float*)lds;
            LAS unsigned* lcnt = (LAS unsigned*)(lds + MISC_OFF) + 16;
            LAS unsigned* lbase = lcnt + 32;
            { const float* rsrc = rtab + (size_t)l * 36 * D + 4 * lane; const unsigned lds0 = (unsigned)(uintptr_t)lds;
              for (int pc = wave; pc < 144; pc += NWAVES) glds16(rsrc + (pc >> 2) * D + (pc & 3) * 256, (unsigned)__builtin_amdgcn_readfirstlane((int)(lds0 + (pc >> 2) * (RT_LD * 4) + (pc & 3) * 1024)));
              if (tid < 64) lcnt[tid] = 0u;
              if (tid < 36) rt[tid * RT_LD + D] = tid < 4 ? args.rgb[(size_t)l * 4 + tid] : args.reb[(size_t)l * NEXP + tid - 4];
              asm volatile("s_waitcnt vmcnt(0)" ::: "memory");
            }
            __syncthreads();
            const float* gam = args.ffn_g + (size_t)l * D;
            unsigned* cnt = ctl + CW_CNT + l * NEXP * 64;
            int myE0 = 0, myE1 = 0, myP0 = 0, myP1 = 0, myRow = -1; float myW0 = 0.f, myW1 = 0.f; int nrow = 0;
            f32x4 v[4][4], vn[4][4];
            constexpr int RPW = M / (256 * NWAVES); const int rbase = gw * RPW;
            f32x4 ca[4], cb[4];
            { const int b = rbase / SEQ;
#pragma unroll
              for (int j = 0; j < 4; ++j) { const int col = 4 * lane + 256 * j;
                  const f32x4 g4 = *(const f32x4*)(gam + col), sc = *(const f32x4*)(modl + (size_t)b * 6 * D + 4 * D + col), sh = *(const f32x4*)(modl + (size_t)b * 6 * D + 3 * D + col);
                  ca[j] = g4 * (sc + 1.0f); cb[j] = sh; } }
#define T2_LOAD(dst, rb) do { _Pragma("unroll") for (int q = 0; q < 4; ++q) { const int row = min((rb) + q, M - 1); \
                _Pragma("unroll") for (int j = 0; j < 4; ++j) dst[q][j] = bf4(*(const u32x2*)(X + (size_t)row * D + 4 * lane + 256 * j)); } } while (0)
            T2_LOAD(v, rbase);
#pragma unroll 1
            for (int r0 = rbase; r0 < rbase + RPW; r0 += 4) {
                T2_LOAD(vn, min(r0 + 4, M - 4));
                float ssq[4];
#pragma unroll
                for (int q = 0; q < 4; ++q) { f32x2 s2 = {0.f, 0.f};
#pragma unroll
                    for (int j = 0; j < 4; ++j) { const f32x2 lo = {v[q][j][0], v[q][j][1]}, hi2 = {v[q][j][2], v[q][j][3]}; s2 = lo * lo + s2; s2 = hi2 * hi2 + s2; }
                    ssq[q] = s2[0] + s2[1]; }
                wave_sum4_u(ssq[0], ssq[1], ssq[2], ssq[3]);
#pragma unroll
                for (int q = 0; q < 4; ++q) {
                    const int row = r0 + q;
                    const float rstd = 1.0f / sqrtf(ssq[q] * (1.f / D) + NORM_EPS);
#pragma unroll
                    for (int j = 0; j < 4; ++j) { const int col = 4 * lane + 256 * j;
                        v[q][j] = v[q][j] * rstd * ca[j] + cb[j];
                        u32x2 w; w.x = cvt_pk_bf16(v[q][j][0], v[q][j][1]); w.y = cvt_pk_bf16(v[q][j][2], v[q][j][3]);
                        *(u32x2*)(Hn + (size_t)row * D + col) = w; }
                }
                float LG[4][4];
#pragma unroll
                for (int n = 0; n < 4; ++n) { f32x2 c0 = {0.f, 0.f}, c1 = c0, c2 = c0, c3 = c0;
#pragma unroll
                    for (int j = 0; j < 4; ++j) { const f32x4 wv = *(const LAS f32x4*)(rt + n * RT_LD + 4 * lane + 256 * j); const f32x2 wl = {wv[0], wv[1]}, wh = {wv[2], wv[3]};
                        c0 = wl * (f32x2){v[0][j][0], v[0][j][1]} + c0; c0 = wh * (f32x2){v[0][j][2], v[0][j][3]} + c0;
                        c1 = wl * (f32x2){v[1][j][0], v[1][j][1]} + c1; c1 = wh * (f32x2){v[1][j][2], v[1][j][3]} + c1;
                        c2 = wl * (f32x2){v[2][j][0], v[2][j][1]} + c2; c2 = wh * (f32x2){v[2][j][2], v[2][j][3]} + c2;
                        c3 = wl * (f32x2){v[3][j][0], v[3][j][1]} + c3; c3 = wh * (f32x2){v[3][j][2], v[3][j][3]} + c3; }
                    float a0 = c0[0] + c0[1], a1 = c1[0] + c1[1], a2 = c2[0] + c2[1], a3 = c3[0] + c3[1];
                    wave_sum4_u(a0, a1, a2, a3);
                    const float bgn = rt[n * RT_LD + D]; LG[0][n] = a0 + bgn; LG[1][n] = a1 + bgn; LG[2][n] = a2 + bgn; LG[3][n] = a3 + bgn; }
#pragma unroll
                for (int q = 0; q < 4; ++q) {
                    const int row = r0 + q;
                    int gsel = 0; float gmx = LG[q][0];
#pragma unroll
                    for (int i = 1; i < 4; ++i) if (LG[q][i] > gmx) { gmx = LG[q][i]; gsel = i; }
                    gsel = __builtin_amdgcn_readfirstlane(gsel);
                    float gsum = 0.f;
#pragma unroll
                    for (int i = 0; i < 4; ++i) gsum += __expf(LG[q][i] - gmx);
                    const float pg = 1.0f / gsum;
                    float le[8];
                    const LAS float* rte = rt + (4 + 8 * gsel) * RT_LD + 4 * lane;
#pragma unroll
                    for (int j8 = 0; j8 < 8; ++j8) { f32x2 c = {0.f, 0.f};
#pragma unroll
                        for (int j = 0; j < 4; ++j) { const f32x4 wv = *(const LAS f32x4*)(rte + j8 * RT_LD + 256 * j);
                            c = (f32x2){wv[0], wv[1]} * (f32x2){v[q][j][0], v[q][j][1]} + c; c = (f32x2){wv[2], wv[3]} * (f32x2){v[q][j][2], v[q][j][3]} + c; }
                        le[j8] = c[0] + c[1]; }
                    wave_sum4_u(le[0], le[1], le[2], le[3]); wave_sum4_u(le[4], le[5], le[6], le[7]);
#pragma unroll
                    for (int j8 = 0; j8 < 8; ++j8) le[j8] += rte[j8 * RT_LD + D - 4 * lane];
                    int e0 = 0; float m0 = le[0];
#pragma unroll
                    for (int j = 1; j < 8; ++j) if (le[j] > m0) { m0 = le[j]; e0 = j; }
                    int e1 = (e0 == 0) ? 1 : 0; float m1 = -3.0e38f;
#pragma unroll
                    for (int j = 0; j < 8; ++j) if (j != e0 && le[j] > m1) { m1 = le[j]; e1 = j; }
                    const float a1 = __expf(m1 - m0), inv = 1.0f / (1.0f + a1);
                    const float w0 = pg * inv, w1 = pg * a1 * inv;
                    const int E0 = gsel * 8 + e0, E1 = gsel * 8 + e1;
                    if (row < M) {
                        unsigned p0 = 0, p1 = 0;
                        if (lane == 0) { p0 = __hip_atomic_fetch_add(lcnt + E0, 1u, __ATOMIC_RELAXED, __HIP_MEMORY_SCOPE_WORKGROUP); p1 = __hip_atomic_fetch_add(lcnt + E1, 1u, __ATOMIC_RELAXED, __HIP_MEMORY_SCOPE_WORKGROUP); }
                        p0 = __builtin_amdgcn_readfirstlane(p0); p1 = __builtin_amdgcn_readfirstlane(p1);
                        if (lane == nrow) { myE0 = E0; myE1 = E1; myP0 = (int)p0; myP1 = (int)p1; myW0 = w0; myW1 = w1; myRow = row; }
                        ++nrow;
                    }
                }
#pragma unroll
                for (int q = 0; q < 4; ++q)
#pragma unroll
                    for (int j = 0; j < 4; ++j) v[q][j] = vn[q][j];
            }
#undef T2_LOAD
            __syncthreads();
            if (tid < NEXP) { const unsigned c = lcnt[tid]; lbase[tid] = c ? __hip_atomic_fetch_add(cnt + tid * 64, c, __ATOMIC_RELAXED, __HIP_MEMORY_SCOPE_AGENT) : 0u; }
            __syncthreads();
            if (myRow >= 0) { const int q0 = myP0 + (int)lbase[myE0], q1 = myP1 + (int)lbase[myE1]; etok[myE0 * 16384 + q0] = myRow; etok[myE1 * 16384 + q1] = myRow;
                              tok_e[2 * myRow] = myE0; tok_e[2 * myRow + 1] = myE1; tok_pos[2 * myRow] = q0; tok_pos[2 * myRow + 1] = q1;
                              tok_w[2 * myRow] = myW0; tok_w[2 * myRow + 1] = myW1; }
            __syncthreads();
        }
        SEAM(pb + 5);
        if (IN(pb + 8) && EN(8)) {
            WSP();
            const unsigned* cnt = ctl + CW_CNT + l * NEXP * 64; unsigned* tcl = ctl + CW_TILE + l * MAXTILES * 16;
            int n1, n3, n4, R;
            int a_pm, a_pn, a_e, a_ts, a_cn, b_pm, b_pn, b_e, b_ts, b_cn, c_pm, c_pn, c_e, c_ts, c_cn;
            int d_pm, d_pn, d_e, d_ts, d_cn, e_pm, e_pn, e_e, e_ts, e_cn, f_pm, f_pn, f_e, f_ts, f_cn, g_pm, g_pn, g_e, g_ts, g_cn;
            {
                const int cv = (lane < NEXP) ? (int)__hip_atomic_load(cnt + lane * 64, __ATOMIC_RELAXED, __HIP_MEMORY_SCOPE_AGENT) : 0;
                const int tl = (cv + 255) >> 8; int tend = 0, ntile = 0;
#pragma unroll
                for (int e = 0; e < NEXP; ++e) { ntile += __builtin_amdgcn_readlane(tl, e); if (lane == e) tend = ntile; }
                const int U = 4 * ntile, nA = min(U, 2 * G), Nf = G - min(U - nA, G), nB = min(nA, 2 * Nf); R = min(U - nA, G);
                auto moe_unit = [&](int v, int& pm, int& pn, int& e, int& ts, int& cn) { const int t = min(v >> 2, ntile - 1); pm = t; pn = v & 3;
                    e = min((int)__builtin_popcountll(__ballot(lane < NEXP && tend <= t)), NEXP - 1); ts = __builtin_amdgcn_readlane(tend - tl, e); cn = max(__builtin_amdgcn_readlane(cv, e), 1); };
                moe_unit(vcu, a_pm, a_pn, a_e, a_ts, a_cn); moe_unit(G + vcu, b_pm, b_pn, b_e, b_ts, b_cn); moe_unit(nA + vcu, c_pm, c_pn, c_e, c_ts, c_cn);
                n1 = (vcu < nA ? 1 : 0) + (G + vcu < nA ? 1 : 0);
                const int v3 = vcu - R, v4 = nB + vcu;
                moe_unit(v3, d_pm, d_pn, d_e, d_ts, d_cn); moe_unit(v3 + Nf, e_pm, e_pn, e_e, e_ts, e_cn); n3 = (vcu >= R) ? (v3 < nB ? 1 : 0) + (v3 + Nf < nB ? 1 : 0) : 0;
                moe_unit(v4, f_pm, f_pn, f_e, f_ts, f_cn); moe_unit(v4 + G, g_pm, g_pn, g_e, g_ts, g_cn); n4 = (v4 < U ? 1 : 0) + (v4 + G < U ? 1 : 0);
            }
#define MOE_M1(n_, p0, p1) do { const pg8::MoeOrder S{(n_), p0##pm, p1##pm, p0##pn, p1##pn, p0##e, p1##e, (size_t)1024 * D * 2, p0##ts, p1##ts, p0##cn, p1##cn, etok, tcl}; \
            pg8::Gemm g{Hn, W13 + (size_t)l * NEXP * 1024 * D, D, D, D};            \
            EpiSwiglu E{HB}; pg8::gemm_phase<EpiSwiglu, pg8::MoeOrder, true, true, true>(lds, g, S, E); } while (0)
#define MOE_M2(n_, p0, p1) do { \
            if (wave == 0) { const int tb_ = (n_) > 1 ? p1##pm : p0##pm; unsigned sp_ = 0; \
                while ((unsigned)__builtin_amdgcn_readfirstlane((int)__hip_atomic_load(tcl + p0##pm * 16, __ATOMIC_RELAXED, __HIP_MEMORY_SCOPE_AGENT)) < 32u && ++sp_ < XB_SPIN_CAP) __builtin_amdgcn_s_sleep(2); \
                while ((unsigned)__builtin_amdgcn_readfirstlane((int)__hip_atomic_load(tcl + tb_ * 16, __ATOMIC_RELAXED, __HIP_MEMORY_SCOPE_AGENT)) < 32u && ++sp_ < XB_SPIN_CAP) __builtin_amdgcn_s_sleep(2); \
                __builtin_amdgcn_fence(__ATOMIC_ACQUIRE, "agent"); asm volatile("s_waitcnt vmcnt(0)" ::: "memory"); }        \
            __syncthreads(); \
            const pg8::MoeOrder S{(n_), p0##pm, p1##pm, p0##pn, p1##pn, p0##e, p1##e, (size_t)D * EH * 2, p0##ts, p1##ts, p0##cn, p1##cn, etok, nullptr}; \
            pg8::Gemm g{HB, W2 + (size_t)l * NEXP * D * EH, EH, EH, EH}; \
            EpiY E{YB}; pg8::gemm_phase<EpiY, pg8::MoeOrder>(lds, g, S, E); } while (0)
            if (n1) MOE_M1(n1, a_, b_);
            if (vcu < R) MOE_M1(1, c_, c_);
            if (n3) MOE_M2(n3, d_, e_);
            if (n4) MOE_M2(n4, f_, g_);
#undef MOE_M1
#undef MOE_M2
        }
        SEAM(pb + 8);
    }
    if (IN(NPHASE - 1) && EN(9)) {
        WSP();
        const float* modprev = modp + (size_t)(DEPTH - 1) * NBATCH * 6 * D;
        constexpr int RPW = M / (256 * NWAVES); const int rbase = gw * RPW, b = rbase / SEQ;
        int slot_v = 0; float w_v = 0.f;
        { const unsigned* cntp = ctl + CW_CNT + (DEPTH - 1) * NEXP * 64;
          const int cv = (lane < NEXP) ? (int)__hip_atomic_load(cntp + lane * 64, __ATOMIC_RELAXED, __HIP_MEMORY_SCOPE_AGENT) : 0;
          const int tl = (cv + 255) >> 8; int tstart = 0, run = 0;
#pragma unroll
          for (int e = 0; e < NEXP; ++e) { if (lane == e) tstart = run; run += __builtin_amdgcn_readlane(tl, e); }
          const int i = min(lane, 2 * RPW - 1);
          const int e = tok_e[2 * rbase + i], pos = tok_pos[2 * rbase + i]; w_v = tok_w[2 * rbase + i];
          slot_v = __builtin_amdgcn_ds_bpermute(4 * e, tstart) * 256 + pos; }
        f32x4 gf[4], fg[4];
#pragma unroll
        for (int j = 0; j < 4; ++j) { const int col = 4 * lane + 256 * j; gf[j] = *(const f32x4*)(modprev + (size_t)b * 6 * D + 5 * D + col); fg[j] = *(const f32x4*)(args.fin_g + col); }
#pragma unroll 1
        for (int r0 = rbase; r0 < rbase + RPW; r0 += 4) {
            u32x2 xr[4][4], y0[4][4], y1[4][4]; float w0[4], w1[4];
#pragma unroll
            for (int q = 0; q < 4; ++q) { const int ix = 2 * (r0 - rbase + q);
                const int s0 = __builtin_amdgcn_readlane(slot_v, ix), s1 = __builtin_amdgcn_readlane(slot_v, ix + 1);
                w0[q] = __builtin_bit_cast(float, __builtin_amdgcn_readlane(__builtin_bit_cast(int, w_v), ix)); w1[q] = __builtin_bit_cast(float, __builtin_amdgcn_readlane(__builtin_bit_cast(int, w_v), ix + 1));
#pragma unroll
                for (int j = 0; j < 4; ++j) { const int col = 4 * lane + 256 * j;
                    xr[q][j] = *(const u32x2*)(X + (size_t)(r0 + q) * D + col); y0[q][j] = *(const u32x2*)(YB + (size_t)s0 * D + col); y1[q][j] = *(const u32x2*)(YB + (size_t)s1 * D + col); } }
#pragma unroll
            for (int q = 0; q < 4; ++q) { const int row = r0 + q;
                f32x4 v[4]; float ss = 0.f;
#pragma unroll
                for (int j = 0; j < 4; ++j) { const f32x4 yy = bf4(y0[q][j]) * w0[q] + bf4(y1[q][j]) * w1[q]; v[j] = bf4(xr[q][j]) + gf[j] * yy;
                    ss += (v[j][0] * v[j][0] + v[j][1] * v[j][1]) + (v[j][2] * v[j][2] + v[j][3] * v[j][3]); }
                const float rstd = 1.0f / sqrtf(wave_sum(ss) * (1.f / D) + NORM_EPS);
#pragma unroll
                for (int j = 0; j < 4; ++j) *(f32x4*)(args.out + (size_t)row * D + 4 * lane + 256 * j) = v[j] * rstd * fg[j];
            }
        }
    }
#undef IN
#undef SEAM
#undef GRID_BAR
}


#ifndef DBG
#define DBG 0
#endif
#if DBG
constexpr size_t WS_REP = WS_END;
__global__ void dbg_scan(const unsigned* buf, size_t nwords, int is_bf16, unsigned long long* rep) {
    unsigned long long nf = 0, ck = 0;
    for (size_t i = (size_t)blockIdx.x * blockDim.x + threadIdx.x; i < nwords; i += (size_t)gridDim.x * blockDim.x) {
        const unsigned w = buf[i]; ck += (unsigned long long)w * (unsigned long long)((i & 1023) + 1);
        if (is_bf16) { if ((w & 0x7f80u) >= (140u << 7)) ++nf; if ((w & 0x7f800000u) >= (140u << 23)) ++nf; }
        else if ((w & 0x7f800000u) >= (140u << 23)) ++nf;
    }
    for (int o = 32; o >= 1; o >>= 1) { nf += __shfl_xor(nf, o); ck += __shfl_xor(ck, o); }
    if ((threadIdx.x & 63) == 0) { if (nf) atomicAdd(rep, nf); atomicAdd(rep + 1, ck); }
}

__global__ void dbg_scan_cols(const unsigned short* buf, int c0, int c1, unsigned long long* rep) {
    unsigned long long nf = 0;
    const int w = c1 - c0;
    for (size_t i = (size_t)blockIdx.x * blockDim.x + threadIdx.x; i < (size_t)M * w; i += (size_t)gridDim.x * blockDim.x) {
        const size_t r = i / w; const int c = c0 + (int)(i % w); const unsigned v = buf[r * D + c];
        if ((v & 0x7f80u) >= (140u << 7)) ++nf; }
    for (int o = 32; o >= 1; o >>= 1) nf += __shfl_xor(nf, o);
    if ((threadIdx.x & 63) == 0 && nf) atomicAdd(rep, nf);
}
__global__ void dbg_encode(const unsigned long long* rep, float* out, size_t n, int nph) {
    int code = 80;
    for (int p = nph - 1; p >= 0; --p) if (rep[(64 + p) * 2 + 1] != rep[p * 2 + 1]) code = 40 + p;
    for (int p = nph - 1; p >= 0; --p) if (rep[p * 2] != 0ull || rep[(64 + p) * 2] != 0ull) code = 1 + p;
    if (code == 80) return;
    const float A = sqrtf((float)code * 0.1f);
    for (size_t i = (size_t)blockIdx.x * blockDim.x + threadIdx.x; i < n; i += (size_t)gridDim.x * blockDim.x) {
        unsigned h = (unsigned)i * 2654435761u; h ^= h >> 15; h *= 2246822519u; h ^= h >> 13;
        out[i] = (h & 1u) ? A : -A; }
}
#endif

extern "C" void kernel_launch(void* const* d_in, const int* in_sizes, int n_in, void* d_out, int out_size, void* d_ws, size_t ws_size, hipStream_t stream) {
    static int grid = 0;
    if (grid == 0) {
        if (n_in != 22 || in_sizes[0] != M * D || out_size != M * D || ws_size < WS_END + (1u << 20)) {
            fprintf(stderr, "kernel_launch: unexpected shapes (n_in %d, in0 %d, out %d, ws %zu, need %zu)\n", n_in, n_in > 0 ? in_sizes[0] : -1, out_size, ws_size, (size_t)WS_END); grid = -1; return; }
        int dev = 0, cus = 0, per_cu = 0;
        if (hipGetDevice(&dev) != hipSuccess || hipDeviceGetAttribute(&cus, hipDeviceAttributeMultiprocessorCount, dev) != hipSuccess) { grid = -1; return; }
        if (hipFuncSetAttribute((const void*)fwd_kernel, hipFuncAttributeMaxDynamicSharedMemorySize, LDS_BYTES) != hipSuccess) { fprintf(stderr, "kernel_launch: hipFuncSetAttribute failed\n"); grid = -1; return; }
        if (hipOccupancyMaxActiveBlocksPerMultiprocessor(&per_cu, (const void*)fwd_kernel, NWAVES * 64, LDS_BYTES) != hipSuccess || per_cu < 1)
            fprintf(stderr, "kernel_launch: occupancy query reports %d\n", per_cu);
        (void)hipGetLastError();
        if (cus != 256) { fprintf(stderr, "kernel_launch: built for 256 CUs (MoE unit deal, T2 row blocks), found %d\n", cus); grid = -1; return; }
        grid = cus;
    }
    if (grid < 0) return;
    if (hipMemsetAsync((char*)d_ws + WS_CTL, 0, CTL_ZERO_BYTES, stream) != hipSuccess) { fprintf(stderr, "kernel_launch: memset failed\n"); return; }
    Args a{};
    a.x = (const float*)d_in[0]; a.c = (const float*)d_in[1]; a.ada_w = (const float*)d_in[2]; a.ada_b = (const float*)d_in[3]; a.mix_g = (const float*)d_in[4]; a.ffn_g = (const float*)d_in[5];
    a.w_in = (const float*)d_in[6]; a.da_lambda = (const float*)d_in[7]; a.da_subln = (const float*)d_in[8]; a.na_rpb = (const float*)d_in[9];
    a.wpa = (const float*)d_in[10]; a.wpn = (const float*)d_in[11]; a.wpd = (const float*)d_in[12]; a.w_out = (const float*)d_in[13];
    a.rgw = (const float*)d_in[14]; a.rgb = (const float*)d_in[15]; a.rew = (const float*)d_in[16]; a.reb = (const float*)d_in[17];
    a.ew1 = (const float*)d_in[18]; a.ew3 = (const float*)d_in[19]; a.ew2 = (const float*)d_in[20]; a.fin_g = (const float*)d_in[21];
    a.out = (float*)d_out; a.ws = (unsigned char*)d_ws;
#if DBG
    {
        unsigned char* ws = (unsigned char*)d_ws;
        unsigned long long* rep = (unsigned long long*)(ws + WS_REP);
        (void)hipMemsetAsync(rep, 0, 2 * 64 * 2 * 8, stream);
        for (int run = 0; run < 2; ++run) {
            (void)hipMemsetAsync((char*)d_ws + WS_CTL, 0, CTL_ZERO_BYTES, stream);
            for (int p = 0; p < NPHASE; ++p) {
                a.ph_lo = p; a.ph_hi = p + 1;
                hipLaunchKernelGGL(fwd_kernel, dim3(grid), dim3(NWAVES * 64), LDS_BYTES, stream, a);
                unsigned long long* r = rep + (size_t)(run * 64 + p) * 2;
#define SCAN(off, bytes, isbf) hipLaunchKernelGGL(dbg_scan, dim3(1024), dim3(256), 0, stream, (const unsigned*)(ws + (off)), (size_t)(bytes) / 4, (isbf), r)
                const int ph = (p == 0) ? -1 : (p == NPHASE - 1) ? 9 : (p - 1) % 9;
                if (ph == -1) { SCAN(WS_MOD, (size_t)DEPTH * NBATCH * 6 * D * 4, 0); SCAN(WS_ROPE, (size_t)SEQ * 64 * 4, 0); SCAN(WS_WIN, WS_END - WS_WIN, 1); }
                else if (ph == 0) { SCAN(WS_X, (size_t)M * D * 4, 0); SCAN(WS_H, (size_t)M * D * 2, 1); }
                else if (ph == 1) { SCAN(WS_Z, (size_t)M * ZW * 2, 1); }
                else if (ph == 2) { SCAN(WS_OCAT, (size_t)M * D * 2, 1); }
                else if (ph == 3) { SCAN(WS_MERGED, (size_t)M * D * 2, 1); }
                else if (ph == 4) { SCAN(WS_X, (size_t)M * D * 4, 0); }
                else if (ph == 5) { SCAN(WS_H, (size_t)M * D * 2, 1); SCAN(WS_ROUTE, (size_t)2 * M * 4, 0); SCAN(WS_ROUTE + (size_t)4 * M * 4, (size_t)2 * M * 4, 0); }
                else if (ph == 9) { hipLaunchKernelGGL(dbg_scan, dim3(1024), dim3(256), 0, stream, (const unsigned*)d_out, (size_t)M * D, 0, r); }
#undef SCAN
            }
        }
        hipLaunchKernelGGL(dbg_encode, dim3(1024), dim3(256), 0, stream, (const unsigned long long*)rep, (float*)d_out, (size_t)M * D, NPHASE);
    }
#elif MK_PER_PHASE
    for (int p = 0; p < NPHASE; ++p) {
        a.ph_lo = p; a.ph_hi = p + 1;
        hipLaunchKernelGGL(fwd_kernel, dim3(grid), dim3(NWAVES * 64), LDS_BYTES, stream, a);
    }
#else
    a.ph_lo = 0; a.ph_hi = NPHASE;
    hipLaunchKernelGGL(fwd_kernel, dim3(grid), dim3(NWAVES * 64), LDS_BYTES, stream, a);
#endif
    const hipError_t le = hipPeekAtLastError();
    if (le != hipSuccess) fprintf(stderr, "kernel_launch: launch failed: %s\n", hipGetErrorName(le));
}
```

```cpp
#include <hip/hip_runtime.h>
#include <cstdio>
#include <cstdint>

#ifndef MK_PER_PHASE
#define MK_PER_PHASE 0
#endif

#define LAS __attribute__((address_space(3)))
#define GAS __attribute__((address_space(1)))
typedef unsigned short bf16_t;
typedef short bf16x8 __attribute__((ext_vector_type(8)));
typedef short s16x4 __attribute__((ext_vector_type(4)));
typedef float f32x4 __attribute__((ext_vector_type(4)));
typedef float f32x2 __attribute__((ext_vector_type(2)));
typedef float f32x16 __attribute__((ext_vector_type(16)));
typedef unsigned u32x4 __attribute__((ext_vector_type(4)));
typedef unsigned u32x2 __attribute__((ext_vector_type(2)));

constexpr int D = 1024, NBATCH = 4, SEQ = 4096, M = NBATCH * SEQ, DEPTH = 4, ZW = 7680;
constexpr int ZQA = 0, ZKA = 512, ZVA = 1024, ZQN = 1536, ZKN = 1792, ZVN = 2048, ZQD = 2304, ZKD = 3072, ZVD = 3840, ZG = 4608;
constexpr int NEXP = 32, EH = 512;
constexpr int MAXTILES = 160, XROWS = MAXTILES * 256;
constexpr float C2 = 0.125f * 1.4426950408889634f;
constexpr float LOG2E = 1.4426950408889634f;
constexpr float NORM_EPS = 1e-6f;
constexpr float NEGBIG = -1e30f;
constexpr float RESCALE_THR = 8.0f;

constexpr size_t MiB = 1u << 20;
constexpr size_t WS_CTL = 0, CTL_ZERO_BYTES = 1 * MiB;
constexpr size_t WS_RT = 1 * MiB;
constexpr size_t WS_MOD = 2 * MiB;
constexpr size_t WS_ROPE = 3 * MiB;
constexpr size_t WS_ROUTE = 4 * MiB;
constexpr size_t WS_X = 8 * MiB;
constexpr size_t WS_H = 72 * MiB;
constexpr size_t WS_OCAT = 104 * MiB;
constexpr size_t WS_MERGED = 136 * MiB;
constexpr size_t WS_Z = 168 * MiB;
constexpr size_t WS_XG = WS_Z;
constexpr size_t WS_HB = WS_Z + 80 * MiB;
constexpr size_t WS_YB = WS_Z + 120 * MiB;
constexpr size_t WS_WIN = 408 * MiB;
constexpr size_t WS_WPROJ = 468 * MiB;
constexpr size_t WS_WOUT = 476 * MiB;
constexpr size_t WS_W13 = 484 * MiB;
constexpr size_t WS_W2 = 740 * MiB;
constexpr size_t WS_END = 868 * MiB;
constexpr int CW_BAR = 4096;
constexpr int CW_CNT = 16384;
constexpr int CW_TILE = 32768;

constexpr int RING_BYTES = 131072;
constexpr int RT_LD = 1028;
constexpr int RT_BYTES = 36 * RT_LD * 4;
constexpr int MISC_OFF = RT_BYTES;
constexpr int LDS_BYTES = MISC_OFF + 512;

__device__ __forceinline__ unsigned f2bf(float f) { unsigned u = __builtin_bit_cast(unsigned, f); return (u + 0x7fffu + ((u >> 16) & 1u)) >> 16; }
__device__ __forceinline__ unsigned pk2(float lo, float hi) { return f2bf(lo) | (f2bf(hi) << 16); }
__device__ __forceinline__ unsigned cvt_pk_bf16(float lo, float hi) { unsigned r; asm("v_cvt_pk_bf16_f32 %0, %1, %2" : "=v"(r) : "v"(lo), "v"(hi)); return r; }
typedef __bf16 bf16x2_t __attribute__((ext_vector_type(2)));
__device__ __forceinline__ unsigned cvtpk_s(float lo, float hi) { f32x2 v = {lo, hi}; bf16x2_t b = __builtin_convertvector(v, bf16x2_t); return __builtin_bit_cast(unsigned, b); }
__device__ __forceinline__ float bflo(unsigned u) { return __builtin_bit_cast(float, u << 16); }
__device__ __forceinline__ float bfhi(unsigned u) { return __builtin_bit_cast(float, u & 0xffff0000u); }
__device__ __forceinline__ f32x4 bf4(u32x2 r) { return (f32x4){bflo(r.x), bfhi(r.x), bflo(r.y), bfhi(r.y)}; }
__device__ __forceinline__ float fexp2(float x) { return __builtin_amdgcn_exp2f(x); }
__device__ __forceinline__ float frcp(float x) { return __builtin_amdgcn_rcpf(x); }
__device__ __forceinline__ void swap32(float& a, float& b) { asm volatile("s_nop 1\n\tv_permlane32_swap_b32 %0, %1\n\ts_nop 1" : "+v"(a), "+v"(b)); }
template <int X> __device__ __forceinline__ float xor_lane(float v) { return __builtin_bit_cast(float, __builtin_amdgcn_ds_swizzle(__builtin_bit_cast(int, v), (X << 10) | 0x1f)); }
__device__ __forceinline__ float half_sum(float v) { v += xor_lane<1>(v); v += xor_lane<2>(v); v += xor_lane<4>(v); v += xor_lane<8>(v); v += xor_lane<16>(v); return v; }
__device__ __forceinline__ float wave_sum(float v) {
    v = half_sum(v);
    float a = v, b = v; swap32(a, b);
    return a + b;
}
template <int CTRL> __device__ __forceinline__ float dpp_f(float v) { return __builtin_bit_cast(float, __builtin_amdgcn_update_dpp(0, __builtin_bit_cast(int, v), CTRL, 0xf, 0xf, false)); }
__device__ __forceinline__ float wave_sum_u(float v) {
    v += dpp_f<0xB1>(v); v += dpp_f<0x4E>(v); v += dpp_f<0x141>(v); v += dpp_f<0x140>(v);
    v += __builtin_bit_cast(float, __builtin_amdgcn_update_dpp(0, __builtin_bit_cast(int, v), 0x142, 0xa, 0xf, false));
    v += __builtin_bit_cast(float, __builtin_amdgcn_update_dpp(0, __builtin_bit_cast(int, v), 0x143, 0xc, 0xf, false));
    float r = __builtin_bit_cast(float, __builtin_amdgcn_readlane(__builtin_bit_cast(int, v), 63));
    asm volatile("" : "+v"(r));
    return r;
}
__device__ __forceinline__ void wave_sum4_u(float& a, float& b, float& c, float& d) {
    unsigned s0, s1, s2, s3;
#define WS4_STEP(ctl) "v_add_f32_dpp %0, %0, %0 " ctl "\n\tv_add_f32_dpp %1, %1, %1 " ctl "\n\tv_add_f32_dpp %2, %2, %2 " ctl "\n\tv_add_f32_dpp %3, %3, %3 " ctl "\n\t"
    asm volatile("s_nop 1\n\t"
        WS4_STEP("quad_perm:[1,0,3,2] row_mask:0xf bank_mask:0xf") WS4_STEP("quad_perm:[2,3,0,1] row_mask:0xf bank_mask:0xf") WS4_STEP("row_half_mirror row_mask:0xf bank_mask:0xf")
        WS4_STEP("row_mirror row_mask:0xf bank_mask:0xf") WS4_STEP("row_bcast:15 row_mask:0xa bank_mask:0xf") WS4_STEP("row_bcast:31 row_mask:0xc bank_mask:0xf")
        "v_readlane_b32 %4, %0, 63\n\tv_readlane_b32 %5, %1, 63\n\tv_readlane_b32 %6, %2, 63\n\tv_readlane_b32 %7, %3, 63\n\t"
        "v_mov_b32 %0, %4\n\tv_mov_b32 %1, %5\n\tv_mov_b32 %2, %6\n\tv_mov_b32 %3, %7"
        : "+v"(a), "+v"(b), "+v"(c), "+v"(d), "=&s"(s0), "=&s"(s1), "=&s"(s2), "=&s"(s3));
#undef WS4_STEP
}
__device__ __forceinline__ void st16_wt(void* p, u32x4 v) { asm volatile("global_store_dwordx4 %0, %1, off sc1\n\ts_nop 1" :: "v"(p), "v"(v) : "memory"); }
#define LDS_WAIT() asm volatile("s_waitcnt lgkmcnt(0)" ::: "memory")
#define VM_WAIT() asm volatile("s_waitcnt vmcnt(0)" ::: "memory")
#define CBAR() asm volatile("" ::: "memory")

namespace pg8 {
constexpr int BM = 256, BK = 64, HALF = 128, HTB = HALF * BK * 2, STAGE_BYTES = 8 * HTB, NXCD = 8, WGM = 8;
__host__ __device__ __forceinline__ int lds_byte(int r, int c) { const int st = (r >> 4) * 2 + (c >> 5), rr = r & 15, cc = c & 31, ob = rr * 64 + cc * 2; return st * 1024 + (ob ^ (((ob >> 9) & 1) << 5)); }
__host__ __device__ __forceinline__ void stage_rc(int b, int& R, int& C) { const int st = b / 1024, sb = b % 1024, swz = sb ^ (((sb >> 9) & 1) << 5); R = (st >> 1) * 16 + swz / 64; C = (st & 1) * 32 + (swz % 64) / 2; }
__host__ __device__ __forceinline__ int perm32(int rho) { const int n = rho >> 4, i = rho & 15; return 8 * (i >> 2) + 4 * n + (i & 3); }

struct Unit { int pm, pn, e, x0, x1; };
struct Gemm { const bf16_t* A; const bf16_t* Bt; int lda, ldb, K; };

struct StaticOrder {
    int nM, nN, nwg, G, c;
    __device__ void init(int M_, int N_, int G_, int c_) { nM = M_ / BM; nN = N_ / BM; nwg = nM * nN; G = G_; c = c_; }
    __device__ bool next(int i, Unit& u) const {
        const long L = (long)i * G + c; if (L >= nwg) return false;
        int wgid = (int)L; { const int q = nwg / NXCD, r = nwg % NXCD, xcd = wgid % NXCD, off = wgid / NXCD; wgid = (xcd < r ? xcd * (q + 1) : r * (q + 1) + (xcd - r) * q) + off; }
        const int nig = WGM * nN, gid = wgid / nig, fm = gid * WGM, gsz = (nM - fm) < WGM ? (nM - fm) : WGM;
        u.pm = fm + ((wgid % nig) % gsz); u.pn = (wgid % nig) / gsz; u.e = 0; u.x0 = 0; u.x1 = 0; return true;
    }
    __device__ __forceinline__ size_t aoff(const Gemm& g, const Unit& u) const { return (size_t)u.pm * BM * g.lda * 2; }
    __device__ __forceinline__ size_t boff(const Gemm& g, const Unit& u) const { return (size_t)u.pn * BM * g.ldb * 2; }
    __device__ __forceinline__ int ktiles(const Gemm& g, const Unit&) const { return g.K / BK; }
    __device__ __forceinline__ void done(const Unit&, int) const {}
};
struct MoeOrder {
    int n; int pm0, pm1, pn0, pn1, e0, e1; size_t estride;
    int ts0, ts1, cn0, cn1; const int* etok;
    unsigned* tcnt;
    __device__ __forceinline__ void done(const Unit& u, int lane) const {
        if (tcnt) { asm volatile("s_waitcnt vmcnt(0)" ::: "memory"); if (lane == 0) __hip_atomic_fetch_add(tcnt + u.pm * 16, 1u, __ATOMIC_RELAXED, __HIP_MEMORY_SCOPE_AGENT); }
    }
    __device__ bool next(int i, Unit& u) const {
        if (i >= n) return false;
        u.pm = i == 0 ? pm0 : pm1; u.pn = i == 0 ? pn0 : pn1; u.e = i == 0 ? e0 : e1;
        u.x0 = i == 0 ? ts0 : ts1; u.x1 = i == 0 ? cn0 : cn1; return true;
    }
    __device__ __forceinline__ size_t aoff(const Gemm& g, const Unit& u) const { return (size_t)u.pm * BM * g.lda * 2; }
    __device__ __forceinline__ size_t boff(const Gemm& g, const Unit& u) const { return (size_t)u.e * estride + (size_t)u.pn * BM * g.ldb * 2; }
    __device__ __forceinline__ int ktiles(const Gemm& g, const Unit&) const { return g.K / BK; }
    __device__ __forceinline__ int gather_row(const Unit& u, int r) const {
        const int pos = min((u.pm - u.x0) * BM + r, u.x1 - 1);
        return etok[u.e * 16384 + pos];
    }
};
struct ProjOrder {
    int pm, pn, rot;
    __device__ bool next(int i, Unit& u) const { if (i >= 3) return false; int seg = i + rot; seg = seg >= 3 ? seg - 3 : seg; u.pm = pm; u.pn = pn; u.e = seg | ((i == 0) ? 16 : 0); u.x0 = 0; u.x1 = 0; return true; }
    __device__ __forceinline__ int kofs(const Unit& u) const { const int seg = u.e & 15; return seg == 0 ? 0 : (seg == 1 ? 512 : 768); }
    __device__ __forceinline__ size_t aoff(const Gemm& g, const Unit& u) const { return (size_t)u.pm * BM * g.lda * 2 + (size_t)kofs(u) * 2; }
    __device__ __forceinline__ size_t boff(const Gemm& g, const Unit& u) const { return (size_t)u.pn * BM * g.ldb * 2 + (size_t)kofs(u) * 2; }
    __device__ __forceinline__ int ktiles(const Gemm&, const Unit& u) const { return (u.e & 15) == 0 ? 8 : 4; }
    __device__ __forceinline__ void done(const Unit&, int) const {}
};

template <class Epi, class Sched, bool ALIGN_EPI = true, bool SP2 = true, bool GATHER = false>
__device__ __forceinline__ void gemm_phase(LAS unsigned char* lds, const Gemm g, const Sched& S, const Epi& E) {
    int tid_ = threadIdx.x; asm volatile("" : "+v"(tid_));
    const int tid = tid_, wid = __builtin_amdgcn_readfirstlane(tid >> 6), lane = tid & 63, wr = wid >> 2, wc = wid & 3, fr = lane & 15, fq = lane >> 4;
    int nt = S.ktiles(g, Unit{0, 0, 0, 0, 0});
    unsigned voffA[2], voffB[2];
#pragma unroll
    for (int i = 0; i < 2; ++i) { int R, C; stage_rc(tid * 16 + i * 8192, R, C); const int Rb = Epi::PERM ? ((R & ~31) + perm32(R & 31)) : R;
        voffA[i] = (unsigned)(R * g.lda + C) * 2u; voffB[i] = (unsigned)(Rb * g.ldb + C) * 2u; }
    const size_t kstep = (size_t)(BK * 2);
    const size_t hstepA = (size_t)HALF * g.lda * 2, hstepB = (size_t)HALF * g.ldb * 2;
    const unsigned ldsw = (unsigned)wid * 1024u;
    const int aoff = lds_byte(wr * 64 + fr, fq * 8), boff = lds_byte(wc * 32 + fr, fq * 8);
#define PG8_SA(b, h) (((b) * 2 + (h)) * HTB)
#define PG8_SB(b, h) ((4 + (b) * 2 + (h)) * HTB)
#define PG8_STAGE(bufoff, gbase, voff) do { _Pragma("unroll") for (int _i = 0; _i < 2; ++_i) \
        __builtin_amdgcn_global_load_lds((const unsigned*)((const char*)(gbase) + (voff)[_i]), (LAS unsigned*)(lds + (bufoff) + ldsw + _i * 8192), 16, 0, 0); } while (0)
    unsigned vo0[2] = {0u, 0u}, vo1[2] = {0u, 0u}, nvo0[2] = {0u, 0u}, nvo1[2] = {0u, 0u};
#define PG8_GOFF(u_, d0_, d1_) do { _Pragma("unroll") for (int _i = 0; _i < 2; ++_i) { int R_, C_; stage_rc(tid * 16 + _i * 8192, R_, C_); \
        d0_[_i] = (unsigned)(S.gather_row(u_, R_) * g.lda + C_) * 2u; d1_[_i] = (unsigned)(S.gather_row(u_, HALF + R_) * g.lda + C_) * 2u; } } while (0)
#define PG8_STAGEA(bufoff, ptr, h, nx) do { if constexpr (GATHER) { unsigned o_[2]; o_[0] = (nx) ? ((h) ? nvo1[0] : nvo0[0]) : ((h) ? vo1[0] : vo0[0]); o_[1] = (nx) ? ((h) ? nvo1[1] : nvo0[1]) : ((h) ? vo1[1] : vo0[1]); \
        PG8_STAGE(bufoff, ptr, o_); } else { PG8_STAGE(bufoff, (ptr) + ((h) ? hstepA : 0), voffA); } } while (0)
#define PG8_LDA(dst, b, h) do { _Pragma("unroll") for (int m = 0; m < 4; ++m) _Pragma("unroll") for (int k = 0; k < 2; ++k) dst[m][k] = *(const LAS bf16x8*)(lds + PG8_SA(b, h) + aoff + m * 2048 + k * 1024); } while (0)
#define PG8_LDB(dst, b, h) do { _Pragma("unroll") for (int n = 0; n < 2; ++n) _Pragma("unroll") for (int k = 0; k < 2; ++k) dst[n][k] = *(const LAS bf16x8*)(lds + PG8_SB(b, h) + boff + n * 2048 + k * 1024); } while (0)
#define PG8_MMA(ai, bj, At, Bt) do { __builtin_amdgcn_s_setprio(1); _Pragma("unroll") for (int m = 0; m < 4; ++m) _Pragma("unroll") for (int n = 0; n < 2; ++n) _Pragma("unroll") for (int k = 0; k < 2; ++k) \
        acc[ai][bj][m][n] = __builtin_amdgcn_mfma_f32_16x16x32_bf16(Bt[n][k], At[m][k], acc[ai][bj][m][n], 0, 0, 0); __builtin_amdgcn_s_setprio(0); } while (0)
#define PG8_WAIT_V(n) asm volatile("s_waitcnt vmcnt(" #n ")" ::: "memory")
#define PG8_WAIT_L(n) asm volatile("s_waitcnt lgkmcnt(" #n ")" ::: "memory")
#define PG8_BAR __builtin_amdgcn_s_barrier()
#define PG8_SCHED __builtin_amdgcn_sched_barrier(0)
    Unit cur, nxt; int ui = 0;
    if (!S.next(0, cur)) return;
    nt = S.ktiles(g, cur);
    f32x4 acc[2][2][4][2];
#pragma unroll
    for (int a = 0; a < 2; ++a)
#pragma unroll
        for (int b = 0; b < 2; ++b)
#pragma unroll
            for (int m = 0; m < 4; ++m)
#pragma unroll
                for (int n = 0; n < 2; ++n) acc[a][b][m][n] = (f32x4){0.f, 0.f, 0.f, 0.f};
    bf16x8 At[4][2], B0[2][2], B1[2][2];
    const char* cA = (const char*)g.A + (GATHER ? (size_t)0 : S.aoff(g, cur)); const char* cB = (const char*)g.Bt + S.boff(g, cur);
    if constexpr (GATHER) { PG8_GOFF(cur, vo0, vo1); asm volatile("s_waitcnt vmcnt(0)" : "+v"(vo0[0]), "+v"(vo0[1]), "+v"(vo1[0]), "+v"(vo1[1]) :: "memory"); }
    if constexpr (SP2) {
        PG8_STAGE(PG8_SB(0, 0), cB, voffB); PG8_STAGE(PG8_SB(0, 1), cB + hstepB, voffB); PG8_STAGEA(PG8_SA(0, 0), cA, 0, false); PG8_STAGEA(PG8_SA(0, 1), cA, 1, false);
        if (wr == 1) PG8_BAR;
        PG8_WAIT_V(2); PG8_BAR;
        PG8_STAGE(PG8_SB(1, 0), cB + kstep, voffB); PG8_STAGEA(PG8_SA(1, 0), cA + kstep, 0, false); PG8_STAGE(PG8_SB(1, 1), cB + hstepB + kstep, voffB);
        PG8_WAIT_V(6); PG8_BAR;
    } else {
        PG8_STAGE(PG8_SB(0, 0), cB, voffB); PG8_STAGE(PG8_SA(0, 0), cA, voffA); PG8_STAGE(PG8_SB(0, 1), cB + hstepB, voffB); PG8_STAGE(PG8_SA(0, 1), cA + hstepA, voffA);
        if (wr == 1) PG8_BAR;
        PG8_WAIT_V(4); PG8_BAR;
        PG8_STAGE(PG8_SB(1, 0), cB + kstep, voffB); PG8_STAGE(PG8_SA(1, 0), cA + kstep, voffA); PG8_STAGE(PG8_SB(1, 1), cB + hstepB + kstep, voffB);
        PG8_WAIT_V(6); PG8_BAR;
    }
    for (;;) {
        const bool has_next = S.next(ui + 1, nxt);
        const char* nA = (has_next && !GATHER) ? (const char*)g.A + S.aoff(g, nxt) : cA; const char* nB = has_next ? (const char*)g.Bt + S.boff(g, nxt) : cB;
        if constexpr (GATHER) { if (has_next) { PG8_GOFF(nxt, nvo0, nvo1); } else { nvo0[0] = vo0[0]; nvo0[1] = vo0[1]; nvo1[0] = vo1[0]; nvo1[1] = vo1[1]; }
            asm volatile("s_waitcnt vmcnt(0)" : "+v"(nvo0[0]), "+v"(nvo0[1]), "+v"(nvo1[0]), "+v"(nvo1[1]) :: "memory"); }
        for (int t = 0; t < nt; t += 2) {
            const bool last = (t == nt - 2);
            const char* a1 = cA + (size_t)(t + 1) * kstep;
            const char* a2 = last ? nA : cA + (size_t)(t + 2) * kstep; const char* b2 = last ? nB : cB + (size_t)(t + 2) * kstep;
            const char* a3 = a2 + kstep; const char* b3 = b2 + kstep;
            if constexpr (SP2) {
            PG8_LDB(B0, 0, 0); PG8_LDB(B1, 0, 1); PG8_SCHED; PG8_LDA(At, 0, 0); PG8_STAGEA(PG8_SA(1, 1), a1, 1, false);
            PG8_WAIT_V(8); PG8_WAIT_L(0); PG8_BAR; PG8_MMA(0, 0, At, B0); PG8_MMA(0, 1, At, B1); PG8_BAR; PG8_SCHED;
            PG8_LDA(At, 0, 1); PG8_STAGE(PG8_SB(0, 0), b2, voffB); PG8_STAGE(PG8_SB(0, 1), b2 + hstepB, voffB); PG8_STAGEA(PG8_SA(0, 0), a2, 0, last);
            PG8_WAIT_V(8); PG8_WAIT_L(0); PG8_BAR; PG8_MMA(1, 0, At, B0); PG8_MMA(1, 1, At, B1); PG8_BAR; PG8_SCHED;
            PG8_LDB(B0, 1, 0); PG8_LDB(B1, 1, 1); PG8_SCHED; PG8_LDA(At, 1, 0); PG8_STAGEA(PG8_SA(0, 1), a2, 1, last);
            PG8_WAIT_V(8); PG8_WAIT_L(0); PG8_BAR; PG8_MMA(0, 0, At, B0); PG8_MMA(0, 1, At, B1); PG8_BAR; PG8_SCHED;
            PG8_LDA(At, 1, 1); PG8_STAGE(PG8_SB(1, 0), b3, voffB); PG8_STAGE(PG8_SB(1, 1), b3 + hstepB, voffB); PG8_STAGEA(PG8_SA(1, 0), a3, 0, last);
            PG8_WAIT_V(8); PG8_WAIT_L(0); PG8_BAR; PG8_MMA(1, 0, At, B0); PG8_MMA(1, 1, At, B1); PG8_BAR; PG8_SCHED;
            } else {
            PG8_LDB(B0, 0, 0); PG8_SCHED; PG8_LDA(At, 0, 0); PG8_STAGE(PG8_SA(1, 1), a1 + hstepA, voffA);
            PG8_WAIT_L(8); PG8_BAR; PG8_WAIT_L(0); PG8_MMA(0, 0, At, B0); PG8_BAR; PG8_SCHED;
            PG8_LDB(B1, 0, 1); PG8_STAGE(PG8_SB(0, 0), b2, voffB);
            PG8_BAR; PG8_WAIT_L(0); PG8_MMA(0, 1, At, B1); PG8_BAR;
            PG8_LDA(At, 0, 1); PG8_STAGE(PG8_SA(0, 0), a2, voffA);
            PG8_BAR; PG8_WAIT_L(0); PG8_MMA(1, 0, At, B0); PG8_BAR; PG8_SCHED;
            PG8_STAGE(PG8_SB(0, 1), b2 + hstepB, voffB);
            PG8_WAIT_V(6); PG8_BAR; PG8_MMA(1, 1, At, B1); PG8_BAR;
            PG8_LDB(B0, 1, 0); PG8_SCHED; PG8_LDA(At, 1, 0); PG8_STAGE(PG8_SA(0, 1), a2 + hstepA, voffA);
            PG8_WAIT_L(8); PG8_BAR; PG8_WAIT_L(0); PG8_MMA(0, 0, At, B0); PG8_BAR; PG8_SCHED;
            PG8_LDB(B1, 1, 1); PG8_STAGE(PG8_SB(1, 0), b3, voffB);
            PG8_BAR; PG8_WAIT_L(0); PG8_MMA(0, 1, At, B1); PG8_BAR;
            PG8_LDA(At, 1, 1); PG8_STAGE(PG8_SA(1, 0), a3, voffA);
            PG8_BAR; PG8_WAIT_L(0); PG8_MMA(1, 0, At, B0); PG8_BAR; PG8_SCHED;
            PG8_STAGE(PG8_SB(1, 1), b3 + hstepB, voffB);
            PG8_WAIT_V(6); PG8_BAR; PG8_MMA(1, 1, At, B1); PG8_BAR;
            }
        }
        if constexpr (ALIGN_EPI) { if (wr == 0) PG8_BAR; }
        E(acc, cur, wr, wc, fr, fq);
        S.done(cur, lane);
        if (!has_next) break;
#pragma unroll
        for (int a = 0; a < 2; ++a)
#pragma unroll
            for (int b = 0; b < 2; ++b)
#pragma unroll
                for (int m = 0; m < 4; ++m)
#pragma unroll
                    for (int n = 0; n < 2; ++n) acc[a][b][m][n] = (f32x4){0.f, 0.f, 0.f, 0.f};
        cur = nxt; cA = nA; cB = nB; ++ui; nt = S.ktiles(g, cur);
        if constexpr (GATHER) { vo0[0] = nvo0[0]; vo0[1] = nvo0[1]; vo1[0] = nvo1[0]; vo1[1] = nvo1[1]; }
        if constexpr (ALIGN_EPI) { if (wr == 1) PG8_BAR; }
    }
    PG8_WAIT_V(0);
    if constexpr (!ALIGN_EPI) { if (wr == 0) PG8_BAR; }
    PG8_BAR;
#undef PG8_SA
#undef PG8_SB
#undef PG8_STAGE
#undef PG8_LDA
#undef PG8_STAGEA
#undef PG8_GOFF
#undef PG8_LDB
#undef PG8_MMA
#undef PG8_WAIT_V
#undef PG8_WAIT_L
#undef PG8_BAR
#undef PG8_SCHED
}
}

#define XB_TMO      128
#define XB_XCNT(j)  (256  + 64 * (j))
#define XB_XSUB(j)  (1280 + 64 * (j))
#define XB_XGEN(j)  (2304 + 64 * (j))
#define XB_TOP      3328
#define XB_TOPGEN   3392
#define XCD_BAR_WORDS 3456
#define XB_SPIN_CAP (1u << 18)
__device__ __forceinline__ unsigned xb_ld(unsigned* p)              { return __hip_atomic_load(p, __ATOMIC_RELAXED, __HIP_MEMORY_SCOPE_AGENT); }
__device__ __forceinline__ unsigned xb_add(unsigned* p, unsigned v) { return __hip_atomic_fetch_add(p, v, __ATOMIC_RELAXED, __HIP_MEMORY_SCOPE_AGENT); }
__device__ __forceinline__ unsigned xb_xcc_id() { return (unsigned)__builtin_amdgcn_s_getreg((3 << 11) | 20) & 0xFu; }
#define XB_SPIN(cond, bar) do { unsigned _sp = 0; while (cond) { __builtin_amdgcn_s_sleep(1); \
    if ((++_sp & 255u) == 0u) { if (xb_ld(&(bar)[XB_TMO])) break; if (_sp > XB_SPIN_CAP) { atomicAdd(&(bar)[XB_TMO], 1u); break; } } } } while (0)
struct XcdBarrier { unsigned* bar; unsigned x; volatile LAS unsigned* st; };
__device__ __forceinline__ XcdBarrier xcd_barrier_post(unsigned* bar, volatile LAS unsigned* st) {
    XcdBarrier b; b.bar = bar; b.x = xb_xcc_id(); b.st = st;
    if (threadIdx.x == 0) (void)xb_add(&bar[XB_XCNT(b.x)], 1u);
    return b;
}
__device__ __forceinline__ void xcd_barrier_complete(unsigned* bar, unsigned x, unsigned& nloc, unsigned& nx) {
    const unsigned G = gridDim.x * gridDim.y * gridDim.z;
    unsigned sum, cnt, mine, sp = 0u;
    for (;;) {
        sum = 0u; cnt = 0u; mine = 0u;
#pragma unroll
        for (unsigned j = 0; j < 16; ++j) { const unsigned c = xb_ld(&bar[XB_XCNT(j)]); sum += c; cnt += (c > 0u) ? 1u : 0u; mine = (j == x) ? c : mine; }
        if (sum == G) break;
        __builtin_amdgcn_s_sleep(1);
        if ((++sp & 255u) == 0u) { if (xb_ld(&bar[XB_TMO])) break; if (sp > XB_SPIN_CAP) { atomicAdd(&bar[XB_TMO], 1u); break; } }
    }
    nloc = mine > 0u ? mine : 1u; nx = cnt > 0u ? cnt : 1u;
}
__device__ __forceinline__ void xcd_barrier(const XcdBarrier& b) {
    asm volatile("s_waitcnt vmcnt(0)" ::: "memory");
    __syncthreads();
    if (threadIdx.x == 0) {
        unsigned* bar = b.bar;
        __builtin_amdgcn_s_waitcnt(0);
        unsigned nloc = b.st[0], nx = b.st[1];
        if (nloc == 0u) { xcd_barrier_complete(bar, b.x, nloc, nx); b.st[0] = nloc; b.st[1] = nx; }
        const unsigned old = xb_add(&bar[XB_XSUB(b.x)], 1u);
        const unsigned gen = old / nloc;
        if (old + 1u == (gen + 1u) * nloc) {
            __builtin_amdgcn_fence(__ATOMIC_RELEASE, "agent");
            asm volatile("s_waitcnt vmcnt(0)" ::: "memory");
            const unsigned og = xb_add(&bar[XB_TOP], 1u);
            const unsigned tg = og / nx;
            if (og + 1u == (tg + 1u) * nx) xb_add(&bar[XB_TOPGEN], 1u);
            else XB_SPIN(xb_ld(&bar[XB_TOPGEN]) == tg, bar);
            __builtin_amdgcn_fence(__ATOMIC_ACQUIRE, "agent");
            xb_add(&bar[XB_XGEN(b.x)], 1u);
            asm volatile("s_waitcnt vmcnt(0)" ::: "memory");
        } else {
            XB_SPIN(xb_ld(&bar[XB_XGEN(b.x)]) == gen, bar);
            __builtin_amdgcn_fence(__ATOMIC_ACQUIRE, "agent");
            asm volatile("s_waitcnt vmcnt(0)" ::: "memory");
        }
    }
    __syncthreads();
}

struct Args {
    const float* x; const float* c; const float* ada_w; const float* ada_b; const float* mix_g; const float* ffn_g; const float* w_in;
    const float* da_lambda; const float* da_subln; const float* na_rpb; const float* wpa; const float* wpn; const float* wpd; const float* w_out;
    const float* rgw; const float* rgb; const float* rew; const float* reb; const float* ew1; const float* ew3; const float* ew2; const float* fin_g;
    float* out; unsigned char* ws; int ph_lo, ph_hi; int variant, pad;
};

__device__ const double ROPE_INV[32] = {
    1.0, 0.7498942093324559, 0.5623413251903491, 0.4216965034285822, 0.31622776601683794, 0.23713737056616552, 0.1778279410038923, 0.1333521432163324,
    0.1, 0.07498942093324558, 0.05623413251903491, 0.04216965034285822, 0.031622776601683794, 0.023713737056616554, 0.01778279410038923, 0.01333521432163324,
    0.01, 0.007498942093324558, 0.005623413251903491, 0.004216965034285822, 0.0031622776601683794, 0.0023713737056616554, 0.001778279410038923, 0.001333521432163324,
    0.001, 0.0007498942093324559, 0.0005623413251903491, 0.0004216965034285822, 0.00031622776601683794, 0.00023713737056616554, 0.0001778279410038923, 0.0001333521432163324};

__device__ __forceinline__ void sincos_d(double a, float& s, float& c) {
    const double k = __builtin_rint(a * 0.6366197723675814);
    double t = __builtin_fma(-k, 1.5707963267948966, a); t = __builtin_fma(-k, 6.123233995736766e-17, t);
    const double t2 = t * t;
    double sp = -1.0 / 1307674368000.0; sp = sp * t2 + 1.0 / 6227020800.0; sp = sp * t2 - 1.0 / 39916800.0; sp = sp * t2 + 1.0 / 362880.0; sp = sp * t2 - 1.0 / 5040.0; sp = sp * t2 + 1.0 / 120.0; sp = sp * t2 - 1.0 / 6.0; sp = sp * t2 + 1.0; sp *= t;
    double cp = 1.0 / 87178291200.0; cp = cp * t2 - 1.0 / 479001600.0; cp = cp * t2 + 1.0 / 3628800.0; cp = cp * t2 - 1.0 / 40320.0; cp = cp * t2 + 1.0 / 720.0; cp = cp * t2 - 1.0 / 24.0; cp = cp * t2 + 0.5; cp = 1.0 - cp * t2;
    const int q = ((int)k) & 3;
    const double ss = (q == 0) ? sp : (q == 1) ? cp : (q == 2) ? -sp : -cp;
    const double cc = (q == 0) ? cp : (q == 1) ? -sp : (q == 2) ? -cp : sp;
    s = (float)ss; c = (float)cc;
}

__device__ __forceinline__ int dst_row(int mode, int n) {
    if (mode == 1) { const bool rot = (n < 1024) || (n >= ZQD && n < ZVD); if (rot) { const int j = n & 63; return (n & ~63) + ((j & 31) << 1) + (j >> 5); } return n; }
    if (mode == 2) return 256 * (n >> 7) + (n & 127);
    if (mode == 3) return 256 * (n >> 7) + 128 + (n & 127);
    return n;
}
__device__ __forceinline__ void tr_item(const float* W, int N, bf16_t* WT, int ldt, int koff, int mode, LAS float* scr, int item, int lane) {
    const int nblk = N / 32, kb = item / nblk, nb = item % nblk, k0 = 64 * kb, n0 = 32 * nb;
#pragma unroll 8
    for (int i = 0; i < 32; ++i) { const int kk = 2 * i + (lane >> 5); scr[kk * 33 + (lane & 31)] = __builtin_nontemporal_load(&W[(size_t)(k0 + kk) * N + n0 + (lane & 31)]); }
    LDS_WAIT();
    const int c = lane & 7;
#pragma unroll
    for (int j = 0; j < 4; ++j) { const int n = (lane >> 3) + 8 * j; const LAS float* s = scr + (8 * c) * 33 + n;
        float f = 1.0f; if (mode == 1) { const int nn = n0 + n; f = (nn < ZKA || (nn >= ZQN && nn < ZKN) || (nn >= ZQD && nn < ZKD)) ? C2 : (nn >= ZG ? -LOG2E : 1.0f); }
        u32x4 o; o.x = cvt_pk_bf16(s[0 * 33] * f, s[1 * 33] * f); o.y = cvt_pk_bf16(s[2 * 33] * f, s[3 * 33] * f); o.z = cvt_pk_bf16(s[4 * 33] * f, s[5 * 33] * f); o.w = cvt_pk_bf16(s[6 * 33] * f, s[7 * 33] * f);
        *(u32x4*)(WT + (size_t)dst_row(mode, n0 + n) * ldt + koff + k0 + 8 * c) = o; }
    LDS_WAIT();
}

__device__ __forceinline__ float max3f(float a, float b, float c) { float r; asm("v_max3_f32 %0, %1, %2, %3" : "=v"(r) : "v"(a), "v"(b), "v"(c)); return r; }
__device__ __forceinline__ int crow(int r, int hi) { return (r & 3) + 8 * (r >> 2) + 4 * hi; }
__device__ __forceinline__ float swapmax(float m) { float a = m, b = m; swap32(a, b); return __builtin_fmaxf(a, b); }
__device__ __forceinline__ float swapsum(float m) { float a = m, b = m; swap32(a, b); return a + b; }
typedef short v4i16_t __attribute__((ext_vector_type(4)));
__device__ __forceinline__ s16x4 vtr(const LAS unsigned char* p) { return __builtin_bit_cast(s16x4, __builtin_amdgcn_ds_read_tr16_b64_v4i16((LAS v4i16_t*)p)); }

template <int DV> struct AttnCfg { static constexpr int ND = DV / 32, NCH = DV / 16, VST = DV * 2 + 64; };

template <int DV> struct TileRegs { u32x4 kr[4]; u32x4 vr[4]; };
template <int DV>
__device__ __forceinline__ void tile_load(TileRegs<DV>& T, const char* zb, const unsigned (&roff)[4], unsigned kcol, unsigned vcol) {
    const unsigned cb = 16u * (threadIdx.x & 7);
#pragma unroll
    for (int i = 0; i < 4; ++i) { T.kr[i] = *(const u32x4*)(zb + (size_t)(roff[i] + kcol + cb)); T.vr[i] = *(const u32x4*)(zb + (size_t)(roff[i] + vcol + cb)); }
}
__device__ __forceinline__ float max16m(const f32x16& p, float m) { float a, b;
    asm("v_max3_f32 %0, %2, %3, %4\n\tv_max3_f32 %1, %5, %6, %7\n\tv_max3_f32 %0, %0, %8, %9\n\tv_max3_f32 %1, %1, %10, %11\n\tv_max3_f32 %0, %0, %12, %13\n\tv_max3_f32 %1, %1, %14, %15\n\t"
        "v_max3_f32 %0, %0, %16, %17\n\tv_max3_f32 %0, %0, %1, %18"
        : "=&v"(a), "=&v"(b) : "v"(p[0]), "v"(p[1]), "v"(p[2]), "v"(p[3]), "v"(p[4]), "v"(p[5]), "v"(p[6]), "v"(p[7]), "v"(p[8]), "v"(p[9]), "v"(p[10]), "v"(p[11]), "v"(p[12]), "v"(p[13]), "v"(p[14]), "v"(p[15]), "v"(m));
    return a; }
template <int DV, class MaskF, class Reload>
__device__ __forceinline__ void attn_tile(f32x16 (&o)[DV / 32], float& m, float& l, const bf16x8 (&qf)[4], TileRegs<DV>& T,
                                          LAS unsigned char* vlds, LAS float* wsf, const MaskF& maskf, const Reload& reload, int lane, int hi) {
    constexpr int ND = AttnCfg<DV>::ND, VST = AttnCfg<DV>::VST, KST = 144;
    static_assert(DV == 64, "gather tiles are 64 wide");
    CBAR();
    { LAS unsigned char* kw = vlds + 6144 + (lane >> 3) * KST + (lane & 7) * 16; LAS unsigned char* vw = vlds + (lane >> 3) * VST + (lane & 7) * 16;
#pragma unroll
      for (int i = 0; i < 4; ++i) { *(LAS u32x4*)(kw + 8 * i * KST) = T.kr[i]; *(LAS u32x4*)(vw + 8 * i * VST) = T.vr[i]; } }
    CBAR();
    reload(T);
    f32x16 p; maskf(p);
    { const LAS unsigned char* kp = vlds + 6144 + (lane & 31) * KST + hi * 16;
#pragma unroll
      for (int d0 = 0; d0 < 4; ++d0) { const bf16x8 kf = *(const LAS bf16x8*)(kp + 32 * d0); p = __builtin_amdgcn_mfma_f32_32x32x16_bf16(kf, qf[d0], p, 0, 0, 0); } }
    asm volatile("s_nop 15\n\ts_nop 7" : "+v"(p));
    float mx = max16m(p, m);
    { float a = mx, b = mx; swap32(a, b); mx = max3f(a, b, m); }
    const float mn = (mx > m + RESCALE_THR) ? mx : m;
    const float alpha = fexp2(m - mn);
    m = mn;
    float rs = 0.f;
#pragma unroll
    for (int r = 0; r < 16; ++r) { p[r] = fexp2(p[r] - mn); rs += p[r]; }
    l = l * alpha + rs;
    if (__any(alpha != 1.0f)) {
        CBAR();
        if (hi == 0) wsf[lane & 31] = alpha;
        CBAR();
#pragma unroll
        for (int g4 = 0; g4 < 4; ++g4) { const f32x4 a4 = *(const LAS f32x4*)(wsf + 8 * g4 + 4 * hi);
#pragma unroll
            for (int d0 = 0; d0 < ND; ++d0) { o[d0][4 * g4 + 0] *= a4[0]; o[d0][4 * g4 + 1] *= a4[1]; o[d0][4 * g4 + 2] *= a4[2]; o[d0][4 * g4 + 3] *= a4[3]; } }
        CBAR();
    }
    CBAR();
    u32x4 pw0, pw1;
    pw0.x = cvtpk_s(p[0], p[1]); pw0.y = cvtpk_s(p[2], p[3]); pw0.z = cvtpk_s(p[4], p[5]); pw0.w = cvtpk_s(p[6], p[7]);
    pw1.x = cvtpk_s(p[8], p[9]); pw1.y = cvtpk_s(p[10], p[11]); pw1.z = cvtpk_s(p[12], p[13]); pw1.w = cvtpk_s(p[14], p[15]);
    const bf16x8 pa0 = __builtin_bit_cast(bf16x8, pw0), pa1 = __builtin_bit_cast(bf16x8, pw1);
    const int li = lane & 15, g16 = lane >> 4;
    const LAS unsigned char* vb = vlds + (4 * hi + (li >> 2)) * VST + (16 * (g16 & 1) + 4 * (li & 3)) * 2;
    s16x4 vlo[2][ND], vhi[2][ND];
#pragma unroll
    for (int s = 0; s < 2; ++s)
#pragma unroll
        for (int d0 = 0; d0 < ND; ++d0) { vlo[s][d0] = vtr(vb + (16 * s) * VST + d0 * 64); vhi[s][d0] = vtr(vb + (16 * s + 8) * VST + d0 * 64); }
    __builtin_amdgcn_sched_barrier(0);
#pragma unroll
    for (int s = 0; s < 2; ++s)
#pragma unroll
        for (int d0 = 0; d0 < ND; ++d0) {
            const bf16x8 vf = (bf16x8){vlo[s][d0][0], vlo[s][d0][1], vlo[s][d0][2], vlo[s][d0][3], vhi[s][d0][0], vhi[s][d0][1], vhi[s][d0][2], vhi[s][d0][3]};
            o[d0] = __builtin_amdgcn_mfma_f32_32x32x16_bf16(s == 0 ? pa0 : pa1, vf, o[d0], 0, 0, 0);
        }
    CBAR();
}
template <int ND>
__device__ __forceinline__ void attn_finish(f32x16 (&o)[ND], float l, LAS float* wsf, int lane, int hi) {
    const float inv = frcp(swapsum(l));
    CBAR();
    if (hi == 0) wsf[lane & 31] = inv;
    CBAR();
#pragma unroll
    for (int g4 = 0; g4 < 4; ++g4) { const f32x4 a4 = *(const LAS f32x4*)(wsf + 8 * g4 + 4 * hi);
#pragma unroll
        for (int d0 = 0; d0 < ND; ++d0) { o[d0][4 * g4 + 0] *= a4[0]; o[d0][4 * g4 + 1] *= a4[1]; o[d0][4 * g4 + 2] *= a4[2]; o[d0][4 * g4 + 3] *= a4[3]; } }
    CBAR();
}

__device__ __forceinline__ void glds16s(const void* sbase, unsigned voff, unsigned lds_dst) { unsigned keep;
    asm volatile("s_mov_b32 %0, m0\n\ts_mov_b32 m0, %2\n\ts_nop 0\n\tglobal_load_lds_dwordx4 %1, %3\n\ts_mov_b32 m0, %0" : "=&s"(keep) : "v"(voff), "s"(lds_dst), "s"(sbase) : "memory"); }
__device__ __forceinline__ void glds16(const void* gsrc, unsigned lds_dst) { unsigned keep;
    asm volatile("s_mov_b32 %0, m0\n\ts_mov_b32 m0, %2\n\ts_nop 0\n\tglobal_load_lds_dwordx4 %1, off\n\ts_mov_b32 m0, %0" : "=&s"(keep) : "v"(gsrc), "s"(lds_dst) : "memory"); }
__device__ __forceinline__ void diff_qk(f32x16& p0, f32x16& p1, const LAS unsigned char* qlds, const LAS unsigned char* kb, int lane, int hi) {
    const int r32 = lane & 31, sw = (r32 >> 1) & 7;
    const LAS unsigned char* kp = kb + r32 * 128;
    p0 = f32x16{}; p1 = f32x16{};
#pragma unroll
    for (int d0 = 0; d0 < 4; ++d0) {
        const bf16x8 q = *(const LAS bf16x8*)(qlds + d0 * 1024 + lane * 16);
        const int po = ((2 * d0 + hi) ^ sw) << 4;
        const bf16x8 k0 = *(const LAS bf16x8*)(kp + po), k1 = *(const LAS bf16x8*)(kp + po + 4096);
        p0 = __builtin_amdgcn_mfma_f32_32x32x16_bf16(k0, q, p0, 0, 0, 0);
        p1 = __builtin_amdgcn_mfma_f32_32x32x16_bf16(k1, q, p1, 0, 0, 0);
    }
}
__device__ __forceinline__ void diff_sm_pv(f32x16 (&o)[4], float& m, float& l, f32x16& p0, f32x16& p1, const LAS unsigned char* vbuf, LAS float* wsf, int lane, int hi) {
    const int r32 = lane & 31;
    float ma = max3f(p0[0], p0[1], p1[0]), mb = max3f(p0[2], p0[3], p1[1]); ma = max3f(ma, p1[2], p1[3]);
#pragma unroll
    for (int r = 4; r < 16; r += 4) { ma = max3f(ma, p0[r], p0[r + 1]); mb = max3f(mb, p0[r + 2], p0[r + 3]); ma = max3f(ma, p1[r], p1[r + 1]); mb = max3f(mb, p1[r + 2], p1[r + 3]); }
    float mx = max3f(ma, mb, m);
    { float a = mx, b = mx; swap32(a, b); mx = max3f(a, b, m); }
    const float mn = (mx > m + RESCALE_THR) ? mx : m;
    const float alpha = fexp2(m - mn);
    m = mn;
    float rs = 0.f;
#pragma unroll
    for (int r = 0; r < 16; ++r) { p0[r] = fexp2(p0[r] - mn); p1[r] = fexp2(p1[r] - mn); rs += p0[r] + p1[r]; }
    l = l * alpha + rs;
    if (__any(alpha != 1.0f)) {
        CBAR();
        if (hi == 0) wsf[r32] = alpha;
        CBAR();
#pragma unroll
        for (int g4 = 0; g4 < 4; ++g4) { const f32x4 a4 = *(const LAS f32x4*)(wsf + 8 * g4 + 4 * hi);
#pragma unroll
            for (int d0 = 0; d0 < 4; ++d0) { o[d0][4 * g4 + 0] *= a4[0]; o[d0][4 * g4 + 1] *= a4[1]; o[d0][4 * g4 + 2] *= a4[2]; o[d0][4 * g4 + 3] *= a4[3]; } }
        CBAR();
    }
    u32x4 pw[4];
#pragma unroll
    for (int i = 0; i < 4; ++i) { pw[0][i] = cvtpk_s(p0[2 * i], p0[2 * i + 1]); pw[1][i] = cvtpk_s(p0[8 + 2 * i], p0[9 + 2 * i]); pw[2][i] = cvtpk_s(p1[2 * i], p1[2 * i + 1]); pw[3][i] = cvtpk_s(p1[8 + 2 * i], p1[9 + 2 * i]); }
    const int li = lane & 15, g16 = lane >> 4;
    const LAS unsigned char* vp = vbuf + hi * 1024 + (li >> 2) * 64 + (16 * (g16 & 1) + 4 * (li & 3)) * 2;
#pragma unroll
    for (int s4 = 0; s4 < 4; ++s4) {
        const bf16x8 pa = __builtin_bit_cast(bf16x8, pw[s4]);
#pragma unroll
        for (int d0 = 0; d0 < 4; ++d0) {
            const s16x4 lo = vtr(vp + s4 * 4096 + d0 * 256), hh = vtr(vp + s4 * 4096 + 2048 + d0 * 256);
            const bf16x8 vf = (bf16x8){lo[0], lo[1], lo[2], lo[3], hh[0], hh[1], hh[2], hh[3]};
            o[d0] = __builtin_amdgcn_mfma_f32_32x32x16_bf16(pa, vf, o[d0], 0, 0, 0);
        }
    }
}

__device__ __forceinline__ void diff_sm(f32x16 (&o)[4], float& m, float& l, f32x16& p0, f32x16& p1, u32x4 (&pw)[4], LAS float* wsf, int lane, int hi) {
    const int r32 = lane & 31;
    float ma = max3f(p0[0], p0[1], p1[0]), mb = max3f(p0[2], p0[3], p1[1]); ma = max3f(ma, p1[2], p1[3]);
#pragma unroll
    for (int r = 4; r < 16; r += 4) { ma = max3f(ma, p0[r], p0[r + 1]); mb = max3f(mb, p0[r + 2], p0[r + 3]); ma = max3f(ma, p1[r], p1[r + 1]); mb = max3f(mb, p1[r + 2], p1[r + 3]); }
    float mx = max3f(ma, mb, m);
    { float a = mx, b = mx; swap32(a, b); mx = max3f(a, b, m); }
    const float mn = (mx > m + RESCALE_THR) ? mx : m;
    const float alpha = fexp2(m - mn);
    m = mn;
    float rs = 0.f;
#pragma unroll
    for (int r = 0; r < 16; ++r) { p0[r] = fexp2(p0[r] - mn); p1[r] = fexp2(p1[r] - mn); rs += p0[r] + p1[r]; }
    l = l * alpha + rs;
    if (__any(alpha != 1.0f)) {
        CBAR();
        if (hi == 0) wsf[r32] = alpha;
        CBAR();
#pragma unroll
        for (int g4 = 0; g4 < 4; ++g4) { const f32x4 a4 = *(const LAS f32x4*)(wsf + 8 * g4 + 4 * hi);
#pragma unroll
            for (int d0 = 0; d0 < 4; ++d0) { o[d0][4 * g4 + 0] *= a4[0]; o[d0][4 * g4 + 1] *= a4[1]; o[d0][4 * g4 + 2] *= a4[2]; o[d0][4 * g4 + 3] *= a4[3]; } }
        CBAR();
    }
#pragma unroll
    for (int i = 0; i < 4; ++i) { pw[0][i] = cvtpk_s(p0[2 * i], p0[2 * i + 1]); pw[1][i] = cvtpk_s(p0[8 + 2 * i], p0[9 + 2 * i]); pw[2][i] = cvtpk_s(p1[2 * i], p1[2 * i + 1]); pw[3][i] = cvtpk_s(p1[8 + 2 * i], p1[9 + 2 * i]); }
}
__device__ __forceinline__ void diff_pv2(f32x16 (&o0)[4], f32x16 (&o1)[4], const u32x4 (&pw0)[4], const u32x4 (&pw1)[4], const LAS unsigned char* vbuf, int lane_, int hi_) {
    int lane = lane_; asm volatile("" : "+v"(lane));
    const int hi = lane >> 5; (void)hi_;
    const int li = lane & 15, g16 = lane >> 4;
    const LAS unsigned char* vp = vbuf + hi * 1024 + (li >> 2) * 64 + (16 * (g16 & 1) + 4 * (li & 3)) * 2;
    __builtin_amdgcn_s_setprio(1);
#pragma unroll
    for (int s4 = 0; s4 < 4; ++s4) {
        const bf16x8 pa0 = __builtin_bit_cast(bf16x8, pw0[s4]), pa1 = __builtin_bit_cast(bf16x8, pw1[s4]);
#pragma unroll
        for (int d0 = 0; d0 < 4; ++d0) {
            const s16x4 lo = vtr(vp + s4 * 4096 + d0 * 256), hh = vtr(vp + s4 * 4096 + 2048 + d0 * 256);
            const bf16x8 vf = (bf16x8){lo[0], lo[1], lo[2], lo[3], hh[0], hh[1], hh[2], hh[3]};
            o0[d0] = __builtin_amdgcn_mfma_f32_32x32x16_bf16(pa0, vf, o0[d0], 0, 0, 0);
            o1[d0] = __builtin_amdgcn_mfma_f32_32x32x16_bf16(pa1, vf, o1[d0], 0, 0, 0);
        }
    }
    __builtin_amdgcn_s_setprio(0);
}
__device__ __forceinline__ void diff_qk_f(f32x16& p0, f32x16& p1, const LAS unsigned char* qlds, const LAS unsigned char* kb, const LAS unsigned char* ap, const LAS unsigned char* bp, int lane_, int hi_) {
    int lane = lane_; asm volatile("" : "+v"(lane));
    const int hi = lane >> 5; (void)hi_;
    const int r32 = lane & 31, sw = (r32 >> 1) & 7;
    const LAS unsigned char* kp = kb + r32 * 128;
    { const bf16x8 a1 = *(const LAS bf16x8*)ap, bm = *(const LAS bf16x8*)bp;
      p0 = __builtin_amdgcn_mfma_f32_32x32x16_bf16(a1, bm, f32x16{}, 0, 0, 0);
      p1 = __builtin_amdgcn_mfma_f32_32x32x16_bf16(a1, bm, f32x16{}, 0, 0, 0); }
#pragma unroll
    for (int d0 = 0; d0 < 4; ++d0) {
        const bf16x8 q = *(const LAS bf16x8*)(qlds + d0 * 1024 + lane * 16);
        const int po = ((2 * d0 + hi) ^ sw) << 4;
        const bf16x8 k0 = *(const LAS bf16x8*)(kp + po), k1 = *(const LAS bf16x8*)(kp + po + 4096);
        p0 = __builtin_amdgcn_mfma_f32_32x32x16_bf16(k0, q, p0, 0, 0, 0);
        p1 = __builtin_amdgcn_mfma_f32_32x32x16_bf16(k1, q, p1, 0, 0, 0);
    }
}
__device__ __forceinline__ void diff_sm_head(f32x16 (&o)[4], float& m, float& l, f32x16& p0, f32x16& p1, LAS float* wsf, LAS unsigned char* bslot, bool first, int lane, int hi) {
    float ma = max3f(p0[0], p0[1], p1[0]), mb = max3f(p0[2], p0[3], p1[1]); ma = max3f(ma, p1[2], p1[3]);
#pragma unroll
    for (int r = 4; r < 16; r += 4) { ma = max3f(ma, p0[r], p0[r + 1]); mb = max3f(mb, p0[r + 2], p0[r + 3]); ma = max3f(ma, p1[r], p1[r + 1]); mb = max3f(mb, p1[r + 2], p1[r + 3]); }
    float mx = __builtin_fmaxf(ma, mb);
    { float a = mx, b = mx; swap32(a, b); mx = __builtin_fmaxf(a, b); }
    const bool up = first || (mx > RESCALE_THR);
    if (__any(up)) {
        const float mnew = up ? __builtin_bit_cast(float, f2bf(m + mx) << 16) : m, delta = mnew - m;
        const float alpha = fexp2(-delta);
        m = mnew; l *= alpha;
        CBAR();
        int l2 = lane; asm volatile("" : "+v"(l2));
        if (hi == 0) { wsf[l2 & 31] = alpha; *(LAS unsigned*)bslot = f2bf(-mnew); }
        CBAR();
#pragma unroll
        for (int g4 = 0; g4 < 4; ++g4) { const f32x4 a4 = *(const LAS f32x4*)(wsf + 8 * g4 + 4 * (l2 >> 5));
#pragma unroll
            for (int d0 = 0; d0 < 4; ++d0) { o[d0][4 * g4 + 0] *= a4[0]; o[d0][4 * g4 + 1] *= a4[1]; o[d0][4 * g4 + 2] *= a4[2]; o[d0][4 * g4 + 3] *= a4[3]; } }
#pragma unroll
        for (int r = 0; r < 16; ++r) { p0[r] -= delta; p1[r] -= delta; }
        CBAR();
    }
}
__device__ __forceinline__ void diff_sm_tail(float& l, f32x16& p0, f32x16& p1, u32x4 (&pw)[4]) {
    float rs = 0.f;
#pragma unroll
    for (int r = 0; r < 16; ++r) { p0[r] = fexp2(p0[r]); p1[r] = fexp2(p1[r]); rs += p0[r] + p1[r]; }
    l += rs;
#pragma unroll
    for (int i = 0; i < 4; ++i) { pw[0][i] = cvtpk_s(p0[2 * i], p0[2 * i + 1]); pw[1][i] = cvtpk_s(p0[8 + 2 * i], p0[9 + 2 * i]); pw[2][i] = cvtpk_s(p1[2 * i], p1[2 * i + 1]); pw[3][i] = cvtpk_s(p1[8 + 2 * i], p1[9 + 2 * i]); }
}
__device__ __forceinline__ void diff_tail_pv2(f32x16 (&o0)[4], f32x16 (&o1)[4], float& l0, float& l1, const f32x16& a0, const f32x16& a1, const f32x16& b0, const f32x16& b1, const LAS unsigned char* vbuf, int lane_) {
    int lane = lane_; asm volatile("" : "+v"(lane));
    const int hi = lane >> 5, li = lane & 15, g16 = lane >> 4;
    const LAS unsigned char* vp = vbuf + hi * 1024 + (li >> 2) * 64 + (16 * (g16 & 1) + 4 * (li & 3)) * 2;
    float rs0 = 0.f, rs1 = 0.f;
    u32x4 pa, pb, pan = {0u, 0u, 0u, 0u}, pbn = {0u, 0u, 0u, 0u};
#define TP_A(st, i) do { const int r_ = ((st) & 1) * 8 + 2 * (i); const float e0_ = fexp2((st) < 2 ? a0[r_] : a1[r_]), e1_ = fexp2((st) < 2 ? a0[r_ + 1] : a1[r_ + 1]); rs0 += e0_; rs0 += e1_; asm volatile("" : "+v"(rs0)); pan[i] = cvtpk_s(e0_, e1_); } while (0)
#define TP_B(st, i) do { const int r_ = ((st) & 1) * 8 + 2 * (i); const float e0_ = fexp2((st) < 2 ? b0[r_] : b1[r_]), e1_ = fexp2((st) < 2 ? b0[r_ + 1] : b1[r_ + 1]); rs1 += e0_; rs1 += e1_; asm volatile("" : "+v"(rs1)); pbn[i] = cvtpk_s(e0_, e1_); } while (0)
#pragma unroll
    for (int i = 0; i < 4; ++i) { TP_A(0, i); TP_B(0, i); }
    pa = pan; pb = pbn;
    s16x4 flo[3], fhh[3];
#define TP_RD(c) do { flo[(c) % 3] = vtr(vp + ((c) >> 2) * 4096 + ((c) & 3) * 256); fhh[(c) % 3] = vtr(vp + ((c) >> 2) * 4096 + 2048 + ((c) & 3) * 256); } while (0)
    TP_RD(0); TP_RD(1);
    __builtin_amdgcn_sched_barrier(0);
#pragma unroll
    for (int c = 0; c < 16; ++c) {
        const int st = c >> 2, d0 = c & 3;
        if (c + 2 < 16) TP_RD(c + 2);
        const bf16x8 vf = (bf16x8){flo[c % 3][0], flo[c % 3][1], flo[c % 3][2], flo[c % 3][3], fhh[c % 3][0], fhh[c % 3][1], fhh[c % 3][2], fhh[c % 3][3]};
        o0[d0] = __builtin_amdgcn_mfma_f32_32x32x16_bf16(__builtin_bit_cast(bf16x8, pa), vf, o0[d0], 0, 0, 0);
        if (st < 3) TP_A(st + 1, d0);
        __builtin_amdgcn_sched_barrier(0);
        o1[d0] = __builtin_amdgcn_mfma_f32_32x32x16_bf16(__builtin_bit_cast(bf16x8, pb), vf, o1[d0], 0, 0, 0);
        if (st < 3) TP_B(st + 1, d0);
        __builtin_amdgcn_sched_barrier(0);
        if (d0 == 3) { pa = pan; pb = pbn; }
    }
#undef TP_A
#undef TP_B
#undef TP_RD
    l0 += rs0; l1 += rs1;
}
__device__ __forceinline__ void hm_step(int k, float& ma, float& mb, const f32x16& p0, const f32x16& p1) {
    if (k == 0) ma = max3f(p0[0], p0[1], p1[0]);
    else if (k == 1) mb = max3f(p0[2], p0[3], p1[1]);
    else if (k == 2) ma = max3f(ma, p1[2], p1[3]);
    else { const int j = (k - 3) >> 2, w = (k - 3) & 3, r = 4 + 4 * j;
        if (w == 0) ma = max3f(ma, p0[r], p0[r + 1]); else if (w == 1) mb = max3f(mb, p0[r + 2], p0[r + 3]); else if (w == 2) ma = max3f(ma, p1[r], p1[r + 1]); else mb = max3f(mb, p1[r + 2], p1[r + 3]); }
}
__device__ __forceinline__ void hm_finish(f32x16 (&o)[4], float& m, float& l, float ma, float mb, f32x16& p0, f32x16& p1, LAS float* wsf, LAS unsigned char* bslot, bool first, int lane) {
    float mx = __builtin_fmaxf(ma, mb);
    { float a = mx, b = mx; swap32(a, b); mx = __builtin_fmaxf(a, b); }
    const bool up = first || (mx > RESCALE_THR);
    if (__any(up)) {
        const float mnew = up ? __builtin_bit_cast(float, f2bf(m + mx) << 16) : m, delta = mnew - m;
        const float alpha = fexp2(-delta);
        m = mnew; l *= alpha;
        CBAR();
        int l2 = lane; asm volatile("" : "+v"(l2));
        if ((l2 >> 5) == 0) { wsf[l2 & 31] = alpha; *(LAS unsigned*)bslot = f2bf(-mnew); }
        CBAR();
#pragma unroll
        for (int g4 = 0; g4 < 4; ++g4) { const f32x4 a4 = *(const LAS f32x4*)(wsf + 8 * g4 + 4 * (l2 >> 5));
#pragma unroll
            for (int d0 = 0; d0 < 4; ++d0) { o[d0][4 * g4 + 0] *= a4[0]; o[d0][4 * g4 + 1] *= a4[1]; o[d0][4 * g4 + 2] *= a4[2]; o[d0][4 * g4 + 3] *= a4[3]; } }
#pragma unroll
        for (int r = 0; r < 16; ++r) { p0[r] -= delta; p1[r] -= delta; }
        CBAR();
    }
}
__device__ __forceinline__ void diffA_step(f32x16 (&o0)[4], f32x16 (&o1)[4], float& m0, float& l0, float& m1, float& l1, const LAS unsigned char* qlds, const LAS unsigned char* kb0, const LAS unsigned char* kb1,
                                           const LAS unsigned char* vbuf, LAS unsigned char* bsel, LAS float* wsf, bool first, int lane_) {
    int lane = lane_; asm volatile("" : "+v"(lane));
    const int hi = lane >> 5;
    f32x16 s0, s1, s2, s3;
    diff_qk_f(s0, s1, qlds, kb0, bsel + 32, bsel, lane, hi);
#define SB() __builtin_amdgcn_sched_barrier(0)
    const int r32 = lane & 31, sw = (r32 >> 1) & 7;
    const LAS unsigned char* kp = kb1 + r32 * 128; const LAS unsigned char* qp = qlds + 4096 + lane * 16;
    float ma = 0.f, mb = 0.f, rs0 = 0.f, rs1 = 0.f;
    u32x4 pa, pb, pan, pbn;
#define TP_A(st, i) do { const int r_ = ((st) & 1) * 8 + 2 * (i); const float e0_ = fexp2((st) < 2 ? s0[r_] : s1[r_]), e1_ = fexp2((st) < 2 ? s0[r_ + 1] : s1[r_ + 1]); rs0 += e0_; rs0 += e1_; asm volatile("" : "+v"(rs0)); pan[i] = cvtpk_s(e0_, e1_); } while (0)
#define TP_B(st, i) do { const int r_ = ((st) & 1) * 8 + 2 * (i); const float e0_ = fexp2((st) < 2 ? s2[r_] : s3[r_]), e1_ = fexp2((st) < 2 ? s2[r_ + 1] : s3[r_ + 1]); rs1 += e0_; rs1 += e1_; asm volatile("" : "+v"(rs1)); pbn[i] = cvtpk_s(e0_, e1_); } while (0)
    {
        const bf16x8 a1 = *(const LAS bf16x8*)(bsel + 32), bm = *(const LAS bf16x8*)(bsel + 16);
        bf16x8 qf[2], k0f, k1f;
#define RD_Q(d0)  qf[(d0) & 1] = *(const LAS bf16x8*)(qp + (d0) * 1024)
#define RD_K0(d0) k0f = *(const LAS bf16x8*)(kp + (((2 * (d0) + hi) ^ sw) << 4))
#define RD_K1(d0) k1f = *(const LAS bf16x8*)(kp + (((2 * (d0) + hi) ^ sw) << 4) + 4096)
        RD_Q(0); RD_K0(0); RD_K1(0); RD_Q(1);
        SB();
        s2 = __builtin_amdgcn_mfma_f32_32x32x16_bf16(a1, bm, f32x16{}, 0, 0, 0);
        asm volatile("s_nop 7" : "+v"(s0), "+v"(s1));
        hm_step(0, ma, mb, s0, s1); hm_step(1, ma, mb, s0, s1);
        SB();
        s3 = __builtin_amdgcn_mfma_f32_32x32x16_bf16(a1, bm, f32x16{}, 0, 0, 0);
        hm_step(2, ma, mb, s0, s1); hm_step(3, ma, mb, s0, s1); hm_step(4, ma, mb, s0, s1);
        SB();
        s2 = __builtin_amdgcn_mfma_f32_32x32x16_bf16(k0f, qf[0], s2, 0, 0, 0);
        RD_K0(1);
        hm_step(5, ma, mb, s0, s1); hm_step(6, ma, mb, s0, s1); hm_step(7, ma, mb, s0, s1);
        SB();
        s3 = __builtin_amdgcn_mfma_f32_32x32x16_bf16(k1f, qf[0], s3, 0, 0, 0);
        RD_K1(1); RD_Q(2);
        hm_step(8, ma, mb, s0, s1); hm_step(9, ma, mb, s0, s1); hm_step(10, ma, mb, s0, s1);
        SB();
        s2 = __builtin_amdgcn_mfma_f32_32x32x16_bf16(k0f, qf[1], s2, 0, 0, 0);
        RD_K0(2);
        hm_step(11, ma, mb, s0, s1); hm_step(12, ma, mb, s0, s1);
        SB();
        s3 = __builtin_amdgcn_mfma_f32_32x32x16_bf16(k1f, qf[1], s3, 0, 0, 0);
        RD_K1(2); RD_Q(3);
        hm_step(13, ma, mb, s0, s1); hm_step(14, ma, mb, s0, s1);
        SB();
        hm_finish(o0, m0, l0, ma, mb, s0, s1, wsf, bsel, first, lane);
        SB();
        s2 = __builtin_amdgcn_mfma_f32_32x32x16_bf16(k0f, qf[0], s2, 0, 0, 0);
        RD_K0(3);
        TP_A(0, 0);
        SB();
        s3 = __builtin_amdgcn_mfma_f32_32x32x16_bf16(k1f, qf[0], s3, 0, 0, 0);
        RD_K1(3);
        TP_A(0, 1);
        SB();
        s2 = __builtin_amdgcn_mfma_f32_32x32x16_bf16(k0f, qf[1], s2, 0, 0, 0);
        TP_A(0, 2);
        SB();
        s3 = __builtin_amdgcn_mfma_f32_32x32x16_bf16(k1f, qf[1], s3, 0, 0, 0);
        TP_A(0, 3);
        SB();
#undef RD_Q
#undef RD_K0
#undef RD_K1
#define QK_RD(x)
#undef QK_RD
    }
    pa = pan;
    asm volatile("s_nop 15\n\ts_nop 7" : "+v"(s2), "+v"(s3));
    ma = 0.f; mb = 0.f;
#pragma unroll
    for (int k = 0; k < 15; ++k) hm_step(k, ma, mb, s2, s3);
    hm_finish(o1, m1, l1, ma, mb, s2, s3, wsf, bsel + 16, first, lane);
#pragma unroll
    for (int i = 0; i < 4; ++i) TP_B(0, i);
    pb = pbn;
    const int li = lane & 15, g16 = lane >> 4;
    const LAS unsigned char* vp = vbuf + hi * 1024 + (li >> 2) * 64 + (16 * (g16 & 1) + 4 * (li & 3)) * 2;
    s16x4 flo[3], fhh[3];
#define TP_RD(c) do { flo[(c) % 3] = vtr(vp + (((c) & 15) >> 2) * 4096 + ((c) & 3) * 256); fhh[(c) % 3] = vtr(vp + (((c) & 15) >> 2) * 4096 + 2048 + ((c) & 3) * 256); } while (0)
#define TP_VF(c) ((bf16x8){flo[(c) % 3][0], flo[(c) % 3][1], flo[(c) % 3][2], flo[(c) % 3][3], fhh[(c) % 3][0], fhh[(c) % 3][1], fhh[(c) % 3][2], fhh[(c) % 3][3]})
    TP_RD(0); TP_RD(1);
    SB();
#pragma unroll
    for (int c = 0; c < 16; ++c) {
        const int st = c >> 2, d0 = c & 3;
        if (c + 2 < 16) TP_RD(c + 2);
        o0[d0] = __builtin_amdgcn_mfma_f32_32x32x16_bf16(__builtin_bit_cast(bf16x8, pa), TP_VF(c), o0[d0], 0, 0, 0);
        if (st < 3) TP_A(st + 1, d0);
        SB();
        o1[d0] = __builtin_amdgcn_mfma_f32_32x32x16_bf16(__builtin_bit_cast(bf16x8, pb), TP_VF(c), o1[d0], 0, 0, 0);
        if (st < 3) TP_B(st + 1, d0);
        SB();
        if (d0 == 3) { pa = pan; pb = pbn; }
    }
#undef TP_A
#undef TP_B
#undef TP_RD
#undef TP_VF
#undef SB
    l0 += rs0; l1 += rs1;
}
struct NoMask { __device__ __forceinline__ void operator()(f32x16&) const {} };

using pg8::Unit;
struct EpiZ {
    static constexpr bool PERM = true;
    bf16_t* Z; const float* ropec; const float* ropes;
    __device__ __forceinline__ void operator()(const f32x4 (&acc)[2][2][4][2], const Unit& u, int wr, int wc, int fr, int fq) const {
        const int pn = u.pn;
        const int type = (pn < 2) ? 0 : (pn < 4) ? 1 : (pn < 6) ? 2 : (pn == 6) ? 3 : (pn < 9) ? 2 : (pn < 12) ? 0 : (pn < 15) ? 1 : (pn < 18) ? 2 : 4;
        const int row0 = u.pm * 256 + wr * 64 + fr, col0 = pn * 256 + wc * 32 + 8 * fq;
        const int j0 = 16 * (wc & 1) + 4 * fq;
#pragma unroll
        for (int ai = 0; ai < 2; ++ai) {
            f32x4 cq[4], sq[4];
#pragma unroll
            for (int m = 0; m < 4; ++m) { const int pos = (row0 + ai * 128 + m * 16) & (SEQ - 1); cq[m] = (f32x4){1.f, 1.f, 1.f, 1.f}; sq[m] = (f32x4){0.f, 0.f, 0.f, 0.f};
                if (type < 2) { cq[m] = *(const f32x4*)(ropec + pos * 32 + j0); sq[m] = *(const f32x4*)(ropes + pos * 32 + j0); } }
#pragma unroll
            for (int m = 0; m < 4; ++m) {
                const int row = row0 + ai * 128 + m * 16;
                const f32x4 c4 = cq[m], s4 = sq[m];
                bf16_t* rowp = Z + (size_t)row * ZW + col0;
#pragma unroll
                for (int bj = 0; bj < 2; ++bj) {
                    f32x4 v0 = acc[ai][bj][m][0], v1 = acc[ai][bj][m][1];
                    if (type < 2) {
                        f32x4 w0, w1;
                        w0[0] = v0[0] * c4[0] - v0[1] * s4[0]; w0[1] = v0[1] * c4[0] + v0[0] * s4[0];
                        w0[2] = v0[2] * c4[1] - v0[3] * s4[1]; w0[3] = v0[3] * c4[1] + v0[2] * s4[1];
                        w1[0] = v1[0] * c4[2] - v1[1] * s4[2]; w1[1] = v1[1] * c4[2] + v1[0] * s4[2];
                        w1[2] = v1[2] * c4[3] - v1[3] * s4[3]; w1[3] = v1[3] * c4[3] + v1[2] * s4[3];
                        v0 = w0; v1 = w1;
                    }
                    if (type == 4) {
#pragma unroll
                        for (int j = 0; j < 4; ++j) { v0[j] = __builtin_fmaxf(frcp(1.f + fexp2(v0[j])), 0.f); v1[j] = __builtin_fmaxf(frcp(1.f + fexp2(v1[j])), 0.f); }
                    }
                    u32x4 w; w.x = cvt_pk_bf16(v0[0], v0[1]); w.y = cvt_pk_bf16(v0[2], v0[3]); w.z = cvt_pk_bf16(v1[0], v1[1]); w.w = cvt_pk_bf16(v1[2], v1[3]);
                    st16_wt(rowp + bj * 128, w);
                }
                CBAR();
            }
        }
    }
};
struct EpiProj {
    static constexpr bool PERM = true;
    bf16_t* Mg; const bf16_t* Zg0;
    __device__ __forceinline__ void operator()(const f32x4 (&acc)[2][2][4][2], const Unit& u, int wr, int wc, int fr, int fq) const {
        const int row0 = u.pm * 256 + wr * 64 + fr, col0 = u.pn * 256 + wc * 32 + 8 * fq;
        const bf16_t* Zg = Zg0 + (u.e & 15) * 1024; const int first = u.e >> 4;
#pragma unroll
        for (int ai = 0; ai < 2; ++ai) {
            u32x4 gq[4][2], oq[4][2];
#pragma unroll
            for (int m = 0; m < 4; ++m)
#pragma unroll
                for (int bj = 0; bj < 2; ++bj) { const int row = row0 + ai * 128 + m * 16, col = col0 + bj * 128;
                    gq[m][bj] = *(const u32x4*)(Zg + (size_t)row * ZW + col);
                    oq[m][bj] = first ? (u32x4){0u, 0u, 0u, 0u} : *(const u32x4*)(Mg + (size_t)row * D + col); }
#pragma unroll
            for (int m = 0; m < 4; ++m)
#pragma unroll
                for (int bj = 0; bj < 2; ++bj) { const int row = row0 + ai * 128 + m * 16, col = col0 + bj * 128;
                    const u32x4 g = gq[m][bj], o = oq[m][bj];
                    const f32x4 v0 = acc[ai][bj][m][0], v1 = acc[ai][bj][m][1];
                    const float r0 = bflo(g.x) * v0[0] + bflo(o.x), r1 = bfhi(g.x) * v0[1] + bfhi(o.x), r2 = bflo(g.y) * v0[2] + bflo(o.y), r3 = bfhi(g.y) * v0[3] + bfhi(o.y);
                    const float r4 = bflo(g.z) * v1[0] + bflo(o.z), r5 = bfhi(g.z) * v1[1] + bfhi(o.z), r6 = bflo(g.w) * v1[2] + bflo(o.w), r7 = bfhi(g.w) * v1[3] + bfhi(o.w);
                    u32x4 w; w.x = cvt_pk_bf16(r0, r1); w.y = cvt_pk_bf16(r2, r3); w.z = cvt_pk_bf16(r4, r5); w.w = cvt_pk_bf16(r6, r7);
                    *(u32x4*)(Mg + (size_t)row * D + col) = w; }
            CBAR();
        }
    }
};
struct EpiOut {
    static constexpr bool PERM = true;
    bf16_t* X; const float* gate;
    __device__ __forceinline__ void operator()(const f32x4 (&acc)[2][2][4][2], const Unit& u, int wr, int wc, int fr, int fq) const {
        const int row0 = u.pm * 256 + wr * 64 + fr, col0 = u.pn * 256 + wc * 32 + 8 * fq;
        const int b = (u.pm * 256) / SEQ;
        f32x4 gv[2][2];
#pragma unroll
        for (int bj = 0; bj < 2; ++bj)
#pragma unroll
            for (int n = 0; n < 2; ++n) gv[bj][n] = *(const f32x4*)(gate + (size_t)b * 6 * D + col0 + bj * 128 + 4 * n);
        u32x4 xq[2][4][2];
#pragma unroll
        for (int ai = 0; ai < 2; ++ai)
#pragma unroll
            for (int m = 0; m < 4; ++m)
#pragma unroll
                for (int bj = 0; bj < 2; ++bj) xq[ai][m][bj] = *(const u32x4*)(X + (size_t)(row0 + ai * 128 + m * 16) * D + col0 + bj * 128);
#pragma unroll
        for (int ai = 0; ai < 2; ++ai) {
#pragma unroll
            for (int m = 0; m < 4; ++m)
#pragma unroll
                for (int bj = 0; bj < 2; ++bj) { const u32x4 o = xq[ai][m][bj];
                    const f32x4 r0 = (f32x4){bflo(o.x), bfhi(o.x), bflo(o.y), bfhi(o.y)} + gv[bj][0] * acc[ai][bj][m][0], r1 = (f32x4){bflo(o.z), bfhi(o.z), bflo(o.w), bfhi(o.w)} + gv[bj][1] * acc[ai][bj][m][1];
                    u32x4 w; w.x = cvt_pk_bf16(r0[0], r0[1]); w.y = cvt_pk_bf16(r0[2], r0[3]); w.z = cvt_pk_bf16(r1[0], r1[1]); w.w = cvt_pk_bf16(r1[2], r1[3]);
                    *(u32x4*)(X + (size_t)(row0 + ai * 128 + m * 16) * D + col0 + bj * 128) = w; }
            CBAR();
        }
    }
};
struct EpiSwiglu {
    static constexpr bool PERM = true;
    bf16_t* H;
    __device__ __forceinline__ void operator()(const f32x4 (&acc)[2][2][4][2], const Unit& u, int wr, int wc, int fr, int fq) const {
        const int row0 = u.pm * 256 + wr * 64 + fr, hc = u.pn * 128 + wc * 32 + 8 * fq;
#pragma unroll
        for (int ai = 0; ai < 2; ++ai)
#pragma unroll
            for (int m = 0; m < 4; ++m) {
                const int row = row0 + ai * 128 + m * 16;
                float h[8];
#pragma unroll
                for (int n = 0; n < 2; ++n) { const f32x4 a = acc[ai][0][m][n], b = acc[ai][1][m][n];
#pragma unroll
                    for (int j = 0; j < 4; ++j) h[4 * n + j] = a[j] * frcp(1.f + fexp2(-a[j] * LOG2E)) * b[j]; }
                u32x4 w; w.x = cvt_pk_bf16(h[0], h[1]); w.y = cvt_pk_bf16(h[2], h[3]); w.z = cvt_pk_bf16(h[4], h[5]); w.w = cvt_pk_bf16(h[6], h[7]);
                st16_wt(H + (size_t)row * EH + hc, w);
            }
    }
};
struct EpiY {
    static constexpr bool PERM = true;
    bf16_t* Y;
    __device__ __forceinline__ void operator()(const f32x4 (&acc)[2][2][4][2], const Unit& u, int wr, int wc, int fr, int fq) const {
        const int row0 = u.pm * 256 + wr * 64 + fr, col0 = u.pn * 256 + wc * 32 + 8 * fq;
#pragma unroll
        for (int ai = 0; ai < 2; ++ai)
#pragma unroll
            for (int m = 0; m < 4; ++m) { bf16_t* rowp = Y + (size_t)(row0 + ai * 128 + m * 16) * D + col0;
#pragma unroll
                for (int bj = 0; bj < 2; ++bj) { const f32x4 v0 = acc[ai][bj][m][0], v1 = acc[ai][bj][m][1];
                    u32x4 w; w.x = cvt_pk_bf16(v0[0], v0[1]); w.y = cvt_pk_bf16(v0[2], v0[3]); w.z = cvt_pk_bf16(v1[0], v1[1]); w.w = cvt_pk_bf16(v1[2], v1[3]);
                    *(u32x4*)(rowp + bj * 128) = w; } }
    }
};

constexpr int NWAVES = 8;
constexpr int NPHASE = 2 + 9 * DEPTH;

__global__ void __launch_bounds__(NWAVES * 64, 2) fwd_kernel(Args args) {
    extern __shared__ __attribute__((aligned(16))) unsigned char lds_raw[];
    LAS unsigned char* lds = (LAS unsigned char*)lds_raw;
    volatile LAS unsigned* MISC = (volatile LAS unsigned*)(lds + MISC_OFF);
    const int tid0 = threadIdx.x;
    const int G = gridDim.x, bx = blockIdx.x;
    const int vcu = (G % 8 == 0) ? (bx % 8) * (G / 8) + bx / 8 : bx;
    const int NGW = G * NWAVES;
#define WSP() size_t wsz_ = 0; asm volatile("" : "+s"(wsz_)); unsigned char* ws = args.ws + wsz_; \
    int tid = tid0; asm volatile("" : "+v"(tid)); const int lane = tid & 63, wave = __builtin_amdgcn_readfirstlane(tid >> 6), hi = lane >> 5, gw = vcu * NWAVES + wave; (void)hi; (void)gw; (void)lane; (void)wave; \
    unsigned* ctl = (unsigned*)(ws + WS_CTL); float* rtab = (float*)(ws + WS_RT); (void)rtab; float* modp = (float*)(ws + WS_MOD); float* ropec = (float*)(ws + WS_ROPE); float* ropes = ropec + SEQ * 32; \
    int* tok_e = (int*)(ws + WS_ROUTE); int* tok_pos = tok_e + 2 * M; float* tok_w = (float*)(tok_pos + 2 * M); int* tok_slot = (int*)(tok_w + 2 * M); int* etok = (int*)(ws + WS_ROUTE + 2 * MiB); \
    bf16_t* X = (bf16_t*)(ws + WS_X); bf16_t* Hn = (bf16_t*)(ws + WS_H); bf16_t* OC = (bf16_t*)(ws + WS_OCAT); bf16_t* MG = (bf16_t*)(ws + WS_MERGED); bf16_t* Z = (bf16_t*)(ws + WS_Z); \
    bf16_t* XG = (bf16_t*)(ws + WS_XG); bf16_t* HB = (bf16_t*)(ws + WS_HB); bf16_t* YB = (bf16_t*)(ws + WS_YB); \
    bf16_t* WIN = (bf16_t*)(ws + WS_WIN); bf16_t* WPR = (bf16_t*)(ws + WS_WPROJ); bf16_t* WOU = (bf16_t*)(ws + WS_WOUT); bf16_t* W13 = (bf16_t*)(ws + WS_W13); bf16_t* W2 = (bf16_t*)(ws + WS_W2); \
    (void)ctl; (void)modp; (void)ropec; (void)ropes; (void)tok_e; (void)tok_pos; (void)tok_w; (void)tok_slot; (void)etok; (void)X; (void)Hn; (void)OC; (void)MG; (void)Z; (void)XG; (void)HB; (void)YB; (void)WIN; (void)WPR; (void)WOU; (void)W13; (void)W2;
    for (int u = tid0; u < 128; u += NWAVES * 64) MISC[u] = 0u;
    __syncthreads();
#if !MK_PER_PHASE
    XcdBarrier bar = xcd_barrier_post((unsigned*)(args.ws + WS_CTL) + CW_BAR, MISC + 8);
#define GRID_BAR() xcd_barrier(bar)
#else
#define GRID_BAR() do {} while (0)
#endif
    const int lo = args.ph_lo, hi_ph = args.ph_hi;
#define IN(k) (lo <= (k) && (k) < hi_ph)
#ifndef EN_MASK
#define EN_MASK 0x3ff
#endif
#define EN(k) ((EN_MASK >> (k)) & 1)
#ifndef DUPK
#define DUPK -1
#endif
#define REP(k) for (int rep_ = 0; rep_ < ((k) == DUPK ? 2 : 1); ++rep_, __syncthreads())
#define SEAM(k) do { if (IN(k) && IN((k) + 1)) GRID_BAR(); } while (0)

    if (IN(0) && EN(0)) REP(0) {
        WSP();
        {
            LAS float* cact = (LAS float*)lds;
            LAS float* part = (LAS float*)(lds + 16384);
            for (int i = tid; i < NBATCH * D; i += NWAVES * 64) { const int b = i / D, k = i % D; const float v = args.c[i]; cact[k * 4 + b] = v / (1.f + __expf(-v)); }
            __syncthreads();
            for (int it = bx; it < DEPTH * 96; it += G) {
                const int l = it / 96, cc = it % 96, col = cc * 64 + lane;
                const float* wp = args.ada_w + (size_t)l * D * 6 * D + col;
                float a0 = 0.f, a1 = 0.f, a2 = 0.f, a3 = 0.f;
#pragma unroll 1
                for (int k0 = 0; k0 < 128; k0 += 32) {
                    float wv[32];
#pragma unroll
                    for (int kk = 0; kk < 32; ++kk) wv[kk] = wp[(size_t)(wave * 128 + k0 + kk) * 6 * D];
#pragma unroll
                    for (int kk = 0; kk < 32; ++kk) { const f32x4 cv = *(const LAS f32x4*)(cact + (wave * 128 + k0 + kk) * 4);
                        a0 += cv[0] * wv[kk]; a1 += cv[1] * wv[kk]; a2 += cv[2] * wv[kk]; a3 += cv[3] * wv[kk]; } }
                part[(wave * 4 + 0) * 64 + lane] = a0; part[(wave * 4 + 1) * 64 + lane] = a1; part[(wave * 4 + 2) * 64 + lane] = a2; part[(wave * 4 + 3) * 64 + lane] = a3;
                __syncthreads();
                if (tid < 256) { const int b = tid >> 6, cl = tid & 63; float s = 0.f;
#pragma unroll
                    for (int w = 0; w < 8; ++w) s += part[(w * 4 + b) * 64 + cl];
                    modp[((size_t)l * NBATCH + b) * 6 * D + cc * 64 + cl] = s + args.ada_b[(size_t)l * 6 * D + cc * 64 + cl]; }
                __syncthreads();
            }
        }
        for (int i = (vcu * NWAVES * 64) + tid; i < SEQ * 32; i += G * NWAVES * 64) { const int pos = i >> 5, j = i & 31; float s, c; sincos_d((double)pos * ROPE_INV[j], s, c); ropec[i] = c; ropes[i] = s; }
        for (int i = (vcu * NWAVES * 64) + tid; i < DEPTH * 36 * D; i += G * NWAVES * 64) { const int k = i & (D - 1), n = (i >> 10) % 36, l2 = i / (36 * D);
            rtab[i] = n < 4 ? args.rgw[((size_t)l2 * D + k) * 4 + n] : args.rew[((size_t)l2 * D + k) * NEXP + (n - 4)]; }
        {
            LAS float* scr = (LAS float*)(lds + wave * 16384);
            constexpr int I_WIN = 16 * 240, I_PA = 8 * 32, I_PN = 4 * 32, I_WO = 16 * 32, I_E = 256, PER_L = I_WIN + I_PA + 2 * I_PN + I_WO + NEXP * 3 * I_E;
            for (int it = gw; it < DEPTH * PER_L; it += NGW) {
                const int l = it / PER_L; int r = it % PER_L;
                if (r < I_WIN) { tr_item(args.w_in + (size_t)l * D * ZW, ZW, WIN + (size_t)l * ZW * D, D, 0, 1, scr, r, lane); continue; } r -= I_WIN;
                if (r < I_PA) { tr_item(args.wpa + (size_t)l * 512 * D, D, WPR + (size_t)l * D * D, D, 0, 0, scr, r, lane); continue; } r -= I_PA;
                if (r < I_PN) { tr_item(args.wpn + (size_t)l * 256 * D, D, WPR + (size_t)l * D * D, D, 512, 0, scr, r, lane); continue; } r -= I_PN;
                if (r < I_PN) { tr_item(args.wpd + (size_t)l * 256 * D, D, WPR + (size_t)l * D * D, D, 768, 0, scr, r, lane); continue; } r -= I_PN;
                if (r < I_WO) { tr_item(args.w_out + (size_t)l * D * D, D, WOU + (size_t)l * D * D, D, 0, 0, scr, r, lane); continue; } r -= I_WO;
                const int e = r / (3 * I_E), q = r % (3 * I_E); const size_t le = (size_t)l * NEXP + e;
                if (q < I_E) tr_item(args.ew1 + le * D * EH, EH, W13 + le * 1024 * D, D, 0, 2, scr, q, lane);
                else if (q < 2 * I_E) tr_item(args.ew3 + le * D * EH, EH, W13 + le * 1024 * D, D, 0, 3, scr, q - I_E, lane);
                else tr_item(args.ew2 + le * EH * D, D, W2 + le * D * EH, EH, 0, 0, scr, q - 2 * I_E, lane);
            }
        }
    }
    SEAM(0);

    for (int l = 0; l < DEPTH; ++l) {
        const int pb = 1 + 9 * l;
        if (IN(pb + 0) && EN(1)) {
            WSP(); const float* modl = modp + (size_t)l * NBATCH * 6 * D; (void)modl;
            const float* gam = args.mix_g + (size_t)l * D;
            const float* modprev = modp + (size_t)(l > 0 ? l - 1 : 0) * NBATCH * 6 * D;
            constexpr int RPW = M / (256 * NWAVES); const int rbase = gw * RPW, b = rbase / SEQ;
            int slot_v = 0; float w_v = 0.f;
            if (l > 0) {
                const unsigned* cntp = ctl + CW_CNT + (l - 1) * NEXP * 64;
                const int cv = (lane < NEXP) ? (int)__hip_atomic_load(cntp + lane * 64, __ATOMIC_RELAXED, __HIP_MEMORY_SCOPE_AGENT) : 0;
                const int tl = (cv + 255) >> 8; int tstart = 0, run = 0;
#pragma unroll
                for (int e = 0; e < NEXP; ++e) { if (lane == e) tstart = run; run += __builtin_amdgcn_readlane(tl, e); }
                const int i = min(lane, 2 * RPW - 1);
                const int e = tok_e[2 * rbase + i], pos = tok_pos[2 * rbase + i]; w_v = tok_w[2 * rbase + i];
                slot_v = __builtin_amdgcn_ds_bpermute(4 * e, tstart) * 256 + pos;
            }
            f32x4 ca[4], cb[4], gf[4];
#pragma unroll
            for (int j = 0; j < 4; ++j) { const int col = 4 * lane + 256 * j;
                const f32x4 g4 = *(const f32x4*)(gam + col), sc = *(const f32x4*)(modl + (size_t)b * 6 * D + 1 * D + col), sh = *(const f32x4*)(modl + (size_t)b * 6 * D + col);
                ca[j] = g4 * (sc + 1.0f); cb[j] = sh; gf[j] = *(const f32x4*)(modprev + (size_t)b * 6 * D + 5 * D + col); }
#pragma unroll 1
            for (int r0 = rbase; r0 < rbase + RPW; r0 += 4) {
                f32x4 v[4][4];
                if (l == 0) {
#pragma unroll
                    for (int q = 0; q < 4; ++q)
#pragma unroll
                        for (int j = 0; j < 4; ++j) v[q][j] = *(const f32x4*)(args.x + (size_t)(r0 + q) * D + 4 * lane + 256 * j);
                } else {
                    u32x2 xr[4][4], y0[4][4], y1[4][4]; float w0[4], w1[4];
#pragma unroll
                    for (int q = 0; q < 4; ++q) { const int ix = 2 * (r0 - rbase + q);
                        const int s0 = __builtin_amdgcn_readlane(slot_v, ix), s1 = __builtin_amdgcn_readlane(slot_v, ix + 1);
                        w0[q] = __builtin_bit_cast(float, __builtin_amdgcn_readlane(__builtin_bit_cast(int, w_v), ix)); w1[q] = __builtin_bit_cast(float, __builtin_amdgcn_readlane(__builtin_bit_cast(int, w_v), ix + 1));
#pragma unroll
                        for (int j = 0; j < 4; ++j) { const int col = 4 * lane + 256 * j;
                            xr[q][j] = *(const u32x2*)(X + (size_t)(r0 + q) * D + col); y0[q][j] = *(const u32x2*)(YB + (size_t)s0 * D + col); y1[q][j] = *(const u32x2*)(YB + (size_t)s1 * D + col); } }
#pragma unroll
                    for (int q = 0; q < 4; ++q)
#pragma unroll
                        for (int j = 0; j < 4; ++j) { const f32x4 yy = bf4(y0[q][j]) * w0[q] + bf4(y1[q][j]) * w1[q]; v[q][j] = bf4(xr[q][j]) + gf[j] * yy; }
                }
#pragma unroll
                for (int q = 0; q < 4; ++q) { const int row = r0 + q;
                    float ss = 0.f;
#pragma unroll
                    for (int j = 0; j < 4; ++j) { u32x2 xw; xw.x = cvt_pk_bf16(v[q][j][0], v[q][j][1]); xw.y = cvt_pk_bf16(v[q][j][2], v[q][j][3]); *(u32x2*)(X + (size_t)row * D + 4 * lane + 256 * j) = xw;
                        ss += (v[q][j][0] * v[q][j][0] + v[q][j][1] * v[q][j][1]) + (v[q][j][2] * v[q][j][2] + v[q][j][3] * v[q][j][3]); }
                    const float rstd = __builtin_amdgcn_rsqf(wave_sum(ss) * (1.f / D) + NORM_EPS);
#pragma unroll
                    for (int j = 0; j < 4; ++j) { const int col = 4 * lane + 256 * j;
                        const f32x4 hv = v[q][j] * rstd * ca[j] + cb[j];
                        u32x2 w; w.x = cvt_pk_bf16(hv[0], hv[1]); w.y = cvt_pk_bf16(hv[2], hv[3]);
                        *(u32x2*)(Hn + (size_t)row * D + col) = w; }
                }
            }
        }
        SEAM(pb + 0);
        if (IN(pb + 1) && EN(2)) REP(2) {
            WSP(); const float* modl = modp + (size_t)l * NBATCH * 6 * D; (void)modl;
            pg8::Gemm g{Hn, WIN + (size_t)l * ZW * D, D, D, D}; pg8::StaticOrder S; S.init(M, ZW, G, bx);
            EpiZ E{Z, ropec, ropes};
            pg8::gemm_phase<EpiZ, pg8::StaticOrder>(lds, g, S, E);
        }
        SEAM(pb + 1);
        if (IN(pb + 2) && EN(3)) REP(3) {
            WSP(); const float* modl = modp + (size_t)l * NBATCH * 6 * D; (void)modl;
            {
                int tidm = tid0; asm volatile("" : "+v"(tidm)); const int lane = tidm & 63, hi = lane >> 5;
                LAS unsigned char* vlds = lds + wave * 12288; LAS float* wsf = (LAS float*)(lds + 98304 + wave * 256);
                const float* lp = args.da_lambda + (size_t)l * 4 * 64;
                const float s01 = wave_sum(lp[lane] * lp[64 + lane]), s23 = wave_sum(lp[128 + lane] * lp[192 + lane]);
                const float lam_init = 0.8f - 0.6f * __expf(-0.3f * (float)l);
                const float lam = __expf(s01) - __expf(s23) + lam_init;
                LAS float* wsfA = (LAS float*)(lds + 131072 + wave * 128);
                const unsigned lds0 = (unsigned)(uintptr_t)lds;
                for (int un = vcu; un < NBATCH * 4 * 16; un += G) {
                    const int b = un >> 6, h = (un >> 4) & 3, qb = un & 15;
                    const size_t rowbase = (size_t)b * SEQ; const int q0 = qb * 256 + wave * 32;
                    LAS unsigned char* qlds = lds + 65536 + wave * 8192;
                    { bf16x8 qf[8];
                      const bf16_t* qp = Z + (rowbase + q0 + (lane & 31)) * ZW + ZQA + h * 128 + 8 * hi;
#pragma unroll
                      for (int i = 0; i < 8; ++i) qf[i] = *(const bf16x8*)(qp + 16 * i);
                      asm volatile("s_waitcnt vmcnt(0)" : "+v"(qf[0]), "+v"(qf[1]), "+v"(qf[2]), "+v"(qf[3]), "+v"(qf[4]), "+v"(qf[5]), "+v"(qf[6]), "+v"(qf[7]) :: "memory");
#pragma unroll
                      for (int i = 0; i < 8; ++i) *(LAS bf16x8*)(qlds + i * 1024 + lane * 16) = qf[i]; }
                    f32x16 o0[4], o1[4];
#pragma unroll
                    for (int d0 = 0; d0 < 4; ++d0) { o0[d0] = f32x16{}; o1[d0] = f32x16{}; }
                    float m0 = 0.f, l0 = 0.f, m1 = 0.f, l1 = 0.f;
                    LAS unsigned char* bsel = lds + 132096 + (hi ? 0 : 64 + (wave * 32 + (lane & 31)) * 48);
                    { unsigned z0 = 0u, e0 = hi ? 0u : 0x3F80u; asm volatile("" : "+v"(z0), "+v"(e0));
                      *(LAS u32x4*)bsel = (u32x4){z0, z0, z0, z0}; *(LAS u32x4*)(bsel + 16) = (u32x4){z0, z0, z0, z0}; *(LAS u32x4*)(bsel + 32) = (u32x4){e0, z0, z0, z0}; }
                    const int krow = 8 * wave + (lane >> 3);
                    const unsigned koff = (unsigned)(((rowbase + krow) * ZW + ZKA + h * 128) * 2 + (((lane & 7) ^ ((krow >> 1) & 7)) << 4));
                    const unsigned voff = (unsigned)(((rowbase + 8 * wave + ((lane >> 2) & 3)) * ZW + ZVA + h * 128 + (4 * (lane >> 4) + (lane & 3)) * 8) * 2);
#define DIFF_DMA(t, bo) do { const char* zb_ = (const char*)Z + (size_t)(t) * 64 * ZW * 2; \
        glds16s(zb_, koff, (unsigned)__builtin_amdgcn_readfirstlane((int)(lds0 + ((bo) * 2 + 0) * 8192 + wave * 1024))); \
        glds16s(zb_ + 128, koff, (unsigned)__builtin_amdgcn_readfirstlane((int)(lds0 + ((bo) * 2 + 1) * 8192 + wave * 1024))); \
        glds16s(zb_, voff, (unsigned)__builtin_amdgcn_readfirstlane((int)(lds0 + 32768 + (bo) * 16384 + wave * 2048))); \
        glds16s(zb_ + (size_t)4 * ZW * 2, voff, (unsigned)__builtin_amdgcn_readfirstlane((int)(lds0 + 32768 + (bo) * 16384 + wave * 2048 + 1024))); } while (0)
#define DIFF_SYNC() do { asm volatile("s_waitcnt vmcnt(0) lgkmcnt(0)" ::: "memory"); __builtin_amdgcn_s_barrier(); asm volatile("" ::: "memory"); } while (0)
                    DIFF_DMA(0, 0);
#pragma unroll 1
                    for (int t = 0; t < SEQ / 64; ++t) {
                        const int bo = t & 1;
                        DIFF_SYNC();
                        if (t + 1 < SEQ / 64) DIFF_DMA(t + 1, bo ^ 1);
                        diffA_step(o0, o1, m0, l0, m1, l1, qlds, lds + (bo * 2 + 0) * 8192, lds + (bo * 2 + 1) * 8192, lds + 32768 + bo * 16384, bsel, wsfA, t == 0, lane);
                    }
                    DIFF_SYNC();
#undef DIFF_DMA
#undef DIFF_SYNC
                    int lane_e = lane; asm volatile("" : "+v"(lane_e)); const int hi_e = lane_e >> 5;
                    attn_finish<4>(o0, l0, wsfA, lane_e, hi_e);
                    attn_finish<4>(o1, l1, wsfA, lane_e, hi_e);
                    const float* sg = args.da_subln + (size_t)l * 128;
                    float g4[4];
#pragma unroll
                    for (int d0 = 0; d0 < 4; ++d0) g4[d0] = sg[32 * d0 + (lane_e & 31)] * (1.0f - lam_init);
#pragma unroll
                    for (int r0 = 0; r0 < 16; r0 += 4) {
                        float ov[4][4], ss[4], tt[4];
#pragma unroll
                        for (int k = 0; k < 4; ++k) {
#pragma unroll
                            for (int d0 = 0; d0 < 4; ++d0) ov[k][d0] = o0[d0][r0 + k] - lam * o1[d0][r0 + k];
                            ss[k] = ov[k][0] * ov[k][0] + ov[k][1] * ov[k][1] + ov[k][2] * ov[k][2] + ov[k][3] * ov[k][3]; }
#pragma unroll
                        for (int k = 0; k < 4; ++k) ss[k] += dpp_f<0xB1>(ss[k]);
#pragma unroll
                        for (int k = 0; k < 4; ++k) ss[k] += dpp_f<0x4E>(ss[k]);
#pragma unroll
                        for (int k = 0; k < 4; ++k) ss[k] += dpp_f<0x141>(ss[k]);
#pragma unroll
                        for (int k = 0; k < 4; ++k) ss[k] += dpp_f<0x140>(ss[k]);
#pragma unroll
                        for (int k = 0; k < 4; ++k) tt[k] = xor_lane<16>(ss[k]);
#pragma unroll
                        for (int k = 0; k < 4; ++k) { const int r = r0 + k;
                            const float rn = __builtin_amdgcn_rsqf((ss[k] + tt[k]) * (1.f / 128.f) + NORM_EPS);
                            bf16_t* op = OC + (rowbase + q0 + crow(r, hi_e)) * D + h * 128 + (lane_e & 31);
#pragma unroll
                            for (int d0 = 0; d0 < 4; ++d0) { const float ovn = ov[k][d0] * rn * g4[d0]; op[32 * d0] = (bf16_t)(cvt_pk_bf16(ovn, ovn) & 0xffffu); } }
                    }
                }
                asm volatile("s_waitcnt vmcnt(0) lgkmcnt(0)" ::: "memory"); __builtin_amdgcn_s_barrier();
            }
            {
                int tidm = tid0; asm volatile("" : "+v"(tidm)); const int lane = tidm & 63, hi = lane >> 5;
                LAS unsigned char* vlds = lds + wave * 12288; LAS float* wsf = (LAS float*)(lds + 98304 + wave * 256);
                LAS float* tab = (LAS float*)(lds + 100352);
                { const float* rpb = args.na_rpb + (size_t)l * 4 * 15 * 31;
                  for (int i = wave * 64 + lane; i < 4 * 15 * 128; i += NWAVES * 64) { const int j = (i & 127) - 48, hb = i >> 7; tab[i] = (j >= 0 && j <= 30) ? rpb[hb * 31 + j] * LOG2E : 0.f; } }
                asm volatile("s_waitcnt vmcnt(0) lgkmcnt(0)" ::: "memory"); __builtin_amdgcn_s_barrier(); asm volatile("" ::: "memory");
                const char* zb = (const char*)Z;
                for (int wu = gw; wu < NBATCH * 4 * 64 * 2; wu += NGW) {
                    const int half = wu & 1, gr = (wu >> 1) & 63, h = (wu >> 7) & 3, b = wu >> 9;
                    const int rowb = b * SEQ; const int c0 = half * 32, cq = c0 + (lane & 31);
                    const int kr0 = min(max(gr - 4, 0), 56), cs = min(max(cq - 8, 0), 48);
                    bf16x8 qf[4];
                    { const unsigned qoff = (unsigned)(((rowb + gr * 64 + cq) * ZW + ZQN + h * 64 + 8 * hi) * 2);
#pragma unroll
                      for (int d0 = 0; d0 < 4; ++d0) qf[d0] = *(const bf16x8*)(zb + (size_t)(qoff + 32u * d0)); }
                    f32x16 o[2]; o[0] = f32x16{}; o[1] = f32x16{};
                    float mrun = NEGBIG, lrun = 0.f;
                    const unsigned kcol = (unsigned)((ZKN + h * 64) * 2), vcol = (unsigned)((ZVN + h * 64) * 2);
                    unsigned rb0[4];
#pragma unroll
                    for (int i = 0; i < 4; ++i) rb0[i] = (unsigned)((rowb + (kr0 + (i >> 1)) * 64 + 16 * half + 8 * (i & 1) + (lane >> 3)) * ZW * 2);
                    TileRegs<64> cur;
                    tile_load<64>(cur, zb, rb0, kcol, vcol);
#pragma unroll 1
                    for (int t = 0, rp = 0, cc = 0; t < 12; ++t) {
                        const int kr = kr0 + 2 * rp, chunk = half + cc;
                        const int cn = (cc == 2) ? 0 : cc + 1, rn = (cc == 2) ? rp + 1 : rp;
                        auto reload = [&](TileRegs<64>& T) { const unsigned adv = (unsigned)((t + 1 < 12) ? (2 * rn * 64 + 16 * cn) : (2 * rp * 64 + 16 * cc)) * (ZW * 2u); unsigned rr[4];
#pragma unroll
                          for (int i = 0; i < 4; ++i) rr[i] = rb0[i] + adv;
                          tile_load<64>(T, zb, rr, kcol, vcol); };
                        const LAS float* bp = tab + (h * 15 + (kr - gr + 7)) * 128 + (16 * chunk + 4 * hi - cq + 63);
                        const int u0 = 16 * chunk + 4 * hi - cs;
                        auto maskf = [&](f32x16& p) {
#pragma unroll
                            for (int r = 0; r < 16; ++r) { const int co = (r & 3) + 8 * (r >> 2);
                                const float bv = bp[(co >> 4) * 128 + (co & 15)]; p[r] = ((unsigned)(u0 + (co & 15)) <= 15u) ? bv : NEGBIG; }
                        };
                        attn_tile<64>(o, mrun, lrun, qf, cur, vlds, wsf, maskf, reload, lane, hi);
                        cc = cn; rp = rn;
                    }
                    attn_finish<2>(o, lrun, wsf, lane, hi);
#pragma unroll
                    for (int r = 0; r < 16; ++r) { bf16_t* op = OC + (size_t)(rowb + gr * 64 + c0 + crow(r, hi)) * D + 512 + h * 64 + (lane & 31);
                        const unsigned w = cvt_pk_bf16(o[0][r], o[1][r]); op[0] = (bf16_t)(w & 0xffffu); op[32] = (bf16_t)(w >> 16); }
                }
            }
            {
                int tidm = tid0; asm volatile("" : "+v"(tidm)); const int lane = tidm & 63, hi = lane >> 5;
                LAS unsigned char* vlds = lds + wave * 12288; LAS float* wsf = (LAS float*)(lds + 98304 + wave * 256);
                const char* zb = (const char*)Z;
                for (int wu = gw; wu < NBATCH * 4 * 8 * 16; wu += NGW) {
                    const int rho = wu & 15, sb = (wu >> 4) & 7, hs = (wu >> 7) & 3, b = wu >> 9;
                    const int rowb = b * SEQ; const int qi = lane & 31; const int tq = 512 * sb + rho + 16 * qi;
                    f32x16 o[2]; o[0] = f32x16{}; o[1] = f32x16{};
                    float mrun = NEGBIG, lrun = 0.f;
                    const unsigned qoff0 = (unsigned)(((rowb + tq) * ZW + ZQD + hs * 64 + 8 * hi) * 2);
                    TileRegs<64> cur;
                    { const int kb0 = 512 * sb + rho - 64;
                      unsigned rr[4];
#pragma unroll
                      for (int i = 0; i < 4; ++i) rr[i] = (unsigned)((rowb + min(max(kb0 + 8 * i + (lane >> 3), 0), SEQ - 1)) * ZW * 2);
                      tile_load<64>(cur, zb, rr, (unsigned)((ZKD + hs * 64) * 2), (unsigned)((ZVD + hs * 64) * 2)); }
#pragma unroll 1
                    for (int gi = 0; gi < 3; ++gi) {
                        const int sh = 2 * gi, res = rho & ((1 << sh) - 1), qa = (512 * sb + rho) >> sh, qk = qa + (16 >> sh) * qi, nsub = SEQ >> sh, ntile = (gi == 0) ? 20 : (gi == 1) ? 8 : 5;
                        const int lo_v = max(qk - 64, 0), span = min(qk + 64, nsub - 1) - lo_v;
                        const unsigned kcol = (unsigned)((ZKD + gi * 256 + hs * 64) * 2), vcol = (unsigned)((ZVD + gi * 256 + hs * 64) * 2), rbase = (unsigned)((rowb + res) * ZW * 2);
                        const int sh2 = sh + 2, res2 = rho & ((1 << sh2) - 1), kbn = ((512 * sb + rho) >> sh2) - 64, nsub2 = SEQ >> sh2;
                        bf16x8 qf[4];
#pragma unroll
                        for (int d0 = 0; d0 < 4; ++d0) qf[d0] = *(const bf16x8*)(zb + (size_t)(qoff0 + (unsigned)(gi * 512) + 32u * d0));
                        int kb = qa - 64;
#pragma unroll 1
                        for (int t = 0; t < ntile; ++t, kb += 32) {
                            auto reload = [&](TileRegs<64>& T) { const bool same = (t + 1 < ntile); const int kbx = same ? kb + 32 : kbn, nsx = same ? nsub : nsub2, shx = same ? sh : sh2;
                              const unsigned rbx = same ? rbase : (unsigned)((rowb + res2) * ZW * 2), kcx = same ? kcol : kcol + 512u, vcx = same ? vcol : vcol + 512u; unsigned rr[4];
                              if (kbx >= 0 && kbx + 32 <= nsx) {
                                  const unsigned b0 = rbx + __umul24((unsigned)((kbx + (lane >> 3)) << shx), ZW * 2u), inc = (8u << shx) * (ZW * 2u);
#pragma unroll
                                  for (int i = 0; i < 4; ++i) rr[i] = b0 + (unsigned)i * inc;
                              } else {
#pragma unroll
                                  for (int i = 0; i < 4; ++i) rr[i] = rbx + __umul24((unsigned)(min(max(kbx + 8 * i + (lane >> 3), 0), nsx - 1) << shx), ZW * 2u);
                              }
                              tile_load<64>(T, zb, rr, kcx, vcx); };
                            const int u0 = kb + 4 * hi - lo_v;
                            auto maskf = [&](f32x16& p) {
#pragma unroll
                                for (int r = 0; r < 16; ++r) { const int co = (r & 3) + 8 * (r >> 2); p[r] = ((unsigned)(u0 + co) <= (unsigned)span) ? 0.f : NEGBIG; }
                            };
                            attn_tile<64>(o, mrun, lrun, qf, cur, vlds, wsf, maskf, reload, lane, hi);
                        }
                    }
                    attn_finish<2>(o, lrun, wsf, lane, hi);
#pragma unroll
                    for (int r = 0; r < 16; ++r) { bf16_t* op = OC + (size_t)(rowb + 512 * sb + rho + 16 * crow(r, hi)) * D + 768 + hs * 64 + (lane & 31);
                        const unsigned w = cvt_pk_bf16(o[0][r], o[1][r]); op[0] = (bf16_t)(w & 0xffffu); op[32] = (bf16_t)(w >> 16); }
                }
            }
        }
        SEAM(pb + 2);
        if (IN(pb + 3) && EN(4)) REP(4) {
            WSP(); const float* modl = modp + (size_t)l * NBATCH * 6 * D; (void)modl;
            pg8::StaticOrder S0; S0.init(M, D, G, bx); pg8::Unit u0; pg8::ProjOrder S; S.pm = 0; S.pn = 0; S.rot = bx & 1;
            const bool have = S0.next(0, u0); S.pm = u0.pm; S.pn = u0.pn;
            if (have) { pg8::Gemm g{OC, WPR + (size_t)l * D * D, D, D, D}; EpiProj E{MG, Z + ZG}; pg8::gemm_phase<EpiProj, pg8::ProjOrder>(lds, g, S, E); }
        }
        SEAM(pb + 3);
        if (IN(pb + 4) && EN(5)) {
            WSP(); const float* modl = modp + (size_t)l * NBATCH * 6 * D; (void)modl;
            pg8::Gemm g{MG, WOU + (size_t)l * D * D, D, D, D}; pg8::StaticOrder S; S.init(M, D, G, bx);
            EpiOut E{X, modl + 2 * D};
            pg8::gemm_phase<EpiOut, pg8::StaticOrder>(lds, g, S, E);
        }
        SEAM(pb + 4);
        if (IN(pb + 5) && EN(6)) {
            WSP(); const float* modl = modp + (size_t)l * NBATCH * 6 * D; (void)modl;
            LAS float* rt = (LAS float*)lds;
            LAS unsigned* lcnt = (LAS unsigned*)(lds + MISC_OFF) + 16;
            LAS unsigned* lbase = lcnt + 32;
            { const float* rsrc = rtab + (size_t)l * 36 * D + 4 * lane; const unsigned lds0 = (unsigned)(uintptr_t)lds;
              for (int pc = wave; pc < 144; pc += NWAVES) glds16(rsrc + (pc >> 2) * D + (pc & 3) * 256, (unsigned)__builtin_amdgcn_readfirstlane((int)(lds0 + (pc >> 2) * (RT_LD * 4) + (pc & 3) * 1024)));
              if (tid < 64) lcnt[tid] = 0u;
              if (tid < 36) rt[tid * RT_LD + D] = tid < 4 ? args.rgb[(size_t)l * 4 + tid] : args.reb[(size_t)l * NEXP + tid - 4];
              asm volatile("s_waitcnt vmcnt(0)" ::: "memory");
            }
            __syncthreads();
            const float* gam = args.ffn_g + (size_t)l * D;
            unsigned* cnt = ctl + CW_CNT + l * NEXP * 64;
            int myE0 = 0, myE1 = 0, myP0 = 0, myP1 = 0, myRow = -1; float myW0 = 0.f, myW1 = 0.f; int nrow = 0;
            f32x4 v[4][4], vn[4][4];
            constexpr int RPW = M / (256 * NWAVES); const int rbase = gw * RPW;
            f32x4 ca[4], cb[4];
            { const int b = rbase / SEQ;
#pragma unroll
              for (int j = 0; j < 4; ++j) { const int col = 4 * lane + 256 * j;
                  const f32x4 g4 = *(const f32x4*)(gam + col), sc = *(const f32x4*)(modl + (size_t)b * 6 * D + 4 * D + col), sh = *(const f32x4*)(modl + (size_t)b * 6 * D + 3 * D + col);
                  ca[j] = g4 * (sc + 1.0f); cb[j] = sh; } }
#define T2_LOAD(dst, rb) do { _Pragma("unroll") for (int q = 0; q < 4; ++q) { const int row = min((rb) + q, M - 1); \
                _Pragma("unroll") for (int j = 0; j < 4; ++j) dst[q][j] = bf4(*(const u32x2*)(X + (size_t)row * D + 4 * lane + 256 * j)); } } while (0)
            T2_LOAD(v, rbase);
#pragma unroll 1
            for (int r0 = rbase; r0 < rbase + RPW; r0 += 4) {
                T2_LOAD(vn, min(r0 + 4, M - 4));
                float ssq[4];
#pragma unroll
                for (int q = 0; q < 4; ++q) { f32x2 s2 = {0.f, 0.f};
#pragma unroll
                    for (int j = 0; j < 4; ++j) { const f32x2 lo = {v[q][j][0], v[q][j][1]}, hi2 = {v[q][j][2], v[q][j][3]}; s2 = lo * lo + s2; s2 = hi2 * hi2 + s2; }
                    ssq[q] = s2[0] + s2[1]; }
                wave_sum4_u(ssq[0], ssq[1], ssq[2], ssq[3]);
#pragma unroll
                for (int q = 0; q < 4; ++q) {
                    const int row = r0 + q;
                    const float rstd = __builtin_amdgcn_rsqf(ssq[q] * (1.f / D) + NORM_EPS);
#pragma unroll
                    for (int j = 0; j < 4; ++j) { const int col = 4 * lane + 256 * j;
                        v[q][j] = v[q][j] * rstd * ca[j] + cb[j];
                        u32x2 w; w.x = cvt_pk_bf16(v[q][j][0], v[q][j][1]); w.y = cvt_pk_bf16(v[q][j][2], v[q][j][3]);
                        *(u32x2*)(Hn + (size_t)row * D + col) = w; }
                }
                float LG[4][4];
#pragma unroll
                for (int n = 0; n < 4; ++n) { f32x2 c0 = {0.f, 0.f}, c1 = c0, c2 = c0, c3 = c0;
#pragma unroll
                    for (int j = 0; j < 4; ++j) { const f32x4 wv = *(const LAS f32x4*)(rt + n * RT_LD + 4 * lane + 256 * j); const f32x2 wl = {wv[0], wv[1]}, wh = {wv[2], wv[3]};
                        c0 = wl * (f32x2){v[0][j][0], v[0][j][1]} + c0; c0 = wh * (f32x2){v[0][j][2], v[0][j][3]} + c0;
                        c1 = wl * (f32x2){v[1][j][0], v[1][j][1]} + c1; c1 = wh * (f32x2){v[1][j][2], v[1][j][3]} + c1;
                        c2 = wl * (f32x2){v[2][j][0], v[2][j][1]} + c2; c2 = wh * (f32x2){v[2][j][2], v[2][j][3]} + c2;
                        c3 = wl * (f32x2){v[3][j][0], v[3][j][1]} + c3; c3 = wh * (f32x2){v[3][j][2], v[3][j][3]} + c3; }
                    float a0 = c0[0] + c0[1], a1 = c1[0] + c1[1], a2 = c2[0] + c2[1], a3 = c3[0] + c3[1];
                    wave_sum4_u(a0, a1, a2, a3);
                    const float bgn = rt[n * RT_LD + D]; LG[0][n] = a0 + bgn; LG[1][n] = a1 + bgn; LG[2][n] = a2 + bgn; LG[3][n] = a3 + bgn; }
#pragma unroll
                for (int q = 0; q < 4; ++q) {
                    const int row = r0 + q;
                    int gsel = 0; float gmx = LG[q][0];
#pragma unroll
                    for (int i = 1; i < 4; ++i) if (LG[q][i] > gmx) { gmx = LG[q][i]; gsel = i; }
                    gsel = __builtin_amdgcn_readfirstlane(gsel);
                    float gsum = 0.f;
#pragma unroll
                    for (int i = 0; i < 4; ++i) gsum += __expf(LG[q][i] - gmx);
                    const float pg = frcp(gsum);
                    float le[8];
                    const LAS float* rte = rt + (4 + 8 * gsel) * RT_LD + 4 * lane;
#pragma unroll
                    for (int j8 = 0; j8 < 8; ++j8) { f32x2 c = {0.f, 0.f};
#pragma unroll
                        for (int j = 0; j < 4; ++j) { const f32x4 wv = *(const LAS f32x4*)(rte + j8 * RT_LD + 256 * j);
                            c = (f32x2){wv[0], wv[1]} * (f32x2){v[q][j][0], v[q][j][1]} + c; c = (f32x2){wv[2], wv[3]} * (f32x2){v[q][j][2], v[q][j][3]} + c; }
                        le[j8] = c[0] + c[1]; }
                    wave_sum4_u(le[0], le[1], le[2], le[3]); wave_sum4_u(le[4], le[5], le[6], le[7]);
#pragma unroll
                    for (int j8 = 0; j8 < 8; ++j8) le[j8] += rte[j8 * RT_LD + D - 4 * lane];
                    int e0 = 0; float m0 = le[0];
#pragma unroll
                    for (int j = 1; j < 8; ++j) if (le[j] > m0) { m0 = le[j]; e0 = j; }
                    int e1 = (e0 == 0) ? 1 : 0; float m1 = -3.0e38f;
#pragma unroll
                    for (int j = 0; j < 8; ++j) if (j != e0 && le[j] > m1) { m1 = le[j]; e1 = j; }
                    const float a1 = __expf(m1 - m0), inv = frcp(1.0f + a1);
                    const float w0 = pg * inv, w1 = pg * a1 * inv;
                    const int E0 = gsel * 8 + e0, E1 = gsel * 8 + e1;
                    if (row < M) {
                        unsigned p0 = 0, p1 = 0;
                        if (lane == 0) { p0 = __hip_atomic_fetch_add(lcnt + E0, 1u, __ATOMIC_RELAXED, __HIP_MEMORY_SCOPE_WORKGROUP); p1 = __hip_atomic_fetch_add(lcnt + E1, 1u, __ATOMIC_RELAXED, __HIP_MEMORY_SCOPE_WORKGROUP); }
                        p0 = __builtin_amdgcn_readfirstlane(p0); p1 = __builtin_amdgcn_readfirstlane(p1);
                        if (lane == nrow) { myE0 = E0; myE1 = E1; myP0 = (int)p0; myP1 = (int)p1; myW0 = w0; myW1 = w1; myRow = row; }
                        ++nrow;
                    }
                }
#pragma unroll
                for (int q = 0; q < 4; ++q)
#pragma unroll
                    for (int j = 0; j < 4; ++j) v[q][j] = vn[q][j];
            }
#undef T2_LOAD
            __syncthreads();
            if (tid < NEXP) { const unsigned c = lcnt[tid]; lbase[tid] = c ? __hip_atomic_fetch_add(cnt + tid * 64, c, __ATOMIC_RELAXED, __HIP_MEMORY_SCOPE_AGENT) : 0u; }
            __syncthreads();
            if (myRow >= 0) { const int q0 = myP0 + (int)lbase[myE0], q1 = myP1 + (int)lbase[myE1]; etok[myE0 * 16384 + q0] = myRow; etok[myE1 * 16384 + q1] = myRow;
                              tok_e[2 * myRow] = myE0; tok_e[2 * myRow + 1] = myE1; tok_pos[2 * myRow] = q0; tok_pos[2 * myRow + 1] = q1;
                              tok_w[2 * myRow] = myW0; tok_w[2 * myRow + 1] = myW1; }
            __syncthreads();
        }
        SEAM(pb + 5);
        if (IN(pb + 8) && EN(8)) {
            WSP();
            const unsigned* cnt = ctl + CW_CNT + l * NEXP * 64; unsigned* tcl = ctl + CW_TILE + l * MAXTILES * 16;
            int n1, n3, n4, R;
            int a_pm, a_pn, a_e, a_ts, a_cn, b_pm, b_pn, b_e, b_ts, b_cn, c_pm, c_pn, c_e, c_ts, c_cn;
            int d_pm, d_pn, d_e, d_ts, d_cn, e_pm, e_pn, e_e, e_ts, e_cn, f_pm, f_pn, f_e, f_ts, f_cn, g_pm, g_pn, g_e, g_ts, g_cn;
            {
                const int cv = (lane < NEXP) ? (int)__hip_atomic_load(cnt + lane * 64, __ATOMIC_RELAXED, __HIP_MEMORY_SCOPE_AGENT) : 0;
                const int tl = (cv + 255) >> 8; int tend = 0, ntile = 0;
#pragma unroll
                for (int e = 0; e < NEXP; ++e) { ntile += __builtin_amdgcn_readlane(tl, e); if (lane == e) tend = ntile; }
                const int U = 4 * ntile, nA = min(U, 2 * G), Nf = G - min(U - nA, G), nB = min(nA, 2 * Nf); R = min(U - nA, G);
                auto moe_unit = [&](int v, int& pm, int& pn, int& e, int& ts, int& cn) { const int t = min(v >> 2, ntile - 1); pm = t; pn = v & 3;
                    e = min((int)__builtin_popcountll(__ballot(lane < NEXP && tend <= t)), NEXP - 1); ts = __builtin_amdgcn_readlane(tend - tl, e); cn = max(__builtin_amdgcn_readlane(cv, e), 1); };
                moe_unit(vcu, a_pm, a_pn, a_e, a_ts, a_cn); moe_unit(G + vcu, b_pm, b_pn, b_e, b_ts, b_cn); moe_unit(nA + vcu, c_pm, c_pn, c_e, c_ts, c_cn);
                n1 = (vcu < nA ? 1 : 0) + (G + vcu < nA ? 1 : 0);
                const int v3 = vcu - R, v4 = nB + vcu;
                moe_unit(v3, d_pm, d_pn, d_e, d_ts, d_cn); moe_unit(v3 + Nf, e_pm, e_pn, e_e, e_ts, e_cn); n3 = (vcu >= R) ? (v3 < nB ? 1 : 0) + (v3 + Nf < nB ? 1 : 0) : 0;
                moe_unit(v4, f_pm, f_pn, f_e, f_ts, f_cn); moe_unit(v4 + G, g_pm, g_pn, g_e, g_ts, g_cn); n4 = (v4 < U ? 1 : 0) + (v4 + G < U ? 1 : 0);
            }
#define MOE_M1(n_, p0, p1) do { const pg8::MoeOrder S{(n_), p0##pm, p1##pm, p0##pn, p1##pn, p0##e, p1##e, (size_t)1024 * D * 2, p0##ts, p1##ts, p0##cn, p1##cn, etok, tcl}; \
            pg8::Gemm g{Hn, W13 + (size_t)l * NEXP * 1024 * D, D, D, D};            \
            EpiSwiglu E{HB}; pg8::gemm_phase<EpiSwiglu, pg8::MoeOrder, true, true, true>(lds, g, S, E); } while (0)
#define MOE_M2(n_, p0, p1) do { \
            if (wave == 0) { const int tb_ = (n_) > 1 ? p1##pm : p0##pm; unsigned sp_ = 0; \
                while ((unsigned)__builtin_amdgcn_readfirstlane((int)__hip_atomic_load(tcl + p0##pm * 16, __ATOMIC_RELAXED, __HIP_MEMORY_SCOPE_AGENT)) < 32u && ++sp_ < XB_SPIN_CAP) __builtin_amdgcn_s_sleep(2); \
                while ((unsigned)__builtin_amdgcn_readfirstlane((int)__hip_atomic_load(tcl + tb_ * 16, __ATOMIC_RELAXED, __HIP_MEMORY_SCOPE_AGENT)) < 32u && ++sp_ < XB_SPIN_CAP) __builtin_amdgcn_s_sleep(2); \
                __builtin_amdgcn_fence(__ATOMIC_ACQUIRE, "agent"); asm volatile("s_waitcnt vmcnt(0)" ::: "memory"); }        \
            __syncthreads(); \
            const pg8::MoeOrder S{(n_), p0##pm, p1##pm, p0##pn, p1##pn, p0##e, p1##e, (size_t)D * EH * 2, p0##ts, p1##ts, p0##cn, p1##cn, etok, nullptr}; \
            pg8::Gemm g{HB, W2 + (size_t)l * NEXP * D * EH, EH, EH, EH}; \
            EpiY E{YB}; pg8::gemm_phase<EpiY, pg8::MoeOrder>(lds, g, S, E); } while (0)
            if (n1) MOE_M1(n1, a_, b_);
            if (vcu < R) MOE_M1(1, c_, c_);
            if (n3) MOE_M2(n3, d_, e_);
            if (n4) MOE_M2(n4, f_, g_);
#undef MOE_M1
#undef MOE_M2
        }
        SEAM(pb + 8);
    }
    if (IN(NPHASE - 1) && EN(9)) {
        WSP();
        const float* modprev = modp + (size_t)(DEPTH - 1) * NBATCH * 6 * D;
        constexpr int RPW = M / (256 * NWAVES); const int rbase = gw * RPW, b = rbase / SEQ;
        int slot_v = 0; float w_v = 0.f;
        { const unsigned* cntp = ctl + CW_CNT + (DEPTH - 1) * NEXP * 64;
          const int cv = (lane < NEXP) ? (int)__hip_atomic_load(cntp + lane * 64, __ATOMIC_RELAXED, __HIP_MEMORY_SCOPE_AGENT) : 0;
          const int tl = (cv + 255) >> 8; int tstart = 0, run = 0;
#pragma unroll
          for (int e = 0; e < NEXP; ++e) { if (lane == e) tstart = run; run += __builtin_amdgcn_readlane(tl, e); }
          const int i = min(lane, 2 * RPW - 1);
          const int e = tok_e[2 * rbase + i], pos = tok_pos[2 * rbase + i]; w_v = tok_w[2 * rbase + i];
          slot_v = __builtin_amdgcn_ds_bpermute(4 * e, tstart) * 256 + pos; }
        f32x4 gf[4], fg[4];
#pragma unroll
        for (int j = 0; j < 4; ++j) { const int col = 4 * lane + 256 * j; gf[j] = *(const f32x4*)(modprev + (size_t)b * 6 * D + 5 * D + col); fg[j] = *(const f32x4*)(args.fin_g + col); }
#pragma unroll 1
        for (int r0 = rbase; r0 < rbase + RPW; r0 += 4) {
            u32x2 xr[4][4], y0[4][4], y1[4][4]; float w0[4], w1[4];
#pragma unroll
            for (int q = 0; q < 4; ++q) { const int ix = 2 * (r0 - rbase + q);
                const int s0 = __builtin_amdgcn_readlane(slot_v, ix), s1 = __builtin_amdgcn_readlane(slot_v, ix + 1);
                w0[q] = __builtin_bit_cast(float, __builtin_amdgcn_readlane(__builtin_bit_cast(int, w_v), ix)); w1[q] = __builtin_bit_cast(float, __builtin_amdgcn_readlane(__builtin_bit_cast(int, w_v), ix + 1));
#pragma unroll
                for (int j = 0; j < 4; ++j) { const int col = 4 * lane + 256 * j;
                    xr[q][j] = *(const u32x2*)(X + (size_t)(r0 + q) * D + col); y0[q][j] = *(const u32x2*)(YB + (size_t)s0 * D + col); y1[q][j] = *(const u32x2*)(YB + (size_t)s1 * D + col); } }
#pragma unroll
            for (int q = 0; q < 4; ++q) { const int row = r0 + q;
                f32x4 v[4]; float ss = 0.f;
#pragma unroll
                for (int j = 0; j < 4; ++j) { const f32x4 yy = bf4(y0[q][j]) * w0[q] + bf4(y1[q][j]) * w1[q]; v[j] = bf4(xr[q][j]) + gf[j] * yy;
                    ss += (v[j][0] * v[j][0] + v[j][1] * v[j][1]) + (v[j][2] * v[j][2] + v[j][3] * v[j][3]); }
                const float rstd = __builtin_amdgcn_rsqf(wave_sum(ss) * (1.f / D) + NORM_EPS);
#pragma unroll
                for (int j = 0; j < 4; ++j) *(f32x4*)(args.out + (size_t)row * D + 4 * lane + 256 * j) = v[j] * rstd * fg[j];
            }
        }
    }
#undef IN
#undef SEAM
#undef GRID_BAR
}


#ifndef DBG
#define DBG 0
#endif
#if DBG
constexpr size_t WS_REP = WS_END;
__global__ void dbg_scan(const unsigned* buf, size_t nwords, int is_bf16, unsigned long long* rep) {
    unsigned long long nf = 0, ck = 0;
    for (size_t i = (size_t)blockIdx.x * blockDim.x + threadIdx.x; i < nwords; i += (size_t)gridDim.x * blockDim.x) {
        const unsigned w = buf[i]; ck += (unsigned long long)w * (unsigned long long)((i & 1023) + 1);
        if (is_bf16) { if ((w & 0x7f80u) >= (140u << 7)) ++nf; if ((w & 0x7f800000u) >= (140u << 23)) ++nf; }
        else if ((w & 0x7f800000u) >= (140u << 23)) ++nf;
    }
    for (int o = 32; o >= 1; o >>= 1) { nf += __shfl_xor(nf, o); ck += __shfl_xor(ck, o); }
    if ((threadIdx.x & 63) == 0) { if (nf) atomicAdd(rep, nf); atomicAdd(rep + 1, ck); }
}

__global__ void dbg_scan_cols(const unsigned short* buf, int c0, int c1, unsigned long long* rep) {
    unsigned long long nf = 0;
    const int w = c1 - c0;
    for (size_t i = (size_t)blockIdx.x * blockDim.x + threadIdx.x; i < (size_t)M * w; i += (size_t)gridDim.x * blockDim.x) {
        const size_t r = i / w; const int c = c0 + (int)(i % w); const unsigned v = buf[r * D + c];
        if ((v & 0x7f80u) >= (140u << 7)) ++nf; }
    for (int o = 32; o >= 1; o >>= 1) nf += __shfl_xor(nf, o);
    if ((threadIdx.x & 63) == 0 && nf) atomicAdd(rep, nf);
}
__global__ void dbg_encode(const unsigned long long* rep, float* out, size_t n, int nph) {
    int code = 80;
    for (int p = nph - 1; p >= 0; --p) if (rep[(64 + p) * 2 + 1] != rep[p * 2 + 1]) code = 40 + p;
    for (int p = nph - 1; p >= 0; --p) if (rep[p * 2] != 0ull || rep[(64 + p) * 2] != 0ull) code = 1 + p;
    if (code == 80) return;
    const float A = sqrtf((float)code * 0.1f);
    for (size_t i = (size_t)blockIdx.x * blockDim.x + threadIdx.x; i < n; i += (size_t)gridDim.x * blockDim.x) {
        unsigned h = (unsigned)i * 2654435761u; h ^= h >> 15; h *= 2246822519u; h ^= h >> 13;
        out[i] = (h & 1u) ? A : -A; }
}
#endif

extern "C" void kernel_launch(void* const* d_in, const int* in_sizes, int n_in, void* d_out, int out_size, void* d_ws, size_t ws_size, hipStream_t stream) {
    static int grid = 0;
    if (grid == 0) {
        if (n_in != 22 || in_sizes[0] != M * D || out_size != M * D || ws_size < WS_END + (1u << 20)) {
            fprintf(stderr, "kernel_launch: unexpected shapes (n_in %d, in0 %d, out %d, ws %zu, need %zu)\n", n_in, n_in > 0 ? in_sizes[0] : -1, out_size, ws_size, (size_t)WS_END); grid = -1; return; }
        int dev = 0, cus = 0, per_cu = 0;
        if (hipGetDevice(&dev) != hipSuccess || hipDeviceGetAttribute(&cus, hipDeviceAttributeMultiprocessorCount, dev) != hipSuccess) { grid = -1; return; }
        if (hipFuncSetAttribute((const void*)fwd_kernel, hipFuncAttributeMaxDynamicSharedMemorySize, LDS_BYTES) != hipSuccess) { fprintf(stderr, "kernel_launch: hipFuncSetAttribute failed\n"); grid = -1; return; }
        if (hipOccupancyMaxActiveBlocksPerMultiprocessor(&per_cu, (const void*)fwd_kernel, NWAVES * 64, LDS_BYTES) != hipSuccess || per_cu < 1)
            fprintf(stderr, "kernel_launch: occupancy query reports %d\n", per_cu);
        (void)hipGetLastError();
        if (cus != 256) { fprintf(stderr, "kernel_launch: built for 256 CUs (MoE unit deal, T2 row blocks), found %d\n", cus); grid = -1; return; }
        grid = cus;
    }
    if (grid < 0) return;
    if (hipMemsetAsync((char*)d_ws + WS_CTL, 0, CTL_ZERO_BYTES, stream) != hipSuccess) { fprintf(stderr, "kernel_launch: memset failed\n"); return; }
    Args a{};
    a.x = (const float*)d_in[0]; a.c = (const float*)d_in[1]; a.ada_w = (const float*)d_in[2]; a.ada_b = (const float*)d_in[3]; a.mix_g = (const float*)d_in[4]; a.ffn_g = (const float*)d_in[5];
    a.w_in = (const float*)d_in[6]; a.da_lambda = (const float*)d_in[7]; a.da_subln = (const float*)d_in[8]; a.na_rpb = (const float*)d_in[9];
    a.wpa = (const float*)d_in[10]; a.wpn = (const float*)d_in[11]; a.wpd = (const float*)d_in[12]; a.w_out = (const float*)d_in[13];
    a.rgw = (const float*)d_in[14]; a.rgb = (const float*)d_in[15]; a.rew = (const float*)d_in[16]; a.reb = (const float*)d_in[17];
    a.ew1 = (const float*)d_in[18]; a.ew3 = (const float*)d_in[19]; a.ew2 = (const float*)d_in[20]; a.fin_g = (const float*)d_in[21];
    a.out = (float*)d_out; a.ws = (unsigned char*)d_ws;
#if DBG
    {
        unsigned char* ws = (unsigned char*)d_ws;
        unsigned long long* rep = (unsigned long long*)(ws + WS_REP);
        (void)hipMemsetAsync(rep, 0, 2 * 64 * 2 * 8, stream);
        for (int run = 0; run < 2; ++run) {
            (void)hipMemsetAsync((char*)d_ws + WS_CTL, 0, CTL_ZERO_BYTES, stream);
            for (int p = 0; p < NPHASE; ++p) {
                a.ph_lo = p; a.ph_hi = p + 1;
                hipLaunchKernelGGL(fwd_kernel, dim3(grid), dim3(NWAVES * 64), LDS_BYTES, stream, a);
                unsigned long long* r = rep + (size_t)(run * 64 + p) * 2;
#define SCAN(off, bytes, isbf) hipLaunchKernelGGL(dbg_scan, dim3(1024), dim3(256), 0, stream, (const unsigned*)(ws + (off)), (size_t)(bytes) / 4, (isbf), r)
                const int ph = (p == 0) ? -1 : (p == NPHASE - 1) ? 9 : (p - 1) % 9;
                if (ph == -1) { SCAN(WS_MOD, (size_t)DEPTH * NBATCH * 6 * D * 4, 0); SCAN(WS_ROPE, (size_t)SEQ * 64 * 4, 0); SCAN(WS_WIN, WS_END - WS_WIN, 1); }
                else if (ph == 0) { SCAN(WS_X, (size_t)M * D * 4, 0); SCAN(WS_H, (size_t)M * D * 2, 1); }
                else if (ph == 1) { SCAN(WS_Z, (size_t)M * ZW * 2, 1); }
                else if (ph == 2) { SCAN(WS_OCAT, (size_t)M * D * 2, 1); }
                else if (ph == 3) { SCAN(WS_MERGED, (size_t)M * D * 2, 1); }
                else if (ph == 4) { SCAN(WS_X, (size_t)M * D * 4, 0); }
                else if (ph == 5) { SCAN(WS_H, (size_t)M * D * 2, 1); SCAN(WS_ROUTE, (size_t)2 * M * 4, 0); SCAN(WS_ROUTE + (size_t)4 * M * 4, (size_t)2 * M * 4, 0); }
                else if (ph == 9) { hipLaunchKernelGGL(dbg_scan, dim3(1024), dim3(256), 0, stream, (const unsigned*)d_out, (size_t)M * D, 0, r); }
#undef SCAN
            }
        }
        hipLaunchKernelGGL(dbg_encode, dim3(1024), dim3(256), 0, stream, (const unsigned long long*)rep, (float*)d_out, (size_t)M * D, NPHASE);
    }
#elif MK_PER_PHASE
    for (int p = 0; p < NPHASE; ++p) {
        a.ph_lo = p; a.ph_hi = p + 1;
        hipLaunchKernelGGL(fwd_kernel, dim3(grid), dim3(NWAVES * 64), LDS_BYTES, stream, a);
    }
#else
    a.ph_lo = 0; a.ph_hi = NPHASE;
    hipLaunchKernelGGL(fwd_kernel, dim3(grid), dim3(NWAVES * 64), LDS_BYTES, stream, a);
#endif
    const hipError_t le = hipPeekAtLastError();
    if (le != hipSuccess) fprintf(stderr, "kernel_launch: launch failed: %s\n", hipGetErrorName(le));
}
```

```cpp
#include <hip/hip_runtime.h>
#include <cstdio>
#include <cstdint>

#ifndef MK_PER_PHASE
#define MK_PER_PHASE 0
#endif

#define LAS __attribute__((address_space(3)))
#define GAS __attribute__((address_space(1)))
typedef unsigned short bf16_t;
typedef short bf16x8 __attribute__((ext_vector_type(8)));
typedef short s16x4 __attribute__((ext_vector_type(4)));
typedef float f32x4 __attribute__((ext_vector_type(4)));
typedef float f32x2 __attribute__((ext_vector_type(2)));
typedef float f32x16 __attribute__((ext_vector_type(16)));
typedef unsigned u32x4 __attribute__((ext_vector_type(4)));
typedef unsigned u32x2 __attribute__((ext_vector_type(2)));

constexpr int D = 1024, NBATCH = 4, SEQ = 4096, M = NBATCH * SEQ, DEPTH = 4, ZW = 7680;
constexpr int ZQA = 0, ZKA = 512, ZVA = 1024, ZQN = 1536, ZKN = 1792, ZVN = 2048, ZQD = 2304, ZKD = 3072, ZVD = 3840, ZG = 4608;
constexpr int NEXP = 32, EH = 512;
constexpr int MAXTILES = 160, XROWS = MAXTILES * 256;
constexpr float C2 = 0.125f * 1.4426950408889634f;
constexpr float LOG2E = 1.4426950408889634f;
constexpr float NORM_EPS = 1e-6f;
constexpr float NEGBIG = -1e30f;
constexpr float RESCALE_THR = 8.0f;

constexpr size_t MiB = 1u << 20;
constexpr size_t WS_CTL = 0, CTL_ZERO_BYTES = 1 * MiB;
constexpr size_t WS_RT = 1 * MiB;
constexpr size_t WS_MOD = 2 * MiB;
constexpr size_t WS_ROPE = 3 * MiB;
constexpr size_t WS_ROUTE = 4 * MiB;
constexpr size_t WS_X = 8 * MiB;
constexpr size_t WS_H = 72 * MiB;
constexpr size_t WS_OCAT = 104 * MiB;
constexpr size_t WS_MERGED = 136 * MiB;
constexpr size_t WS_Z = 168 * MiB;
constexpr size_t WS_XG = WS_Z;
constexpr size_t WS_HB = WS_Z + 80 * MiB;
constexpr size_t WS_YB = WS_Z + 120 * MiB;
constexpr size_t WS_WIN = 408 * MiB;
constexpr size_t WS_WPROJ = 468 * MiB;
constexpr size_t WS_WOUT = 476 * MiB;
constexpr size_t WS_W13 = 484 * MiB;
constexpr size_t WS_W2 = 740 * MiB;
constexpr size_t WS_END = 868 * MiB;
constexpr int CW_BAR = 4096;
constexpr int CW_CNT = 16384;
constexpr int CW_TILE = 32768;

constexpr int RING_BYTES = 131072;
constexpr int RT_LD = 1028;
constexpr int RT_BYTES = 36 * RT_LD * 4;
constexpr int MISC_OFF = RT_BYTES;
constexpr int LDS_BYTES = MISC_OFF + 512;

__device__ __forceinline__ unsigned f2bf(float f) { unsigned u = __builtin_bit_cast(unsigned, f); return (u + 0x7fffu + ((u >> 16) & 1u)) >> 16; }
__device__ __forceinline__ unsigned pk2(float lo, float hi) { return f2bf(lo) | (f2bf(hi) << 16); }
__device__ __forceinline__ unsigned cvt_pk_bf16(float lo, float hi) { unsigned r; asm("v_cvt_pk_bf16_f32 %0, %1, %2" : "=v"(r) : "v"(lo), "v"(hi)); return r; }
typedef __bf16 bf16x2_t __attribute__((ext_vector_type(2)));
__device__ __forceinline__ unsigned cvtpk_s(float lo, float hi) { f32x2 v = {lo, hi}; bf16x2_t b = __builtin_convertvector(v, bf16x2_t); return __builtin_bit_cast(unsigned, b); }
__device__ __forceinline__ float bflo(unsigned u) { return __builtin_bit_cast(float, u << 16); }
__device__ __forceinline__ float bfhi(unsigned u) { return __builtin_bit_cast(float, u & 0xffff0000u); }
__device__ __forceinline__ f32x4 bf4(u32x2 r) { return (f32x4){bflo(r.x), bfhi(r.x), bflo(r.y), bfhi(r.y)}; }
__device__ __forceinline__ float fexp2(float x) { return __builtin_amdgcn_exp2f(x); }
__device__ __forceinline__ float frcp(float x) { return __builtin_amdgcn_rcpf(x); }
__device__ __forceinline__ void swap32(float& a, float& b) { asm volatile("s_nop 1\n\tv_permlane32_swap_b32 %0, %1\n\ts_nop 1" : "+v"(a), "+v"(b)); }
template <int X> __device__ __forceinline__ float xor_lane(float v) { return __builtin_bit_cast(float, __builtin_amdgcn_ds_swizzle(__builtin_bit_cast(int, v), (X << 10) | 0x1f)); }
__device__ __forceinline__ float half_sum(float v) { v += xor_lane<1>(v); v += xor_lane<2>(v); v += xor_lane<4>(v); v += xor_lane<8>(v); v += xor_lane<16>(v); return v; }
__device__ __forceinline__ float wave_sum(float v) {
    v = half_sum(v);
    float a = v, b = v; swap32(a, b);
    return a + b;
}
template <int CTRL> __device__ __forceinline__ float dpp_f(float v) { return __builtin_bit_cast(float, __builtin_amdgcn_update_dpp(0, __builtin_bit_cast(int, v), CTRL, 0xf, 0xf, false)); }
__device__ __forceinline__ float wave_sum_u(float v) {
    v += dpp_f<0xB1>(v); v += dpp_f<0x4E>(v); v += dpp_f<0x141>(v); v += dpp_f<0x140>(v);
    v += __builtin_bit_cast(float, __builtin_amdgcn_update_dpp(0, __builtin_bit_cast(int, v), 0x142, 0xa, 0xf, false));
    v += __builtin_bit_cast(float, __builtin_amdgcn_update_dpp(0, __builtin_bit_cast(int, v), 0x143, 0xc, 0xf, false));
    float r = __builtin_bit_cast(float, __builtin_amdgcn_readlane(__builtin_bit_cast(int, v), 63));
    asm volatile("" : "+v"(r));
    return r;
}
__device__ __forceinline__ void wave_sum4_u(float& a, float& b, float& c, float& d) {
    unsigned s0, s1, s2, s3;
#define WS4_STEP(ctl) "v_add_f32_dpp %0, %0, %0 " ctl "\n\tv_add_f32_dpp %1, %1, %1 " ctl "\n\tv_add_f32_dpp %2, %2, %2 " ctl "\n\tv_add_f32_dpp %3, %3, %3 " ctl "\n\t"
    asm volatile("s_nop 1\n\t"
        WS4_STEP("quad_perm:[1,0,3,2] row_mask:0xf bank_mask:0xf") WS4_STEP("quad_perm:[2,3,0,1] row_mask:0xf bank_mask:0xf") WS4_STEP("row_half_mirror row_mask:0xf bank_mask:0xf")
        WS4_STEP("row_mirror row_mask:0xf bank_mask:0xf") WS4_STEP("row_bcast:15 row_mask:0xa bank_mask:0xf") WS4_STEP("row_bcast:31 row_mask:0xc bank_mask:0xf")
        "v_readlane_b32 %4, %0, 63\n\tv_readlane_b32 %5, %1, 63\n\tv_readlane_b32 %6, %2, 63\n\tv_readlane_b32 %7, %3, 63\n\t"
        "v_mov_b32 %0, %4\n\tv_mov_b32 %1, %5\n\tv_mov_b32 %2, %6\n\tv_mov_b32 %3, %7"
        : "+v"(a), "+v"(b), "+v"(c), "+v"(d), "=&s"(s0), "=&s"(s1), "=&s"(s2), "=&s"(s3));
#undef WS4_STEP
}
__device__ __forceinline__ void st16_wt(void* p, u32x4 v) { asm volatile("global_store_dwordx4 %0, %1, off sc1\n\ts_nop 1" :: "v"(p), "v"(v) : "memory"); }
#define LDS_WAIT() asm volatile("s_waitcnt lgkmcnt(0)" ::: "memory")
#define VM_WAIT() asm volatile("s_waitcnt vmcnt(0)" ::: "memory")
#define CBAR() asm volatile("" ::: "memory")

namespace pg8 {
constexpr int BM = 256, BK = 64, HALF = 128, HTB = HALF * BK * 2, STAGE_BYTES = 8 * HTB, NXCD = 8, WGM = 8;
__host__ __device__ __forceinline__ int lds_byte(int r, int c) { const int st = (r >> 4) * 2 + (c >> 5), rr = r & 15, cc = c & 31, ob = rr * 64 + cc * 2; return st * 1024 + (ob ^ (((ob >> 9) & 1) << 5)); }
__host__ __device__ __forceinline__ void stage_rc(int b, int& R, int& C) { const int st = b / 1024, sb = b % 1024, swz = sb ^ (((sb >> 9) & 1) << 5); R = (st >> 1) * 16 + swz / 64; C = (st & 1) * 32 + (swz % 64) / 2; }
__host__ __device__ __forceinline__ int perm32(int rho) { const int n = rho >> 4, i = rho & 15; return 8 * (i >> 2) + 4 * n + (i & 3); }

struct Unit { int pm, pn, e, x0, x1; };
struct Gemm { const bf16_t* A; const bf16_t* Bt; int lda, ldb, K; };

struct StaticOrder {
    int nM, nN, nwg, G, c;
    __device__ void init(int M_, int N_, int G_, int c_) { nM = M_ / BM; nN = N_ / BM; nwg = nM * nN; G = G_; c = c_; }
    __device__ bool next(int i, Unit& u) const {
        const long L = (long)i * G + c; if (L >= nwg) return false;
        int wgid = (int)L; { const int q = nwg / NXCD, r = nwg % NXCD, xcd = wgid % NXCD, off = wgid / NXCD; wgid = (xcd < r ? xcd * (q + 1) : r * (q + 1) + (xcd - r) * q) + off; }
        const int nig = WGM * nN, gid = wgid / nig, fm = gid * WGM, gsz = (nM - fm) < WGM ? (nM - fm) : WGM;
        u.pm = fm + ((wgid % nig) % gsz); u.pn = (wgid % nig) / gsz; u.e = 0; u.x0 = 0; u.x1 = 0; return true;
    }
    __device__ __forceinline__ size_t aoff(const Gemm& g, const Unit& u) const { return (size_t)u.pm * BM * g.lda * 2; }
    __device__ __forceinline__ size_t boff(const Gemm& g, const Unit& u) const { return (size_t)u.pn * BM * g.ldb * 2; }
    __device__ __forceinline__ int ktiles(const Gemm& g, const Unit&) const { return g.K / BK; }
    __device__ __forceinline__ void done(const Unit&, int) const {}
};
struct MoeOrder {
    int n; int pm0, pm1, pn0, pn1, e0, e1; size_t estride;
    int ts0, ts1, cn0, cn1; const int* etok;
    unsigned* tcnt;
    __device__ __forceinline__ void done(const Unit& u, int lane) const {
        if (tcnt) { asm volatile("s_waitcnt vmcnt(0)" ::: "memory"); if (lane == 0) __hip_atomic_fetch_add(tcnt + u.pm * 16, 1u, __ATOMIC_RELAXED, __HIP_MEMORY_SCOPE_AGENT); }
    }
    __device__ bool next(int i, Unit& u) const {
        if (i >= n) return false;
        u.pm = i == 0 ? pm0 : pm1; u.pn = i == 0 ? pn0 : pn1; u.e = i == 0 ? e0 : e1;
        u.x0 = i == 0 ? ts0 : ts1; u.x1 = i == 0 ? cn0 : cn1; return true;
    }
    __device__ __forceinline__ size_t aoff(const Gemm& g, const Unit& u) const { return (size_t)u.pm * BM * g.lda * 2; }
    __device__ __forceinline__ size_t boff(const Gemm& g, const Unit& u) const { return (size_t)u.e * estride + (size_t)u.pn * BM * g.ldb * 2; }
    __device__ __forceinline__ int ktiles(const Gemm& g, const Unit&) const { return g.K / BK; }
    __device__ __forceinline__ int gather_row(const Unit& u, int r) const {
        const int pos = min((u.pm - u.x0) * BM + r, u.x1 - 1);
        return etok[u.e * 16384 + pos];
    }
};
struct ProjOrder {
    int pm, pn, rot;
    __device__ bool next(int i, Unit& u) const { if (i >= 3) return false; int seg = i + rot; seg = seg >= 3 ? seg - 3 : seg; u.pm = pm; u.pn = pn; u.e = seg | ((i == 0) ? 16 : 0); u.x0 = 0; u.x1 = 0; return true; }
    __device__ __forceinline__ int kofs(const Unit& u) const { const int seg = u.e & 15; return seg == 0 ? 0 : (seg == 1 ? 512 : 768); }
    __device__ __forceinline__ size_t aoff(const Gemm& g, const Unit& u) const { return (size_t)u.pm * BM * g.lda * 2 + (size_t)kofs(u) * 2; }
    __device__ __forceinline__ size_t boff(const Gemm& g, const Unit& u) const { return (size_t)u.pn * BM * g.ldb * 2 + (size_t)kofs(u) * 2; }
    __device__ __forceinline__ int ktiles(const Gemm&, const Unit& u) const { return (u.e & 15) == 0 ? 8 : 4; }
    __device__ __forceinline__ void done(const Unit&, int) const {}
};

template <class Epi, class Sched, bool ALIGN_EPI = true, bool SP2 = true, bool GATHER = false>
__device__ __forceinline__ void gemm_phase(LAS unsigned char* lds, const Gemm g, const Sched& S, const Epi& E) {
    int tid_ = threadIdx.x; asm volatile("" : "+v"(tid_));
    const int tid = tid_, wid = __builtin_amdgcn_readfirstlane(tid >> 6), lane = tid & 63, wr = wid >> 2, wc = wid & 3, fr = lane & 15, fq = lane >> 4;
    int nt = S.ktiles(g, Unit{0, 0, 0, 0, 0});
    unsigned voffA[2], voffB[2];
#pragma unroll
    for (int i = 0; i < 2; ++i) { int R, C; stage_rc(tid * 16 + i * 8192, R, C); const int Rb = Epi::PERM ? ((R & ~31) + perm32(R & 31)) : R;
        voffA[i] = (unsigned)(R * g.lda + C) * 2u; voffB[i] = (unsigned)(Rb * g.ldb + C) * 2u; }
    const size_t kstep = (size_t)(BK * 2);
    const size_t hstepA = (size_t)HALF * g.lda * 2, hstepB = (size_t)HALF * g.ldb * 2;
    const unsigned ldsw = (unsigned)wid * 1024u;
    const int aoff = lds_byte(wr * 64 + fr, fq * 8), boff = lds_byte(wc * 32 + fr, fq * 8);
#define PG8_SA(b, h) (((b) * 2 + (h)) * HTB)
#define PG8_SB(b, h) ((4 + (b) * 2 + (h)) * HTB)
#define PG8_STAGE(bufoff, gbase, voff) do { _Pragma("unroll") for (int _i = 0; _i < 2; ++_i) \
        __builtin_amdgcn_global_load_lds((const unsigned*)((const char*)(gbase) + (voff)[_i]), (LAS unsigned*)(lds + (bufoff) + ldsw + _i * 8192), 16, 0, 0); } while (0)
    unsigned vo0[2] = {0u, 0u}, vo1[2] = {0u, 0u}, nvo0[2] = {0u, 0u}, nvo1[2] = {0u, 0u};
#define PG8_GOFF(u_, d0_, d1_) do { _Pragma("unroll") for (int _i = 0; _i < 2; ++_i) { int R_, C_; stage_rc(tid * 16 + _i * 8192, R_, C_); \
        d0_[_i] = (unsigned)(S.gather_row(u_, R_) * g.lda + C_) * 2u; d1_[_i] = (unsigned)(S.gather_row(u_, HALF + R_) * g.lda + C_) * 2u; } } while (0)
#define PG8_STAGEA(bufoff, ptr, h, nx) do { if constexpr (GATHER) { unsigned o_[2]; o_[0] = (nx) ? ((h) ? nvo1[0] : nvo0[0]) : ((h) ? vo1[0] : vo0[0]); o_[1] = (nx) ? ((h) ? nvo1[1] : nvo0[1]) : ((h) ? vo1[1] : vo0[1]); \
        PG8_STAGE(bufoff, ptr, o_); } else { PG8_STAGE(bufoff, (ptr) + ((h) ? hstepA : 0), voffA); } } while (0)
#define PG8_LDA(dst, b, h) do { _Pragma("unroll") for (int m = 0; m < 4; ++m) _Pragma("unroll") for (int k = 0; k < 2; ++k) dst[m][k] = *(const LAS bf16x8*)(lds + PG8_SA(b, h) + aoff + m * 2048 + k * 1024); } while (0)
#define PG8_LDB(dst, b, h) do { _Pragma("unroll") for (int n = 0; n < 2; ++n) _Pragma("unroll") for (int k = 0; k < 2; ++k) dst[n][k] = *(const LAS bf16x8*)(lds + PG8_SB(b, h) + boff + n * 2048 + k * 1024); } while (0)
#define PG8_MMA(ai, bj, At, Bt) do { __builtin_amdgcn_s_setprio(1); _Pragma("unroll") for (int m = 0; m < 4; ++m) _Pragma("unroll") for (int n = 0; n < 2; ++n) _Pragma("unroll") for (int k = 0; k < 2; ++k) \
        acc[ai][bj][m][n] = __builtin_amdgcn_mfma_f32_16x16x32_bf16(Bt[n][k], At[m][k], acc[ai][bj][m][n], 0, 0, 0); __builtin_amdgcn_s_setprio(0); } while (0)
#define PG8_WAIT_V(n) asm volatile("s_waitcnt vmcnt(" #n ")" ::: "memory")
#define PG8_WAIT_L(n) asm volatile("s_waitcnt lgkmcnt(" #n ")" ::: "memory")
#define PG8_BAR __builtin_amdgcn_s_barrier()
#define PG8_SCHED __builtin_amdgcn_sched_barrier(0)
    Unit cur, nxt; int ui = 0;
    if (!S.next(0, cur)) return;
    nt = S.ktiles(g, cur);
    f32x4 acc[2][2][4][2];
#pragma unroll
    for (int a = 0; a < 2; ++a)
#pragma unroll
        for (int b = 0; b < 2; ++b)
#pragma unroll
            for (int m = 0; m < 4; ++m)
#pragma unroll
                for (int n = 0; n < 2; ++n) acc[a][b][m][n] = (f32x4){0.f, 0.f, 0.f, 0.f};
    bf16x8 At[4][2], B0[2][2], B1[2][2];
    const char* cA = (const char*)g.A + (GATHER ? (size_t)0 : S.aoff(g, cur)); const char* cB = (const char*)g.Bt + S.boff(g, cur);
    if constexpr (GATHER) { PG8_GOFF(cur, vo0, vo1); asm volatile("s_waitcnt vmcnt(0)" : "+v"(vo0[0]), "+v"(vo0[1]), "+v"(vo1[0]), "+v"(vo1[1]) :: "memory"); }
    if constexpr (SP2) {
        PG8_STAGE(PG8_SB(0, 0), cB, voffB); PG8_STAGE(PG8_SB(0, 1), cB + hstepB, voffB); PG8_STAGEA(PG8_SA(0, 0), cA, 0, false); PG8_STAGEA(PG8_SA(0, 1), cA, 1, false);
        if (wr == 1) PG8_BAR;
        PG8_WAIT_V(2); PG8_BAR;
        PG8_STAGE(PG8_SB(1, 0), cB + kstep, voffB); PG8_STAGEA(PG8_SA(1, 0), cA + kstep, 0, false); PG8_STAGE(PG8_SB(1, 1), cB + hstepB + kstep, voffB);
        PG8_WAIT_V(6); PG8_BAR;
    } else {
        PG8_STAGE(PG8_SB(0, 0), cB, voffB); PG8_STAGE(PG8_SA(0, 0), cA, voffA); PG8_STAGE(PG8_SB(0, 1), cB + hstepB, voffB); PG8_STAGE(PG8_SA(0, 1), cA + hstepA, voffA);
        if (wr == 1) PG8_BAR;
        PG8_WAIT_V(4); PG8_BAR;
        PG8_STAGE(PG8_SB(1, 0), cB + kstep, voffB); PG8_STAGE(PG8_SA(1, 0), cA + kstep, voffA); PG8_STAGE(PG8_SB(1, 1), cB + hstepB + kstep, voffB);
        PG8_WAIT_V(6); PG8_BAR;
    }
    for (;;) {
        const bool has_next = S.next(ui + 1, nxt);
        const char* nA = (has_next && !GATHER) ? (const char*)g.A + S.aoff(g, nxt) : cA; const char* nB = has_next ? (const char*)g.Bt + S.boff(g, nxt) : cB;
        if constexpr (GATHER) { if (has_next) { PG8_GOFF(nxt, nvo0, nvo1); } else { nvo0[0] = vo0[0]; nvo0[1] = vo0[1]; nvo1[0] = vo1[0]; nvo1[1] = vo1[1]; }
            asm volatile("s_waitcnt vmcnt(0)" : "+v"(nvo0[0]), "+v"(nvo0[1]), "+v"(nvo1[0]), "+v"(nvo1[1]) :: "memory"); }
        for (int t = 0; t < nt; t += 2) {
            const bool last = (t == nt - 2);
            const char* a1 = cA + (size_t)(t + 1) * kstep;
            const char* a2 = last ? nA : cA + (size_t)(t + 2) * kstep; const char* b2 = last ? nB : cB + (size_t)(t + 2) * kstep;
            const char* a3 = a2 + kstep; const char* b3 = b2 + kstep;
            if constexpr (SP2) {
            PG8_LDB(B0, 0, 0); PG8_LDB(B1, 0, 1); PG8_SCHED; PG8_LDA(At, 0, 0); PG8_STAGEA(PG8_SA(1, 1), a1, 1, false);
            PG8_WAIT_V(8); PG8_WAIT_L(0); PG8_BAR; PG8_MMA(0, 0, At, B0); PG8_MMA(0, 1, At, B1); PG8_BAR; PG8_SCHED;
            PG8_LDA(At, 0, 1); PG8_STAGE(PG8_SB(0, 0), b2, voffB); PG8_STAGE(PG8_SB(0, 1), b2 + hstepB, voffB); PG8_STAGEA(PG8_SA(0, 0), a2, 0, last);
            PG8_WAIT_V(8); PG8_WAIT_L(0); PG8_BAR; PG8_MMA(1, 0, At, B0); PG8_MMA(1, 1, At, B1); PG8_BAR; PG8_SCHED;
            PG8_LDB(B0, 1, 0); PG8_LDB(B1, 1, 1); PG8_SCHED; PG8_LDA(At, 1, 0); PG8_STAGEA(PG8_SA(0, 1), a2, 1, last);
            PG8_WAIT_V(8); PG8_WAIT_L(0); PG8_BAR; PG8_MMA(0, 0, At, B0); PG8_MMA(0, 1, At, B1); PG8_BAR; PG8_SCHED;
            PG8_LDA(At, 1, 1); PG8_STAGE(PG8_SB(1, 0), b3, voffB); PG8_STAGE(PG8_SB(1, 1), b3 + hstepB, voffB); PG8_STAGEA(PG8_SA(1, 0), a3, 0, last);
            PG8_WAIT_V(8); PG8_WAIT_L(0); PG8_BAR; PG8_MMA(1, 0, At, B0); PG8_MMA(1, 1, At, B1); PG8_BAR; PG8_SCHED;
            } else {
            PG8_LDB(B0, 0, 0); PG8_SCHED; PG8_LDA(At, 0, 0); PG8_STAGE(PG8_SA(1, 1), a1 + hstepA, voffA);
            PG8_WAIT_L(8); PG8_BAR; PG8_WAIT_L(0); PG8_MMA(0, 0, At, B0); PG8_BAR; PG8_SCHED;
            PG8_LDB(B1, 0, 1); PG8_STAGE(PG8_SB(0, 0), b2, voffB);
            PG8_BAR; PG8_WAIT_L(0); PG8_MMA(0, 1, At, B1); PG8_BAR;
            PG8_LDA(At, 0, 1); PG8_STAGE(PG8_SA(0, 0), a2, voffA);
            PG8_BAR; PG8_WAIT_L(0); PG8_MMA(1, 0, At, B0); PG8_BAR; PG8_SCHED;
            PG8_STAGE(PG8_SB(0, 1), b2 + hstepB, voffB);
            PG8_WAIT_V(6); PG8_BAR; PG8_MMA(1, 1, At, B1); PG8_BAR;
            PG8_LDB(B0, 1, 0); PG8_SCHED; PG8_LDA(At, 1, 0); PG8_STAGE(PG8_SA(0, 1), a2 + hstepA, voffA);
            PG8_WAIT_L(8); PG8_BAR; PG8_WAIT_L(0); PG8_MMA(0, 0, At, B0); PG8_BAR; PG8_SCHED;
            PG8_LDB(B1, 1, 1); PG8_STAGE(PG8_SB(1, 0), b3, voffB);
            PG8_BAR; PG8_WAIT_L(0); PG8_MMA(0, 1, At, B1); PG8_BAR;
            PG8_LDA(At, 1, 1); PG8_STAGE(PG8_SA(1, 0), a3, voffA);
            PG8_BAR; PG8_WAIT_L(0); PG8_MMA(1, 0, At, B0); PG8_BAR; PG8_SCHED;
            PG8_STAGE(PG8_SB(1, 1), b3 + hstepB, voffB);
            PG8_WAIT_V(6); PG8_BAR; PG8_MMA(1, 1, At, B1); PG8_BAR;
            }
        }
        if constexpr (ALIGN_EPI) { if (wr == 0) PG8_BAR; }
        E(acc, cur, wr, wc, fr, fq);
        S.done(cur, lane);
        if (!has_next) break;
#pragma unroll
        for (int a = 0; a < 2; ++a)
#pragma unroll
            for (int b = 0; b < 2; ++b)
#pragma unroll
                for (int m = 0; m < 4; ++m)
#pragma unroll
                    for (int n = 0; n < 2; ++n) acc[a][b][m][n] = (f32x4){0.f, 0.f, 0.f, 0.f};
        cur = nxt; cA = nA; cB = nB; ++ui; nt = S.ktiles(g, cur);
        if constexpr (GATHER) { vo0[0] = nvo0[0]; vo0[1] = nvo0[1]; vo1[0] = nvo1[0]; vo1[1] = nvo1[1]; }
        if constexpr (ALIGN_EPI) { if (wr == 1) PG8_BAR; }
    }
    PG8_WAIT_V(0);
    if constexpr (!ALIGN_EPI) { if (wr == 0) PG8_BAR; }
    PG8_BAR;
#undef PG8_SA
#undef PG8_SB
#undef PG8_STAGE
#undef PG8_LDA
#undef PG8_STAGEA
#undef PG8_GOFF
#undef PG8_LDB
#undef PG8_MMA
#undef PG8_WAIT_V
#undef PG8_WAIT_L
#undef PG8_BAR
#undef PG8_SCHED
}
}

#define XB_TMO      128
#define XB_XCNT(j)  (256  + 64 * (j))
#define XB_XSUB(j)  (1280 + 64 * (j))
#define XB_XGEN(j)  (2304 + 64 * (j))
#define XB_TOP      3328
#define XB_TOPGEN   3392
#define XCD_BAR_WORDS 3456
#define XB_SPIN_CAP (1u << 18)
__device__ __forceinline__ unsigned xb_ld(unsigned* p)              { return __hip_atomic_load(p, __ATOMIC_RELAXED, __HIP_MEMORY_SCOPE_AGENT); }
__device__ __forceinline__ unsigned xb_add(unsigned* p, unsigned v) { return __hip_atomic_fetch_add(p, v, __ATOMIC_RELAXED, __HIP_MEMORY_SCOPE_AGENT); }
__device__ __forceinline__ unsigned xb_xcc_id() { return (unsigned)__builtin_amdgcn_s_getreg((3 << 11) | 20) & 0xFu; }
#define XB_SPIN(cond, bar) do { unsigned _sp = 0; while (cond) { __builtin_amdgcn_s_sleep(1); \
    if ((++_sp & 255u) == 0u) { if (xb_ld(&(bar)[XB_TMO])) break; if (_sp > XB_SPIN_CAP) { atomicAdd(&(bar)[XB_TMO], 1u); break; } } } } while (0)
struct XcdBarrier { unsigned* bar; unsigned x; volatile LAS unsigned* st; };
__device__ __forceinline__ XcdBarrier xcd_barrier_post(unsigned* bar, volatile LAS unsigned* st) {
    XcdBarrier b; b.bar = bar; b.x = xb_xcc_id(); b.st = st;
    if (threadIdx.x == 0) (void)xb_add(&bar[XB_XCNT(b.x)], 1u);
    return b;
}
__device__ __forceinline__ void xcd_barrier_complete(unsigned* bar, unsigned x, unsigned& nloc, unsigned& nx) {
    const unsigned G = gridDim.x * gridDim.y * gridDim.z;
    unsigned sum, cnt, mine, sp = 0u;
    for (;;) {
        sum = 0u; cnt = 0u; mine = 0u;
#pragma unroll
        for (unsigned j = 0; j < 16; ++j) { const unsigned c = xb_ld(&bar[XB_XCNT(j)]); sum += c; cnt += (c > 0u) ? 1u : 0u; mine = (j == x) ? c : mine; }
        if (sum == G) break;
        __builtin_amdgcn_s_sleep(1);
        if ((++sp & 255u) == 0u) { if (xb_ld(&bar[XB_TMO])) break; if (sp > XB_SPIN_CAP) { atomicAdd(&bar[XB_TMO], 1u); break; } }
    }
    nloc = mine > 0u ? mine : 1u; nx = cnt > 0u ? cnt : 1u;
}
__device__ __forceinline__ void xcd_barrier(const XcdBarrier& b) {
    asm volatile("s_waitcnt vmcnt(0)" ::: "memory");
    __syncthreads();
    if (threadIdx.x == 0) {
        unsigned* bar = b.bar;
        __builtin_amdgcn_s_waitcnt(0);
        unsigned nloc = b.st[0], nx = b.st[1];
        if (nloc == 0u) { xcd_barrier_complete(bar, b.x, nloc, nx); b.st[0] = nloc; b.st[1] = nx; }
        const unsigned old = xb_add(&bar[XB_XSUB(b.x)], 1u);
        const unsigned gen = old / nloc;
        if (old + 1u == (gen + 1u) * nloc) {
            __builtin_amdgcn_fence(__ATOMIC_RELEASE, "agent");
            asm volatile("s_waitcnt vmcnt(0)" ::: "memory");
            const unsigned og = xb_add(&bar[XB_TOP], 1u);
            const unsigned tg = og / nx;
            if (og + 1u == (tg + 1u) * nx) xb_add(&bar[XB_TOPGEN], 1u);
            else XB_SPIN(xb_ld(&bar[XB_TOPGEN]) == tg, bar);
            __builtin_amdgcn_fence(__ATOMIC_ACQUIRE, "agent");
            xb_add(&bar[XB_XGEN(b.x)], 1u);
            asm volatile("s_waitcnt vmcnt(0)" ::: "memory");
        } else {
            XB_SPIN(xb_ld(&bar[XB_XGEN(b.x)]) == gen, bar);
            __builtin_amdgcn_fence(__ATOMIC_ACQUIRE, "agent");
            asm volatile("s_waitcnt vmcnt(0)" ::: "memory");
        }
    }
    __syncthreads();
}

struct Args {
    const float* x; const float* c; const float* ada_w; const float* ada_b; const float* mix_g; const float* ffn_g; const float* w_in;
    const float* da_lambda; const float* da_subln; const float* na_rpb; const float* wpa; const float* wpn; const float* wpd; const float* w_out;
    const float* rgw; const float* rgb; const float* rew; const float* reb; const float* ew1; const float* ew3; const float* ew2; const float* fin_g;
    float* out; unsigned char* ws; int ph_lo, ph_hi; int variant, pad;
};

__device__ const double ROPE_INV[32] = {
    1.0, 0.7498942093324559, 0.5623413251903491, 0.4216965034285822, 0.31622776601683794, 0.23713737056616552, 0.1778279410038923, 0.1333521432163324,
    0.1, 0.07498942093324558, 0.05623413251903491, 0.04216965034285822, 0.031622776601683794, 0.023713737056616554, 0.01778279410038923, 0.01333521432163324,
    0.01, 0.007498942093324558, 0.005623413251903491, 0.004216965034285822, 0.0031622776601683794, 0.0023713737056616554, 0.001778279410038923, 0.001333521432163324,
    0.001, 0.0007498942093324559, 0.0005623413251903491, 0.0004216965034285822, 0.00031622776601683794, 0.00023713737056616554, 0.0001778279410038923, 0.0001333521432163324};

__device__ __forceinline__ void sincos_d(double a, float& s, float& c) {
    const double k = __builtin_rint(a * 0.6366197723675814);
    double t = __builtin_fma(-k, 1.5707963267948966, a); t = __builtin_fma(-k, 6.123233995736766e-17, t);
    const double t2 = t * t;
    double sp = -1.0 / 1307674368000.0; sp = sp * t2 + 1.0 / 6227020800.0; sp = sp * t2 - 1.0 / 39916800.0; sp = sp * t2 + 1.0 / 362880.0; sp = sp * t2 - 1.0 / 5040.0; sp = sp * t2 + 1.0 / 120.0; sp = sp * t2 - 1.0 / 6.0; sp = sp * t2 + 1.0; sp *= t;
    double cp = 1.0 / 87178291200.0; cp = cp * t2 - 1.0 / 479001600.0; cp = cp * t2 + 1.0 / 3628800.0; cp = cp * t2 - 1.0 / 40320.0; cp = cp * t2 + 1.0 / 720.0; cp = cp * t2 - 1.0 / 24.0; cp = cp * t2 + 0.5; cp = 1.0 - cp * t2;
    const int q = ((int)k) & 3;
    const double ss = (q == 0) ? sp : (q == 1) ? cp : (q == 2) ? -sp : -cp;
    const double cc = (q == 0) ? cp : (q == 1) ? -sp : (q == 2) ? -cp : sp;
    s = (float)ss; c = (float)cc;
}

__device__ __forceinline__ int dst_row(int mode, int n) {
    if (mode == 1) { const bool rot = (n < 1024) || (n >= ZQD && n < ZVD); if (rot) { const int j = n & 63; return (n & ~63) + ((j & 31) << 1) + (j >> 5); } return n; }
    if (mode == 2) return 256 * (n >> 7) + (n & 127);
    if (mode == 3) return 256 * (n >> 7) + 128 + (n & 127);
    return n;
}
__device__ __forceinline__ void tr_item(const float* W, int N, bf16_t* WT, int ldt, int koff, int mode, LAS float* scr, int item, int lane) {
    const int nblk = N / 32, kb = item / nblk, nb = item % nblk, k0 = 64 * kb, n0 = 32 * nb;
#pragma unroll 8
    for (int i = 0; i < 32; ++i) { const int kk = 2 * i + (lane >> 5); scr[kk * 33 + (lane & 31)] = __builtin_nontemporal_load(&W[(size_t)(k0 + kk) * N + n0 + (lane & 31)]); }
    LDS_WAIT();
    const int c = lane & 7;
#pragma unroll
    for (int j = 0; j < 4; ++j) { const int n = (lane >> 3) + 8 * j; const LAS float* s = scr + (8 * c) * 33 + n;
        float f = 1.0f; if (mode == 1) { const int nn = n0 + n; f = (nn < ZKA || (nn >= ZQN && nn < ZKN) || (nn >= ZQD && nn < ZKD)) ? C2 : (nn >= ZG ? -LOG2E : 1.0f); }
        u32x4 o; o.x = cvt_pk_bf16(s[0 * 33] * f, s[1 * 33] * f); o.y = cvt_pk_bf16(s[2 * 33] * f, s[3 * 33] * f); o.z = cvt_pk_bf16(s[4 * 33] * f, s[5 * 33] * f); o.w = cvt_pk_bf16(s[6 * 33] * f, s[7 * 33] * f);
        *(u32x4*)(WT + (size_t)dst_row(mode, n0 + n) * ldt + koff + k0 + 8 * c) = o; }
    LDS_WAIT();
}

__device__ __forceinline__ float max3f(float a, float b, float c) { float r; asm("v_max3_f32 %0, %1, %2, %3" : "=v"(r) : "v"(a), "v"(b), "v"(c)); return r; }
__device__ __forceinline__ int crow(int r, int hi) { return (r & 3) + 8 * (r >> 2) + 4 * hi; }
__device__ __forceinline__ float swapmax(float m) { float a = m, b = m; swap32(a, b); return __builtin_fmaxf(a, b); }
__device__ __forceinline__ float swapsum(float m) { float a = m, b = m; swap32(a, b); return a + b; }
typedef short v4i16_t __attribute__((ext_vector_type(4)));
__device__ __forceinline__ s16x4 vtr(const LAS unsigned char* p) { return __builtin_bit_cast(s16x4, __builtin_amdgcn_ds_read_tr16_b64_v4i16((LAS v4i16_t*)p)); }

template <int DV> struct AttnCfg { static constexpr int ND = DV / 32, NCH = DV / 16, VST = DV * 2 + 64; };

template <int DV> struct TileRegs { u32x4 kr[4]; u32x4 vr[4]; };
template <int DV>
__device__ __forceinline__ void tile_load(TileRegs<DV>& T, const char* zb, const unsigned (&roff)[4], unsigned kcol, unsigned vcol) {
    const unsigned cb = 16u * (threadIdx.x & 7);
#pragma unroll
    for (int i = 0; i < 4; ++i) { T.kr[i] = *(const u32x4*)(zb + (size_t)(roff[i] + kcol + cb)); T.vr[i] = *(const u32x4*)(zb + (size_t)(roff[i] + vcol + cb)); }
}
__device__ __forceinline__ float max16m(const f32x16& p, float m) { float a, b;
    asm("v_max3_f32 %0, %2, %3, %4\n\tv_max3_f32 %1, %5, %6, %7\n\tv_max3_f32 %0, %0, %8, %9\n\tv_max3_f32 %1, %1, %10, %11\n\tv_max3_f32 %0, %0, %12, %13\n\tv_max3_f32 %1, %1, %14, %15\n\t"
        "v_max3_f32 %0, %0, %16, %17\n\tv_max3_f32 %0, %0, %1, %18"
        : "=&v"(a), "=&v"(b) : "v"(p[0]), "v"(p[1]), "v"(p[2]), "v"(p[3]), "v"(p[4]), "v"(p[5]), "v"(p[6]), "v"(p[7]), "v"(p[8]), "v"(p[9]), "v"(p[10]), "v"(p[11]), "v"(p[12]), "v"(p[13]), "v"(p[14]), "v"(p[15]), "v"(m));
    return a; }
template <int DV, class MaskF, class Reload>
__device__ __forceinline__ void attn_tile(f32x16 (&o)[DV / 32], float& m, float& l, const bf16x8 (&qf)[4], TileRegs<DV>& T,
                                          LAS unsigned char* vlds, LAS float* wsf, const MaskF& maskf, const Reload& reload, int lane, int hi) {
    constexpr int ND = AttnCfg<DV>::ND, VST = AttnCfg<DV>::VST, KST = 144;
    static_assert(DV == 64, "gather tiles are 64 wide");
    CBAR();
    { LAS unsigned char* kw = vlds + 6144 + (lane >> 3) * KST + (lane & 7) * 16; LAS unsigned char* vw = vlds + (lane >> 3) * VST + (lane & 7) * 16;
#pragma unroll
      for (int i = 0; i < 4; ++i) { *(LAS u32x4*)(kw + 8 * i * KST) = T.kr[i]; *(LAS u32x4*)(vw + 8 * i * VST) = T.vr[i]; } }
    CBAR();
    reload(T);
    f32x16 p; maskf(p);
    { const LAS unsigned char* kp = vlds + 6144 + (lane & 31) * KST + hi * 16;
#pragma unroll
      for (int d0 = 0; d0 < 4; ++d0) { const bf16x8 kf = *(const LAS bf16x8*)(kp + 32 * d0); p = __builtin_amdgcn_mfma_f32_32x32x16_bf16(kf, qf[d0], p, 0, 0, 0); } }
    asm volatile("s_nop 15\n\ts_nop 7" : "+v"(p));
    float mx = max16m(p, m);
    { float a = mx, b = mx; swap32(a, b); mx = max3f(a, b, m); }
    const float mn = (mx > m + RESCALE_THR) ? mx : m;
    const float alpha = fexp2(m - mn);
    m = mn;
    float rs = 0.f;
#pragma unroll
    for (int r = 0; r < 16; ++r) { p[r] = fexp2(p[r] - mn); rs += p[r]; }
    l = l * alpha + rs;
    if (__any(alpha != 1.0f)) {
        CBAR();
        if (hi == 0) wsf[lane & 31] = alpha;
        CBAR();
#pragma unroll
        for (int g4 = 0; g4 < 4; ++g4) { const f32x4 a4 = *(const LAS f32x4*)(wsf + 8 * g4 + 4 * hi);
#pragma unroll
            for (int d0 = 0; d0 < ND; ++d0) { o[d0][4 * g4 + 0] *= a4[0]; o[d0][4 * g4 + 1] *= a4[1]; o[d0][4 * g4 + 2] *= a4[2]; o[d0][4 * g4 + 3] *= a4[3]; } }
        CBAR();
    }
    CBAR();
    u32x4 pw0, pw1;
    pw0.x = cvtpk_s(p[0], p[1]); pw0.y = cvtpk_s(p[2], p[3]); pw0.z = cvtpk_s(p[4], p[5]); pw0.w = cvtpk_s(p[6], p[7]);
    pw1.x = cvtpk_s(p[8], p[9]); pw1.y = cvtpk_s(p[10], p[11]); pw1.z = cvtpk_s(p[12], p[13]); pw1.w = cvtpk_s(p[14], p[15]);
    const bf16x8 pa0 = __builtin_bit_cast(bf16x8, pw0), pa1 = __builtin_bit_cast(bf16x8, pw1);
    const int li = lane & 15, g16 = lane >> 4;
    const LAS unsigned char* vb = vlds + (4 * hi + (li >> 2)) * VST + (16 * (g16 & 1) + 4 * (li & 3)) * 2;
    s16x4 vlo[2][ND], vhi[2][ND];
#pragma unroll
    for (int s = 0; s < 2; ++s)
#pragma unroll
        for (int d0 = 0; d0 < ND; ++d0) { vlo[s][d0] = vtr(vb + (16 * s) * VST + d0 * 64); vhi[s][d0] = vtr(vb + (16 * s + 8) * VST + d0 * 64); }
    __builtin_amdgcn_sched_barrier(0);
#pragma unroll
    for (int s = 0; s < 2; ++s)
#pragma unroll
        for (int d0 = 0; d0 < ND; ++d0) {
            const bf16x8 vf = (bf16x8){vlo[s][d0][0], vlo[s][d0][1], vlo[s][d0][2], vlo[s][d0][3], vhi[s][d0][0], vhi[s][d0][1], vhi[s][d0][2], vhi[s][d0][3]};
            o[d0] = __builtin_amdgcn_mfma_f32_32x32x16_bf16(s == 0 ? pa0 : pa1, vf, o[d0], 0, 0, 0);
        }
    CBAR();
}
template <int ND>
__device__ __forceinline__ void attn_finish(f32x16 (&o)[ND], float l, LAS float* wsf, int lane, int hi) {
    const float inv = frcp(swapsum(l));
    CBAR();
    if (hi == 0) wsf[lane & 31] = inv;
    CBAR();
#pragma unroll
    for (int g4 = 0; g4 < 4; ++g4) { const f32x4 a4 = *(const LAS f32x4*)(wsf + 8 * g4 + 4 * hi);
#pragma unroll
        for (int d0 = 0; d0 < ND; ++d0) { o[d0][4 * g4 + 0] *= a4[0]; o[d0][4 * g4 + 1] *= a4[1]; o[d0][4 * g4 + 2] *= a4[2]; o[d0][4 * g4 + 3] *= a4[3]; } }
    CBAR();
}

__device__ __forceinline__ void glds16s(const void* sbase, unsigned voff, unsigned lds_dst) { unsigned keep;
    asm volatile("s_mov_b32 %0, m0\n\ts_mov_b32 m0, %2\n\ts_nop 0\n\tglobal_load_lds_dwordx4 %1, %3\n\ts_mov_b32 m0, %0" : "=&s"(keep) : "v"(voff), "s"(lds_dst), "s"(sbase) : "memory"); }
__device__ __forceinline__ void glds16(const void* gsrc, unsigned lds_dst) { unsigned keep;
    asm volatile("s_mov_b32 %0, m0\n\ts_mov_b32 m0, %2\n\ts_nop 0\n\tglobal_load_lds_dwordx4 %1, off\n\ts_mov_b32 m0, %0" : "=&s"(keep) : "v"(gsrc), "s"(lds_dst) : "memory"); }
__device__ __forceinline__ void diff_qk(f32x16& p0, f32x16& p1, const LAS unsigned char* qlds, const LAS unsigned char* kb, int lane, int hi) {
    const int r32 = lane & 31, sw = (r32 >> 1) & 7;
    const LAS unsigned char* kp = kb + r32 * 128;
    p0 = f32x16{}; p1 = f32x16{};
#pragma unroll
    for (int d0 = 0; d0 < 4; ++d0) {
        const bf16x8 q = *(const LAS bf16x8*)(qlds + d0 * 1024 + lane * 16);
        const int po = ((2 * d0 + hi) ^ sw) << 4;
        const bf16x8 k0 = *(const LAS bf16x8*)(kp + po), k1 = *(const LAS bf16x8*)(kp + po + 4096);
        p0 = __builtin_amdgcn_mfma_f32_32x32x16_bf16(k0, q, p0, 0, 0, 0);
        p1 = __builtin_amdgcn_mfma_f32_32x32x16_bf16(k1, q, p1, 0, 0, 0);
    }
}
__device__ __forceinline__ void diff_sm_pv(f32x16 (&o)[4], float& m, float& l, f32x16& p0, f32x16& p1, const LAS unsigned char* vbuf, LAS float* wsf, int lane, int hi) {
    const int r32 = lane & 31;
    float ma = max3f(p0[0], p0[1], p1[0]), mb = max3f(p0[2], p0[3], p1[1]); ma = max3f(ma, p1[2], p1[3]);
#pragma unroll
    for (int r = 4; r < 16; r += 4) { ma = max3f(ma, p0[r], p0[r + 1]); mb = max3f(mb, p0[r + 2], p0[r + 3]); ma = max3f(ma, p1[r], p1[r + 1]); mb = max3f(mb, p1[r + 2], p1[r + 3]); }
    float mx = max3f(ma, mb, m);
    { float a = mx, b = mx; swap32(a, b); mx = max3f(a, b, m); }
    const float mn = (mx > m + RESCALE_THR) ? mx : m;
    const float alpha = fexp2(m - mn);
    m = mn;
    float rs = 0.f;
#pragma unroll
    for (int r = 0; r < 16; ++r) { p0[r] = fexp2(p0[r] - mn); p1[r] = fexp2(p1[r] - mn); rs += p0[r] + p1[r]; }
    l = l * alpha + rs;
    if (__any(alpha != 1.0f)) {
        CBAR();
        if (hi == 0) wsf[r32] = alpha;
        CBAR();
#pragma unroll
        for (int g4 = 0; g4 < 4; ++g4) { const f32x4 a4 = *(const LAS f32x4*)(wsf + 8 * g4 + 4 * hi);
#pragma unroll
            for (int d0 = 0; d0 < 4; ++d0) { o[d0][4 * g4 + 0] *= a4[0]; o[d0][4 * g4 + 1] *= a4[1]; o[d0][4 * g4 + 2] *= a4[2]; o[d0][4 * g4 + 3] *= a4[3]; } }
        CBAR();
    }
    u32x4 pw[4];
#pragma unroll
    for (int i = 0; i < 4; ++i) { pw[0][i] = cvtpk_s(p0[2 * i], p0[2 * i + 1]); pw[1][i] = cvtpk_s(p0[8 + 2 * i], p0[9 + 2 * i]); pw[2][i] = cvtpk_s(p1[2 * i], p1[2 * i + 1]); pw[3][i] = cvtpk_s(p1[8 + 2 * i], p1[9 + 2 * i]); }
    const int li = lane & 15, g16 = lane >> 4;
    const LAS unsigned char* vp = vbuf + hi * 1024 + (li >> 2) * 64 + (16 * (g16 & 1) + 4 * (li & 3)) * 2;
#pragma unroll
    for (int s4 = 0; s4 < 4; ++s4) {
        const bf16x8 pa = __builtin_bit_cast(bf16x8, pw[s4]);
#pragma unroll
        for (int d0 = 0; d0 < 4; ++d0) {
            const s16x4 lo = vtr(vp + s4 * 4096 + d0 * 256), hh = vtr(vp + s4 * 4096 + 2048 + d0 * 256);
            const bf16x8 vf = (bf16x8){lo[0], lo[1], lo[2], lo[3], hh[0], hh[1], hh[2], hh[3]};
            o[d0] = __builtin_amdgcn_mfma_f32_32x32x16_bf16(pa, vf, o[d0], 0, 0, 0);
        }
    }
}

__device__ __forceinline__ void diff_sm(f32x16 (&o)[4], float& m, float& l, f32x16& p0, f32x16& p1, u32x4 (&pw)[4], LAS float* wsf, int lane, int hi) {
    const int r32 = lane & 31;
    float ma = max3f(p0[0], p0[1], p1[0]), mb = max3f(p0[2], p0[3], p1[1]); ma = max3f(ma, p1[2], p1[3]);
#pragma unroll
    for (int r = 4; r < 16; r += 4) { ma = max3f(ma, p0[r], p0[r + 1]); mb = max3f(mb, p0[r + 2], p0[r + 3]); ma = max3f(ma, p1[r], p1[r + 1]); mb = max3f(mb, p1[r + 2], p1[r + 3]); }
    float mx = max3f(ma, mb, m);
    { float a = mx, b = mx; swap32(a, b); mx = max3f(a, b, m); }
    const float mn = (mx > m + RESCALE_THR) ? mx : m;
    const float alpha = fexp2(m - mn);
    m = mn;
    float rs = 0.f;
#pragma unroll
    for (int r = 0; r < 16; ++r) { p0[r] = fexp2(p0[r] - mn); p1[r] = fexp2(p1[r] - mn); rs += p0[r] + p1[r]; }
    l = l * alpha + rs;
    if (__any(alpha != 1.0f)) {
        CBAR();
        if (hi == 0) wsf[r32] = alpha;
        CBAR();
#pragma unroll
        for (int g4 = 0; g4 < 4; ++g4) { const f32x4 a4 = *(const LAS f32x4*)(wsf + 8 * g4 + 4 * hi);
#pragma unroll
            for (int d0 = 0; d0 < 4; ++d0) { o[d0][4 * g4 + 0] *= a4[0]; o[d0][4 * g4 + 1] *= a4[1]; o[d0][4 * g4 + 2] *= a4[2]; o[d0][4 * g4 + 3] *= a4[3]; } }
        CBAR();
    }
#pragma unroll
    for (int i = 0; i < 4; ++i) { pw[0][i] = cvtpk_s(p0[2 * i], p0[2 * i + 1]); pw[1][i] = cvtpk_s(p0[8 + 2 * i], p0[9 + 2 * i]); pw[2][i] = cvtpk_s(p1[2 * i], p1[2 * i + 1]); pw[3][i] = cvtpk_s(p1[8 + 2 * i], p1[9 + 2 * i]); }
}
__device__ __forceinline__ void diff_pv2(f32x16 (&o0)[4], f32x16 (&o1)[4], const u32x4 (&pw0)[4], const u32x4 (&pw1)[4], const LAS unsigned char* vbuf, int lane_, int hi_) {
    int lane = lane_; asm volatile("" : "+v"(lane));
    const int hi = lane >> 5; (void)hi_;
    const int li = lane & 15, g16 = lane >> 4;
    const LAS unsigned char* vp = vbuf + hi * 1024 + (li >> 2) * 64 + (16 * (g16 & 1) + 4 * (li & 3)) * 2;
    __builtin_amdgcn_s_setprio(1);
#pragma unroll
    for (int s4 = 0; s4 < 4; ++s4) {
        const bf16x8 pa0 = __builtin_bit_cast(bf16x8, pw0[s4]), pa1 = __builtin_bit_cast(bf16x8, pw1[s4]);
#pragma unroll
        for (int d0 = 0; d0 < 4; ++d0) {
            const s16x4 lo = vtr(vp + s4 * 4096 + d0 * 256), hh = vtr(vp + s4 * 4096 + 2048 + d0 * 256);
            const bf16x8 vf = (bf16x8){lo[0], lo[1], lo[2], lo[3], hh[0], hh[1], hh[2], hh[3]};
            o0[d0] = __builtin_amdgcn_mfma_f32_32x32x16_bf16(pa0, vf, o0[d0], 0, 0, 0);
            o1[d0] = __builtin_amdgcn_mfma_f32_32x32x16_bf16(pa1, vf, o1[d0], 0, 0, 0);
        }
    }
    __builtin_amdgcn_s_setprio(0);
}
__device__ __forceinline__ void diff_qk_f(f32x16& p0, f32x16& p1, const LAS unsigned char* qlds, const LAS unsigned char* kb, const LAS unsigned char* ap, const LAS unsigned char* bp, int lane_, int hi_) {
    int lane = lane_; asm volatile("" : "+v"(lane));
    const int hi = lane >> 5; (void)hi_;
    const int r32 = lane & 31, sw = (r32 >> 1) & 7;
    const LAS unsigned char* kp = kb + r32 * 128;
    { const bf16x8 a1 = *(const LAS bf16x8*)ap, bm = *(const LAS bf16x8*)bp;
      p0 = __builtin_amdgcn_mfma_f32_32x32x16_bf16(a1, bm, f32x16{}, 0, 0, 0);
      p1 = __builtin_amdgcn_mfma_f32_32x32x16_bf16(a1, bm, f32x16{}, 0, 0, 0); }
#pragma unroll
    for (int d0 = 0; d0 < 4; ++d0) {
        const bf16x8 q = *(const LAS bf16x8*)(qlds + d0 * 1024 + lane * 16);
        const int po = ((2 * d0 + hi) ^ sw) << 4;
        const bf16x8 k0 = *(const LAS bf16x8*)(kp + po), k1 = *(const LAS bf16x8*)(kp + po + 4096);
        p0 = __builtin_amdgcn_mfma_f32_32x32x16_bf16(k0, q, p0, 0, 0, 0);
        p1 = __builtin_amdgcn_mfma_f32_32x32x16_bf16(k1, q, p1, 0, 0, 0);
    }
}
__device__ __forceinline__ void diff_sm_head(f32x16 (&o)[4], float& m, float& l, f32x16& p0, f32x16& p1, LAS float* wsf, LAS unsigned char* bslot, bool first, int lane, int hi) {
    float ma = max3f(p0[0], p0[1], p1[0]), mb = max3f(p0[2], p0[3], p1[1]); ma = max3f(ma, p1[2], p1[3]);
#pragma unroll
    for (int r = 4; r < 16; r += 4) { ma = max3f(ma, p0[r], p0[r + 1]); mb = max3f(mb, p0[r + 2], p0[r + 3]); ma = max3f(ma, p1[r], p1[r + 1]); mb = max3f(mb, p1[r + 2], p1[r + 3]); }
    float mx = __builtin_fmaxf(ma, mb);
    { float a = mx, b = mx; swap32(a, b); mx = __builtin_fmaxf(a, b); }
    const bool up = first || (mx > RESCALE_THR);
    if (__any(up)) {
        const float mnew = up ? __builtin_bit_cast(float, f2bf(m + mx) << 16) : m, delta = mnew - m;
        const float alpha = fexp2(-delta);
        m = mnew; l *= alpha;
        CBAR();
        int l2 = lane; asm volatile("" : "+v"(l2));
        if (hi == 0) { wsf[l2 & 31] = alpha; *(LAS unsigned*)bslot = f2bf(-mnew); }
        CBAR();
#pragma unroll
        for (int g4 = 0; g4 < 4; ++g4) { const f32x4 a4 = *(const LAS f32x4*)(wsf + 8 * g4 + 4 * (l2 >> 5));
#pragma unroll
            for (int d0 = 0; d0 < 4; ++d0) { o[d0][4 * g4 + 0] *= a4[0]; o[d0][4 * g4 + 1] *= a4[1]; o[d0][4 * g4 + 2] *= a4[2]; o[d0][4 * g4 + 3] *= a4[3]; } }
#pragma unroll
        for (int r = 0; r < 16; ++r) { p0[r] -= delta; p1[r] -= delta; }
        CBAR();
    }
}
__device__ __forceinline__ void diff_sm_tail(float& l, f32x16& p0, f32x16& p1, u32x4 (&pw)[4]) {
    float rs = 0.f;
#pragma unroll
    for (int r = 0; r < 16; ++r) { p0[r] = fexp2(p0[r]); p1[r] = fexp2(p1[r]); rs += p0[r] + p1[r]; }
    l += rs;
#pragma unroll
    for (int i = 0; i < 4; ++i) { pw[0][i] = cvtpk_s(p0[2 * i], p0[2 * i + 1]); pw[1][i] = cvtpk_s(p0[8 + 2 * i], p0[9 + 2 * i]); pw[2][i] = cvtpk_s(p1[2 * i], p1[2 * i + 1]); pw[3][i] = cvtpk_s(p1[8 + 2 * i], p1[9 + 2 * i]); }
}
__device__ __forceinline__ void diff_tail_pv2(f32x16 (&o0)[4], f32x16 (&o1)[4], float& l0, float& l1, const f32x16& a0, const f32x16& a1, const f32x16& b0, const f32x16& b1, const LAS unsigned char* vbuf, int lane_) {
    int lane = lane_; asm volatile("" : "+v"(lane));
    const int hi = lane >> 5, li = lane & 15, g16 = lane >> 4;
    const LAS unsigned char* vp = vbuf + hi * 1024 + (li >> 2) * 64 + (16 * (g16 & 1) + 4 * (li & 3)) * 2;
    float rs0 = 0.f, rs1 = 0.f;
    u32x4 pa, pb, pan = {0u, 0u, 0u, 0u}, pbn = {0u, 0u, 0u, 0u};
#define TP_A(st, i) do { const int r_ = ((st) & 1) * 8 + 2 * (i); const float e0_ = fexp2((st) < 2 ? a0[r_] : a1[r_]), e1_ = fexp2((st) < 2 ? a0[r_ + 1] : a1[r_ + 1]); rs0 += e0_; rs0 += e1_; asm volatile("" : "+v"(rs0)); pan[i] = cvtpk_s(e0_, e1_); } while (0)
#define TP_B(st, i) do { const int r_ = ((st) & 1) * 8 + 2 * (i); const float e0_ = fexp2((st) < 2 ? b0[r_] : b1[r_]), e1_ = fexp2((st) < 2 ? b0[r_ + 1] : b1[r_ + 1]); rs1 += e0_; rs1 += e1_; asm volatile("" : "+v"(rs1)); pbn[i] = cvtpk_s(e0_, e1_); } while (0)
#pragma unroll
    for (int i = 0; i < 4; ++i) { TP_A(0, i); TP_B(0, i); }
    pa = pan; pb = pbn;
    s16x4 flo[3], fhh[3];
#define TP_RD(c) do { flo[(c) % 3] = vtr(vp + ((c) >> 2) * 4096 + ((c) & 3) * 256); fhh[(c) % 3] = vtr(vp + ((c) >> 2) * 4096 + 2048 + ((c) & 3) * 256); } while (0)
    TP_RD(0); TP_RD(1);
    __builtin_amdgcn_sched_barrier(0);
#pragma unroll
    for (int c = 0; c < 16; ++c) {
        const int st = c >> 2, d0 = c & 3;
        if (c + 2 < 16) TP_RD(c + 2);
        const bf16x8 vf = (bf16x8){flo[c % 3][0], flo[c % 3][1], flo[c % 3][2], flo[c % 3][3], fhh[c % 3][0], fhh[c % 3][1], fhh[c % 3][2], fhh[c % 3][3]};
        o0[d0] = __builtin_amdgcn_mfma_f32_32x32x16_bf16(__builtin_bit_cast(bf16x8, pa), vf, o0[d0], 0, 0, 0);
        if (st < 3) TP_A(st + 1, d0);
        __builtin_amdgcn_sched_barrier(0);
        o1[d0] = __builtin_amdgcn_mfma_f32_32x32x16_bf16(__builtin_bit_cast(bf16x8, pb), vf, o1[d0], 0, 0, 0);
        if (st < 3) TP_B(st + 1, d0);
        __builtin_amdgcn_sched_barrier(0);
        if (d0 == 3) { pa = pan; pb = pbn; }
    }
#undef TP_A
#undef TP_B
#undef TP_RD
    l0 += rs0; l1 += rs1;
}
__device__ __forceinline__ void hm_step(int k, float& ma, float& mb, const f32x16& p0, const f32x16& p1) {
    if (k == 0) ma = max3f(p0[0], p0[1], p1[0]);
    else if (k == 1) mb = max3f(p0[2], p0[3], p1[1]);
    else if (k == 2) ma = max3f(ma, p1[2], p1[3]);
    else { const int j = (k - 3) >> 2, w = (k - 3) & 3, r = 4 + 4 * j;
        if (w == 0) ma = max3f(ma, p0[r], p0[r + 1]); else if (w == 1) mb = max3f(mb, p0[r + 2], p0[r + 3]); else if (w == 2) ma = max3f(ma, p1[r], p1[r + 1]); else mb = max3f(mb, p1[r + 2], p1[r + 3]); }
}
__device__ __forceinline__ void hm_finish(f32x16 (&o)[4], float& m, float& l, float ma, float mb, f32x16& p0, f32x16& p1, LAS float* wsf, LAS unsigned char* bslot, bool first, int lane) {
    float mx = __builtin_fmaxf(ma, mb);
    { float a = mx, b = mx; swap32(a, b); mx = __builtin_fmaxf(a, b); }
    const bool up = first || (mx > RESCALE_THR);
    if (__any(up)) {
        const float mnew = up ? __builtin_bit_cast(float, f2bf(m + mx) << 16) : m, delta = mnew - m;
        const float alpha = fexp2(-delta);
        m = mnew; l *= alpha;
        CBAR();
        int l2 = lane; asm volatile("" : "+v"(l2));
        if ((l2 >> 5) == 0) { wsf[l2 & 31] = alpha; *(LAS unsigned*)bslot = f2bf(-mnew); }
        CBAR();
#pragma unroll
        for (int g4 = 0; g4 < 4; ++g4) { const f32x4 a4 = *(const LAS f32x4*)(wsf + 8 * g4 + 4 * (l2 >> 5));
#pragma unroll
            for (int d0 = 0; d0 < 4; ++d0) { o[d0][4 * g4 + 0] *= a4[0]; o[d0][4 * g4 + 1] *= a4[1]; o[d0][4 * g4 + 2] *= a4[2]; o[d0][4 * g4 + 3] *= a4[3]; } }
#pragma unroll
        for (int r = 0; r < 16; ++r) { p0[r] -= delta; p1[r] -= delta; }
        CBAR();
    }
}
__device__ __forceinline__ void diffA_step(f32x16 (&o0)[4], f32x16 (&o1)[4], float& m0, float& l0, float& m1, float& l1, const LAS unsigned char* qlds, const LAS unsigned char* kb0, const LAS unsigned char* kb1,
                                           const LAS unsigned char* vbuf, LAS unsigned char* bsel, LAS float* wsf, bool first, int lane_) {
    int lane = lane_; asm volatile("" : "+v"(lane));
    const int hi = lane >> 5;
    f32x16 s0, s1, s2, s3;
    diff_qk_f(s0, s1, qlds, kb0, bsel + 32, bsel, lane, hi);
#define SB() __builtin_amdgcn_sched_barrier(0)
    const int r32 = lane & 31, sw = (r32 >> 1) & 7;
    const LAS unsigned char* kp = kb1 + r32 * 128; const LAS unsigned char* qp = qlds + 4096 + lane * 16;
    float ma = 0.f, mb = 0.f, rs0 = 0.f, rs1 = 0.f;
    u32x4 pa, pb, pan, pbn;
#define TP_A(st, i) do { const int r_ = ((st) & 1) * 8 + 2 * (i); const float e0_ = fexp2((st) < 2 ? s0[r_] : s1[r_]), e1_ = fexp2((st) < 2 ? s0[r_ + 1] : s1[r_ + 1]); rs0 += e0_; rs0 += e1_; asm volatile("" : "+v"(rs0)); pan[i] = cvtpk_s(e0_, e1_); } while (0)
#define TP_B(st, i) do { const int r_ = ((st) & 1) * 8 + 2 * (i); const float e0_ = fexp2((st) < 2 ? s2[r_] : s3[r_]), e1_ = fexp2((st) < 2 ? s2[r_ + 1] : s3[r_ + 1]); rs1 += e0_; rs1 += e1_; asm volatile("" : "+v"(rs1)); pbn[i] = cvtpk_s(e0_, e1_); } while (0)
    {
        const bf16x8 a1 = *(const LAS bf16x8*)(bsel + 32), bm = *(const LAS bf16x8*)(bsel + 16);
        bf16x8 qf[2], k0f, k1f;
#define RD_Q(d0)  qf[(d0) & 1] = *(const LAS bf16x8*)(qp + (d0) * 1024)
#define RD_K0(d0) k0f = *(const LAS bf16x8*)(kp + (((2 * (d0) + hi) ^ sw) << 4))
#define RD_K1(d0) k1f = *(const LAS bf16x8*)(kp + (((2 * (d0) + hi) ^ sw) << 4) + 4096)
        RD_Q(0); RD_K0(0); RD_K1(0); RD_Q(1);
        SB();
        s2 = __builtin_amdgcn_mfma_f32_32x32x16_bf16(a1, bm, f32x16{}, 0, 0, 0);
        asm volatile("s_nop 7" : "+v"(s0), "+v"(s1));
        hm_step(0, ma, mb, s0, s1); hm_step(1, ma, mb, s0, s1);
        SB();
        s3 = __builtin_amdgcn_mfma_f32_32x32x16_bf16(a1, bm, f32x16{}, 0, 0, 0);
        hm_step(2, ma, mb, s0, s1); hm_step(3, ma, mb, s0, s1); hm_step(4, ma, mb, s0, s1);
        SB();
        s2 = __builtin_amdgcn_mfma_f32_32x32x16_bf16(k0f, qf[0], s2, 0, 0, 0);
        RD_K0(1);
        hm_step(5, ma, mb, s0, s1); hm_step(6, ma, mb, s0, s1); hm_step(7, ma, mb, s0, s1);
        SB();
        s3 = __builtin_amdgcn_mfma_f32_32x32x16_bf16(k1f, qf[0], s3, 0, 0, 0);
        RD_K1(1); RD_Q(2);
        hm_step(8, ma, mb, s0, s1); hm_step(9, ma, mb, s0, s1); hm_step(10, ma, mb, s0, s1);
        SB();
        s2 = __builtin_amdgcn_mfma_f32_32x32x16_bf16(k0f, qf[1], s2, 0, 0, 0);
        RD_K0(2);
        hm_step(11, ma, mb, s0, s1); hm_step(12, ma, mb, s0, s1);
        SB();
        s3 = __builtin_amdgcn_mfma_f32_32x32x16_bf16(k1f, qf[1], s3, 0, 0, 0);
        RD_K1(2); RD_Q(3);
        hm_step(13, ma, mb, s0, s1); hm_step(14, ma, mb, s0, s1);
        SB();
        hm_finish(o0, m0, l0, ma, mb, s0, s1, wsf, bsel, first, lane);
        SB();
        s2 = __builtin_amdgcn_mfma_f32_32x32x16_bf16(k0f, qf[0], s2, 0, 0, 0);
        RD_K0(3);
        TP_A(0, 0);
        SB();
        s3 = __builtin_amdgcn_mfma_f32_32x32x16_bf16(k1f, qf[0], s3, 0, 0, 0);
        RD_K1(3);
        TP_A(0, 1);
        SB();
        s2 = __builtin_amdgcn_mfma_f32_32x32x16_bf16(k0f, qf[1], s2, 0, 0, 0);
        TP_A(0, 2);
        SB();
        s3 = __builtin_amdgcn_mfma_f32_32x32x16_bf16(k1f, qf[1], s3, 0, 0, 0);
        TP_A(0, 3);
        SB();
#undef RD_Q
#undef RD_K0
#undef RD_K1
#define QK_RD(x)
#undef QK_RD
    }
    pa = pan;
    asm volatile("s_nop 15\n\ts_nop 7" : "+v"(s2), "+v"(s3));
    ma = 0.f; mb = 0.f;
#pragma unroll
    for (int k = 0; k < 15; ++k) hm_step(k, ma, mb, s2, s3);
    hm_finish(o1, m1, l1, ma, mb, s2, s3, wsf, bsel + 16, first, lane);
#pragma unroll
    for (int i = 0; i < 4; ++i) TP_B(0, i);
    pb = pbn;
    const int li = lane & 15, g16 = lane >> 4;
    const LAS unsigned char* vp = vbuf + hi * 1024 + (li >> 2) * 64 + (16 * (g16 & 1) + 4 * (li & 3)) * 2;
    s16x4 flo[3], fhh[3];
#define TP_RD(c) do { flo[(c) % 3] = vtr(vp + (((c) & 15) >> 2) * 4096 + ((c) & 3) * 256); fhh[(c) % 3] = vtr(vp + (((c) & 15) >> 2) * 4096 + 2048 + ((c) & 3) * 256); } while (0)
#define TP_VF(c) ((bf16x8){flo[(c) % 3][0], flo[(c) % 3][1], flo[(c) % 3][2], flo[(c) % 3][3], fhh[(c) % 3][0], fhh[(c) % 3][1], fhh[(c) % 3][2], fhh[(c) % 3][3]})
    TP_RD(0); TP_RD(1);
    SB();
#pragma unroll
    for (int c = 0; c < 16; ++c) {
        const int st = c >> 2, d0 = c & 3;
        if (c + 2 < 16) TP_RD(c + 2);
        o0[d0] = __builtin_amdgcn_mfma_f32_32x32x16_bf16(__builtin_bit_cast(bf16x8, pa), TP_VF(c), o0[d0], 0, 0, 0);
        if (st < 3) TP_A(st + 1, d0);
        SB();
        o1[d0] = __builtin_amdgcn_mfma_f32_32x32x16_bf16(__builtin_bit_cast(bf16x8, pb), TP_VF(c), o1[d0], 0, 0, 0);
        if (st < 3) TP_B(st + 1, d0);
        SB();
        if (d0 == 3) { pa = pan; pb = pbn; }
    }
#undef TP_A
#undef TP_B
#undef TP_RD
#undef TP_VF
#undef SB
    l0 += rs0; l1 += rs1;
}
struct NoMask { __device__ __forceinline__ void operator()(f32x16&) const {} };

using pg8::Unit;
struct EpiZ {
    static constexpr bool PERM = true;
    bf16_t* Z; const float* ropec; const float* ropes;
    __device__ __forceinline__ void operator()(const f32x4 (&acc)[2][2][4][2], const Unit& u, int wr, int wc, int fr, int fq) const {
        const int pn = u.pn;
        const int type = (pn < 2) ? 0 : (pn < 4) ? 1 : (pn < 6) ? 2 : (pn == 6) ? 3 : (pn < 9) ? 2 : (pn < 12) ? 0 : (pn < 15) ? 1 : (pn < 18) ? 2 : 4;
        const int row0 = u.pm * 256 + wr * 64 + fr, col0 = pn * 256 + wc * 32 + 8 * fq;
        const int j0 = 16 * (wc & 1) + 4 * fq;
#pragma unroll
        for (int ai = 0; ai < 2; ++ai) {
            f32x4 cq[4], sq[4];
#pragma unroll
            for (int m = 0; m < 4; ++m) { const int pos = (row0 + ai * 128 + m * 16) & (SEQ - 1); cq[m] = (f32x4){1.f, 1.f, 1.f, 1.f}; sq[m] = (f32x4){0.f, 0.f, 0.f, 0.f};
                if (type < 2) { cq[m] = *(const f32x4*)(ropec + pos * 32 + j0); sq[m] = *(const f32x4*)(ropes + pos * 32 + j0); } }
#pragma unroll
            for (int m = 0; m < 4; ++m) {
                const int row = row0 + ai * 128 + m * 16;
                const f32x4 c4 = cq[m], s4 = sq[m];
                bf16_t* rowp = Z + (size_t)row * ZW + col0;
#pragma unroll
                for (int bj = 0; bj < 2; ++bj) {
                    f32x4 v0 = acc[ai][bj][m][0], v1 = acc[ai][bj][m][1];
                    if (type < 2) {
                        f32x4 w0, w1;
                        w0[0] = v0[0] * c4[0] - v0[1] * s4[0]; w0[1] = v0[1] * c4[0] + v0[0] * s4[0];
                        w0[2] = v0[2] * c4[1] - v0[3] * s4[1]; w0[3] = v0[3] * c4[1] + v0[2] * s4[1];
                        w1[0] = v1[0] * c4[2] - v1[1] * s4[2]; w1[1] = v1[1] * c4[2] + v1[0] * s4[2];
                        w1[2] = v1[2] * c4[3] - v1[3] * s4[3]; w1[3] = v1[3] * c4[3] + v1[2] * s4[3];
                        v0 = w0; v1 = w1;
                    }
                    if (type == 4) {
#pragma unroll
                        for (int j = 0; j < 4; ++j) { v0[j] = __builtin_fmaxf(frcp(1.f + fexp2(v0[j])), 0.f); v1[j] = __builtin_fmaxf(frcp(1.f + fexp2(v1[j])), 0.f); }
                    }
                    u32x4 w; w.x = cvt_pk_bf16(v0[0], v0[1]); w.y = cvt_pk_bf16(v0[2], v0[3]); w.z = cvt_pk_bf16(v1[0], v1[1]); w.w = cvt_pk_bf16(v1[2], v1[3]);
                    st16_wt(rowp + bj * 128, w);
                }
                CBAR();
            }
        }
    }
};
struct EpiProj {
    static constexpr bool PERM = true;
    bf16_t* Mg; const bf16_t* Zg0;
    __device__ __forceinline__ void operator()(const f32x4 (&acc)[2][2][4][2], const Unit& u, int wr, int wc, int fr, int fq) const {
        const int row0 = u.pm * 256 + wr * 64 + fr, col0 = u.pn * 256 + wc * 32 + 8 * fq;
        const bf16_t* Zg = Zg0 + (u.e & 15) * 1024; const int first = u.e >> 4;
#pragma unroll
        for (int ai = 0; ai < 2; ++ai) {
            u32x4 gq[4][2], oq[4][2];
#pragma unroll
            for (int m = 0; m < 4; ++m)
#pragma unroll
                for (int bj = 0; bj < 2; ++bj) { const int row = row0 + ai * 128 + m * 16, col = col0 + bj * 128;
                    gq[m][bj] = *(const u32x4*)(Zg + (size_t)row * ZW + col);
                    oq[m][bj] = first ? (u32x4){0u, 0u, 0u, 0u} : *(const u32x4*)(Mg + (size_t)row * D + col); }
#pragma unroll
            for (int m = 0; m < 4; ++m)
#pragma unroll
                for (int bj = 0; bj < 2; ++bj) { const int row = row0 + ai * 128 + m * 16, col = col0 + bj * 128;
                    const u32x4 g = gq[m][bj], o = oq[m][bj];
                    const f32x4 v0 = acc[ai][bj][m][0], v1 = acc[ai][bj][m][1];
                    const float r0 = bflo(g.x) * v0[0] + bflo(o.x), r1 = bfhi(g.x) * v0[1] + bfhi(o.x), r2 = bflo(g.y) * v0[2] + bflo(o.y), r3 = bfhi(g.y) * v0[3] + bfhi(o.y);
                    const float r4 = bflo(g.z) * v1[0] + bflo(o.z), r5 = bfhi(g.z) * v1[1] + bfhi(o.z), r6 = bflo(g.w) * v1[2] + bflo(o.w), r7 = bfhi(g.w) * v1[3] + bfhi(o.w);
                    u32x4 w; w.x = cvt_pk_bf16(r0, r1); w.y = cvt_pk_bf16(r2, r3); w.z = cvt_pk_bf16(r4, r5); w.w = cvt_pk_bf16(r6, r7);
                    *(u32x4*)(Mg + (size_t)row * D + col) = w; }
            CBAR();
        }
    }
};
struct EpiOut {
    static constexpr bool PERM = true;
    bf16_t* X; const float* gate;
    __device__ __forceinline__ void operator()(const f32x4 (&acc)[2][2][4][2], const Unit& u, int wr, int wc, int fr, int fq) const {
        const int row0 = u.pm * 256 + wr * 64 + fr, col0 = u.pn * 256 + wc * 32 + 8 * fq;
        const int b = (u.pm * 256) / SEQ;
        f32x4 gv[2][2];
#pragma unroll
        for (int bj = 0; bj < 2; ++bj)
#pragma unroll
            for (int n = 0; n < 2; ++n) gv[bj][n] = *(const f32x4*)(gate + (size_t)b * 6 * D + col0 + bj * 128 + 4 * n);
        u32x4 xq[2][4][2];
#pragma unroll
        for (int ai = 0; ai < 2; ++ai)
#pragma unroll
            for (int m = 0; m < 4; ++m)
#pragma unroll
                for (int bj = 0; bj < 2; ++bj) xq[ai][m][bj] = *(const u32x4*)(X + (size_t)(row0 + ai * 128 + m * 16) * D + col0 + bj * 128);
#pragma unroll
        for (int ai = 0; ai < 2; ++ai) {
#pragma unroll
            for (int m = 0; m < 4; ++m)
#pragma unroll
                for (int bj = 0; bj < 2; ++bj) { const u32x4 o = xq[ai][m][bj];
                    const f32x4 r0 = (f32x4){bflo(o.x), bfhi(o.x), bflo(o.y), bfhi(o.y)} + gv[bj][0] * acc[ai][bj][m][0], r1 = (f32x4){bflo(o.z), bfhi(o.z), bflo(o.w), bfhi(o.w)} + gv[bj][1] * acc[ai][bj][m][1];
                    u32x4 w; w.x = cvt_pk_bf16(r0[0], r0[1]); w.y = cvt_pk_bf16(r0[2], r0[3]); w.z = cvt_pk_bf16(r1[0], r1[1]); w.w = cvt_pk_bf16(r1[2], r1[3]);
                    *(u32x4*)(X + (size_t)(row0 + ai * 128 + m * 16) * D + col0 + bj * 128) = w; }
            CBAR();
        }
    }
};
struct EpiSwiglu {
    static constexpr bool PERM = true;
    bf16_t* H;
    __device__ __forceinline__ void operator()(const f32x4 (&acc)[2][2][4][2], const Unit& u, int wr, int wc, int fr, int fq) const {
        const int row0 = u.pm * 256 + wr * 64 + fr, hc = u.pn * 128 + wc * 32 + 8 * fq;
#pragma unroll
        for (int ai = 0; ai < 2; ++ai)
#pragma unroll
            for (int m = 0; m < 4; ++m) {
                const int row = row0 + ai * 128 + m * 16;
                float h[8];
#pragma unroll
                for (int n = 0; n < 2; ++n) { const f32x4 a = acc[ai][0][m][n], b = acc[ai][1][m][n];
#pragma unroll
                    for (int j = 0; j < 4; ++j) h[4 * n + j] = a[j] * frcp(1.f + fexp2(-a[j] * LOG2E)) * b[j]; }
                u32x4 w; w.x = cvt_pk_bf16(h[0], h[1]); w.y = cvt_pk_bf16(h[2], h[3]); w.z = cvt_pk_bf16(h[4], h[5]); w.w = cvt_pk_bf16(h[6], h[7]);
                st16_wt(H + (size_t)row * EH + hc, w);
            }
    }
};
struct EpiY {
    static constexpr bool PERM = true;
    bf16_t* Y;
    __device__ __forceinline__ void operator()(const f32x4 (&acc)[2][2][4][2], const Unit& u, int wr, int wc, int fr, int fq) const {
        const int row0 = u.pm * 256 + wr * 64 + fr, col0 = u.pn * 256 + wc * 32 + 8 * fq;
#pragma unroll
        for (int ai = 0; ai < 2; ++ai)
#pragma unroll
            for (int m = 0; m < 4; ++m) { bf16_t* rowp = Y + (size_t)(row0 + ai * 128 + m * 16) * D + col0;
#pragma unroll
                for (int bj = 0; bj < 2; ++bj) { const f32x4 v0 = acc[ai][bj][m][0], v1 = acc[ai][bj][m][1];
                    u32x4 w; w.x = cvt_pk_bf16(v0[0], v0[1]); w.y = cvt_pk_bf16(v0[2], v0[3]); w.z = cvt_pk_bf16(v1[0], v1[1]); w.w = cvt_pk_bf16(v1[2], v1[3]);
                    *(u32x4*)(rowp + bj * 128) = w; } }
    }
};

constexpr int NWAVES = 8;
constexpr int NPHASE = 2 + 9 * DEPTH;

__global__ void __launch_bounds__(NWAVES * 64, 2) fwd_kernel(Args args) {
    extern __shared__ __attribute__((aligned(16))) unsigned char lds_raw[];
    LAS unsigned char* lds = (LAS unsigned char*)lds_raw;
    volatile LAS unsigned* MISC = (volatile LAS unsigned*)(lds + MISC_OFF);
    const int tid0 = threadIdx.x;
    const int G = gridDim.x, bx = blockIdx.x;
    const int vcu = (G % 8 == 0) ? (bx % 8) * (G / 8) + bx / 8 : bx;
    const int NGW = G * NWAVES;
#define WSP() size_t wsz_ = 0; asm volatile("" : "+s"(wsz_)); unsigned char* ws = args.ws + wsz_; \
    int tid = tid0; asm volatile("" : "+v"(tid)); const int lane = tid & 63, wave = __builtin_amdgcn_readfirstlane(tid >> 6), hi = lane >> 5, gw = vcu * NWAVES + wave; (void)hi; (void)gw; (void)lane; (void)wave; \
    unsigned* ctl = (unsigned*)(ws + WS_CTL); float* rtab = (float*)(ws + WS_RT); (void)rtab; float* modp = (float*)(ws + WS_MOD); float* ropec = (float*)(ws + WS_ROPE); float* ropes = ropec + SEQ * 32; \
    int* tok_e = (int*)(ws + WS_ROUTE); int* tok_pos = tok_e + 2 * M; float* tok_w = (float*)(tok_pos + 2 * M); int* tok_slot = (int*)(tok_w + 2 * M); int* etok = (int*)(ws + WS_ROUTE + 2 * MiB); \
    bf16_t* X = (bf16_t*)(ws + WS_X); bf16_t* Hn = (bf16_t*)(ws + WS_H); bf16_t* OC = (bf16_t*)(ws + WS_OCAT); bf16_t* MG = (bf16_t*)(ws + WS_MERGED); bf16_t* Z = (bf16_t*)(ws + WS_Z); \
    bf16_t* XG = (bf16_t*)(ws + WS_XG); bf16_t* HB = (bf16_t*)(ws + WS_HB); bf16_t* YB = (bf16_t*)(ws + WS_YB); \
    bf16_t* WIN = (bf16_t*)(ws + WS_WIN); bf16_t* WPR = (bf16_t*)(ws + WS_WPROJ); bf16_t* WOU = (bf16_t*)(ws + WS_WOUT); bf16_t* W13 = (bf16_t*)(ws + WS_W13); bf16_t* W2 = (bf16_t*)(ws + WS_W2); \
    (void)ctl; (void)modp; (void)ropec; (void)ropes; (void)tok_e; (void)tok_pos; (void)tok_w; (void)tok_slot; (void)etok; (void)X; (void)Hn; (void)OC; (void)MG; (void)Z; (void)XG; (void)HB; (void)YB; (void)WIN; (void)WPR; (void)WOU; (void)W13; (void)W2;
    for (int u = tid0; u < 128; u += NWAVES * 64) MISC[u] = 0u;
    __syncthreads();
#if !MK_PER_PHASE
    XcdBarrier bar = xcd_barrier_post((unsigned*)(args.ws + WS_CTL) + CW_BAR, MISC + 8);
#define GRID_BAR() xcd_barrier(bar)
#else
#define GRID_BAR() do {} while (0)
#endif
    const int lo = args.ph_lo, hi_ph = args.ph_hi;
#define IN(k) (lo <= (k) && (k) < hi_ph)
#ifndef EN_MASK
#define EN_MASK 0x3ff
#endif
#define EN(k) ((EN_MASK >> (k)) & 1)
#ifndef DUPK
#define DUPK -1
#endif
#define REP(k) for (int rep_ = 0; rep_ < ((k) == DUPK ? 2 : 1); ++rep_, __syncthreads())
#define SEAM(k) do { if (IN(k) && IN((k) + 1)) GRID_BAR(); } while (0)

    if (IN(0) && EN(0)) REP(0) {
        WSP();
        {
            LAS float* cact = (LAS float*)lds;
            LAS float* part = (LAS float*)(lds + 16384);
            for (int i = tid; i < NBATCH * D; i += NWAVES * 64) { const int b = i / D, k = i % D; const float v = args.c[i]; cact[k * 4 + b] = v / (1.f + __expf(-v)); }
            __syncthreads();
            for (int it = bx; it < DEPTH * 96; it += G) {
                const int l = it / 96, cc = it % 96, col = cc * 64 + lane;
                const float* wp = args.ada_w + (size_t)l * D * 6 * D + col;
                float a0 = 0.f, a1 = 0.f, a2 = 0.f, a3 = 0.f;
#pragma unroll 1
                for (int k0 = 0; k0 < 128; k0 += 32) {
                    float wv[32];
#pragma unroll
                    for (int kk = 0; kk < 32; ++kk) wv[kk] = wp[(size_t)(wave * 128 + k0 + kk) * 6 * D];
#pragma unroll
                    for (int kk = 0; kk < 32; ++kk) { const f32x4 cv = *(const LAS f32x4*)(cact + (wave * 128 + k0 + kk) * 4);
                        a0 += cv[0] * wv[kk]; a1 += cv[1] * wv[kk]; a2 += cv[2] * wv[kk]; a3 += cv[3] * wv[kk]; } }
                part[(wave * 4 + 0) * 64 + lane] = a0; part[(wave * 4 + 1) * 64 + lane] = a1; part[(wave * 4 + 2) * 64 + lane] = a2; part[(wave * 4 + 3) * 64 + lane] = a3;
                __syncthreads();
                if (tid < 256) { const int b = tid >> 6, cl = tid & 63; float s = 0.f;
#pragma unroll
                    for (int w = 0; w < 8; ++w) s += part[(w * 4 + b) * 64 + cl];
                    modp[((size_t)l * NBATCH + b) * 6 * D + cc * 64 + cl] = s + args.ada_b[(size_t)l * 6 * D + cc * 64 + cl]; }
                __syncthreads();
            }
        }
        for (int i = (vcu * NWAVES * 64) + tid; i < SEQ * 32; i += G * NWAVES * 64) { const int pos = i >> 5, j = i & 31; float s, c; sincos_d((double)pos * ROPE_INV[j], s, c); ropec[i] = c; ropes[i] = s; }
        for (int i = (vcu * NWAVES * 64) + tid; i < DEPTH * 36 * D; i += G * NWAVES * 64) { const int k = i & (D - 1), n = (i >> 10) % 36, l2 = i / (36 * D);
            rtab[i] = n < 4 ? args.rgw[((size_t)l2 * D + k) * 4 + n] : args.rew[((size_t)l2 * D + k) * NEXP + (n - 4)]; }
        {
            LAS float* scr = (LAS float*)(lds + wave * 16384);
            constexpr int I_WIN = 16 * 240, I_PA = 8 * 32, I_PN = 4 * 32, I_WO = 16 * 32, I_E = 256, PER_L = I_WIN + I_PA + 2 * I_PN + I_WO + NEXP * 3 * I_E;
            for (int it = gw; it < DEPTH * PER_L; it += NGW) {
                const int l = it / PER_L; int r = it % PER_L;
                if (r < I_WIN) { tr_item(args.w_in + (size_t)l * D * ZW, ZW, WIN + (size_t)l * ZW * D, D, 0, 1, scr, r, lane); continue; } r -= I_WIN;
                if (r < I_PA) { tr_item(args.wpa + (size_t)l * 512 * D, D, WPR + (size_t)l * D * D, D, 0, 0, scr, r, lane); continue; } r -= I_PA;
                if (r < I_PN) { tr_item(args.wpn + (size_t)l * 256 * D, D, WPR + (size_t)l * D * D, D, 512, 0, scr, r, lane); continue; } r -= I_PN;
                if (r < I_PN) { tr_item(args.wpd + (size_t)l * 256 * D, D, WPR + (size_t)l * D * D, D, 768, 0, scr, r, lane); continue; } r -= I_PN;
                if (r < I_WO) { tr_item(args.w_out + (size_t)l * D * D, D, WOU + (size_t)l * D * D, D, 0, 0, scr, r, lane); continue; } r -= I_WO;
                const int e = r / (3 * I_E), q = r % (3 * I_E); const size_t le = (size_t)l * NEXP + e;
                if (q < I_E) tr_item(args.ew1 + le * D * EH, EH, W13 + le * 1024 * D, D, 0, 2, scr, q, lane);
                else if (q < 2 * I_E) tr_item(args.ew3 + le * D * EH, EH, W13 + le * 1024 * D, D, 0, 3, scr, q - I_E, lane);
                else tr_item(args.ew2 + le * EH * D, D, W2 + le * D * EH, EH, 0, 0, scr, q - 2 * I_E, lane);
            }
        }
    }
    SEAM(0);

    for (int l = 0; l < DEPTH; ++l) {
        const int pb = 1 + 9 * l;
        if (IN(pb + 0) && EN(1)) {
            WSP(); const float* modl = modp + (size_t)l * NBATCH * 6 * D; (void)modl;
            const float* gam = args.mix_g + (size_t)l * D;
            const float* modprev = modp + (size_t)(l > 0 ? l - 1 : 0) * NBATCH * 6 * D;
            constexpr int RPW = M / (256 * NWAVES); const int rbase = gw * RPW, b = rbase / SEQ;
            int slot_v = 0; float w_v = 0.f;
            if (l > 0) {
                const unsigned* cntp = ctl + CW_CNT + (l - 1) * NEXP * 64;
                const int cv = (lane < NEXP) ? (int)__hip_atomic_load(cntp + lane * 64, __ATOMIC_RELAXED, __HIP_MEMORY_SCOPE_AGENT) : 0;
                const int tl = (cv + 255) >> 8; int tstart = 0, run = 0;
#pragma unroll
                for (int e = 0; e < NEXP; ++e) { if (lane == e) tstart = run; run += __builtin_amdgcn_readlane(tl, e); }
                const int i = min(lane, 2 * RPW - 1);
                const int e = tok_e[2 * rbase + i], pos = tok_pos[2 * rbase + i]; w_v = tok_w[2 * rbase + i];
                slot_v = __builtin_amdgcn_ds_bpermute(4 * e, tstart) * 256 + pos;
            }
            f32x4 ca[4], cb[4], gf[4];
#pragma unroll
            for (int j = 0; j < 4; ++j) { const int col = 4 * lane + 256 * j;
                const f32x4 g4 = *(const f32x4*)(gam + col), sc = *(const f32x4*)(modl + (size_t)b * 6 * D + 1 * D + col), sh = *(const f32x4*)(modl + (size_t)b * 6 * D + col);
                ca[j] = g4 * (sc + 1.0f); cb[j] = sh; gf[j] = *(const f32x4*)(modprev + (size_t)b * 6 * D + 5 * D + col); }
#pragma unroll 1
            for (int r0 = rbase; r0 < rbase + RPW; r0 += 4) {
                f32x4 v[4][4];
                if (l == 0) {
#pragma unroll
                    for (int q = 0; q < 4; ++q)
#pragma unroll
                        for (int j = 0; j < 4; ++j) v[q][j] = *(const f32x4*)(args.x + (size_t)(r0 + q) * D + 4 * lane + 256 * j);
                } else {
                    u32x2 xr[4][4], y0[4][4], y1[4][4]; float w0[4], w1[4];
#pragma unroll
                    for (int q = 0; q < 4; ++q) { const int ix = 2 * (r0 - rbase + q);
                        const int s0 = __builtin_amdgcn_readlane(slot_v, ix), s1 = __builtin_amdgcn_readlane(slot_v, ix + 1);
                        w0[q] = __builtin_bit_cast(float, __builtin_amdgcn_readlane(__builtin_bit_cast(int, w_v), ix)); w1[q] = __builtin_bit_cast(float, __builtin_amdgcn_readlane(__builtin_bit_cast(int, w_v), ix + 1));
#pragma unroll
                        for (int j = 0; j < 4; ++j) { const int col = 4 * lane + 256 * j;
                            xr[q][j] = *(const u32x2*)(X + (size_t)(r0 + q) * D + col); y0[q][j] = *(const u32x2*)(YB + (size_t)s0 * D + col); y1[q][j] = *(const u32x2*)(YB + (size_t)s1 * D + col); } }
#pragma unroll
                    for (int q = 0; q < 4; ++q)
#pragma unroll
                        for (int j = 0; j < 4; ++j) { const f32x4 yy = bf4(y0[q][j]) * w0[q] + bf4(y1[q][j]) * w1[q]; v[q][j] = bf4(xr[q][j]) + gf[j] * yy; }
                }
                float ssq[4];
#pragma unroll
                for (int q = 0; q < 4; ++q) { const int row = r0 + q;
                    float ss = 0.f;
#pragma unroll
                    for (int j = 0; j < 4; ++j) { u32x2 xw; xw.x = cvt_pk_bf16(v[q][j][0], v[q][j][1]); xw.y = cvt_pk_bf16(v[q][j][2], v[q][j][3]); *(u32x2*)(X + (size_t)row * D + 4 * lane + 256 * j) = xw;
                        ss += (v[q][j][0] * v[q][j][0] + v[q][j][1] * v[q][j][1]) + (v[q][j][2] * v[q][j][2] + v[q][j][3] * v[q][j][3]); }
                    ssq[q] = ss; }
                wave_sum4_u(ssq[0], ssq[1], ssq[2], ssq[3]);
#pragma unroll
                for (int q = 0; q < 4; ++q) { const int row = r0 + q;
                    const float rstd = __builtin_amdgcn_rsqf(ssq[q] * (1.f / D) + NORM_EPS);
#pragma unroll
                    for (int j = 0; j < 4; ++j) { const int col = 4 * lane + 256 * j;
                        const f32x4 hv = v[q][j] * rstd * ca[j] + cb[j];
                        u32x2 w; w.x = cvt_pk_bf16(hv[0], hv[1]); w.y = cvt_pk_bf16(hv[2], hv[3]);
                        *(u32x2*)(Hn + (size_t)row * D + col) = w; }
                }
            }
        }
        SEAM(pb + 0);
        if (IN(pb + 1) && EN(2)) REP(2) {
            WSP(); const float* modl = modp + (size_t)l * NBATCH * 6 * D; (void)modl;
            pg8::Gemm g{Hn, WIN + (size_t)l * ZW * D, D, D, D}; pg8::StaticOrder S; S.init(M, ZW, G, bx);
            EpiZ E{Z, ropec, ropes};
            pg8::gemm_phase<EpiZ, pg8::StaticOrder>(lds, g, S, E);
        }
        SEAM(pb + 1);
        if (IN(pb + 2) && EN(3)) REP(3) {
            WSP(); const float* modl = modp + (size_t)l * NBATCH * 6 * D; (void)modl;
            {
                int tidm = tid0; asm volatile("" : "+v"(tidm)); const int lane = tidm & 63, hi = lane >> 5;
                LAS unsigned char* vlds = lds + wave * 12288; LAS float* wsf = (LAS float*)(lds + 98304 + wave * 256);
                const float* lp = args.da_lambda + (size_t)l * 4 * 64;
                const float s01 = wave_sum(lp[lane] * lp[64 + lane]), s23 = wave_sum(lp[128 + lane] * lp[192 + lane]);
                const float lam_init = 0.8f - 0.6f * __expf(-0.3f * (float)l);
                const float lam = __expf(s01) - __expf(s23) + lam_init;
                LAS float* wsfA = (LAS float*)(lds + 131072 + wave * 128);
                const unsigned lds0 = (unsigned)(uintptr_t)lds;
                for (int un = vcu; un < NBATCH * 4 * 16; un += G) {
                    const int b = un >> 6, h = (un >> 4) & 3, qb = un & 15;
                    const size_t rowbase = (size_t)b * SEQ; const int q0 = qb * 256 + wave * 32;
                    LAS unsigned char* qlds = lds + 65536 + wave * 8192;
                    { bf16x8 qf[8];
                      const bf16_t* qp = Z + (rowbase + q0 + (lane & 31)) * ZW + ZQA + h * 128 + 8 * hi;
#pragma unroll
                      for (int i = 0; i < 8; ++i) qf[i] = *(const bf16x8*)(qp + 16 * i);
                      asm volatile("s_waitcnt vmcnt(0)" : "+v"(qf[0]), "+v"(qf[1]), "+v"(qf[2]), "+v"(qf[3]), "+v"(qf[4]), "+v"(qf[5]), "+v"(qf[6]), "+v"(qf[7]) :: "memory");
#pragma unroll
                      for (int i = 0; i < 8; ++i) *(LAS bf16x8*)(qlds + i * 1024 + lane * 16) = qf[i]; }
                    f32x16 o0[4], o1[4];
#pragma unroll
                    for (int d0 = 0; d0 < 4; ++d0) { o0[d0] = f32x16{}; o1[d0] = f32x16{}; }
                    float m0 = 0.f, l0 = 0.f, m1 = 0.f, l1 = 0.f;
                    LAS unsigned char* bsel = lds + 132096 + (hi ? 0 : 64 + (wave * 32 + (lane & 31)) * 48);
                    { unsigned z0 = 0u, e0 = hi ? 0u : 0x3F80u; asm volatile("" : "+v"(z0), "+v"(e0));
                      *(LAS u32x4*)bsel = (u32x4){z0, z0, z0, z0}; *(LAS u32x4*)(bsel + 16) = (u32x4){z0, z0, z0, z0}; *(LAS u32x4*)(bsel + 32) = (u32x4){e0, z0, z0, z0}; }
                    const int krow = 8 * wave + (lane >> 3);
                    const unsigned koff = (unsigned)(((rowbase + krow) * ZW + ZKA + h * 128) * 2 + (((lane & 7) ^ ((krow >> 1) & 7)) << 4));
                    const unsigned voff = (unsigned)(((rowbase + 8 * wave + ((lane >> 2) & 3)) * ZW + ZVA + h * 128 + (4 * (lane >> 4) + (lane & 3)) * 8) * 2);
#define DIFF_DMA(t, bo) do { const char* zb_ = (const char*)Z + (size_t)(t) * 64 * ZW * 2; \
        glds16s(zb_, koff, (unsigned)__builtin_amdgcn_readfirstlane((int)(lds0 + ((bo) * 2 + 0) * 8192 + wave * 1024))); \
        glds16s(zb_ + 128, koff, (unsigned)__builtin_amdgcn_readfirstlane((int)(lds0 + ((bo) * 2 + 1) * 8192 + wave * 1024))); \
        glds16s(zb_, voff, (unsigned)__builtin_amdgcn_readfirstlane((int)(lds0 + 32768 + (bo) * 16384 + wave * 2048))); \
        glds16s(zb_ + (size_t)4 * ZW * 2, voff, (unsigned)__builtin_amdgcn_readfirstlane((int)(lds0 + 32768 + (bo) * 16384 + wave * 2048 + 1024))); } while (0)
#define DIFF_SYNC() do { asm volatile("s_waitcnt vmcnt(0) lgkmcnt(0)" ::: "memory"); __builtin_amdgcn_s_barrier(); asm volatile("" ::: "memory"); } while (0)
                    DIFF_DMA(0, 0);
#pragma unroll 1
                    for (int t = 0; t < SEQ / 64; ++t) {
                        const int bo = t & 1;
                        DIFF_SYNC();
                        if (t + 1 < SEQ / 64) DIFF_DMA(t + 1, bo ^ 1);
                        diffA_step(o0, o1, m0, l0, m1, l1, qlds, lds + (bo * 2 + 0) * 8192, lds + (bo * 2 + 1) * 8192, lds + 32768 + bo * 16384, bsel, wsfA, t == 0, lane);
                    }
                    DIFF_SYNC();
#undef DIFF_DMA
#undef DIFF_SYNC
                    int lane_e = lane; asm volatile("" : "+v"(lane_e)); const int hi_e = lane_e >> 5;
                    attn_finish<4>(o0, l0, wsfA, lane_e, hi_e);
                    attn_finish<4>(o1, l1, wsfA, lane_e, hi_e);
                    const float* sg = args.da_subln + (size_t)l * 128;
                    float g4[4];
#pragma unroll
                    for (int d0 = 0; d0 < 4; ++d0) g4[d0] = sg[32 * d0 + (lane_e & 31)] * (1.0f - lam_init);
#pragma unroll
                    for (int r0 = 0; r0 < 16; r0 += 4) {
                        float ov[4][4], ss[4], tt[4];
#pragma unroll
                        for (int k = 0; k < 4; ++k) {
#pragma unroll
                            for (int d0 = 0; d0 < 4; ++d0) ov[k][d0] = o0[d0][r0 + k] - lam * o1[d0][r0 + k];
                            ss[k] = ov[k][0] * ov[k][0] + ov[k][1] * ov[k][1] + ov[k][2] * ov[k][2] + ov[k][3] * ov[k][3]; }
#pragma unroll
                        for (int k = 0; k < 4; ++k) ss[k] += dpp_f<0xB1>(ss[k]);
#pragma unroll
                        for (int k = 0; k < 4; ++k) ss[k] += dpp_f<0x4E>(ss[k]);
#pragma unroll
                        for (int k = 0; k < 4; ++k) ss[k] += dpp_f<0x141>(ss[k]);
#pragma unroll
                        for (int k = 0; k < 4; ++k) ss[k] += dpp_f<0x140>(ss[k]);
#pragma unroll
                        for (int k = 0; k < 4; ++k) tt[k] = xor_lane<16>(ss[k]);
#pragma unroll
                        for (int k = 0; k < 4; ++k) { const int r = r0 + k;
                            const float rn = __builtin_amdgcn_rsqf((ss[k] + tt[k]) * (1.f / 128.f) + NORM_EPS);
                            bf16_t* op = OC + (rowbase + q0 + crow(r, hi_e)) * D + h * 128 + (lane_e & 31);
#pragma unroll
                            for (int d0 = 0; d0 < 4; ++d0) { const float ovn = ov[k][d0] * rn * g4[d0]; op[32 * d0] = (bf16_t)(cvt_pk_bf16(ovn, ovn) & 0xffffu); } }
                    }
                }
                asm volatile("s_waitcnt vmcnt(0) lgkmcnt(0)" ::: "memory"); __builtin_amdgcn_s_barrier();
            }
            {
                int tidm = tid0; asm volatile("" : "+v"(tidm)); const int lane = tidm & 63, hi = lane >> 5;
                LAS unsigned char* vlds = lds + wave * 12288; LAS float* wsf = (LAS float*)(lds + 98304 + wave * 256);
                LAS float* tab = (LAS float*)(lds + 100352);
                { const float* rpb = args.na_rpb + (size_t)l * 4 * 15 * 31;
                  for (int i = wave * 64 + lane; i < 4 * 15 * 128; i += NWAVES * 64) { const int j = (i & 127) - 48, hb = i >> 7; tab[i] = (j >= 0 && j <= 30) ? rpb[hb * 31 + j] * LOG2E : 0.f; } }
                asm volatile("s_waitcnt vmcnt(0) lgkmcnt(0)" ::: "memory"); __builtin_amdgcn_s_barrier(); asm volatile("" ::: "memory");
                const char* zb = (const char*)Z;
                for (int wu = gw; wu < NBATCH * 4 * 64 * 2; wu += NGW) {
                    const int half = wu & 1, gr = (wu >> 1) & 63, h = (wu >> 7) & 3, b = wu >> 9;
                    const int rowb = b * SEQ; const int c0 = half * 32, cq = c0 + (lane & 31);
                    const int kr0 = min(max(gr - 4, 0), 56), cs = min(max(cq - 8, 0), 48);
                    bf16x8 qf[4];
                    { const unsigned qoff = (unsigned)(((rowb + gr * 64 + cq) * ZW + ZQN + h * 64 + 8 * hi) * 2);
#pragma unroll
                      for (int d0 = 0; d0 < 4; ++d0) qf[d0] = *(const bf16x8*)(zb + (size_t)(qoff + 32u * d0)); }
                    f32x16 o[2]; o[0] = f32x16{}; o[1] = f32x16{};
                    float mrun = NEGBIG, lrun = 0.f;
                    const unsigned kcol = (unsigned)((ZKN + h * 64) * 2), vcol = (unsigned)((ZVN + h * 64) * 2);
                    unsigned rb0[4];
#pragma unroll
                    for (int i = 0; i < 4; ++i) rb0[i] = (unsigned)((rowb + (kr0 + (i >> 1)) * 64 + 16 * half + 8 * (i & 1) + (lane >> 3)) * ZW * 2);
                    TileRegs<64> cur;
                    tile_load<64>(cur, zb, rb0, kcol, vcol);
#pragma unroll 1
                    for (int t = 0, rp = 0, cc = 0; t < 12; ++t) {
                        const int kr = kr0 + 2 * rp, chunk = half + cc;
                        const int cn = (cc == 2) ? 0 : cc + 1, rn = (cc == 2) ? rp + 1 : rp;
                        auto reload = [&](TileRegs<64>& T) { const unsigned adv = (unsigned)((t + 1 < 12) ? (2 * rn * 64 + 16 * cn) : (2 * rp * 64 + 16 * cc)) * (ZW * 2u); unsigned rr[4];
#pragma unroll
                          for (int i = 0; i < 4; ++i) rr[i] = rb0[i] + adv;
                          tile_load<64>(T, zb, rr, kcol, vcol); };
                        const LAS float* bp = tab + (h * 15 + (kr - gr + 7)) * 128 + (16 * chunk + 4 * hi - cq + 63);
                        const int u0 = 16 * chunk + 4 * hi - cs;
                        auto maskf = [&](f32x16& p) {
#pragma unroll
                            for (int r = 0; r < 16; ++r) { const int co = (r & 3) + 8 * (r >> 2);
                                const float bv = bp[(co >> 4) * 128 + (co & 15)]; p[r] = ((unsigned)(u0 + (co & 15)) <= 15u) ? bv : NEGBIG; }
                        };
                        attn_tile<64>(o, mrun, lrun, qf, cur, vlds, wsf, maskf, reload, lane, hi);
                        cc = cn; rp = rn;
                    }
                    attn_finish<2>(o, lrun, wsf, lane, hi);
#pragma unroll
                    for (int r = 0; r < 16; ++r) { bf16_t* op = OC + (size_t)(rowb + gr * 64 + c0 + crow(r, hi)) * D + 512 + h * 64 + (lane & 31);
                        const unsigned w = cvt_pk_bf16(o[0][r], o[1][r]); op[0] = (bf16_t)(w & 0xffffu); op[32] = (bf16_t)(w >> 16); }
                }
            }
            {
                int tidm = tid0; asm volatile("" : "+v"(tidm)); const int lane = tidm & 63, hi = lane >> 5;
                LAS unsigned char* vlds = lds + wave * 12288; LAS float* wsf = (LAS float*)(lds + 98304 + wave * 256);
                const char* zb = (const char*)Z;
                for (int wu = gw; wu < NBATCH * 4 * 8 * 16; wu += NGW) {
                    const int rho = wu & 15, sb = (wu >> 4) & 7, hs = (wu >> 7) & 3, b = wu >> 9;
                    const int rowb = b * SEQ; const int qi = lane & 31; const int tq = 512 * sb + rho + 16 * qi;
                    f32x16 o[2]; o[0] = f32x16{}; o[1] = f32x16{};
                    float mrun = NEGBIG, lrun = 0.f;
                    const unsigned qoff0 = (unsigned)(((rowb + tq) * ZW + ZQD + hs * 64 + 8 * hi) * 2);
                    TileRegs<64> cur;
                    { const int kb0 = 512 * sb + rho - 64;
                      unsigned rr[4];
#pragma unroll
                      for (int i = 0; i < 4; ++i) rr[i] = (unsigned)((rowb + min(max(kb0 + 8 * i + (lane >> 3), 0), SEQ - 1)) * ZW * 2);
                      tile_load<64>(cur, zb, rr, (unsigned)((ZKD + hs * 64) * 2), (unsigned)((ZVD + hs * 64) * 2)); }
#pragma unroll 1
                    for (int gi = 0; gi < 3; ++gi) {
                        const int sh = 2 * gi, res = rho & ((1 << sh) - 1), qa = (512 * sb + rho) >> sh, qk = qa + (16 >> sh) * qi, nsub = SEQ >> sh, ntile = (gi == 0) ? 20 : (gi == 1) ? 8 : 5;
                        const int lo_v = max(qk - 64, 0), span = min(qk + 64, nsub - 1) - lo_v;
                        const unsigned kcol = (unsigned)((ZKD + gi * 256 + hs * 64) * 2), vcol = (unsigned)((ZVD + gi * 256 + hs * 64) * 2), rbase = (unsigned)((rowb + res) * ZW * 2);
                        const int sh2 = sh + 2, res2 = rho & ((1 << sh2) - 1), kbn = ((512 * sb + rho) >> sh2) - 64, nsub2 = SEQ >> sh2;
                        bf16x8 qf[4];
#pragma unroll
                        for (int d0 = 0; d0 < 4; ++d0) qf[d0] = *(const bf16x8*)(zb + (size_t)(qoff0 + (unsigned)(gi * 512) + 32u * d0));
                        int kb = qa - 64;
#pragma unroll 1
                        for (int t = 0; t < ntile; ++t, kb += 32) {
                            auto reload = [&](TileRegs<64>& T) { const bool same = (t + 1 < ntile); const int kbx = same ? kb + 32 : kbn, nsx = same ? nsub : nsub2, shx = same ? sh : sh2;
                              const unsigned rbx = same ? rbase : (unsigned)((rowb + res2) * ZW * 2), kcx = same ? kcol : kcol + 512u, vcx = same ? vcol : vcol + 512u; unsigned rr[4];
                              if (kbx >= 0 && kbx + 32 <= nsx) {
                                  const unsigned b0 = rbx + __umul24((unsigned)((kbx + (lane >> 3)) << shx), ZW * 2u), inc = (8u << shx) * (ZW * 2u);
#pragma unroll
                                  for (int i = 0; i < 4; ++i) rr[i] = b0 + (unsigned)i * inc;
                              } else {
#pragma unroll
                                  for (int i = 0; i < 4; ++i) rr[i] = rbx + __umul24((unsigned)(min(max(kbx + 8 * i + (lane >> 3), 0), nsx - 1) << shx), ZW * 2u);
                              }
                              tile_load<64>(T, zb, rr, kcx, vcx); };
                            const int u0 = kb + 4 * hi - lo_v;
                            auto maskf = [&](f32x16& p) {
#pragma unroll
                                for (int r = 0; r < 16; ++r) { const int co = (r & 3) + 8 * (r >> 2); p[r] = ((unsigned)(u0 + co) <= (unsigned)span) ? 0.f : NEGBIG; }
                            };
                            attn_tile<64>(o, mrun, lrun, qf, cur, vlds, wsf, maskf, reload, lane, hi);
                        }
                    }
                    attn_finish<2>(o, lrun, wsf, lane, hi);
#pragma unroll
                    for (int r = 0; r < 16; ++r) { bf16_t* op = OC + (size_t)(rowb + 512 * sb + rho + 16 * crow(r, hi)) * D + 768 + hs * 64 + (lane & 31);
                        const unsigned w = cvt_pk_bf16(o[0][r], o[1][r]); op[0] = (bf16_t)(w & 0xffffu); op[32] = (bf16_t)(w >> 16); }
                }
            }
        }
        SEAM(pb + 2);
        if (IN(pb + 3) && EN(4)) REP(4) {
            WSP(); const float* modl = modp + (size_t)l * NBATCH * 6 * D; (void)modl;
            pg8::StaticOrder S0; S0.init(M, D, G, bx); pg8::Unit u0; pg8::ProjOrder S; S.pm = 0; S.pn = 0; S.rot = bx & 1;
            const bool have = S0.next(0, u0); S.pm = u0.pm; S.pn = u0.pn;
            if (have) { pg8::Gemm g{OC, WPR + (size_t)l * D * D, D, D, D}; EpiProj E{MG, Z + ZG}; pg8::gemm_phase<EpiProj, pg8::ProjOrder>(lds, g, S, E); }
        }
        SEAM(pb + 3);
        if (IN(pb + 4) && EN(5)) {
            WSP(); const float* modl = modp + (size_t)l * NBATCH * 6 * D; (void)modl;
            pg8::Gemm g{MG, WOU + (size_t)l * D * D, D, D, D}; pg8::StaticOrder S; S.init(M, D, G, bx);
            EpiOut E{X, modl + 2 * D};
            pg8::gemm_phase<EpiOut, pg8::StaticOrder>(lds, g, S, E);
        }
        SEAM(pb + 4);
        if (IN(pb + 5) && EN(6)) {
            WSP(); const float* modl = modp + (size_t)l * NBATCH * 6 * D; (void)modl;
            LAS float* rt = (LAS float*)lds;
            LAS unsigned* lcnt = (LAS unsigned*)(lds + MISC_OFF) + 16;
            LAS unsigned* lbase = lcnt + 32;
            { const float* rsrc = rtab + (size_t)l * 36 * D + 4 * lane; const unsigned lds0 = (unsigned)(uintptr_t)lds;
              for (int pc = wave; pc < 144; pc += NWAVES) glds16(rsrc + (pc >> 2) * D + (pc & 3) * 256, (unsigned)__builtin_amdgcn_readfirstlane((int)(lds0 + (pc >> 2) * (RT_LD * 4) + (pc & 3) * 1024)));
              if (tid < 64) lcnt[tid] = 0u;
              if (tid < 36) rt[tid * RT_LD + D] = tid < 4 ? args.rgb[(size_t)l * 4 + tid] : args.reb[(size_t)l * NEXP + tid - 4];
              asm volatile("s_waitcnt vmcnt(0)" ::: "memory");
            }
            __syncthreads();
            const float* gam = args.ffn_g + (size_t)l * D;
            unsigned* cnt = ctl + CW_CNT + l * NEXP * 64;
            int myE0 = 0, myE1 = 0, myP0 = 0, myP1 = 0, myRow = -1; float myW0 = 0.f, myW1 = 0.f; int nrow = 0;
            f32x4 v[4][4], vn[4][4];
            constexpr int RPW = M / (256 * NWAVES); const int rbase = gw * RPW;
            f32x4 ca[4], cb[4];
            { const int b = rbase / SEQ;
#pragma unroll
              for (int j = 0; j < 4; ++j) { const int col = 4 * lane + 256 * j;
                  const f32x4 g4 = *(const f32x4*)(gam + col), sc = *(const f32x4*)(modl + (size_t)b * 6 * D + 4 * D + col), sh = *(const f32x4*)(modl + (size_t)b * 6 * D + 3 * D + col);
                  ca[j] = g4 * (sc + 1.0f); cb[j] = sh; } }
#define T2_LOAD(dst, rb) do { _Pragma("unroll") for (int q = 0; q < 4; ++q) { const int row = min((rb) + q, M - 1); \
                _Pragma("unroll") for (int j = 0; j < 4; ++j) dst[q][j] = bf4(*(const u32x2*)(X + (size_t)row * D + 4 * lane + 256 * j)); } } while (0)
            T2_LOAD(v, rbase);
#pragma unroll 1
            for (int r0 = rbase; r0 < rbase + RPW; r0 += 4) {
                T2_LOAD(vn, min(r0 + 4, M - 4));
                float ssq[4];
#pragma unroll
                for (int q = 0; q < 4; ++q) { f32x2 s2 = {0.f, 0.f};
#pragma unroll
                    for (int j = 0; j < 4; ++j) { const f32x2 lo = {v[q][j][0], v[q][j][1]}, hi2 = {v[q][j][2], v[q][j][3]}; s2 = lo * lo + s2; s2 = hi2 * hi2 + s2; }
                    ssq[q] = s2[0] + s2[1]; }
                wave_sum4_u(ssq[0], ssq[1], ssq[2], ssq[3]);
#pragma unroll
                for (int q = 0; q < 4; ++q) {
                    const int row = r0 + q;
                    const float rstd = __builtin_amdgcn_rsqf(ssq[q] * (1.f / D) + NORM_EPS);
#pragma unroll
                    for (int j = 0; j < 4; ++j) { const int col = 4 * lane + 256 * j;
                        v[q][j] = v[q][j] * rstd * ca[j] + cb[j];
                        u32x2 w; w.x = cvt_pk_bf16(v[q][j][0], v[q][j][1]); w.y = cvt_pk_bf16(v[q][j][2], v[q][j][3]);
                        *(u32x2*)(Hn + (size_t)row * D + col) = w; }
                }
                float LG[4][4];
#pragma unroll
                for (int n = 0; n < 4; ++n) { f32x2 c0 = {0.f, 0.f}, c1 = c0, c2 = c0, c3 = c0;
#pragma unroll
                    for (int j = 0; j < 4; ++j) { const f32x4 wv = *(const LAS f32x4*)(rt + n * RT_LD + 4 * lane + 256 * j); const f32x2 wl = {wv[0], wv[1]}, wh = {wv[2], wv[3]};
                        c0 = wl * (f32x2){v[0][j][0], v[0][j][1]} + c0; c0 = wh * (f32x2){v[0][j][2], v[0][j][3]} + c0;
                        c1 = wl * (f32x2){v[1][j][0], v[1][j][1]} + c1; c1 = wh * (f32x2){v[1][j][2], v[1][j][3]} + c1;
                        c2 = wl * (f32x2){v[2][j][0], v[2][j][1]} + c2; c2 = wh * (f32x2){v[2][j][2], v[2][j][3]} + c2;
                        c3 = wl * (f32x2){v[3][j][0], v[3][j][1]} + c3; c3 = wh * (f32x2){v[3][j][2], v[3][j][3]} + c3; }
                    float a0 = c0[0] + c0[1], a1 = c1[0] + c1[1], a2 = c2[0] + c2[1], a3 = c3[0] + c3[1];
                    wave_sum4_u(a0, a1, a2, a3);
                    const float bgn = rt[n * RT_LD + D]; LG[0][n] = a0 + bgn; LG[1][n] = a1 + bgn; LG[2][n] = a2 + bgn; LG[3][n] = a3 + bgn; }
#pragma unroll
                for (int q = 0; q < 4; ++q) {
                    const int row = r0 + q;
                    int gsel = 0; float gmx = LG[q][0];
#pragma unroll
                    for (int i = 1; i < 4; ++i) if (LG[q][i] > gmx) { gmx = LG[q][i]; gsel = i; }
                    gsel = __builtin_amdgcn_readfirstlane(gsel);
                    float gsum = 0.f;
#pragma unroll
                    for (int i = 0; i < 4; ++i) gsum += __expf(LG[q][i] - gmx);
                    const float pg = frcp(gsum);
                    float le[8];
                    const LAS float* rte = rt + (4 + 8 * gsel) * RT_LD + 4 * lane;
#pragma unroll
                    for (int j8 = 0; j8 < 8; ++j8) { f32x2 c = {0.f, 0.f};
#pragma unroll
                        for (int j = 0; j < 4; ++j) { const f32x4 wv = *(const LAS f32x4*)(rte + j8 * RT_LD + 256 * j);
                            c = (f32x2){wv[0], wv[1]} * (f32x2){v[q][j][0], v[q][j][1]} + c; c = (f32x2){wv[2], wv[3]} * (f32x2){v[q][j][2], v[q][j][3]} + c; }
                        le[j8] = c[0] + c[1]; }
                    wave_sum4_u(le[0], le[1], le[2], le[3]); wave_sum4_u(le[4], le[5], le[6], le[7]);
#pragma unroll
                    for (int j8 = 0; j8 < 8; ++j8) le[j8] += rte[j8 * RT_LD + D - 4 * lane];
                    int e0 = 0; float m0 = le[0];
#pragma unroll
                    for (int j = 1; j < 8; ++j) if (le[j] > m0) { m0 = le[j]; e0 = j; }
                    int e1 = (e0 == 0) ? 1 : 0; float m1 = -3.0e38f;
#pragma unroll
                    for (int j = 0; j < 8; ++j) if (j != e0 && le[j] > m1) { m1 = le[j]; e1 = j; }
                    const float a1 = __expf(m1 - m0), inv = frcp(1.0f + a1);
                    const float w0 = pg * inv, w1 = pg * a1 * inv;
                    const int E0 = gsel * 8 + e0, E1 = gsel * 8 + e1;
                    if (row < M) {
                        unsigned p0 = 0, p1 = 0;
                        if (lane == 0) { p0 = __hip_atomic_fetch_add(lcnt + E0, 1u, __ATOMIC_RELAXED, __HIP_MEMORY_SCOPE_WORKGROUP); p1 = __hip_atomic_fetch_add(lcnt + E1, 1u, __ATOMIC_RELAXED, __HIP_MEMORY_SCOPE_WORKGROUP); }
                        p0 = __builtin_amdgcn_readfirstlane(p0); p1 = __builtin_amdgcn_readfirstlane(p1);
                        if (lane == nrow) { myE0 = E0; myE1 = E1; myP0 = (int)p0; myP1 = (int)p1; myW0 = w0; myW1 = w1; myRow = row; }
                        ++nrow;
                    }
                }
#pragma unroll
                for (int q = 0; q < 4; ++q)
#pragma unroll
                    for (int j = 0; j < 4; ++j) v[q][j] = vn[q][j];
            }
#undef T2_LOAD
            __syncthreads();
            if (tid < NEXP) { const unsigned c = lcnt[tid]; lbase[tid] = c ? __hip_atomic_fetch_add(cnt + tid * 64, c, __ATOMIC_RELAXED, __HIP_MEMORY_SCOPE_AGENT) : 0u; }
            __syncthreads();
            if (myRow >= 0) { const int q0 = myP0 + (int)lbase[myE0], q1 = myP1 + (int)lbase[myE1]; etok[myE0 * 16384 + q0] = myRow; etok[myE1 * 16384 + q1] = myRow;
                              tok_e[2 * myRow] = myE0; tok_e[2 * myRow + 1] = myE1; tok_pos[2 * myRow] = q0; tok_pos[2 * myRow + 1] = q1;
                              tok_w[2 * myRow] = myW0; tok_w[2 * myRow + 1] = myW1; }
            __syncthreads();
        }
        SEAM(pb + 5);
        if (IN(pb + 8) && EN(8)) {
            WSP();
            const unsigned* cnt = ctl + CW_CNT + l * NEXP * 64; unsigned* tcl = ctl + CW_TILE + l * MAXTILES * 16;
            int n1, n3, n4, R;
            int a_pm, a_pn, a_e, a_ts, a_cn, b_pm, b_pn, b_e, b_ts, b_cn, c_pm, c_pn, c_e, c_ts, c_cn;
            int d_pm, d_pn, d_e, d_ts, d_cn, e_pm, e_pn, e_e, e_ts, e_cn, f_pm, f_pn, f_e, f_ts, f_cn, g_pm, g_pn, g_e, g_ts, g_cn;
            {
                const int cv = (lane < NEXP) ? (int)__hip_atomic_load(cnt + lane * 64, __ATOMIC_RELAXED, __HIP_MEMORY_SCOPE_AGENT) : 0;
                const int tl = (cv + 255) >> 8; int tend = 0, ntile = 0;
#pragma unroll
                for (int e = 0; e < NEXP; ++e) { ntile += __builtin_amdgcn_readlane(tl, e); if (lane == e) tend = ntile; }
                const int U = 4 * ntile, nA = min(U, 2 * G), Nf = G - min(U - nA, G), nB = min(nA, 2 * Nf); R = min(U - nA, G);
                auto moe_unit = [&](int v, int& pm, int& pn, int& e, int& ts, int& cn) { const int t = min(v >> 2, ntile - 1); pm = t; pn = v & 3;
                    e = min((int)__builtin_popcountll(__ballot(lane < NEXP && tend <= t)), NEXP - 1); ts = __builtin_amdgcn_readlane(tend - tl, e); cn = max(__builtin_amdgcn_readlane(cv, e), 1); };
                moe_unit(vcu, a_pm, a_pn, a_e, a_ts, a_cn); moe_unit(G + vcu, b_pm, b_pn, b_e, b_ts, b_cn); moe_unit(nA + vcu, c_pm, c_pn, c_e, c_ts, c_cn);
                n1 = (vcu < nA ? 1 : 0) + (G + vcu < nA ? 1 : 0);
                const int v3 = vcu - R, v4 = nB + vcu;
                moe_unit(v3, d_pm, d_pn, d_e, d_ts, d_cn); moe_unit(v3 + Nf, e_pm, e_pn, e_e, e_ts, e_cn); n3 = (vcu >= R) ? (v3 < nB ? 1 : 0) + (v3 + Nf < nB ? 1 : 0) : 0;
                moe_unit(v4, f_pm, f_pn, f_e, f_ts, f_cn); moe_unit(v4 + G, g_pm, g_pn, g_e, g_ts, g_cn); n4 = (v4 < U ? 1 : 0) + (v4 + G < U ? 1 : 0);
            }
#define MOE_M1(n_, p0, p1) do { const pg8::MoeOrder S{(n_), p0##pm, p1##pm, p0##pn, p1##pn, p0##e, p1##e, (size_t)1024 * D * 2, p0##ts, p1##ts, p0##cn, p1##cn, etok, tcl}; \
            pg8::Gemm g{Hn, W13 + (size_t)l * NEXP * 1024 * D, D, D, D};            \
            EpiSwiglu E{HB}; pg8::gemm_phase<EpiSwiglu, pg8::MoeOrder, true, true, true>(lds, g, S, E); } while (0)
#define MOE_M2(n_, p0, p1) do { \
            if (wave == 0) { const int tb_ = (n_) > 1 ? p1##pm : p0##pm; unsigned sp_ = 0; \
                while ((unsigned)__builtin_amdgcn_readfirstlane((int)__hip_atomic_load(tcl + p0##pm * 16, __ATOMIC_RELAXED, __HIP_MEMORY_SCOPE_AGENT)) < 32u && ++sp_ < XB_SPIN_CAP) __builtin_amdgcn_s_sleep(2); \
                while ((unsigned)__builtin_amdgcn_readfirstlane((int)__hip_atomic_load(tcl + tb_ * 16, __ATOMIC_RELAXED, __HIP_MEMORY_SCOPE_AGENT)) < 32u && ++sp_ < XB_SPIN_CAP) __builtin_amdgcn_s_sleep(2); \
                __builtin_amdgcn_fence(__ATOMIC_ACQUIRE, "agent"); asm volatile("s_waitcnt vmcnt(0)" ::: "memory"); }        \
            __syncthreads(); \
            const pg8::MoeOrder S{(n_), p0##pm, p1##pm, p0##pn, p1##pn, p0##e, p1##e, (size_t)D * EH * 2, p0##ts, p1##ts, p0##cn, p1##cn, etok, nullptr}; \
            pg8::Gemm g{HB, W2 + (size_t)l * NEXP * D * EH, EH, EH, EH}; \
            EpiY E{YB}; pg8::gemm_phase<EpiY, pg8::MoeOrder>(lds, g, S, E); } while (0)
            if (n1) MOE_M1(n1, a_, b_);
            if (vcu < R) MOE_M1(1, c_, c_);
            if (n3) MOE_M2(n3, d_, e_);
            if (n4) MOE_M2(n4, f_, g_);
#undef MOE_M1
#undef MOE_M2
        }
        SEAM(pb + 8);
    }
    if (IN(NPHASE - 1) && EN(9)) {
        WSP();
        const float* modprev = modp + (size_t)(DEPTH - 1) * NBATCH * 6 * D;
        constexpr int RPW = M / (256 * NWAVES); const int rbase = gw * RPW, b = rbase / SEQ;
        int slot_v = 0; float w_v = 0.f;
        { const unsigned* cntp = ctl + CW_CNT + (DEPTH - 1) * NEXP * 64;
          const int cv = (lane < NEXP) ? (int)__hip_atomic_load(cntp + lane * 64, __ATOMIC_RELAXED, __HIP_MEMORY_SCOPE_AGENT) : 0;
          const int tl = (cv + 255) >> 8; int tstart = 0, run = 0;
#pragma unroll
          for (int e = 0; e < NEXP; ++e) { if (lane == e) tstart = run; run += __builtin_amdgcn_readlane(tl, e); }
          const int i = min(lane, 2 * RPW - 1);
          const int e = tok_e[2 * rbase + i], pos = tok_pos[2 * rbase + i]; w_v = tok_w[2 * rbase + i];
          slot_v = __builtin_amdgcn_ds_bpermute(4 * e, tstart) * 256 + pos; }
        f32x4 gf[4], fg[4];
#pragma unroll
        for (int j = 0; j < 4; ++j) { const int col = 4 * lane + 256 * j; gf[j] = *(const f32x4*)(modprev + (size_t)b * 6 * D + 5 * D + col); fg[j] = *(const f32x4*)(args.fin_g + col); }
#pragma unroll 1
        for (int r0 = rbase; r0 < rbase + RPW; r0 += 4) {
            u32x2 xr[4][4], y0[4][4], y1[4][4]; float w0[4], w1[4];
#pragma unroll
            for (int q = 0; q < 4; ++q) { const int ix = 2 * (r0 - rbase + q);
                const int s0 = __builtin_amdgcn_readlane(slot_v, ix), s1 = __builtin_amdgcn_readlane(slot_v, ix + 1);
                w0[q] = __builtin_bit_cast(float, __builtin_amdgcn_readlane(__builtin_bit_cast(int, w_v), ix)); w1[q] = __builtin_bit_cast(float, __builtin_amdgcn_readlane(__builtin_bit_cast(int, w_v), ix + 1));
#pragma unroll
                for (int j = 0; j < 4; ++j) { const int col = 4 * lane + 256 * j;
                    xr[q][j] = *(const u32x2*)(X + (size_t)(r0 + q) * D + col); y0[q][j] = *(const u32x2*)(YB + (size_t)s0 * D + col); y1[q][j] = *(const u32x2*)(YB + (size_t)s1 * D + col); } }
            f32x4 v[4][4]; float ssq[4];
#pragma unroll
            for (int q = 0; q < 4; ++q) { float ss = 0.f;
#pragma unroll
                for (int j = 0; j < 4; ++j) { const f32x4 yy = bf4(y0[q][j]) * w0[q] + bf4(y1[q][j]) * w1[q]; v[q][j] = bf4(xr[q][j]) + gf[j] * yy;
                    ss += (v[q][j][0] * v[q][j][0] + v[q][j][1] * v[q][j][1]) + (v[q][j][2] * v[q][j][2] + v[q][j][3] * v[q][j][3]); }
                ssq[q] = ss; }
            wave_sum4_u(ssq[0], ssq[1], ssq[2], ssq[3]);
#pragma unroll
            for (int q = 0; q < 4; ++q) { const int row = r0 + q;
                const float rstd = __builtin_amdgcn_rsqf(ssq[q] * (1.f / D) + NORM_EPS);
#pragma unroll
                for (int j = 0; j < 4; ++j) *(f32x4*)(args.out + (size_t)row * D + 4 * lane + 256 * j) = v[q][j] * rstd * fg[j];
            }
        }
    }
#undef IN
#undef SEAM
#undef GRID_BAR
}


#ifndef DBG
#define DBG 0
#endif
#if DBG
constexpr size_t WS_REP = WS_END;
__global__ void dbg_scan(const unsigned* buf, size_t nwords, int is_bf16, unsigned long long* rep) {
    unsigned long long nf = 0, ck = 0;
    for (size_t i = (size_t)blockIdx.x * blockDim.x + threadIdx.x; i < nwords; i += (size_t)gridDim.x * blockDim.x) {
        const unsigned w = buf[i]; ck += (unsigned long long)w * (unsigned long long)((i & 1023) + 1);
        if (is_bf16) { if ((w & 0x7f80u) >= (140u << 7)) ++nf; if ((w & 0x7f800000u) >= (140u << 23)) ++nf; }
        else if ((w & 0x7f800000u) >= (140u << 23)) ++nf;
    }
    for (int o = 32; o >= 1; o >>= 1) { nf += __shfl_xor(nf, o); ck += __shfl_xor(ck, o); }
    if ((threadIdx.x & 63) == 0) { if (nf) atomicAdd(rep, nf); atomicAdd(rep + 1, ck); }
}

__global__ void dbg_scan_cols(const unsigned short* buf, int c0, int c1, unsigned long long* rep) {
    unsigned long long nf = 0;
    const int w = c1 - c0;
    for (size_t i = (size_t)blockIdx.x * blockDim.x + threadIdx.x; i < (size_t)M * w; i += (size_t)gridDim.x * blockDim.x) {
        const size_t r = i / w; const int c = c0 + (int)(i % w); const unsigned v = buf[r * D + c];
        if ((v & 0x7f80u) >= (140u << 7)) ++nf; }
    for (int o = 32; o >= 1; o >>= 1) nf += __shfl_xor(nf, o);
    if ((threadIdx.x & 63) == 0 && nf) atomicAdd(rep, nf);
}
__global__ void dbg_encode(const unsigned long long* rep, float* out, size_t n, int nph) {
    int code = 80;
    for (int p = nph - 1; p >= 0; --p) if (rep[(64 + p) * 2 + 1] != rep[p * 2 + 1]) code = 40 + p;
    for (int p = nph - 1; p >= 0; --p) if (rep[p * 2] != 0ull || rep[(64 + p) * 2] != 0ull) code = 1 + p;
    if (code == 80) return;
    const float A = sqrtf((float)code * 0.1f);
    for (size_t i = (size_t)blockIdx.x * blockDim.x + threadIdx.x; i < n; i += (size_t)gridDim.x * blockDim.x) {
        unsigned h = (unsigned)i * 2654435761u; h ^= h >> 15; h *= 2246822519u; h ^= h >> 13;
        out[i] = (h & 1u) ? A : -A; }
}
#endif

extern "C" void kernel_launch(void* const* d_in, const int* in_sizes, int n_in, void* d_out, int out_size, void* d_ws, size_t ws_size, hipStream_t stream) {
    static int grid = 0;
    if (grid == 0) {
        if (n_in != 22 || in_sizes[0] != M * D || out_size != M * D || ws_size < WS_END + (1u << 20)) {
            fprintf(stderr, "kernel_launch: unexpected shapes (n_in %d, in0 %d, out %d, ws %zu, need %zu)\n", n_in, n_in > 0 ? in_sizes[0] : -1, out_size, ws_size, (size_t)WS_END); grid = -1; return; }
        int dev = 0, cus = 0, per_cu = 0;
        if (hipGetDevice(&dev) != hipSuccess || hipDeviceGetAttribute(&cus, hipDeviceAttributeMultiprocessorCount, dev) != hipSuccess) { grid = -1; return; }
        if (hipFuncSetAttribute((const void*)fwd_kernel, hipFuncAttributeMaxDynamicSharedMemorySize, LDS_BYTES) != hipSuccess) { fprintf(stderr, "kernel_launch: hipFuncSetAttribute failed\n"); grid = -1; return; }
        if (hipOccupancyMaxActiveBlocksPerMultiprocessor(&per_cu, (const void*)fwd_kernel, NWAVES * 64, LDS_BYTES) != hipSuccess || per_cu < 1)
            fprintf(stderr, "kernel_launch: occupancy query reports %d\n", per_cu);
        (void)hipGetLastError();
        if (cus != 256) { fprintf(stderr, "kernel_launch: built for 256 CUs (MoE unit deal, T2 row blocks), found %d\n", cus); grid = -1; return; }
        grid = cus;
    }
    if (grid < 0) return;
    if (hipMemsetAsync((char*)d_ws + WS_CTL, 0, CTL_ZERO_BYTES, stream) != hipSuccess) { fprintf(stderr, "kernel_launch: memset failed\n"); return; }
    Args a{};
    a.x = (const float*)d_in[0]; a.c = (const float*)d_in[1]; a.ada_w = (const float*)d_in[2]; a.ada_b = (const float*)d_in[3]; a.mix_g = (const float*)d_in[4]; a.ffn_g = (const float*)d_in[5];
    a.w_in = (const float*)d_in[6]; a.da_lambda = (const float*)d_in[7]; a.da_subln = (const float*)d_in[8]; a.na_rpb = (const float*)d_in[9];
    a.wpa = (const float*)d_in[10]; a.wpn = (const float*)d_in[11]; a.wpd = (const float*)d_in[12]; a.w_out = (const float*)d_in[13];
    a.rgw = (const float*)d_in[14]; a.rgb = (const float*)d_in[15]; a.rew = (const float*)d_in[16]; a.reb = (const float*)d_in[17];
    a.ew1 = (const float*)d_in[18]; a.ew3 = (const float*)d_in[19]; a.ew2 = (const float*)d_in[20]; a.fin_g = (const float*)d_in[21];
    a.out = (float*)d_out; a.ws = (unsigned char*)d_ws;
#if DBG
    {
        unsigned char* ws = (unsigned char*)d_ws;
        unsigned long long* rep = (unsigned long long*)(ws + WS_REP);
        (void)hipMemsetAsync(rep, 0, 2 * 64 * 2 * 8, stream);
        for (int run = 0; run < 2; ++run) {
            (void)hipMemsetAsync((char*)d_ws + WS_CTL, 0, CTL_ZERO_BYTES, stream);
            for (int p = 0; p < NPHASE; ++p) {
                a.ph_lo = p; a.ph_hi = p + 1;
                hipLaunchKernelGGL(fwd_kernel, dim3(grid), dim3(NWAVES * 64), LDS_BYTES, stream, a);
                unsigned long long* r = rep + (size_t)(run * 64 + p) * 2;
#define SCAN(off, bytes, isbf) hipLaunchKernelGGL(dbg_scan, dim3(1024), dim3(256), 0, stream, (const unsigned*)(ws + (off)), (size_t)(bytes) / 4, (isbf), r)
                const int ph = (p == 0) ? -1 : (p == NPHASE - 1) ? 9 : (p - 1) % 9;
                if (ph == -1) { SCAN(WS_MOD, (size_t)DEPTH * NBATCH * 6 * D * 4, 0); SCAN(WS_ROPE, (size_t)SEQ * 64 * 4, 0); SCAN(WS_WIN, WS_END - WS_WIN, 1); }
                else if (ph == 0) { SCAN(WS_X, (size_t)M * D * 4, 0); SCAN(WS_H, (size_t)M * D * 2, 1); }
                else if (ph == 1) { SCAN(WS_Z, (size_t)M * ZW * 2, 1); }
                else if (ph == 2) { SCAN(WS_OCAT, (size_t)M * D * 2, 1); }
                else if (ph == 3) { SCAN(WS_MERGED, (size_t)M * D * 2, 1); }
                else if (ph == 4) { SCAN(WS_X, (size_t)M * D * 4, 0); }
                else if (ph == 5) { SCAN(WS_H, (size_t)M * D * 2, 1); SCAN(WS_ROUTE, (size_t)2 * M * 4, 0); SCAN(WS_ROUTE + (size_t)4 * M * 4, (size_t)2 * M * 4, 0); }
                else if (ph == 9) { hipLaunchKernelGGL(dbg_scan, dim3(1024), dim3(256), 0, stream, (const unsigned*)d_out, (size_t)M * D, 0, r); }
#undef SCAN
            }
        }
        hipLaunchKernelGGL(dbg_encode, dim3(1024), dim3(256), 0, stream, (const unsigned long long*)rep, (float*)d_out, (size_t)M * D, NPHASE);
    }
#elif MK_PER_PHASE
    for (int p = 0; p < NPHASE; ++p) {
        a.ph_lo = p; a.ph_hi = p + 1;
        hipLaunchKernelGGL(fwd_kernel, dim3(grid), dim3(NWAVES * 64), LDS_BYTES, stream, a);
    }
#else
    a.ph_lo = 0; a.ph_hi = NPHASE;
    hipLaunchKernelGGL(fwd_kernel, dim3(grid), dim3(NWAVES * 64), LDS_BYTES, stream, a);
#endif
    const hipError_t le = hipPeekAtLastError();
    if (le != hipSuccess) fprintf(stderr, "kernel_launch: launch failed: %s\n", hipGetErrorName(le));
}
```

```cpp
#include <hip/hip_runtime.h>
#include <cstdio>
#include <cstdint>

#ifndef MK_PER_PHASE
#define MK_PER_PHASE 0
#endif

#define LAS __attribute__((address_space(3)))
#define GAS __attribute__((address_space(1)))
typedef unsigned short bf16_t;
typedef short bf16x8 __attribute__((ext_vector_type(8)));
typedef short s16x4 __attribute__((ext_vector_type(4)));
typedef float f32x4 __attribute__((ext_vector_type(4)));
typedef float f32x2 __attribute__((ext_vector_type(2)));
typedef float f32x16 __attribute__((ext_vector_type(16)));
typedef unsigned u32x4 __attribute__((ext_vector_type(4)));
typedef unsigned u32x2 __attribute__((ext_vector_type(2)));

constexpr int D = 1024, NBATCH = 4, SEQ = 4096, M = NBATCH * SEQ, DEPTH = 4, ZW = 7680;
constexpr int ZQA = 0, ZKA = 512, ZVA = 1024, ZQN = 1536, ZKN = 1792, ZVN = 2048, ZQD = 2304, ZKD = 3072, ZVD = 3840, ZG = 4608;
constexpr int NEXP = 32, EH = 512;
constexpr int MAXTILES = 160, XROWS = MAXTILES * 256;
constexpr float C2 = 0.125f * 1.4426950408889634f;
constexpr float LOG2E = 1.4426950408889634f;
constexpr float NORM_EPS = 1e-6f;
constexpr float NEGBIG = -1e30f;
constexpr float RESCALE_THR = 8.0f;

constexpr size_t MiB = 1u << 20;
constexpr size_t WS_CTL = 0, CTL_ZERO_BYTES = 1 * MiB;
constexpr size_t WS_RT = 1 * MiB;
constexpr size_t WS_MOD = 2 * MiB;
constexpr size_t WS_ROPE = 3 * MiB;
constexpr size_t WS_ROUTE = 4 * MiB;
constexpr size_t WS_X = 8 * MiB;
constexpr size_t WS_H = 72 * MiB;
constexpr size_t WS_OCAT = 104 * MiB;
constexpr size_t WS_MERGED = 136 * MiB;
constexpr size_t WS_Z = 168 * MiB;
constexpr size_t WS_XG = WS_Z;
constexpr size_t WS_HB = WS_Z + 80 * MiB;
constexpr size_t WS_YB = WS_Z + 120 * MiB;
constexpr size_t WS_WIN = 408 * MiB;
constexpr size_t WS_WPROJ = 468 * MiB;
constexpr size_t WS_WOUT = 476 * MiB;
constexpr size_t WS_W13 = 484 * MiB;
constexpr size_t WS_W2 = 740 * MiB;
constexpr size_t WS_END = 868 * MiB;
constexpr int CW_BAR = 4096;
constexpr int CW_CNT = 16384;
constexpr int CW_TILE = 32768;

constexpr int RING_BYTES = 131072;
constexpr int RT_LD = 1028;
constexpr int RT_BYTES = 36 * RT_LD * 4;
constexpr int MISC_OFF = RT_BYTES;
constexpr int LDS_BYTES = MISC_OFF + 512;

__device__ __forceinline__ unsigned f2bf(float f) { unsigned u = __builtin_bit_cast(unsigned, f); return (u + 0x7fffu + ((u >> 16) & 1u)) >> 16; }
__device__ __forceinline__ unsigned pk2(float lo, float hi) { return f2bf(lo) | (f2bf(hi) << 16); }
__device__ __forceinline__ unsigned cvt_pk_bf16(float lo, float hi) { unsigned r; asm("v_cvt_pk_bf16_f32 %0, %1, %2" : "=v"(r) : "v"(lo), "v"(hi)); return r; }
typedef __bf16 bf16x2_t __attribute__((ext_vector_type(2)));
__device__ __forceinline__ unsigned cvtpk_s(float lo, float hi) { f32x2 v = {lo, hi}; bf16x2_t b = __builtin_convertvector(v, bf16x2_t); return __builtin_bit_cast(unsigned, b); }
__device__ __forceinline__ float bflo(unsigned u) { return __builtin_bit_cast(float, u << 16); }
__device__ __forceinline__ float bfhi(unsigned u) { return __builtin_bit_cast(float, u & 0xffff0000u); }
__device__ __forceinline__ f32x4 bf4(u32x2 r) { return (f32x4){bflo(r.x), bfhi(r.x), bflo(r.y), bfhi(r.y)}; }
__device__ __forceinline__ float fexp2(float x) { return __builtin_amdgcn_exp2f(x); }
__device__ __forceinline__ float frcp(float x) { return __builtin_amdgcn_rcpf(x); }
__device__ __forceinline__ void swap32(float& a, float& b) { asm volatile("s_nop 1\n\tv_permlane32_swap_b32 %0, %1\n\ts_nop 1" : "+v"(a), "+v"(b)); }
template <int X> __device__ __forceinline__ float xor_lane(float v) { return __builtin_bit_cast(float, __builtin_amdgcn_ds_swizzle(__builtin_bit_cast(int, v), (X << 10) | 0x1f)); }
__device__ __forceinline__ float half_sum(float v) { v += xor_lane<1>(v); v += xor_lane<2>(v); v += xor_lane<4>(v); v += xor_lane<8>(v); v += xor_lane<16>(v); return v; }
__device__ __forceinline__ float wave_sum(float v) {
    v = half_sum(v);
    float a = v, b = v; swap32(a, b);
    return a + b;
}
template <int CTRL> __device__ __forceinline__ float dpp_f(float v) { return __builtin_bit_cast(float, __builtin_amdgcn_update_dpp(0, __builtin_bit_cast(int, v), CTRL, 0xf, 0xf, false)); }
__device__ __forceinline__ float wave_sum_u(float v) {
    v += dpp_f<0xB1>(v); v += dpp_f<0x4E>(v); v += dpp_f<0x141>(v); v += dpp_f<0x140>(v);
    v += __builtin_bit_cast(float, __builtin_amdgcn_update_dpp(0, __builtin_bit_cast(int, v), 0x142, 0xa, 0xf, false));
    v += __builtin_bit_cast(float, __builtin_amdgcn_update_dpp(0, __builtin_bit_cast(int, v), 0x143, 0xc, 0xf, false));
    float r = __builtin_bit_cast(float, __builtin_amdgcn_readlane(__builtin_bit_cast(int, v), 63));
    asm volatile("" : "+v"(r));
    return r;
}
__device__ __forceinline__ void wave_sum4_u(float& a, float& b, float& c, float& d) {
    unsigned s0, s1, s2, s3;
#define WS4_STEP(ctl) "v_add_f32_dpp %0, %0, %0 " ctl "\n\tv_add_f32_dpp %1, %1, %1 " ctl "\n\tv_add_f32_dpp %2, %2, %2 " ctl "\n\tv_add_f32_dpp %3, %3, %3 " ctl "\n\t"
    asm volatile("s_nop 1\n\t"
        WS4_STEP("quad_perm:[1,0,3,2] row_mask:0xf bank_mask:0xf") WS4_STEP("quad_perm:[2,3,0,1] row_mask:0xf bank_mask:0xf") WS4_STEP("row_half_mirror row_mask:0xf bank_mask:0xf")
        WS4_STEP("row_mirror row_mask:0xf bank_mask:0xf") WS4_STEP("row_bcast:15 row_mask:0xa bank_mask:0xf") WS4_STEP("row_bcast:31 row_mask:0xc bank_mask:0xf")
        "v_readlane_b32 %4, %0, 63\n\tv_readlane_b32 %5, %1, 63\n\tv_readlane_b32 %6, %2, 63\n\tv_readlane_b32 %7, %3, 63\n\t"
        "v_mov_b32 %0, %4\n\tv_mov_b32 %1, %5\n\tv_mov_b32 %2, %6\n\tv_mov_b32 %3, %7"
        : "+v"(a), "+v"(b), "+v"(c), "+v"(d), "=&s"(s0), "=&s"(s1), "=&s"(s2), "=&s"(s3));
#undef WS4_STEP
}
__device__ __forceinline__ void st16_wt(void* p, u32x4 v) { asm volatile("global_store_dwordx4 %0, %1, off sc1\n\ts_nop 1" :: "v"(p), "v"(v) : "memory"); }
#define LDS_WAIT() asm volatile("s_waitcnt lgkmcnt(0)" ::: "memory")
#define VM_WAIT() asm volatile("s_waitcnt vmcnt(0)" ::: "memory")
#define CBAR() asm volatile("" ::: "memory")

namespace pg8 {
constexpr int BM = 256, BK = 64, HALF = 128, HTB = HALF * BK * 2, STAGE_BYTES = 8 * HTB, NXCD = 8, WGM = 8;
__host__ __device__ __forceinline__ int lds_byte(int r, int c) { const int st = (r >> 4) * 2 + (c >> 5), rr = r & 15, cc = c & 31, ob = rr * 64 + cc * 2; return st * 1024 + (ob ^ (((ob >> 9) & 1) << 5)); }
__host__ __device__ __forceinline__ void stage_rc(int b, int& R, int& C) { const int st = b / 1024, sb = b % 1024, swz = sb ^ (((sb >> 9) & 1) << 5); R = (st >> 1) * 16 + swz / 64; C = (st & 1) * 32 + (swz % 64) / 2; }
__host__ __device__ __forceinline__ int perm32(int rho) { const int n = rho >> 4, i = rho & 15; return 8 * (i >> 2) + 4 * n + (i & 3); }

struct Unit { int pm, pn, e, x0, x1; };
struct Gemm { const bf16_t* A; const bf16_t* Bt; int lda, ldb, K; };

struct StaticOrder {
    int nM, nN, nwg, G, c;
    __device__ void init(int M_, int N_, int G_, int c_) { nM = M_ / BM; nN = N_ / BM; nwg = nM * nN; G = G_; c = c_; }
    __device__ bool next(int i, Unit& u) const {
        const long L = (long)i * G + c; if (L >= nwg) return false;
        int wgid = (int)L; { const int q = nwg / NXCD, r = nwg % NXCD, xcd = wgid % NXCD, off = wgid / NXCD; wgid = (xcd < r ? xcd * (q + 1) : r * (q + 1) + (xcd - r) * q) + off; }
        const int nig = WGM * nN, gid = wgid / nig, fm = gid * WGM, gsz = (nM - fm) < WGM ? (nM - fm) : WGM;
        u.pm = fm + ((wgid % nig) % gsz); u.pn = (wgid % nig) / gsz; u.e = 0; u.x0 = 0; u.x1 = 0; return true;
    }
    __device__ __forceinline__ size_t aoff(const Gemm& g, const Unit& u) const { return (size_t)u.pm * BM * g.lda * 2; }
    __device__ __forceinline__ size_t boff(const Gemm& g, const Unit& u) const { return (size_t)u.pn * BM * g.ldb * 2; }
    __device__ __forceinline__ int ktiles(const Gemm& g, const Unit&) const { return g.K / BK; }
    __device__ __forceinline__ void done(const Unit&, int) const {}
};
struct MoeOrder {
    int n; int pm0, pm1, pn0, pn1, e0, e1; size_t estride;
    int ts0, ts1, cn0, cn1; const int* etok;
    unsigned* tcnt;
    __device__ __forceinline__ void done(const Unit& u, int lane) const {
        if (tcnt) { asm volatile("s_waitcnt vmcnt(0)" ::: "memory"); if (lane == 0) __hip_atomic_fetch_add(tcnt + u.pm * 16, 1u, __ATOMIC_RELAXED, __HIP_MEMORY_SCOPE_AGENT); }
    }
    __device__ bool next(int i, Unit& u) const {
        if (i >= n) return false;
        u.pm = i == 0 ? pm0 : pm1; u.pn = i == 0 ? pn0 : pn1; u.e = i == 0 ? e0 : e1;
        u.x0 = i == 0 ? ts0 : ts1; u.x1 = i == 0 ? cn0 : cn1; return true;
    }
    __device__ __forceinline__ size_t aoff(const Gemm& g, const Unit& u) const { return (size_t)u.pm * BM * g.lda * 2; }
    __device__ __forceinline__ size_t boff(const Gemm& g, const Unit& u) const { return (size_t)u.e * estride + (size_t)u.pn * BM * g.ldb * 2; }
    __device__ __forceinline__ int ktiles(const Gemm& g, const Unit&) const { return g.K / BK; }
    __device__ __forceinline__ int gather_row(const Unit& u, int r) const {
        const int pos = min((u.pm - u.x0) * BM + r, u.x1 - 1);
        return etok[u.e * 16384 + pos];
    }
};
struct ProjOrder {
    int pm, pn, rot;
    __device__ bool next(int i, Unit& u) const { if (i >= 3) return false; int seg = i + rot; seg = seg >= 3 ? seg - 3 : seg; u.pm = pm; u.pn = pn; u.e = seg | ((i == 0) ? 16 : 0); u.x0 = 0; u.x1 = 0; return true; }
    __device__ __forceinline__ int kofs(const Unit& u) const { const int seg = u.e & 15; return seg == 0 ? 0 : (seg == 1 ? 512 : 768); }
    __device__ __forceinline__ size_t aoff(const Gemm& g, const Unit& u) const { return (size_t)u.pm * BM * g.lda * 2 + (size_t)kofs(u) * 2; }
    __device__ __forceinline__ size_t boff(const Gemm& g, const Unit& u) const { return (size_t)u.pn * BM * g.ldb * 2 + (size_t)kofs(u) * 2; }
    __device__ __forceinline__ int ktiles(const Gemm&, const Unit& u) const { return (u.e & 15) == 0 ? 8 : 4; }
    __device__ __forceinline__ void done(const Unit&, int) const {}
};

template <class Epi, class Sched, bool ALIGN_EPI = true, bool SP2 = true, bool GATHER = false>
__device__ __forceinline__ void gemm_phase(LAS unsigned char* lds, const Gemm g, const Sched& S, const Epi& E) {
    int tid_ = threadIdx.x; asm volatile("" : "+v"(tid_));
    const int tid = tid_, wid = __builtin_amdgcn_readfirstlane(tid >> 6), lane = tid & 63, wr = wid >> 2, wc = wid & 3, fr = lane & 15, fq = lane >> 4;
    int nt = S.ktiles(g, Unit{0, 0, 0, 0, 0});
    unsigned voffA[2], voffB[2];
#pragma unroll
    for (int i = 0; i < 2; ++i) { int R, C; stage_rc(tid * 16 + i * 8192, R, C); const int Rb = Epi::PERM ? ((R & ~31) + perm32(R & 31)) : R;
        voffA[i] = (unsigned)(R * g.lda + C) * 2u; voffB[i] = (unsigned)(Rb * g.ldb + C) * 2u; }
    const size_t kstep = (size_t)(BK * 2);
    const size_t hstepA = (size_t)HALF * g.lda * 2, hstepB = (size_t)HALF * g.ldb * 2;
    const unsigned ldsw = (unsigned)wid * 1024u;
    const int aoff = lds_byte(wr * 64 + fr, fq * 8), boff = lds_byte(wc * 32 + fr, fq * 8);
#define PG8_SA(b, h) (((b) * 2 + (h)) * HTB)
#define PG8_SB(b, h) ((4 + (b) * 2 + (h)) * HTB)
#define PG8_STAGE(bufoff, gbase, voff) do { _Pragma("unroll") for (int _i = 0; _i < 2; ++_i) \
        __builtin_amdgcn_global_load_lds((const unsigned*)((const char*)(gbase) + (voff)[_i]), (LAS unsigned*)(lds + (bufoff) + ldsw + _i * 8192), 16, 0, 0); } while (0)
    unsigned vo0[2] = {0u, 0u}, vo1[2] = {0u, 0u}, nvo0[2] = {0u, 0u}, nvo1[2] = {0u, 0u};
#define PG8_GOFF(u_, d0_, d1_) do { _Pragma("unroll") for (int _i = 0; _i < 2; ++_i) { int R_, C_; stage_rc(tid * 16 + _i * 8192, R_, C_); \
        d0_[_i] = (unsigned)(S.gather_row(u_, R_) * g.lda + C_) * 2u; d1_[_i] = (unsigned)(S.gather_row(u_, HALF + R_) * g.lda + C_) * 2u; } } while (0)
#define PG8_STAGEA(bufoff, ptr, h, nx) do { if constexpr (GATHER) { unsigned o_[2]; o_[0] = (nx) ? ((h) ? nvo1[0] : nvo0[0]) : ((h) ? vo1[0] : vo0[0]); o_[1] = (nx) ? ((h) ? nvo1[1] : nvo0[1]) : ((h) ? vo1[1] : vo0[1]); \
        PG8_STAGE(bufoff, ptr, o_); } else { PG8_STAGE(bufoff, (ptr) + ((h) ? hstepA : 0), voffA); } } while (0)
#define PG8_LDA(dst, b, h) do { _Pragma("unroll") for (int m = 0; m < 4; ++m) _Pragma("unroll") for (int k = 0; k < 2; ++k) dst[m][k] = *(const LAS bf16x8*)(lds + PG8_SA(b, h) + aoff + m * 2048 + k * 1024); } while (0)
#define PG8_LDB(dst, b, h) do { _Pragma("unroll") for (int n = 0; n < 2; ++n) _Pragma("unroll") for (int k = 0; k < 2; ++k) dst[n][k] = *(const LAS bf16x8*)(lds + PG8_SB(b, h) + boff + n * 2048 + k * 1024); } while (0)
#define PG8_MMA(ai, bj, At, Bt) do { __builtin_amdgcn_s_setprio(1); _Pragma("unroll") for (int m = 0; m < 4; ++m) _Pragma("unroll") for (int n = 0; n < 2; ++n) _Pragma("unroll") for (int k = 0; k < 2; ++k) \
        acc[ai][bj][m][n] = __builtin_amdgcn_mfma_f32_16x16x32_bf16(Bt[n][k], At[m][k], acc[ai][bj][m][n], 0, 0, 0); __builtin_amdgcn_s_setprio(0); } while (0)
#define PG8_WAIT_V(n) asm volatile("s_waitcnt vmcnt(" #n ")" ::: "memory")
#define PG8_WAIT_L(n) asm volatile("s_waitcnt lgkmcnt(" #n ")" ::: "memory")
#define PG8_BAR __builtin_amdgcn_s_barrier()
#define PG8_SCHED __builtin_amdgcn_sched_barrier(0)
    Unit cur, nxt; int ui = 0;
    if (!S.next(0, cur)) return;
    nt = S.ktiles(g, cur);
    f32x4 acc[2][2][4][2];
#pragma unroll
    for (int a = 0; a < 2; ++a)
#pragma unroll
        for (int b = 0; b < 2; ++b)
#pragma unroll
            for (int m = 0; m < 4; ++m)
#pragma unroll
                for (int n = 0; n < 2; ++n) acc[a][b][m][n] = (f32x4){0.f, 0.f, 0.f, 0.f};
    bf16x8 At[4][2], B0[2][2], B1[2][2];
    const char* cA = (const char*)g.A + (GATHER ? (size_t)0 : S.aoff(g, cur)); const char* cB = (const char*)g.Bt + S.boff(g, cur);
    if constexpr (GATHER) { PG8_GOFF(cur, vo0, vo1); asm volatile("s_waitcnt vmcnt(0)" : "+v"(vo0[0]), "+v"(vo0[1]), "+v"(vo1[0]), "+v"(vo1[1]) :: "memory"); }
    if constexpr (SP2) {
        PG8_STAGE(PG8_SB(0, 0), cB, voffB); PG8_STAGE(PG8_SB(0, 1), cB + hstepB, voffB); PG8_STAGEA(PG8_SA(0, 0), cA, 0, false); PG8_STAGEA(PG8_SA(0, 1), cA, 1, false);
        if (wr == 1) PG8_BAR;
        PG8_WAIT_V(2); PG8_BAR;
        PG8_STAGE(PG8_SB(1, 0), cB + kstep, voffB); PG8_STAGEA(PG8_SA(1, 0), cA + kstep, 0, false); PG8_STAGE(PG8_SB(1, 1), cB + hstepB + kstep, voffB);
        PG8_WAIT_V(6); PG8_BAR;
    } else {
        PG8_STAGE(PG8_SB(0, 0), cB, voffB); PG8_STAGE(PG8_SA(0, 0), cA, voffA); PG8_STAGE(PG8_SB(0, 1), cB + hstepB, voffB); PG8_STAGE(PG8_SA(0, 1), cA + hstepA, voffA);
        if (wr == 1) PG8_BAR;
        PG8_WAIT_V(4); PG8_BAR;
        PG8_STAGE(PG8_SB(1, 0), cB + kstep, voffB); PG8_STAGE(PG8_SA(1, 0), cA + kstep, voffA); PG8_STAGE(PG8_SB(1, 1), cB + hstepB + kstep, voffB);
        PG8_WAIT_V(6); PG8_BAR;
    }
    for (;;) {
        const bool has_next = S.next(ui + 1, nxt);
        const char* nA = (has_next && !GATHER) ? (const char*)g.A + S.aoff(g, nxt) : cA; const char* nB = has_next ? (const char*)g.Bt + S.boff(g, nxt) : cB;
        if constexpr (GATHER) { if (has_next) { PG8_GOFF(nxt, nvo0, nvo1); } else { nvo0[0] = vo0[0]; nvo0[1] = vo0[1]; nvo1[0] = vo1[0]; nvo1[1] = vo1[1]; }
            asm volatile("s_waitcnt vmcnt(0)" : "+v"(nvo0[0]), "+v"(nvo0[1]), "+v"(nvo1[0]), "+v"(nvo1[1]) :: "memory"); }
        for (int t = 0; t < nt; t += 2) {
            const bool last = (t == nt - 2);
            const char* a1 = cA + (size_t)(t + 1) * kstep;
            const char* a2 = last ? nA : cA + (size_t)(t + 2) * kstep; const char* b2 = last ? nB : cB + (size_t)(t + 2) * kstep;
            const char* a3 = a2 + kstep; const char* b3 = b2 + kstep;
            if constexpr (SP2) {
            PG8_LDB(B0, 0, 0); PG8_LDB(B1, 0, 1); PG8_SCHED; PG8_LDA(At, 0, 0); PG8_STAGEA(PG8_SA(1, 1), a1, 1, false);
            PG8_WAIT_V(8); PG8_WAIT_L(0); PG8_BAR; PG8_MMA(0, 0, At, B0); PG8_MMA(0, 1, At, B1); PG8_BAR; PG8_SCHED;
            PG8_LDA(At, 0, 1); PG8_STAGE(PG8_SB(0, 0), b2, voffB); PG8_STAGE(PG8_SB(0, 1), b2 + hstepB, voffB); PG8_STAGEA(PG8_SA(0, 0), a2, 0, last);
            PG8_WAIT_V(8); PG8_WAIT_L(0); PG8_BAR; PG8_MMA(1, 0, At, B0); PG8_MMA(1, 1, At, B1); PG8_BAR; PG8_SCHED;
            PG8_LDB(B0, 1, 0); PG8_LDB(B1, 1, 1); PG8_SCHED; PG8_LDA(At, 1, 0); PG8_STAGEA(PG8_SA(0, 1), a2, 1, last);
            PG8_WAIT_V(8); PG8_WAIT_L(0); PG8_BAR; PG8_MMA(0, 0, At, B0); PG8_MMA(0, 1, At, B1); PG8_BAR; PG8_SCHED;
            PG8_LDA(At, 1, 1); PG8_STAGE(PG8_SB(1, 0), b3, voffB); PG8_STAGE(PG8_SB(1, 1), b3 + hstepB, voffB); PG8_STAGEA(PG8_SA(1, 0), a3, 0, last);
            PG8_WAIT_V(8); PG8_WAIT_L(0); PG8_BAR; PG8_MMA(1, 0, At, B0); PG8_MMA(1, 1, At, B1); PG8_BAR; PG8_SCHED;
            } else {
            PG8_LDB(B0, 0, 0); PG8_SCHED; PG8_LDA(At, 0, 0); PG8_STAGE(PG8_SA(1, 1), a1 + hstepA, voffA);
            PG8_WAIT_L(8); PG8_BAR; PG8_WAIT_L(0); PG8_MMA(0, 0, At, B0); PG8_BAR; PG8_SCHED;
            PG8_LDB(B1, 0, 1); PG8_STAGE(PG8_SB(0, 0), b2, voffB);
            PG8_BAR; PG8_WAIT_L(0); PG8_MMA(0, 1, At, B1); PG8_BAR;
            PG8_LDA(At, 0, 1); PG8_STAGE(PG8_SA(0, 0), a2, voffA);
            PG8_BAR; PG8_WAIT_L(0); PG8_MMA(1, 0, At, B0); PG8_BAR; PG8_SCHED;
            PG8_STAGE(PG8_SB(0, 1), b2 + hstepB, voffB);
            PG8_WAIT_V(6); PG8_BAR; PG8_MMA(1, 1, At, B1); PG8_BAR;
            PG8_LDB(B0, 1, 0); PG8_SCHED; PG8_LDA(At, 1, 0); PG8_STAGE(PG8_SA(0, 1), a2 + hstepA, voffA);
            PG8_WAIT_L(8); PG8_BAR; PG8_WAIT_L(0); PG8_MMA(0, 0, At, B0); PG8_BAR; PG8_SCHED;
            PG8_LDB(B1, 1, 1); PG8_STAGE(PG8_SB(1, 0), b3, voffB);
            PG8_BAR; PG8_WAIT_L(0); PG8_MMA(0, 1, At, B1); PG8_BAR;
            PG8_LDA(At, 1, 1); PG8_STAGE(PG8_SA(1, 0), a3, voffA);
            PG8_BAR; PG8_WAIT_L(0); PG8_MMA(1, 0, At, B0); PG8_BAR; PG8_SCHED;
            PG8_STAGE(PG8_SB(1, 1), b3 + hstepB, voffB);
            PG8_WAIT_V(6); PG8_BAR; PG8_MMA(1, 1, At, B1); PG8_BAR;
            }
        }
        if constexpr (ALIGN_EPI) { if (wr == 0) PG8_BAR; }
        E(acc, cur, wr, wc, fr, fq);
        S.done(cur, lane);
        if (!has_next) break;
#pragma unroll
        for (int a = 0; a < 2; ++a)
#pragma unroll
            for (int b = 0; b < 2; ++b)
#pragma unroll
                for (int m = 0; m < 4; ++m)
#pragma unroll
                    for (int n = 0; n < 2; ++n) acc[a][b][m][n] = (f32x4){0.f, 0.f, 0.f, 0.f};
        cur = nxt; cA = nA; cB = nB; ++ui; nt = S.ktiles(g, cur);
        if constexpr (GATHER) { vo0[0] = nvo0[0]; vo0[1] = nvo0[1]; vo1[0] = nvo1[0]; vo1[1] = nvo1[1]; }
        if constexpr (ALIGN_EPI) { if (wr == 1) PG8_BAR; }
    }
    PG8_WAIT_V(0);
    if constexpr (!ALIGN_EPI) { if (wr == 0) PG8_BAR; }
    PG8_BAR;
#undef PG8_SA
#undef PG8_SB
#undef PG8_STAGE
#undef PG8_LDA
#undef PG8_STAGEA
#undef PG8_GOFF
#undef PG8_LDB
#undef PG8_MMA
#undef PG8_WAIT_V
#undef PG8_WAIT_L
#undef PG8_BAR
#undef PG8_SCHED
}
}

#define XB_TMO      128
#define XB_XCNT(j)  (256  + 64 * (j))
#define XB_XSUB(j)  (1280 + 64 * (j))
#define XB_XGEN(j)  (2304 + 64 * (j))
#define XB_TOP      3328
#define XB_TOPGEN   3392
#define XCD_BAR_WORDS 3456
#define XB_SPIN_CAP (1u << 18)
__device__ __forceinline__ unsigned xb_ld(unsigned* p)              { return __hip_atomic_load(p, __ATOMIC_RELAXED, __HIP_MEMORY_SCOPE_AGENT); }
__device__ __forceinline__ unsigned xb_add(unsigned* p, unsigned v) { return __hip_atomic_fetch_add(p, v, __ATOMIC_RELAXED, __HIP_MEMORY_SCOPE_AGENT); }
__device__ __forceinline__ unsigned xb_xcc_id() { return (unsigned)__builtin_amdgcn_s_getreg((3 << 11) | 20) & 0xFu; }
#define XB_SPIN(cond, bar) do { unsigned _sp = 0; while (cond) { __builtin_amdgcn_s_sleep(1); \
    if ((++_sp & 255u) == 0u) { if (xb_ld(&(bar)[XB_TMO])) break; if (_sp > XB_SPIN_CAP) { atomicAdd(&(bar)[XB_TMO], 1u); break; } } } } while (0)
struct XcdBarrier { unsigned* bar; unsigned x; volatile LAS unsigned* st; };
__device__ __forceinline__ XcdBarrier xcd_barrier_post(unsigned* bar, volatile LAS unsigned* st) {
    XcdBarrier b; b.bar = bar; b.x = xb_xcc_id(); b.st = st;
    if (threadIdx.x == 0) (void)xb_add(&bar[XB_XCNT(b.x)], 1u);
    return b;
}
__device__ __forceinline__ void xcd_barrier_complete(unsigned* bar, unsigned x, unsigned& nloc, unsigned& nx) {
    const unsigned G = gridDim.x * gridDim.y * gridDim.z;
    unsigned sum, cnt, mine, sp = 0u;
    for (;;) {
        sum = 0u; cnt = 0u; mine = 0u;
#pragma unroll
        for (unsigned j = 0; j < 16; ++j) { const unsigned c = xb_ld(&bar[XB_XCNT(j)]); sum += c; cnt += (c > 0u) ? 1u : 0u; mine = (j == x) ? c : mine; }
        if (sum == G) break;
        __builtin_amdgcn_s_sleep(1);
        if ((++sp & 255u) == 0u) { if (xb_ld(&bar[XB_TMO])) break; if (sp > XB_SPIN_CAP) { atomicAdd(&bar[XB_TMO], 1u); break; } }
    }
    nloc = mine > 0u ? mine : 1u; nx = cnt > 0u ? cnt : 1u;
}
__device__ __forceinline__ void xcd_barrier(const XcdBarrier& b) {
    asm volatile("s_waitcnt vmcnt(0)" ::: "memory");
    __syncthreads();
    if (threadIdx.x == 0) {
        unsigned* bar = b.bar;
        __builtin_amdgcn_s_waitcnt(0);
        unsigned nloc = b.st[0], nx = b.st[1];
        if (nloc == 0u) { xcd_barrier_complete(bar, b.x, nloc, nx); b.st[0] = nloc; b.st[1] = nx; }
        const unsigned old = xb_add(&bar[XB_XSUB(b.x)], 1u);
        const unsigned gen = old / nloc;
        if (old + 1u == (gen + 1u) * nloc) {
            __builtin_amdgcn_fence(__ATOMIC_RELEASE, "agent");
            asm volatile("s_waitcnt vmcnt(0)" ::: "memory");
            const unsigned og = xb_add(&bar[XB_TOP], 1u);
            const unsigned tg = og / nx;
            if (og + 1u == (tg + 1u) * nx) xb_add(&bar[XB_TOPGEN], 1u);
            else XB_SPIN(xb_ld(&bar[XB_TOPGEN]) == tg, bar);
            __builtin_amdgcn_fence(__ATOMIC_ACQUIRE, "agent");
            xb_add(&bar[XB_XGEN(b.x)], 1u);
            asm volatile("s_waitcnt vmcnt(0)" ::: "memory");
        } else {
            XB_SPIN(xb_ld(&bar[XB_XGEN(b.x)]) == gen, bar);
            __builtin_amdgcn_fence(__ATOMIC_ACQUIRE, "agent");
            asm volatile("s_waitcnt vmcnt(0)" ::: "memory");
        }
    }
    __syncthreads();
}

struct Args {
    const float* x; const float* c; const float* ada_w; const float* ada_b; const float* mix_g; const float* ffn_g; const float* w_in;
    const float* da_lambda; const float* da_subln; const float* na_rpb; const float* wpa; const float* wpn; const float* wpd; const float* w_out;
    const float* rgw; const float* rgb; const float* rew; const float* reb; const float* ew1; const float* ew3; const float* ew2; const float* fin_g;
    float* out; unsigned char* ws; int ph_lo, ph_hi; int variant, pad;
};

__device__ const double ROPE_INV[32] = {
    1.0, 0.7498942093324559, 0.5623413251903491, 0.4216965034285822, 0.31622776601683794, 0.23713737056616552, 0.1778279410038923, 0.1333521432163324,
    0.1, 0.07498942093324558, 0.05623413251903491, 0.04216965034285822, 0.031622776601683794, 0.023713737056616554, 0.01778279410038923, 0.01333521432163324,
    0.01, 0.007498942093324558, 0.005623413251903491, 0.004216965034285822, 0.0031622776601683794, 0.0023713737056616554, 0.001778279410038923, 0.001333521432163324,
    0.001, 0.0007498942093324559, 0.0005623413251903491, 0.0004216965034285822, 0.00031622776601683794, 0.00023713737056616554, 0.0001778279410038923, 0.0001333521432163324};

__device__ __forceinline__ void sincos_d(double a, float& s, float& c) {
    const double k = __builtin_rint(a * 0.6366197723675814);
    double t = __builtin_fma(-k, 1.5707963267948966, a); t = __builtin_fma(-k, 6.123233995736766e-17, t);
    const double t2 = t * t;
    double sp = -1.0 / 1307674368000.0; sp = sp * t2 + 1.0 / 6227020800.0; sp = sp * t2 - 1.0 / 39916800.0; sp = sp * t2 + 1.0 / 362880.0; sp = sp * t2 - 1.0 / 5040.0; sp = sp * t2 + 1.0 / 120.0; sp = sp * t2 - 1.0 / 6.0; sp = sp * t2 + 1.0; sp *= t;
    double cp = 1.0 / 87178291200.0; cp = cp * t2 - 1.0 / 479001600.0; cp = cp * t2 + 1.0 / 3628800.0; cp = cp * t2 - 1.0 / 40320.0; cp = cp * t2 + 1.0 / 720.0; cp = cp * t2 - 1.0 / 24.0; cp = cp * t2 + 0.5; cp = 1.0 - cp * t2;
    const int q = ((int)k) & 3;
    const double ss = (q == 0) ? sp : (q == 1) ? cp : (q == 2) ? -sp : -cp;
    const double cc = (q == 0) ? cp : (q == 1) ? -sp : (q == 2) ? -cp : sp;
    s = (float)ss; c = (float)cc;
}

__device__ __forceinline__ int dst_row(int mode, int n) {
    if (mode == 1) { const bool rot = (n < 1024) || (n >= ZQD && n < ZVD); if (rot) { const int j = n & 63; return (n & ~63) + ((j & 31) << 1) + (j >> 5); } return n; }
    if (mode == 2) return 256 * (n >> 7) + (n & 127);
    if (mode == 3) return 256 * (n >> 7) + 128 + (n & 127);
    return n;
}
template <int UNR>
__device__ __forceinline__ void tr_item(const float* W, int N, bf16_t* WT, int ldt, int koff, int mode, LAS float* scr, int item, int lane) {
    const int nblk = N / 32, kb = item / nblk, nb = item % nblk, k0 = 64 * kb, n0 = 32 * nb;
    if constexpr (UNR == 32) {
        float v[32];
#pragma unroll
        for (int i = 0; i < 32; ++i) { const int kk = 2 * i + (lane >> 5); v[i] = __builtin_nontemporal_load(&W[(size_t)(k0 + kk) * N + n0 + (lane & 31)]); }
        __builtin_amdgcn_sched_barrier(0); asm volatile("" ::: "memory"); __builtin_amdgcn_sched_barrier(0);
#pragma unroll
        for (int i = 0; i < 32; ++i) { const int kk = 2 * i + (lane >> 5); scr[kk * 33 + (lane & 31)] = v[i]; }
    } else {
#pragma unroll UNR
    for (int i = 0; i < 32; ++i) { const int kk = 2 * i + (lane >> 5); scr[kk * 33 + (lane & 31)] = __builtin_nontemporal_load(&W[(size_t)(k0 + kk) * N + n0 + (lane & 31)]); }
    }
    LDS_WAIT();
    const int c = lane & 7;
#pragma unroll
    for (int j = 0; j < 4; ++j) { const int n = (lane >> 3) + 8 * j; const LAS float* s = scr + (8 * c) * 33 + n;
        float f = 1.0f; if (mode == 1) { const int nn = n0 + n; f = (nn < ZKA || (nn >= ZQN && nn < ZKN) || (nn >= ZQD && nn < ZKD)) ? C2 : (nn >= ZG ? -LOG2E : 1.0f); }
        u32x4 o; o.x = cvt_pk_bf16(s[0 * 33] * f, s[1 * 33] * f); o.y = cvt_pk_bf16(s[2 * 33] * f, s[3 * 33] * f); o.z = cvt_pk_bf16(s[4 * 33] * f, s[5 * 33] * f); o.w = cvt_pk_bf16(s[6 * 33] * f, s[7 * 33] * f);
        *(u32x4*)(WT + (size_t)dst_row(mode, n0 + n) * ldt + koff + k0 + 8 * c) = o; }
    LDS_WAIT();
}

constexpr int CV_WIN = 16 * 240, CV_PA = 8 * 32, CV_PN = 4 * 32, CV_WO = 16 * 32, CV_E = 256, CV_PER_L = CV_WIN + CV_PA + 2 * CV_PN + CV_WO + NEXP * 3 * CV_E;
#ifndef CV_NDEF
#define CV_NDEF 8192
#endif
template <int UNR>
__device__ __forceinline__ void conv_item(const Args& args, int l, int r, bf16_t* WIN, bf16_t* WPR, bf16_t* WOU, bf16_t* W13, bf16_t* W2, LAS float* scr, int lane) {
    if (r < CV_WIN) { tr_item<UNR>(args.w_in + (size_t)l * D * ZW, ZW, WIN + (size_t)l * ZW * D, D, 0, 1, scr, r, lane); return; } r -= CV_WIN;
    if (r < CV_PA) { tr_item<UNR>(args.wpa + (size_t)l * 512 * D, D, WPR + (size_t)l * D * D, D, 0, 0, scr, r, lane); return; } r -= CV_PA;
    if (r < CV_PN) { tr_item<UNR>(args.wpn + (size_t)l * 256 * D, D, WPR + (size_t)l * D * D, D, 512, 0, scr, r, lane); return; } r -= CV_PN;
    if (r < CV_PN) { tr_item<UNR>(args.wpd + (size_t)l * 256 * D, D, WPR + (size_t)l * D * D, D, 768, 0, scr, r, lane); return; } r -= CV_PN;
    if (r < CV_WO) { tr_item<UNR>(args.w_out + (size_t)l * D * D, D, WOU + (size_t)l * D * D, D, 0, 0, scr, r, lane); return; } r -= CV_WO;
    const int e = r / (3 * CV_E), q = r % (3 * CV_E); const size_t le = (size_t)l * NEXP + e;
    if (q < CV_E) tr_item<UNR>(args.ew1 + le * D * EH, EH, W13 + le * 1024 * D, D, 0, 2, scr, q, lane);
    else if (q < 2 * CV_E) tr_item<UNR>(args.ew3 + le * D * EH, EH, W13 + le * 1024 * D, D, 0, 3, scr, q - CV_E, lane);
    else tr_item<UNR>(args.ew2 + le * EH * D, D, W2 + le * D * EH, EH, 0, 0, scr, q - 2 * CV_E, lane);
}

__device__ __forceinline__ float max3f(float a, float b, float c) { float r; asm("v_max3_f32 %0, %1, %2, %3" : "=v"(r) : "v"(a), "v"(b), "v"(c)); return r; }
__device__ __forceinline__ int crow(int r, int hi) { return (r & 3) + 8 * (r >> 2) + 4 * hi; }
__device__ __forceinline__ float swapmax(float m) { float a = m, b = m; swap32(a, b); return __builtin_fmaxf(a, b); }
__device__ __forceinline__ float swapsum(float m) { float a = m, b = m; swap32(a, b); return a + b; }
typedef short v4i16_t __attribute__((ext_vector_type(4)));
__device__ __forceinline__ s16x4 vtr(const LAS unsigned char* p) { return __builtin_bit_cast(s16x4, __builtin_amdgcn_ds_read_tr16_b64_v4i16((LAS v4i16_t*)p)); }

template <int DV> struct AttnCfg { static constexpr int ND = DV / 32, NCH = DV / 16, VST = DV * 2 + 64; };

template <int DV> struct TileRegs { u32x4 kr[4]; u32x4 vr[4]; };
template <int DV>
__device__ __forceinline__ void tile_load(TileRegs<DV>& T, const char* zb, const unsigned (&roff)[4], unsigned kcol, unsigned vcol) {
    const unsigned cb = 16u * (threadIdx.x & 7);
#pragma unroll
    for (int i = 0; i < 4; ++i) { T.kr[i] = *(const u32x4*)(zb + (size_t)(roff[i] + kcol + cb)); T.vr[i] = *(const u32x4*)(zb + (size_t)(roff[i] + vcol + cb)); }
}
__device__ __forceinline__ float max16m(const f32x16& p, float m) { float a, b;
    asm("v_max3_f32 %0, %2, %3, %4\n\tv_max3_f32 %1, %5, %6, %7\n\tv_max3_f32 %0, %0, %8, %9\n\tv_max3_f32 %1, %1, %10, %11\n\tv_max3_f32 %0, %0, %12, %13\n\tv_max3_f32 %1, %1, %14, %15\n\t"
        "v_max3_f32 %0, %0, %16, %17\n\tv_max3_f32 %0, %0, %1, %18"
        : "=&v"(a), "=&v"(b) : "v"(p[0]), "v"(p[1]), "v"(p[2]), "v"(p[3]), "v"(p[4]), "v"(p[5]), "v"(p[6]), "v"(p[7]), "v"(p[8]), "v"(p[9]), "v"(p[10]), "v"(p[11]), "v"(p[12]), "v"(p[13]), "v"(p[14]), "v"(p[15]), "v"(m));
    return a; }
template <int DV, class MaskF, class Reload>
__device__ __forceinline__ void attn_tile(f32x16 (&o)[DV / 32], float& m, float& l, const bf16x8 (&qf)[4], TileRegs<DV>& T,
                                          LAS unsigned char* vlds, LAS float* wsf, const MaskF& maskf, const Reload& reload, int lane, int hi) {
    constexpr int ND = AttnCfg<DV>::ND, VST = AttnCfg<DV>::VST, KST = 144;
    static_assert(DV == 64, "gather tiles are 64 wide");
    CBAR();
    { LAS unsigned char* kw = vlds + 6144 + (lane >> 3) * KST + (lane & 7) * 16; LAS unsigned char* vw = vlds + (lane >> 3) * VST + (lane & 7) * 16;
#pragma unroll
      for (int i = 0; i < 4; ++i) { *(LAS u32x4*)(kw + 8 * i * KST) = T.kr[i]; *(LAS u32x4*)(vw + 8 * i * VST) = T.vr[i]; } }
    CBAR();
    reload(T);
    f32x16 p; maskf(p);
    { const LAS unsigned char* kp = vlds + 6144 + (lane & 31) * KST + hi * 16;
#pragma unroll
      for (int d0 = 0; d0 < 4; ++d0) { const bf16x8 kf = *(const LAS bf16x8*)(kp + 32 * d0); p = __builtin_amdgcn_mfma_f32_32x32x16_bf16(kf, qf[d0], p, 0, 0, 0); } }
    asm volatile("s_nop 15\n\ts_nop 7" : "+v"(p));
    float mx = max16m(p, m);
    { float a = mx, b = mx; swap32(a, b); mx = max3f(a, b, m); }
    const float mn = (mx > m + RESCALE_THR) ? mx : m;
    const float alpha = fexp2(m - mn);
    m = mn;
    float rs = 0.f;
#pragma unroll
    for (int r = 0; r < 16; ++r) { p[r] = fexp2(p[r] - mn); rs += p[r]; }
    l = l * alpha + rs;
    if (__any(alpha != 1.0f)) {
        CBAR();
        if (hi == 0) wsf[lane & 31] = alpha;
        CBAR();
#pragma unroll
        for (int g4 = 0; g4 < 4; ++g4) { const f32x4 a4 = *(const LAS f32x4*)(wsf + 8 * g4 + 4 * hi);
#pragma unroll
            for (int d0 = 0; d0 < ND; ++d0) { o[d0][4 * g4 + 0] *= a4[0]; o[d0][4 * g4 + 1] *= a4[1]; o[d0][4 * g4 + 2] *= a4[2]; o[d0][4 * g4 + 3] *= a4[3]; } }
        CBAR();
    }
    CBAR();
    u32x4 pw0, pw1;
    pw0.x = cvtpk_s(p[0], p[1]); pw0.y = cvtpk_s(p[2], p[3]); pw0.z = cvtpk_s(p[4], p[5]); pw0.w = cvtpk_s(p[6], p[7]);
    pw1.x = cvtpk_s(p[8], p[9]); pw1.y = cvtpk_s(p[10], p[11]); pw1.z = cvtpk_s(p[12], p[13]); pw1.w = cvtpk_s(p[14], p[15]);
    const bf16x8 pa0 = __builtin_bit_cast(bf16x8, pw0), pa1 = __builtin_bit_cast(bf16x8, pw1);
    const int li = lane & 15, g16 = lane >> 4;
    const LAS unsigned char* vb = vlds + (4 * hi + (li >> 2)) * VST + (16 * (g16 & 1) + 4 * (li & 3)) * 2;
    s16x4 vlo[2][ND], vhi[2][ND];
#pragma unroll
    for (int s = 0; s < 2; ++s)
#pragma unroll
        for (int d0 = 0; d0 < ND; ++d0) { vlo[s][d0] = vtr(vb + (16 * s) * VST + d0 * 64); vhi[s][d0] = vtr(vb + (16 * s + 8) * VST + d0 * 64); }
    __builtin_amdgcn_sched_barrier(0);
#pragma unroll
    for (int s = 0; s < 2; ++s)
#pragma unroll
        for (int d0 = 0; d0 < ND; ++d0) {
            const bf16x8 vf = (bf16x8){vlo[s][d0][0], vlo[s][d0][1], vlo[s][d0][2], vlo[s][d0][3], vhi[s][d0][0], vhi[s][d0][1], vhi[s][d0][2], vhi[s][d0][3]};
            o[d0] = __builtin_amdgcn_mfma_f32_32x32x16_bf16(s == 0 ? pa0 : pa1, vf, o[d0], 0, 0, 0);
        }
    CBAR();
}
template <int ND>
__device__ __forceinline__ void attn_finish(f32x16 (&o)[ND], float l, LAS float* wsf, int lane, int hi) {
    const float inv = frcp(swapsum(l));
    CBAR();
    if (hi == 0) wsf[lane & 31] = inv;
    CBAR();
#pragma unroll
    for (int g4 = 0; g4 < 4; ++g4) { const f32x4 a4 = *(const LAS f32x4*)(wsf + 8 * g4 + 4 * hi);
#pragma unroll
        for (int d0 = 0; d0 < ND; ++d0) { o[d0][4 * g4 + 0] *= a4[0]; o[d0][4 * g4 + 1] *= a4[1]; o[d0][4 * g4 + 2] *= a4[2]; o[d0][4 * g4 + 3] *= a4[3]; } }
    CBAR();
}

__device__ __forceinline__ void glds16s(const void* sbase, unsigned voff, unsigned lds_dst) { unsigned keep;
    asm volatile("s_mov_b32 %0, m0\n\ts_mov_b32 m0, %2\n\ts_nop 0\n\tglobal_load_lds_dwordx4 %1, %3\n\ts_mov_b32 m0, %0" : "=&s"(keep) : "v"(voff), "s"(lds_dst), "s"(sbase) : "memory"); }
__device__ __forceinline__ void glds16(const void* gsrc, unsigned lds_dst) { unsigned keep;
    asm volatile("s_mov_b32 %0, m0\n\ts_mov_b32 m0, %2\n\ts_nop 0\n\tglobal_load_lds_dwordx4 %1, off\n\ts_mov_b32 m0, %0" : "=&s"(keep) : "v"(gsrc), "s"(lds_dst) : "memory"); }
__device__ __forceinline__ void diff_qk(f32x16& p0, f32x16& p1, const LAS unsigned char* qlds, const LAS unsigned char* kb, int lane, int hi) {
    const int r32 = lane & 31, sw = (r32 >> 1) & 7;
    const LAS unsigned char* kp = kb + r32 * 128;
    p0 = f32x16{}; p1 = f32x16{};
#pragma unroll
    for (int d0 = 0; d0 < 4; ++d0) {
        const bf16x8 q = *(const LAS bf16x8*)(qlds + d0 * 1024 + lane * 16);
        const int po = ((2 * d0 + hi) ^ sw) << 4;
        const bf16x8 k0 = *(const LAS bf16x8*)(kp + po), k1 = *(const LAS bf16x8*)(kp + po + 4096);
        p0 = __builtin_amdgcn_mfma_f32_32x32x16_bf16(k0, q, p0, 0, 0, 0);
        p1 = __builtin_amdgcn_mfma_f32_32x32x16_bf16(k1, q, p1, 0, 0, 0);
    }
}
__device__ __forceinline__ void diff_sm_pv(f32x16 (&o)[4], float& m, float& l, f32x16& p0, f32x16& p1, const LAS unsigned char* vbuf, LAS float* wsf, int lane, int hi) {
    const int r32 = lane & 31;
    float ma = max3f(p0[0], p0[1], p1[0]), mb = max3f(p0[2], p0[3], p1[1]); ma = max3f(ma, p1[2], p1[3]);
#pragma unroll
    for (int r = 4; r < 16; r += 4) { ma = max3f(ma, p0[r], p0[r + 1]); mb = max3f(mb, p0[r + 2], p0[r + 3]); ma = max3f(ma, p1[r], p1[r + 1]); mb = max3f(mb, p1[r + 2], p1[r + 3]); }
    float mx = max3f(ma, mb, m);
    { float a = mx, b = mx; swap32(a, b); mx = max3f(a, b, m); }
    const float mn = (mx > m + RESCALE_THR) ? mx : m;
    const float alpha = fexp2(m - mn);
    m = mn;
    float rs = 0.f;
#pragma unroll
    for (int r = 0; r < 16; ++r) { p0[r] = fexp2(p0[r] - mn); p1[r] = fexp2(p1[r] - mn); rs += p0[r] + p1[r]; }
    l = l * alpha + rs;
    if (__any(alpha != 1.0f)) {
        CBAR();
        if (hi == 0) wsf[r32] = alpha;
        CBAR();
#pragma unroll
        for (int g4 = 0; g4 < 4; ++g4) { const f32x4 a4 = *(const LAS f32x4*)(wsf + 8 * g4 + 4 * hi);
#pragma unroll
            for (int d0 = 0; d0 < 4; ++d0) { o[d0][4 * g4 + 0] *= a4[0]; o[d0][4 * g4 + 1] *= a4[1]; o[d0][4 * g4 + 2] *= a4[2]; o[d0][4 * g4 + 3] *= a4[3]; } }
        CBAR();
    }
    u32x4 pw[4];
#pragma unroll
    for (int i = 0; i < 4; ++i) { pw[0][i] = cvtpk_s(p0[2 * i], p0[2 * i + 1]); pw[1][i] = cvtpk_s(p0[8 + 2 * i], p0[9 + 2 * i]); pw[2][i] = cvtpk_s(p1[2 * i], p1[2 * i + 1]); pw[3][i] = cvtpk_s(p1[8 + 2 * i], p1[9 + 2 * i]); }
    const int li = lane & 15, g16 = lane >> 4;
    const LAS unsigned char* vp = vbuf + hi * 1024 + (li >> 2) * 64 + (16 * (g16 & 1) + 4 * (li & 3)) * 2;
#pragma unroll
    for (int s4 = 0; s4 < 4; ++s4) {
        const bf16x8 pa = __builtin_bit_cast(bf16x8, pw[s4]);
#pragma unroll
        for (int d0 = 0; d0 < 4; ++d0) {
            const s16x4 lo = vtr(vp + s4 * 4096 + d0 * 256), hh = vtr(vp + s4 * 4096 + 2048 + d0 * 256);
            const bf16x8 vf = (bf16x8){lo[0], lo[1], lo[2], lo[3], hh[0], hh[1], hh[2], hh[3]};
            o[d0] = __builtin_amdgcn_mfma_f32_32x32x16_bf16(pa, vf, o[d0], 0, 0, 0);
        }
    }
}

__device__ __forceinline__ void diff_sm(f32x16 (&o)[4], float& m, float& l, f32x16& p0, f32x16& p1, u32x4 (&pw)[4], LAS float* wsf, int lane, int hi) {
    const int r32 = lane & 31;
    float ma = max3f(p0[0], p0[1], p1[0]), mb = max3f(p0[2], p0[3], p1[1]); ma = max3f(ma, p1[2], p1[3]);
#pragma unroll
    for (int r = 4; r < 16; r += 4) { ma = max3f(ma, p0[r], p0[r + 1]); mb = max3f(mb, p0[r + 2], p0[r + 3]); ma = max3f(ma, p1[r], p1[r + 1]); mb = max3f(mb, p1[r + 2], p1[r + 3]); }
    float mx = max3f(ma, mb, m);
    { float a = mx, b = mx; swap32(a, b); mx = max3f(a, b, m); }
    const float mn = (mx > m + RESCALE_THR) ? mx : m;
    const float alpha = fexp2(m - mn);
    m = mn;
    float rs = 0.f;
#pragma unroll
    for (int r = 0; r < 16; ++r) { p0[r] = fexp2(p0[r] - mn); p1[r] = fexp2(p1[r] - mn); rs += p0[r] + p1[r]; }
    l = l * alpha + rs;
    if (__any(alpha != 1.0f)) {
        CBAR();
        if (hi == 0) wsf[r32] = alpha;
        CBAR();
#pragma unroll
        for (int g4 = 0; g4 < 4; ++g4) { const f32x4 a4 = *(const LAS f32x4*)(wsf + 8 * g4 + 4 * hi);
#pragma unroll
            for (int d0 = 0; d0 < 4; ++d0) { o[d0][4 * g4 + 0] *= a4[0]; o[d0][4 * g4 + 1] *= a4[1]; o[d0][4 * g4 + 2] *= a4[2]; o[d0][4 * g4 + 3] *= a4[3]; } }
        CBAR();
    }
#pragma unroll
    for (int i = 0; i < 4; ++i) { pw[0][i] = cvtpk_s(p0[2 * i], p0[2 * i + 1]); pw[1][i] = cvtpk_s(p0[8 + 2 * i], p0[9 + 2 * i]); pw[2][i] = cvtpk_s(p1[2 * i], p1[2 * i + 1]); pw[3][i] = cvtpk_s(p1[8 + 2 * i], p1[9 + 2 * i]); }
}
__device__ __forceinline__ void diff_pv2(f32x16 (&o0)[4], f32x16 (&o1)[4], const u32x4 (&pw0)[4], const u32x4 (&pw1)[4], const LAS unsigned char* vbuf, int lane_, int hi_) {
    int lane = lane_; asm volatile("" : "+v"(lane));
    const int hi = lane >> 5; (void)hi_;
    const int li = lane & 15, g16 = lane >> 4;
    const LAS unsigned char* vp = vbuf + hi * 1024 + (li >> 2) * 64 + (16 * (g16 & 1) + 4 * (li & 3)) * 2;
    __builtin_amdgcn_s_setprio(1);
#pragma unroll
    for (int s4 = 0; s4 < 4; ++s4) {
        const bf16x8 pa0 = __builtin_bit_cast(bf16x8, pw0[s4]), pa1 = __builtin_bit_cast(bf16x8, pw1[s4]);
#pragma unroll
        for (int d0 = 0; d0 < 4; ++d0) {
            const s16x4 lo = vtr(vp + s4 * 4096 + d0 * 256), hh = vtr(vp + s4 * 4096 + 2048 + d0 * 256);
            const bf16x8 vf = (bf16x8){lo[0], lo[1], lo[2], lo[3], hh[0], hh[1], hh[2], hh[3]};
            o0[d0] = __builtin_amdgcn_mfma_f32_32x32x16_bf16(pa0, vf, o0[d0], 0, 0, 0);
            o1[d0] = __builtin_amdgcn_mfma_f32_32x32x16_bf16(pa1, vf, o1[d0], 0, 0, 0);
        }
    }
    __builtin_amdgcn_s_setprio(0);
}
__device__ __forceinline__ void diff_qk_f(f32x16& p0, f32x16& p1, const LAS unsigned char* qlds, const LAS unsigned char* kb, const LAS unsigned char* ap, const LAS unsigned char* bp, int lane_, int hi_) {
    int lane = lane_; asm volatile("" : "+v"(lane));
    const int hi = lane >> 5; (void)hi_;
    const int r32 = lane & 31, sw = (r32 >> 1) & 7;
    const LAS unsigned char* kp = kb + r32 * 128;
    { const bf16x8 a1 = *(const LAS bf16x8*)ap, bm = *(const LAS bf16x8*)bp;
      p0 = __builtin_amdgcn_mfma_f32_32x32x16_bf16(a1, bm, f32x16{}, 0, 0, 0);
      p1 = __builtin_amdgcn_mfma_f32_32x32x16_bf16(a1, bm, f32x16{}, 0, 0, 0); }
#pragma unroll
    for (int d0 = 0; d0 < 4; ++d0) {
        const bf16x8 q = *(const LAS bf16x8*)(qlds + d0 * 1024 + lane * 16);
        const int po = ((2 * d0 + hi) ^ sw) << 4;
        const bf16x8 k0 = *(const LAS bf16x8*)(kp + po), k1 = *(const LAS bf16x8*)(kp + po + 4096);
        p0 = __builtin_amdgcn_mfma_f32_32x32x16_bf16(k0, q, p0, 0, 0, 0);
        p1 = __builtin_amdgcn_mfma_f32_32x32x16_bf16(k1, q, p1, 0, 0, 0);
    }
}
__device__ __forceinline__ void diff_sm_head(f32x16 (&o)[4], float& m, float& l, f32x16& p0, f32x16& p1, LAS float* wsf, LAS unsigned char* bslot, bool first, int lane, int hi) {
    float ma = max3f(p0[0], p0[1], p1[0]), mb = max3f(p0[2], p0[3], p1[1]); ma = max3f(ma, p1[2], p1[3]);
#pragma unroll
    for (int r = 4; r < 16; r += 4) { ma = max3f(ma, p0[r], p0[r + 1]); mb = max3f(mb, p0[r + 2], p0[r + 3]); ma = max3f(ma, p1[r], p1[r + 1]); mb = max3f(mb, p1[r + 2], p1[r + 3]); }
    float mx = __builtin_fmaxf(ma, mb);
    { float a = mx, b = mx; swap32(a, b); mx = __builtin_fmaxf(a, b); }
    const bool up = first || (mx > RESCALE_THR);
    if (__any(up)) {
        const float mnew = up ? __builtin_bit_cast(float, f2bf(m + mx) << 16) : m, delta = mnew - m;
        const float alpha = fexp2(-delta);
        m = mnew; l *= alpha;
        CBAR();
        int l2 = lane; asm volatile("" : "+v"(l2));
        if (hi == 0) { wsf[l2 & 31] = alpha; *(LAS unsigned*)bslot = f2bf(-mnew); }
        CBAR();
#pragma unroll
        for (int g4 = 0; g4 < 4; ++g4) { const f32x4 a4 = *(const LAS f32x4*)(wsf + 8 * g4 + 4 * (l2 >> 5));
#pragma unroll
            for (int d0 = 0; d0 < 4; ++d0) { o[d0][4 * g4 + 0] *= a4[0]; o[d0][4 * g4 + 1] *= a4[1]; o[d0][4 * g4 + 2] *= a4[2]; o[d0][4 * g4 + 3] *= a4[3]; } }
#pragma unroll
        for (int r = 0; r < 16; ++r) { p0[r] -= delta; p1[r] -= delta; }
        CBAR();
    }
}
__device__ __forceinline__ void diff_sm_tail(float& l, f32x16& p0, f32x16& p1, u32x4 (&pw)[4]) {
    float rs = 0.f;
#pragma unroll
    for (int r = 0; r < 16; ++r) { p0[r] = fexp2(p0[r]); p1[r] = fexp2(p1[r]); rs += p0[r] + p1[r]; }
    l += rs;
#pragma unroll
    for (int i = 0; i < 4; ++i) { pw[0][i] = cvtpk_s(p0[2 * i], p0[2 * i + 1]); pw[1][i] = cvtpk_s(p0[8 + 2 * i], p0[9 + 2 * i]); pw[2][i] = cvtpk_s(p1[2 * i], p1[2 * i + 1]); pw[3][i] = cvtpk_s(p1[8 + 2 * i], p1[9 + 2 * i]); }
}
__device__ __forceinline__ void diff_tail_pv2(f32x16 (&o0)[4], f32x16 (&o1)[4], float& l0, float& l1, const f32x16& a0, const f32x16& a1, const f32x16& b0, const f32x16& b1, const LAS unsigned char* vbuf, int lane_) {
    int lane = lane_; asm volatile("" : "+v"(lane));
    const int hi = lane >> 5, li = lane & 15, g16 = lane >> 4;
    const LAS unsigned char* vp = vbuf + hi * 1024 + (li >> 2) * 64 + (16 * (g16 & 1) + 4 * (li & 3)) * 2;
    float rs0 = 0.f, rs1 = 0.f;
    u32x4 pa, pb, pan = {0u, 0u, 0u, 0u}, pbn = {0u, 0u, 0u, 0u};
#define TP_A(st, i) do { const int r_ = ((st) & 1) * 8 + 2 * (i); const float e0_ = fexp2((st) < 2 ? a0[r_] : a1[r_]), e1_ = fexp2((st) < 2 ? a0[r_ + 1] : a1[r_ + 1]); rs0 += e0_; rs0 += e1_; asm volatile("" : "+v"(rs0)); pan[i] = cvtpk_s(e0_, e1_); } while (0)
#define TP_B(st, i) do { const int r_ = ((st) & 1) * 8 + 2 * (i); const float e0_ = fexp2((st) < 2 ? b0[r_] : b1[r_]), e1_ = fexp2((st) < 2 ? b0[r_ + 1] : b1[r_ + 1]); rs1 += e0_; rs1 += e1_; asm volatile("" : "+v"(rs1)); pbn[i] = cvtpk_s(e0_, e1_); } while (0)
#pragma unroll
    for (int i = 0; i < 4; ++i) { TP_A(0, i); TP_B(0, i); }
    pa = pan; pb = pbn;
    s16x4 flo[3], fhh[3];
#define TP_RD(c) do { flo[(c) % 3] = vtr(vp + ((c) >> 2) * 4096 + ((c) & 3) * 256); fhh[(c) % 3] = vtr(vp + ((c) >> 2) * 4096 + 2048 + ((c) & 3) * 256); } while (0)
    TP_RD(0); TP_RD(1);
    __builtin_amdgcn_sched_barrier(0);
#pragma unroll
    for (int c = 0; c < 16; ++c) {
        const int st = c >> 2, d0 = c & 3;
        if (c + 2 < 16) TP_RD(c + 2);
        const bf16x8 vf = (bf16x8){flo[c % 3][0], flo[c % 3][1], flo[c % 3][2], flo[c % 3][3], fhh[c % 3][0], fhh[c % 3][1], fhh[c % 3][2], fhh[c % 3][3]};
        o0[d0] = __builtin_amdgcn_mfma_f32_32x32x16_bf16(__builtin_bit_cast(bf16x8, pa), vf, o0[d0], 0, 0, 0);
        if (st < 3) TP_A(st + 1, d0);
        __builtin_amdgcn_sched_barrier(0);
        o1[d0] = __builtin_amdgcn_mfma_f32_32x32x16_bf16(__builtin_bit_cast(bf16x8, pb), vf, o1[d0], 0, 0, 0);
        if (st < 3) TP_B(st + 1, d0);
        __builtin_amdgcn_sched_barrier(0);
        if (d0 == 3) { pa = pan; pb = pbn; }
    }
#undef TP_A
#undef TP_B
#undef TP_RD
    l0 += rs0; l1 += rs1;
}
__device__ __forceinline__ void hm_step(int k, float& ma, float& mb, const f32x16& p0, const f32x16& p1) {
    if (k == 0) ma = max3f(p0[0], p0[1], p1[0]);
    else if (k == 1) mb = max3f(p0[2], p0[3], p1[1]);
    else if (k == 2) ma = max3f(ma, p1[2], p1[3]);
    else { const int j = (k - 3) >> 2, w = (k - 3) & 3, r = 4 + 4 * j;
        if (w == 0) ma = max3f(ma, p0[r], p0[r + 1]); else if (w == 1) mb = max3f(mb, p0[r + 2], p0[r + 3]); else if (w == 2) ma = max3f(ma, p1[r], p1[r + 1]); else mb = max3f(mb, p1[r + 2], p1[r + 3]); }
}
__device__ __forceinline__ void hm_finish(f32x16 (&o)[4], float& m, float& l, float ma, float mb, f32x16& p0, f32x16& p1, LAS float* wsf, LAS unsigned char* bslot, bool first, int lane) {
    float mx = __builtin_fmaxf(ma, mb);
    { float a = mx, b = mx; swap32(a, b); mx = __builtin_fmaxf(a, b); }
    const bool up = first || (mx > RESCALE_THR);
    if (__any(up)) {
        const float mnew = up ? __builtin_bit_cast(float, f2bf(m + mx) << 16) : m, delta = mnew - m;
        const float alpha = fexp2(-delta);
        m = mnew; l *= alpha;
        CBAR();
        int l2 = lane; asm volatile("" : "+v"(l2));
        if ((l2 >> 5) == 0) { wsf[l2 & 31] = alpha; *(LAS unsigned*)bslot = f2bf(-mnew); }
        CBAR();
#pragma unroll
        for (int g4 = 0; g4 < 4; ++g4) { const f32x4 a4 = *(const LAS f32x4*)(wsf + 8 * g4 + 4 * (l2 >> 5));
#pragma unroll
            for (int d0 = 0; d0 < 4; ++d0) { o[d0][4 * g4 + 0] *= a4[0]; o[d0][4 * g4 + 1] *= a4[1]; o[d0][4 * g4 + 2] *= a4[2]; o[d0][4 * g4 + 3] *= a4[3]; } }
#pragma unroll
        for (int r = 0; r < 16; ++r) { p0[r] -= delta; p1[r] -= delta; }
        CBAR();
    }
}
__device__ __forceinline__ void diffA_step(f32x16 (&o0)[4], f32x16 (&o1)[4], float& m0, float& l0, float& m1, float& l1, const LAS unsigned char* qlds, const LAS unsigned char* kb0, const LAS unsigned char* kb1,
                                           const LAS unsigned char* vbuf, LAS unsigned char* bsel, LAS float* wsf, bool first, int lane_) {
    int lane = lane_; asm volatile("" : "+v"(lane));
    const int hi = lane >> 5;
    f32x16 s0, s1, s2, s3;
    diff_qk_f(s0, s1, qlds, kb0, bsel + 32, bsel, lane, hi);
#define SB() __builtin_amdgcn_sched_barrier(0)
    const int r32 = lane & 31, sw = (r32 >> 1) & 7;
    const LAS unsigned char* kp = kb1 + r32 * 128; const LAS unsigned char* qp = qlds + 4096 + lane * 16;
    float ma = 0.f, mb = 0.f, rs0 = 0.f, rs1 = 0.f;
    u32x4 pa, pb, pan, pbn;
#define TP_A(st, i) do { const int r_ = ((st) & 1) * 8 + 2 * (i); const float e0_ = fexp2((st) < 2 ? s0[r_] : s1[r_]), e1_ = fexp2((st) < 2 ? s0[r_ + 1] : s1[r_ + 1]); rs0 += e0_; rs0 += e1_; asm volatile("" : "+v"(rs0)); pan[i] = cvtpk_s(e0_, e1_); } while (0)
#define TP_B(st, i) do { const int r_ = ((st) & 1) * 8 + 2 * (i); const float e0_ = fexp2((st) < 2 ? s2[r_] : s3[r_]), e1_ = fexp2((st) < 2 ? s2[r_ + 1] : s3[r_ + 1]); rs1 += e0_; rs1 += e1_; asm volatile("" : "+v"(rs1)); pbn[i] = cvtpk_s(e0_, e1_); } while (0)
    {
        const bf16x8 a1 = *(const LAS bf16x8*)(bsel + 32), bm = *(const LAS bf16x8*)(bsel + 16);
        bf16x8 qf[2], k0f, k1f;
#define RD_Q(d0)  qf[(d0) & 1] = *(const LAS bf16x8*)(qp + (d0) * 1024)
#define RD_K0(d0) k0f = *(const LAS bf16x8*)(kp + (((2 * (d0) + hi) ^ sw) << 4))
#define RD_K1(d0) k1f = *(const LAS bf16x8*)(kp + (((2 * (d0) + hi) ^ sw) << 4) + 4096)
        RD_Q(0); RD_K0(0); RD_K1(0); RD_Q(1);
        SB();
        s2 = __builtin_amdgcn_mfma_f32_32x32x16_bf16(a1, bm, f32x16{}, 0, 0, 0);
        asm volatile("s_nop 7" : "+v"(s0), "+v"(s1));
        hm_step(0, ma, mb, s0, s1); hm_step(1, ma, mb, s0, s1);
        SB();
        s3 = __builtin_amdgcn_mfma_f32_32x32x16_bf16(a1, bm, f32x16{}, 0, 0, 0);
        hm_step(2, ma, mb, s0, s1); hm_step(3, ma, mb, s0, s1); hm_step(4, ma, mb, s0, s1);
        SB();
        s2 = __builtin_amdgcn_mfma_f32_32x32x16_bf16(k0f, qf[0], s2, 0, 0, 0);
        RD_K0(1);
        hm_step(5, ma, mb, s0, s1); hm_step(6, ma, mb, s0, s1); hm_step(7, ma, mb, s0, s1);
        SB();
        s3 = __builtin_amdgcn_mfma_f32_32x32x16_bf16(k1f, qf[0], s3, 0, 0, 0);
        RD_K1(1); RD_Q(2);
        hm_step(8, ma, mb, s0, s1); hm_step(9, ma, mb, s0, s1); hm_step(10, ma, mb, s0, s1);
        SB();
        s2 = __builtin_amdgcn_mfma_f32_32x32x16_bf16(k0f, qf[1], s2, 0, 0, 0);
        RD_K0(2);
        hm_step(11, ma, mb, s0, s1); hm_step(12, ma, mb, s0, s1);
        SB();
        s3 = __builtin_amdgcn_mfma_f32_32x32x16_bf16(k1f, qf[1], s3, 0, 0, 0);
        RD_K1(2); RD_Q(3);
        hm_step(13, ma, mb, s0, s1); hm_step(14, ma, mb, s0, s1);
        SB();
        hm_finish(o0, m0, l0, ma, mb, s0, s1, wsf, bsel, first, lane);
        SB();
        s2 = __builtin_amdgcn_mfma_f32_32x32x16_bf16(k0f, qf[0], s2, 0, 0, 0);
        RD_K0(3);
        TP_A(0, 0);
        SB();
        s3 = __builtin_amdgcn_mfma_f32_32x32x16_bf16(k1f, qf[0], s3, 0, 0, 0);
        RD_K1(3);
        TP_A(0, 1);
        SB();
        s2 = __builtin_amdgcn_mfma_f32_32x32x16_bf16(k0f, qf[1], s2, 0, 0, 0);
        TP_A(0, 2);
        SB();
        s3 = __builtin_amdgcn_mfma_f32_32x32x16_bf16(k1f, qf[1], s3, 0, 0, 0);
        TP_A(0, 3);
        SB();
#undef RD_Q
#undef RD_K0
#undef RD_K1
#define QK_RD(x)
#undef QK_RD
    }
    pa = pan;
    asm volatile("s_nop 15\n\ts_nop 7" : "+v"(s2), "+v"(s3));
    ma = 0.f; mb = 0.f;
#pragma unroll
    for (int k = 0; k < 15; ++k) hm_step(k, ma, mb, s2, s3);
    hm_finish(o1, m1, l1, ma, mb, s2, s3, wsf, bsel + 16, first, lane);
#pragma unroll
    for (int i = 0; i < 4; ++i) TP_B(0, i);
    pb = pbn;
    const int li = lane & 15, g16 = lane >> 4;
    const LAS unsigned char* vp = vbuf + hi * 1024 + (li >> 2) * 64 + (16 * (g16 & 1) + 4 * (li & 3)) * 2;
    s16x4 flo[3], fhh[3];
#define TP_RD(c) do { flo[(c) % 3] = vtr(vp + (((c) & 15) >> 2) * 4096 + ((c) & 3) * 256); fhh[(c) % 3] = vtr(vp + (((c) & 15) >> 2) * 4096 + 2048 + ((c) & 3) * 256); } while (0)
#define TP_VF(c) ((bf16x8){flo[(c) % 3][0], flo[(c) % 3][1], flo[(c) % 3][2], flo[(c) % 3][3], fhh[(c) % 3][0], fhh[(c) % 3][1], fhh[(c) % 3][2], fhh[(c) % 3][3]})
    TP_RD(0); TP_RD(1);
    SB();
#pragma unroll
    for (int c = 0; c < 16; ++c) {
        const int st = c >> 2, d0 = c & 3;
        if (c + 2 < 16) TP_RD(c + 2);
        o0[d0] = __builtin_amdgcn_mfma_f32_32x32x16_bf16(__builtin_bit_cast(bf16x8, pa), TP_VF(c), o0[d0], 0, 0, 0);
        if (st < 3) TP_A(st + 1, d0);
        SB();
        o1[d0] = __builtin_amdgcn_mfma_f32_32x32x16_bf16(__builtin_bit_cast(bf16x8, pb), TP_VF(c), o1[d0], 0, 0, 0);
        if (st < 3) TP_B(st + 1, d0);
        SB();
        if (d0 == 3) { pa = pan; pb = pbn; }
    }
#undef TP_A
#undef TP_B
#undef TP_RD
#undef TP_VF
#undef SB
    l0 += rs0; l1 += rs1;
}
struct NoMask { __device__ __forceinline__ void operator()(f32x16&) const {} };

using pg8::Unit;
struct EpiZ {
    static constexpr bool PERM = true;
    bf16_t* Z; const float* ropec; const float* ropes;
    __device__ __forceinline__ void operator()(const f32x4 (&acc)[2][2][4][2], const Unit& u, int wr, int wc, int fr, int fq) const {
        const int pn = u.pn;
        const int type = (pn < 2) ? 0 : (pn < 4) ? 1 : (pn < 6) ? 2 : (pn == 6) ? 3 : (pn < 9) ? 2 : (pn < 12) ? 0 : (pn < 15) ? 1 : (pn < 18) ? 2 : 4;
        const int row0 = u.pm * 256 + wr * 64 + fr, col0 = pn * 256 + wc * 32 + 8 * fq;
        const int j0 = 16 * (wc & 1) + 4 * fq;
#pragma unroll
        for (int ai = 0; ai < 2; ++ai) {
            f32x4 cq[4], sq[4];
#pragma unroll
            for (int m = 0; m < 4; ++m) { const int pos = (row0 + ai * 128 + m * 16) & (SEQ - 1); cq[m] = (f32x4){1.f, 1.f, 1.f, 1.f}; sq[m] = (f32x4){0.f, 0.f, 0.f, 0.f};
                if (type < 2) { cq[m] = *(const f32x4*)(ropec + pos * 32 + j0); sq[m] = *(const f32x4*)(ropes + pos * 32 + j0); } }
#pragma unroll
            for (int m = 0; m < 4; ++m) {
                const int row = row0 + ai * 128 + m * 16;
                const f32x4 c4 = cq[m], s4 = sq[m];
                bf16_t* rowp = Z + (size_t)row * ZW + col0;
#pragma unroll
                for (int bj = 0; bj < 2; ++bj) {
                    f32x4 v0 = acc[ai][bj][m][0], v1 = acc[ai][bj][m][1];
                    if (type < 2) {
                        f32x4 w0, w1;
                        w0[0] = v0[0] * c4[0] - v0[1] * s4[0]; w0[1] = v0[1] * c4[0] + v0[0] * s4[0];
                        w0[2] = v0[2] * c4[1] - v0[3] * s4[1]; w0[3] = v0[3] * c4[1] + v0[2] * s4[1];
                        w1[0] = v1[0] * c4[2] - v1[1] * s4[2]; w1[1] = v1[1] * c4[2] + v1[0] * s4[2];
                        w1[2] = v1[2] * c4[3] - v1[3] * s4[3]; w1[3] = v1[3] * c4[3] + v1[2] * s4[3];
                        v0 = w0; v1 = w1;
                    }
                    if (type == 4) {
#pragma unroll
                        for (int j = 0; j < 4; ++j) { v0[j] = __builtin_fmaxf(frcp(1.f + fexp2(v0[j])), 0.f); v1[j] = __builtin_fmaxf(frcp(1.f + fexp2(v1[j])), 0.f); }
                    }
                    u32x4 w; w.x = cvt_pk_bf16(v0[0], v0[1]); w.y = cvt_pk_bf16(v0[2], v0[3]); w.z = cvt_pk_bf16(v1[0], v1[1]); w.w = cvt_pk_bf16(v1[2], v1[3]);
                    st16_wt(rowp + bj * 128, w);
                }
                CBAR();
            }
        }
    }
};
struct EpiProj {
    static constexpr bool PERM = true;
    bf16_t* Mg; const bf16_t* Zg0;
    __device__ __forceinline__ void operator()(const f32x4 (&acc)[2][2][4][2], const Unit& u, int wr, int wc, int fr, int fq) const {
        const int row0 = u.pm * 256 + wr * 64 + fr, col0 = u.pn * 256 + wc * 32 + 8 * fq;
        const bf16_t* Zg = Zg0 + (u.e & 15) * 1024; const int first = u.e >> 4;
#pragma unroll
        for (int ai = 0; ai < 2; ++ai) {
            u32x4 gq[4][2], oq[4][2];
#pragma unroll
            for (int m = 0; m < 4; ++m)
#pragma unroll
                for (int bj = 0; bj < 2; ++bj) { const int row = row0 + ai * 128 + m * 16, col = col0 + bj * 128;
                    gq[m][bj] = *(const u32x4*)(Zg + (size_t)row * ZW + col);
                    oq[m][bj] = first ? (u32x4){0u, 0u, 0u, 0u} : *(const u32x4*)(Mg + (size_t)row * D + col); }
#pragma unroll
            for (int m = 0; m < 4; ++m)
#pragma unroll
                for (int bj = 0; bj < 2; ++bj) { const int row = row0 + ai * 128 + m * 16, col = col0 + bj * 128;
                    const u32x4 g = gq[m][bj], o = oq[m][bj];
                    const f32x4 v0 = acc[ai][bj][m][0], v1 = acc[ai][bj][m][1];
                    const float r0 = bflo(g.x) * v0[0] + bflo(o.x), r1 = bfhi(g.x) * v0[1] + bfhi(o.x), r2 = bflo(g.y) * v0[2] + bflo(o.y), r3 = bfhi(g.y) * v0[3] + bfhi(o.y);
                    const float r4 = bflo(g.z) * v1[0] + bflo(o.z), r5 = bfhi(g.z) * v1[1] + bfhi(o.z), r6 = bflo(g.w) * v1[2] + bflo(o.w), r7 = bfhi(g.w) * v1[3] + bfhi(o.w);
                    u32x4 w; w.x = cvt_pk_bf16(r0, r1); w.y = cvt_pk_bf16(r2, r3); w.z = cvt_pk_bf16(r4, r5); w.w = cvt_pk_bf16(r6, r7);
                    *(u32x4*)(Mg + (size_t)row * D + col) = w; }
            CBAR();
        }
    }
};
struct EpiOut {
    static constexpr bool PERM = true;
    bf16_t* X; const float* gate;
    __device__ __forceinline__ void operator()(const f32x4 (&acc)[2][2][4][2], const Unit& u, int wr, int wc, int fr, int fq) const {
        const int row0 = u.pm * 256 + wr * 64 + fr, col0 = u.pn * 256 + wc * 32 + 8 * fq;
        const int b = (u.pm * 256) / SEQ;
        f32x4 gv[2][2];
#pragma unroll
        for (int bj = 0; bj < 2; ++bj)
#pragma unroll
            for (int n = 0; n < 2; ++n) gv[bj][n] = *(const f32x4*)(gate + (size_t)b * 6 * D + col0 + bj * 128 + 4 * n);
        u32x4 xq[2][4][2];
#pragma unroll
        for (int ai = 0; ai < 2; ++ai)
#pragma unroll
            for (int m = 0; m < 4; ++m)
#pragma unroll
                for (int bj = 0; bj < 2; ++bj) xq[ai][m][bj] = *(const u32x4*)(X + (size_t)(row0 + ai * 128 + m * 16) * D + col0 + bj * 128);
#pragma unroll
        for (int ai = 0; ai < 2; ++ai) {
#pragma unroll
            for (int m = 0; m < 4; ++m)
#pragma unroll
                for (int bj = 0; bj < 2; ++bj) { const u32x4 o = xq[ai][m][bj];
                    const f32x4 r0 = (f32x4){bflo(o.x), bfhi(o.x), bflo(o.y), bfhi(o.y)} + gv[bj][0] * acc[ai][bj][m][0], r1 = (f32x4){bflo(o.z), bfhi(o.z), bflo(o.w), bfhi(o.w)} + gv[bj][1] * acc[ai][bj][m][1];
                    u32x4 w; w.x = cvt_pk_bf16(r0[0], r0[1]); w.y = cvt_pk_bf16(r0[2], r0[3]); w.z = cvt_pk_bf16(r1[0], r1[1]); w.w = cvt_pk_bf16(r1[2], r1[3]);
                    *(u32x4*)(X + (size_t)(row0 + ai * 128 + m * 16) * D + col0 + bj * 128) = w; }
            CBAR();
        }
    }
};
struct EpiSwiglu {
    static constexpr bool PERM = true;
    bf16_t* H;
    __device__ __forceinline__ void operator()(const f32x4 (&acc)[2][2][4][2], const Unit& u, int wr, int wc, int fr, int fq) const {
        const int row0 = u.pm * 256 + wr * 64 + fr, hc = u.pn * 128 + wc * 32 + 8 * fq;
#pragma unroll
        for (int ai = 0; ai < 2; ++ai)
#pragma unroll
            for (int m = 0; m < 4; ++m) {
                const int row = row0 + ai * 128 + m * 16;
                float h[8];
#pragma unroll
                for (int n = 0; n < 2; ++n) { const f32x4 a = acc[ai][0][m][n], b = acc[ai][1][m][n];
#pragma unroll
                    for (int j = 0; j < 4; ++j) h[4 * n + j] = a[j] * frcp(1.f + fexp2(-a[j] * LOG2E)) * b[j]; }
                u32x4 w; w.x = cvt_pk_bf16(h[0], h[1]); w.y = cvt_pk_bf16(h[2], h[3]); w.z = cvt_pk_bf16(h[4], h[5]); w.w = cvt_pk_bf16(h[6], h[7]);
                st16_wt(H + (size_t)row * EH + hc, w);
            }
    }
};
struct EpiY {
    static constexpr bool PERM = true;
    bf16_t* Y;
    __device__ __forceinline__ void operator()(const f32x4 (&acc)[2][2][4][2], const Unit& u, int wr, int wc, int fr, int fq) const {
        const int row0 = u.pm * 256 + wr * 64 + fr, col0 = u.pn * 256 + wc * 32 + 8 * fq;
#pragma unroll
        for (int ai = 0; ai < 2; ++ai)
#pragma unroll
            for (int m = 0; m < 4; ++m) { bf16_t* rowp = Y + (size_t)(row0 + ai * 128 + m * 16) * D + col0;
#pragma unroll
                for (int bj = 0; bj < 2; ++bj) { const f32x4 v0 = acc[ai][bj][m][0], v1 = acc[ai][bj][m][1];
                    u32x4 w; w.x = cvt_pk_bf16(v0[0], v0[1]); w.y = cvt_pk_bf16(v0[2], v0[3]); w.z = cvt_pk_bf16(v1[0], v1[1]); w.w = cvt_pk_bf16(v1[2], v1[3]);
                    *(u32x4*)(rowp + bj * 128) = w; } }
    }
};

constexpr int NWAVES = 8;
constexpr int NPHASE = 2 + 9 * DEPTH;

__global__ void __launch_bounds__(NWAVES * 64, 2) fwd_kernel(Args args) {
    extern __shared__ __attribute__((aligned(16))) unsigned char lds_raw[];
    LAS unsigned char* lds = (LAS unsigned char*)lds_raw;
    volatile LAS unsigned* MISC = (volatile LAS unsigned*)(lds + MISC_OFF);
    const int tid0 = threadIdx.x;
    const int G = gridDim.x, bx = blockIdx.x;
    const int vcu = (G % 8 == 0) ? (bx % 8) * (G / 8) + bx / 8 : bx;
    const int NGW = G * NWAVES;
#define WSP() size_t wsz_ = 0; asm volatile("" : "+s"(wsz_)); unsigned char* ws = args.ws + wsz_; \
    int tid = tid0; asm volatile("" : "+v"(tid)); const int lane = tid & 63, wave = __builtin_amdgcn_readfirstlane(tid >> 6), hi = lane >> 5, gw = vcu * NWAVES + wave; (void)hi; (void)gw; (void)lane; (void)wave; \
    unsigned* ctl = (unsigned*)(ws + WS_CTL); float* rtab = (float*)(ws + WS_RT); (void)rtab; float* modp = (float*)(ws + WS_MOD); float* ropec = (float*)(ws + WS_ROPE); float* ropes = ropec + SEQ * 32; \
    int* tok_e = (int*)(ws + WS_ROUTE); int* tok_pos = tok_e + 2 * M; float* tok_w = (float*)(tok_pos + 2 * M); int* tok_slot = (int*)(tok_w + 2 * M); int* etok = (int*)(ws + WS_ROUTE + 2 * MiB); \
    bf16_t* X = (bf16_t*)(ws + WS_X); bf16_t* Hn = (bf16_t*)(ws + WS_H); bf16_t* OC = (bf16_t*)(ws + WS_OCAT); bf16_t* MG = (bf16_t*)(ws + WS_MERGED); bf16_t* Z = (bf16_t*)(ws + WS_Z); \
    bf16_t* XG = (bf16_t*)(ws + WS_XG); bf16_t* HB = (bf16_t*)(ws + WS_HB); bf16_t* YB = (bf16_t*)(ws + WS_YB); \
    bf16_t* WIN = (bf16_t*)(ws + WS_WIN); bf16_t* WPR = (bf16_t*)(ws + WS_WPROJ); bf16_t* WOU = (bf16_t*)(ws + WS_WOUT); bf16_t* W13 = (bf16_t*)(ws + WS_W13); bf16_t* W2 = (bf16_t*)(ws + WS_W2); \
    (void)ctl; (void)modp; (void)ropec; (void)ropes; (void)tok_e; (void)tok_pos; (void)tok_w; (void)tok_slot; (void)etok; (void)X; (void)Hn; (void)OC; (void)MG; (void)Z; (void)XG; (void)HB; (void)YB; (void)WIN; (void)WPR; (void)WOU; (void)W13; (void)W2;
    for (int u = tid0; u < 128; u += NWAVES * 64) MISC[u] = 0u;
    __syncthreads();
#if !MK_PER_PHASE
    XcdBarrier bar = xcd_barrier_post((unsigned*)(args.ws + WS_CTL) + CW_BAR, MISC + 8);
#define GRID_BAR() xcd_barrier(bar)
#else
#define GRID_BAR() do {} while (0)
#endif
    const int lo = args.ph_lo, hi_ph = args.ph_hi;
#define IN(k) (lo <= (k) && (k) < hi_ph)
#ifndef EN_MASK
#define EN_MASK 0x3ff
#endif
#define EN(k) ((EN_MASK >> (k)) & 1)
#ifndef DUPK
#define DUPK -1
#endif
#define REP(k) for (int rep_ = 0; rep_ < ((k) == DUPK ? 2 : 1); ++rep_, __syncthreads())
#define SEAM(k) do { if (IN(k) && IN((k) + 1)) GRID_BAR(); } while (0)

    if (IN(0) && EN(0)) REP(0) {
        WSP();
        {
            LAS float* cact = (LAS float*)lds;
            LAS float* part = (LAS float*)(lds + 16384);
            for (int i = tid; i < NBATCH * D; i += NWAVES * 64) { const int b = i / D, k = i % D; const float v = args.c[i]; cact[k * 4 + b] = v / (1.f + __expf(-v)); }
            __syncthreads();
            for (int it = bx; it < DEPTH * 96; it += G) {
                const int l = it / 96, cc = it % 96, col = cc * 64 + lane;
                const float* wp = args.ada_w + (size_t)l * D * 6 * D + col;
                float a0 = 0.f, a1 = 0.f, a2 = 0.f, a3 = 0.f;
#pragma unroll 1
                for (int k0 = 0; k0 < 128; k0 += 32) {
                    float wv[32];
#pragma unroll
                    for (int kk = 0; kk < 32; ++kk) wv[kk] = wp[(size_t)(wave * 128 + k0 + kk) * 6 * D];
#pragma unroll
                    for (int kk = 0; kk < 32; ++kk) { const f32x4 cv = *(const LAS f32x4*)(cact + (wave * 128 + k0 + kk) * 4);
                        a0 += cv[0] * wv[kk]; a1 += cv[1] * wv[kk]; a2 += cv[2] * wv[kk]; a3 += cv[3] * wv[kk]; } }
                part[(wave * 4 + 0) * 64 + lane] = a0; part[(wave * 4 + 1) * 64 + lane] = a1; part[(wave * 4 + 2) * 64 + lane] = a2; part[(wave * 4 + 3) * 64 + lane] = a3;
                __syncthreads();
                if (tid < 256) { const int b = tid >> 6, cl = tid & 63; float s = 0.f;
#pragma unroll
                    for (int w = 0; w < 8; ++w) s += part[(w * 4 + b) * 64 + cl];
                    modp[((size_t)l * NBATCH + b) * 6 * D + cc * 64 + cl] = s + args.ada_b[(size_t)l * 6 * D + cc * 64 + cl]; }
                __syncthreads();
            }
        }
        for (int i = (vcu * NWAVES * 64) + tid; i < SEQ * 32; i += G * NWAVES * 64) { const int pos = i >> 5, j = i & 31; float s, c; sincos_d((double)pos * ROPE_INV[j], s, c); ropec[i] = c; ropes[i] = s; }
        for (int i = (vcu * NWAVES * 64) + tid; i < DEPTH * 36 * D; i += G * NWAVES * 64) { const int k = i & (D - 1), n = (i >> 10) % 36, l2 = i / (36 * D);
            rtab[i] = n < 4 ? args.rgw[((size_t)l2 * D + k) * 4 + n] : args.rew[((size_t)l2 * D + k) * NEXP + (n - 4)]; }
        {
            LAS float* scr = (LAS float*)(lds + wave * 16384);
            constexpr int NEARLY = CV_PER_L + (DEPTH - 1) * (CV_PER_L - CV_NDEF);
            for (int it = gw; it < NEARLY; it += NGW) {
                int l = 0, r = it;
                if (it >= CV_PER_L) { const int j = it - CV_PER_L; l = 1 + j / (CV_PER_L - CV_NDEF); r = CV_NDEF + j % (CV_PER_L - CV_NDEF); }
                conv_item<8>(args, l, r, WIN, WPR, WOU, W13, W2, scr, lane);
            }
        }
    }
    SEAM(0);

    for (int l = 0; l < DEPTH; ++l) {
        const int pb = 1 + 9 * l;
        if (IN(pb + 0) && EN(1)) {
            WSP(); const float* modl = modp + (size_t)l * NBATCH * 6 * D; (void)modl;
            const float* gam = args.mix_g + (size_t)l * D;
            const float* modprev = modp + (size_t)(l > 0 ? l - 1 : 0) * NBATCH * 6 * D;
            constexpr int RPW = M / (256 * NWAVES); const int rbase = gw * RPW, b = rbase / SEQ;
            int slot_v = 0; float w_v = 0.f;
            if (l > 0) {
                const unsigned* cntp = ctl + CW_CNT + (l - 1) * NEXP * 64;
                const int cv = (lane < NEXP) ? (int)__hip_atomic_load(cntp + lane * 64, __ATOMIC_RELAXED, __HIP_MEMORY_SCOPE_AGENT) : 0;
                const int tl = (cv + 255) >> 8; int tstart = 0, run = 0;
#pragma unroll
                for (int e = 0; e < NEXP; ++e) { if (lane == e) tstart = run; run += __builtin_amdgcn_readlane(tl, e); }
                const int i = min(lane, 2 * RPW - 1);
                const int e = tok_e[2 * rbase + i], pos = tok_pos[2 * rbase + i]; w_v = tok_w[2 * rbase + i];
                slot_v = __builtin_amdgcn_ds_bpermute(4 * e, tstart) * 256 + pos;
            }
            f32x4 ca[4], cb[4], gf[4];
#pragma unroll
            for (int j = 0; j < 4; ++j) { const int col = 4 * lane + 256 * j;
                const f32x4 g4 = *(const f32x4*)(gam + col), sc = *(const f32x4*)(modl + (size_t)b * 6 * D + 1 * D + col), sh = *(const f32x4*)(modl + (size_t)b * 6 * D + col);
                ca[j] = g4 * (sc + 1.0f); cb[j] = sh; gf[j] = *(const f32x4*)(modprev + (size_t)b * 6 * D + 5 * D + col); }
#pragma unroll 1
            for (int r0 = rbase; r0 < rbase + RPW; r0 += 4) {
                f32x4 v[4][4];
                if (l == 0) {
#pragma unroll
                    for (int q = 0; q < 4; ++q)
#pragma unroll
                        for (int j = 0; j < 4; ++j) v[q][j] = *(const f32x4*)(args.x + (size_t)(r0 + q) * D + 4 * lane + 256 * j);
                } else {
                    u32x2 xr[4][4], y0[4][4], y1[4][4]; float w0[4], w1[4];
#pragma unroll
                    for (int q = 0; q < 4; ++q) { const int ix = 2 * (r0 - rbase + q);
                        const int s0 = __builtin_amdgcn_readlane(slot_v, ix), s1 = __builtin_amdgcn_readlane(slot_v, ix + 1);
                        w0[q] = __builtin_bit_cast(float, __builtin_amdgcn_readlane(__builtin_bit_cast(int, w_v), ix)); w1[q] = __builtin_bit_cast(float, __builtin_amdgcn_readlane(__builtin_bit_cast(int, w_v), ix + 1));
#pragma unroll
                        for (int j = 0; j < 4; ++j) { const int col = 4 * lane + 256 * j;
                            xr[q][j] = *(const u32x2*)(X + (size_t)(r0 + q) * D + col); y0[q][j] = *(const u32x2*)(YB + (size_t)s0 * D + col); y1[q][j] = *(const u32x2*)(YB + (size_t)s1 * D + col); } }
#pragma unroll
                    for (int q = 0; q < 4; ++q)
#pragma unroll
                        for (int j = 0; j < 4; ++j) { const f32x4 yy = bf4(y0[q][j]) * w0[q] + bf4(y1[q][j]) * w1[q]; v[q][j] = bf4(xr[q][j]) + gf[j] * yy; }
                }
                float ssq[4];
#pragma unroll
                for (int q = 0; q < 4; ++q) { const int row = r0 + q;
                    float ss = 0.f;
#pragma unroll
                    for (int j = 0; j < 4; ++j) { u32x2 xw; xw.x = cvt_pk_bf16(v[q][j][0], v[q][j][1]); xw.y = cvt_pk_bf16(v[q][j][2], v[q][j][3]); *(u32x2*)(X + (size_t)row * D + 4 * lane + 256 * j) = xw;
                        ss += (v[q][j][0] * v[q][j][0] + v[q][j][1] * v[q][j][1]) + (v[q][j][2] * v[q][j][2] + v[q][j][3] * v[q][j][3]); }
                    ssq[q] = ss; }
                wave_sum4_u(ssq[0], ssq[1], ssq[2], ssq[3]);
#pragma unroll
                for (int q = 0; q < 4; ++q) { const int row = r0 + q;
                    const float rstd = __builtin_amdgcn_rsqf(ssq[q] * (1.f / D) + NORM_EPS);
#pragma unroll
                    for (int j = 0; j < 4; ++j) { const int col = 4 * lane + 256 * j;
                        const f32x4 hv = v[q][j] * rstd * ca[j] + cb[j];
                        u32x2 w; w.x = cvt_pk_bf16(hv[0], hv[1]); w.y = cvt_pk_bf16(hv[2], hv[3]);
                        *(u32x2*)(Hn + (size_t)row * D + col) = w; }
                }
            }
        }
        SEAM(pb + 0);
        if (IN(pb + 1) && EN(2)) REP(2) {
            WSP(); const float* modl = modp + (size_t)l * NBATCH * 6 * D; (void)modl;
            pg8::Gemm g{Hn, WIN + (size_t)l * ZW * D, D, D, D}; pg8::StaticOrder S; S.init(M, ZW, G, bx);
            EpiZ E{Z, ropec, ropes};
            pg8::gemm_phase<EpiZ, pg8::StaticOrder>(lds, g, S, E);
            constexpr int G1_TAIL0 = ((M / 256) * (ZW / 256)) % 256;
            if (l + 1 < DEPTH && bx >= G1_TAIL0) {
                __syncthreads();
                LAS float* scr = (LAS float*)(lds + wave * 16384);
                for (int r = (bx - G1_TAIL0) * NWAVES + wave; r < CV_NDEF; r += (256 - G1_TAIL0) * NWAVES) conv_item<32>(args, l + 1, r, WIN, WPR, WOU, W13, W2, scr, lane);
            }
        }
        SEAM(pb + 1);
        if (IN(pb + 2) && EN(3)) REP(3) {
            WSP(); const float* modl = modp + (size_t)l * NBATCH * 6 * D; (void)modl;
            {
                int tidm = tid0; asm volatile("" : "+v"(tidm)); const int lane = tidm & 63, hi = lane >> 5;
                LAS unsigned char* vlds = lds + wave * 12288; LAS float* wsf = (LAS float*)(lds + 98304 + wave * 256);
                const float* lp = args.da_lambda + (size_t)l * 4 * 64;
                const float s01 = wave_sum(lp[lane] * lp[64 + lane]), s23 = wave_sum(lp[128 + lane] * lp[192 + lane]);
                const float lam_init = 0.8f - 0.6f * __expf(-0.3f * (float)l);
                const float lam = __expf(s01) - __expf(s23) + lam_init;
                LAS float* wsfA = (LAS float*)(lds + 131072 + wave * 128);
                const unsigned lds0 = (unsigned)(uintptr_t)lds;
                for (int un = vcu; un < NBATCH * 4 * 16; un += G) {
                    const int b = un >> 6, h = (un >> 4) & 3, qb = un & 15;
                    const size_t rowbase = (size_t)b * SEQ; const int q0 = qb * 256 + wave * 32;
                    LAS unsigned char* qlds = lds + 65536 + wave * 8192;
                    { bf16x8 qf[8];
                      const bf16_t* qp = Z + (rowbase + q0 + (lane & 31)) * ZW + ZQA + h * 128 + 8 * hi;
#pragma unroll
                      for (int i = 0; i < 8; ++i) qf[i] = *(const bf16x8*)(qp + 16 * i);
                      asm volatile("s_waitcnt vmcnt(0)" : "+v"(qf[0]), "+v"(qf[1]), "+v"(qf[2]), "+v"(qf[3]), "+v"(qf[4]), "+v"(qf[5]), "+v"(qf[6]), "+v"(qf[7]) :: "memory");
#pragma unroll
                      for (int i = 0; i < 8; ++i) *(LAS bf16x8*)(qlds + i * 1024 + lane * 16) = qf[i]; }
                    f32x16 o0[4], o1[4];
#pragma unroll
                    for (int d0 = 0; d0 < 4; ++d0) { o0[d0] = f32x16{}; o1[d0] = f32x16{}; }
                    float m0 = 0.f, l0 = 0.f, m1 = 0.f, l1 = 0.f;
                    LAS unsigned char* bsel = lds + 132096 + (hi ? 0 : 64 + (wave * 32 + (lane & 31)) * 48);
                    { unsigned z0 = 0u, e0 = hi ? 0u : 0x3F80u; asm volatile("" : "+v"(z0), "+v"(e0));
                      *(LAS u32x4*)bsel = (u32x4){z0, z0, z0, z0}; *(LAS u32x4*)(bsel + 16) = (u32x4){z0, z0, z0, z0}; *(LAS u32x4*)(bsel + 32) = (u32x4){e0, z0, z0, z0}; }
                    const int krow = 8 * wave + (lane >> 3);
                    const unsigned koff = (unsigned)(((rowbase + krow) * ZW + ZKA + h * 128) * 2 + (((lane & 7) ^ ((krow >> 1) & 7)) << 4));
                    const unsigned voff = (unsigned)(((rowbase + 8 * wave + ((lane >> 2) & 3)) * ZW + ZVA + h * 128 + (4 * (lane >> 4) + (lane & 3)) * 8) * 2);
#define DIFF_DMA(t, bo) do { const char* zb_ = (const char*)Z + (size_t)(t) * 64 * ZW * 2; \
        glds16s(zb_, koff, (unsigned)__builtin_amdgcn_readfirstlane((int)(lds0 + ((bo) * 2 + 0) * 8192 + wave * 1024))); \
        glds16s(zb_ + 128, koff, (unsigned)__builtin_amdgcn_readfirstlane((int)(lds0 + ((bo) * 2 + 1) * 8192 + wave * 1024))); \
        glds16s(zb_, voff, (unsigned)__builtin_amdgcn_readfirstlane((int)(lds0 + 32768 + (bo) * 16384 + wave * 2048))); \
        glds16s(zb_ + (size_t)4 * ZW * 2, voff, (unsigned)__builtin_amdgcn_readfirstlane((int)(lds0 + 32768 + (bo) * 16384 + wave * 2048 + 1024))); } while (0)
#define DIFF_SYNC() do { asm volatile("s_waitcnt vmcnt(0) lgkmcnt(0)" ::: "memory"); __builtin_amdgcn_s_barrier(); asm volatile("" ::: "memory"); } while (0)
                    DIFF_DMA(0, 0);
#pragma unroll 1
                    for (int t = 0; t < SEQ / 64; ++t) {
                        const int bo = t & 1;
                        DIFF_SYNC();
                        if (t + 1 < SEQ / 64) DIFF_DMA(t + 1, bo ^ 1);
                        diffA_step(o0, o1, m0, l0, m1, l1, qlds, lds + (bo * 2 + 0) * 8192, lds + (bo * 2 + 1) * 8192, lds + 32768 + bo * 16384, bsel, wsfA, t == 0, lane);
                    }
                    DIFF_SYNC();
#undef DIFF_DMA
#undef DIFF_SYNC
                    int lane_e = lane; asm volatile("" : "+v"(lane_e)); const int hi_e = lane_e >> 5;
                    attn_finish<4>(o0, l0, wsfA, lane_e, hi_e);
                    attn_finish<4>(o1, l1, wsfA, lane_e, hi_e);
                    const float* sg = args.da_subln + (size_t)l * 128;
                    float g4[4];
#pragma unroll
                    for (int d0 = 0; d0 < 4; ++d0) g4[d0] = sg[32 * d0 + (lane_e & 31)] * (1.0f - lam_init);
#pragma unroll
                    for (int r0 = 0; r0 < 16; r0 += 4) {
                        float ov[4][4], ss[4], tt[4];
#pragma unroll
                        for (int k = 0; k < 4; ++k) {
#pragma unroll
                            for (int d0 = 0; d0 < 4; ++d0) ov[k][d0] = o0[d0][r0 + k] - lam * o1[d0][r0 + k];
                            ss[k] = ov[k][0] * ov[k][0] + ov[k][1] * ov[k][1] + ov[k][2] * ov[k][2] + ov[k][3] * ov[k][3]; }
#pragma unroll
                        for (int k = 0; k < 4; ++k) ss[k] += dpp_f<0xB1>(ss[k]);
#pragma unroll
                        for (int k = 0; k < 4; ++k) ss[k] += dpp_f<0x4E>(ss[k]);
#pragma unroll
                        for (int k = 0; k < 4; ++k) ss[k] += dpp_f<0x141>(ss[k]);
#pragma unroll
                        for (int k = 0; k < 4; ++k) ss[k] += dpp_f<0x140>(ss[k]);
#pragma unroll
                        for (int k = 0; k < 4; ++k) tt[k] = xor_lane<16>(ss[k]);
#pragma unroll
                        for (int k = 0; k < 4; ++k) { const int r = r0 + k;
                            const float rn = __builtin_amdgcn_rsqf((ss[k] + tt[k]) * (1.f / 128.f) + NORM_EPS);
                            bf16_t* op = OC + (rowbase + q0 + crow(r, hi_e)) * D + h * 128 + (lane_e & 31);
#pragma unroll
                            for (int d0 = 0; d0 < 4; ++d0) { const float ovn = ov[k][d0] * rn * g4[d0]; op[32 * d0] = (bf16_t)(cvt_pk_bf16(ovn, ovn) & 0xffffu); } }
                    }
                }
                asm volatile("s_waitcnt vmcnt(0) lgkmcnt(0)" ::: "memory"); __builtin_amdgcn_s_barrier();
            }
            {
                int tidm = tid0; asm volatile("" : "+v"(tidm)); const int lane = tidm & 63, hi = lane >> 5;
                LAS unsigned char* vlds = lds + wave * 12288; LAS float* wsf = (LAS float*)(lds + 98304 + wave * 256);
                LAS float* tab = (LAS float*)(lds + 100352);
                { const float* rpb = args.na_rpb + (size_t)l * 4 * 15 * 31;
                  for (int i = wave * 64 + lane; i < 4 * 15 * 128; i += NWAVES * 64) { const int j = (i & 127) - 48, hb = i >> 7; tab[i] = (j >= 0 && j <= 30) ? rpb[hb * 31 + j] * LOG2E : 0.f; } }
                asm volatile("s_waitcnt vmcnt(0) lgkmcnt(0)" ::: "memory"); __builtin_amdgcn_s_barrier(); asm volatile("" ::: "memory");
                const char* zb = (const char*)Z;
                for (int wu = gw; wu < NBATCH * 4 * 64 * 2; wu += NGW) {
                    const int half = wu & 1, gr = (wu >> 1) & 63, h = (wu >> 7) & 3, b = wu >> 9;
                    const int rowb = b * SEQ; const int c0 = half * 32, cq = c0 + (lane & 31);
                    const int kr0 = min(max(gr - 4, 0), 56), cs = min(max(cq - 8, 0), 48);
                    bf16x8 qf[4];
                    { const unsigned qoff = (unsigned)(((rowb + gr * 64 + cq) * ZW + ZQN + h * 64 + 8 * hi) * 2);
#pragma unroll
                      for (int d0 = 0; d0 < 4; ++d0) qf[d0] = *(const bf16x8*)(zb + (size_t)(qoff + 32u * d0)); }
                    f32x16 o[2]; o[0] = f32x16{}; o[1] = f32x16{};
                    float mrun = NEGBIG, lrun = 0.f;
                    const unsigned kcol = (unsigned)((ZKN + h * 64) * 2), vcol = (unsigned)((ZVN + h * 64) * 2);
                    unsigned rb0[4];
#pragma unroll
                    for (int i = 0; i < 4; ++i) rb0[i] = (unsigned)((rowb + (kr0 + (i >> 1)) * 64 + 16 * half + 8 * (i & 1) + (lane >> 3)) * ZW * 2);
                    TileRegs<64> cur;
                    tile_load<64>(cur, zb, rb0, kcol, vcol);
#pragma unroll 1
                    for (int t = 0, rp = 0, cc = 0; t < 12; ++t) {
                        const int kr = kr0 + 2 * rp, chunk = half + cc;
                        const int cn = (cc == 2) ? 0 : cc + 1, rn = (cc == 2) ? rp + 1 : rp;
                        auto reload = [&](TileRegs<64>& T) { const unsigned adv = (unsigned)((t + 1 < 12) ? (2 * rn * 64 + 16 * cn) : (2 * rp * 64 + 16 * cc)) * (ZW * 2u); unsigned rr[4];
#pragma unroll
                          for (int i = 0; i < 4; ++i) rr[i] = rb0[i] + adv;
                          tile_load<64>(T, zb, rr, kcol, vcol); };
                        const LAS float* bp = tab + (h * 15 + (kr - gr + 7)) * 128 + (16 * chunk + 4 * hi - cq + 63);
                        const int u0 = 16 * chunk + 4 * hi - cs;
                        auto maskf = [&](f32x16& p) {
#pragma unroll
                            for (int r = 0; r < 16; ++r) { const int co = (r & 3) + 8 * (r >> 2);
                                const float bv = bp[(co >> 4) * 128 + (co & 15)]; p[r] = ((unsigned)(u0 + (co & 15)) <= 15u) ? bv : NEGBIG; }
                        };
                        attn_tile<64>(o, mrun, lrun, qf, cur, vlds, wsf, maskf, reload, lane, hi);
                        cc = cn; rp = rn;
                    }
                    attn_finish<2>(o, lrun, wsf, lane, hi);
#pragma unroll
                    for (int r = 0; r < 16; ++r) { bf16_t* op = OC + (size_t)(rowb + gr * 64 + c0 + crow(r, hi)) * D + 512 + h * 64 + (lane & 31);
                        const unsigned w = cvt_pk_bf16(o[0][r], o[1][r]); op[0] = (bf16_t)(w & 0xffffu); op[32] = (bf16_t)(w >> 16); }
                }
            }
            {
                int tidm = tid0; asm volatile("" : "+v"(tidm)); const int lane = tidm & 63, hi = lane >> 5;
                LAS unsigned char* vlds = lds + wave * 12288; LAS float* wsf = (LAS float*)(lds + 98304 + wave * 256);
                const char* zb = (const char*)Z;
                for (int wu = gw; wu < NBATCH * 4 * 8 * 16; wu += NGW) {
                    const int rho = wu & 15, sb = (wu >> 4) & 7, hs = (wu >> 7) & 3, b = wu >> 9;
                    const int rowb = b * SEQ; const int qi = lane & 31; const int tq = 512 * sb + rho + 16 * qi;
                    f32x16 o[2]; o[0] = f32x16{}; o[1] = f32x16{};
                    float mrun = NEGBIG, lrun = 0.f;
                    const unsigned qoff0 = (unsigned)(((rowb + tq) * ZW + ZQD + hs * 64 + 8 * hi) * 2);
                    TileRegs<64> cur;
                    { const int kb0 = 512 * sb + rho - 64;
                      unsigned rr[4];
#pragma unroll
                      for (int i = 0; i < 4; ++i) rr[i] = (unsigned)((rowb + min(max(kb0 + 8 * i + (lane >> 3), 0), SEQ - 1)) * ZW * 2);
                      tile_load<64>(cur, zb, rr, (unsigned)((ZKD + hs * 64) * 2), (unsigned)((ZVD + hs * 64) * 2)); }
#pragma unroll 1
                    for (int gi = 0; gi < 3; ++gi) {
                        const int sh = 2 * gi, res = rho & ((1 << sh) - 1), qa = (512 * sb + rho) >> sh, qk = qa + (16 >> sh) * qi, nsub = SEQ >> sh, ntile = (gi == 0) ? 20 : (gi == 1) ? 8 : 5;
                        const int lo_v = max(qk - 64, 0), span = min(qk + 64, nsub - 1) - lo_v;
                        const unsigned kcol = (unsigned)((ZKD + gi * 256 + hs * 64) * 2), vcol = (unsigned)((ZVD + gi * 256 + hs * 64) * 2), rbase = (unsigned)((rowb + res) * ZW * 2);
                        const int sh2 = sh + 2, res2 = rho & ((1 << sh2) - 1), kbn = ((512 * sb + rho) >> sh2) - 64, nsub2 = SEQ >> sh2;
                        bf16x8 qf[4];
#pragma unroll
                        for (int d0 = 0; d0 < 4; ++d0) qf[d0] = *(const bf16x8*)(zb + (size_t)(qoff0 + (unsigned)(gi * 512) + 32u * d0));
                        int kb = qa - 64;
#pragma unroll 1
                        for (int t = 0; t < ntile; ++t, kb += 32) {
                            auto reload = [&](TileRegs<64>& T) { const bool same = (t + 1 < ntile); const int kbx = same ? kb + 32 : kbn, nsx = same ? nsub : nsub2, shx = same ? sh : sh2;
                              const unsigned rbx = same ? rbase : (unsigned)((rowb + res2) * ZW * 2), kcx = same ? kcol : kcol + 512u, vcx = same ? vcol : vcol + 512u; unsigned rr[4];
                              if (kbx >= 0 && kbx + 32 <= nsx) {
                                  const unsigned b0 = rbx + __umul24((unsigned)((kbx + (lane >> 3)) << shx), ZW * 2u), inc = (8u << shx) * (ZW * 2u);
#pragma unroll
                                  for (int i = 0; i < 4; ++i) rr[i] = b0 + (unsigned)i * inc;
                              } else {
#pragma unroll
                                  for (int i = 0; i < 4; ++i) rr[i] = rbx + __umul24((unsigned)(min(max(kbx + 8 * i + (lane >> 3), 0), nsx - 1) << shx), ZW * 2u);
                              }
                              tile_load<64>(T, zb, rr, kcx, vcx); };
                            const int u0 = kb + 4 * hi - lo_v;
                            auto maskf = [&](f32x16& p) {
#pragma unroll
                                for (int r = 0; r < 16; ++r) { const int co = (r & 3) + 8 * (r >> 2); p[r] = ((unsigned)(u0 + co) <= (unsigned)span) ? 0.f : NEGBIG; }
                            };
                            attn_tile<64>(o, mrun, lrun, qf, cur, vlds, wsf, maskf, reload, lane, hi);
                        }
                    }
                    attn_finish<2>(o, lrun, wsf, lane, hi);
#pragma unroll
                    for (int r = 0; r < 16; ++r) { bf16_t* op = OC + (size_t)(rowb + 512 * sb + rho + 16 * crow(r, hi)) * D + 768 + hs * 64 + (lane & 31);
                        const unsigned w = cvt_pk_bf16(o[0][r], o[1][r]); op[0] = (bf16_t)(w & 0xffffu); op[32] = (bf16_t)(w >> 16); }
                }
            }
        }
        SEAM(pb + 2);
        if (IN(pb + 3) && EN(4)) REP(4) {
            WSP(); const float* modl = modp + (size_t)l * NBATCH * 6 * D; (void)modl;
            pg8::StaticOrder S0; S0.init(M, D, G, bx); pg8::Unit u0; pg8::ProjOrder S; S.pm = 0; S.pn = 0; S.rot = bx & 1;
            const bool have = S0.next(0, u0); S.pm = u0.pm; S.pn = u0.pn;
            if (have) { pg8::Gemm g{OC, WPR + (size_t)l * D * D, D, D, D}; EpiProj E{MG, Z + ZG}; pg8::gemm_phase<EpiProj, pg8::ProjOrder>(lds, g, S, E); }
        }
        SEAM(pb + 3);
        if (IN(pb + 4) && EN(5)) {
            WSP(); const float* modl = modp + (size_t)l * NBATCH * 6 * D; (void)modl;
            pg8::Gemm g{MG, WOU + (size_t)l * D * D, D, D, D}; pg8::StaticOrder S; S.init(M, D, G, bx);
            EpiOut E{X, modl + 2 * D};
            pg8::gemm_phase<EpiOut, pg8::StaticOrder>(lds, g, S, E);
        }
        SEAM(pb + 4);
        if (IN(pb + 5) && EN(6)) {
            WSP(); const float* modl = modp + (size_t)l * NBATCH * 6 * D; (void)modl;
            LAS float* rt = (LAS float*)lds;
            LAS unsigned* lcnt = (LAS unsigned*)(lds + MISC_OFF) + 16;
            LAS unsigned* lbase = lcnt + 32;
            { const float* rsrc = rtab + (size_t)l * 36 * D + 4 * lane; const unsigned lds0 = (unsigned)(uintptr_t)lds;
              for (int pc = wave; pc < 144; pc += NWAVES) glds16(rsrc + (pc >> 2) * D + (pc & 3) * 256, (unsigned)__builtin_amdgcn_readfirstlane((int)(lds0 + (pc >> 2) * (RT_LD * 4) + (pc & 3) * 1024)));
              if (tid < 64) lcnt[tid] = 0u;
              if (tid < 36) rt[tid * RT_LD + D] = tid < 4 ? args.rgb[(size_t)l * 4 + tid] : args.reb[(size_t)l * NEXP + tid - 4];
              asm volatile("s_waitcnt vmcnt(0)" ::: "memory");
            }
            __syncthreads();
            const float* gam = args.ffn_g + (size_t)l * D;
            unsigned* cnt = ctl + CW_CNT + l * NEXP * 64;
            int myE0 = 0, myE1 = 0, myP0 = 0, myP1 = 0, myRow = -1; float myW0 = 0.f, myW1 = 0.f; int nrow = 0;
            f32x4 v[4][4], vn[4][4];
            constexpr int RPW = M / (256 * NWAVES); const int rbase = gw * RPW;
            f32x4 ca[4], cb[4];
            { const int b = rbase / SEQ;
#pragma unroll
              for (int j = 0; j < 4; ++j) { const int col = 4 * lane + 256 * j;
                  const f32x4 g4 = *(const f32x4*)(gam + col), sc = *(const f32x4*)(modl + (size_t)b * 6 * D + 4 * D + col), sh = *(const f32x4*)(modl + (size_t)b * 6 * D + 3 * D + col);
                  ca[j] = g4 * (sc + 1.0f); cb[j] = sh; } }
#define T2_LOAD(dst, rb) do { _Pragma("unroll") for (int q = 0; q < 4; ++q) { const int row = min((rb) + q, M - 1); \
                _Pragma("unroll") for (int j = 0; j < 4; ++j) dst[q][j] = bf4(*(const u32x2*)(X + (size_t)row * D + 4 * lane + 256 * j)); } } while (0)
            T2_LOAD(v, rbase);
#pragma unroll 1
            for (int r0 = rbase; r0 < rbase + RPW; r0 += 4) {
                T2_LOAD(vn, min(r0 + 4, M - 4));
                float ssq[4];
#pragma unroll
                for (int q = 0; q < 4; ++q) { f32x2 s2 = {0.f, 0.f};
#pragma unroll
                    for (int j = 0; j < 4; ++j) { const f32x2 lo = {v[q][j][0], v[q][j][1]}, hi2 = {v[q][j][2], v[q][j][3]}; s2 = lo * lo + s2; s2 = hi2 * hi2 + s2; }
                    ssq[q] = s2[0] + s2[1]; }
                wave_sum4_u(ssq[0], ssq[1], ssq[2], ssq[3]);
#pragma unroll
                for (int q = 0; q < 4; ++q) {
                    const int row = r0 + q;
                    const float rstd = __builtin_amdgcn_rsqf(ssq[q] * (1.f / D) + NORM_EPS);
#pragma unroll
                    for (int j = 0; j < 4; ++j) { const int col = 4 * lane + 256 * j;
                        v[q][j] = v[q][j] * rstd * ca[j] + cb[j];
                        u32x2 w; w.x = cvt_pk_bf16(v[q][j][0], v[q][j][1]); w.y = cvt_pk_bf16(v[q][j][2], v[q][j][3]);
                        *(u32x2*)(Hn + (size_t)row * D + col) = w; }
                }
                float LG[4][4];
#pragma unroll
                for (int n = 0; n < 4; ++n) { f32x2 c0 = {0.f, 0.f}, c1 = c0, c2 = c0, c3 = c0;
#pragma unroll
                    for (int j = 0; j < 4; ++j) { const f32x4 wv = *(const LAS f32x4*)(rt + n * RT_LD + 4 * lane + 256 * j); const f32x2 wl = {wv[0], wv[1]}, wh = {wv[2], wv[3]};
                        c0 = wl * (f32x2){v[0][j][0], v[0][j][1]} + c0; c0 = wh * (f32x2){v[0][j][2], v[0][j][3]} + c0;
                        c1 = wl * (f32x2){v[1][j][0], v[1][j][1]} + c1; c1 = wh * (f32x2){v[1][j][2], v[1][j][3]} + c1;
                        c2 = wl * (f32x2){v[2][j][0], v[2][j][1]} + c2; c2 = wh * (f32x2){v[2][j][2], v[2][j][3]} + c2;
                        c3 = wl * (f32x2){v[3][j][0], v[3][j][1]} + c3; c3 = wh * (f32x2){v[3][j][2], v[3][j][3]} + c3; }
                    float a0 = c0[0] + c0[1], a1 = c1[0] + c1[1], a2 = c2[0] + c2[1], a3 = c3[0] + c3[1];
                    wave_sum4_u(a0, a1, a2, a3);
                    const float bgn = rt[n * RT_LD + D]; LG[0][n] = a0 + bgn; LG[1][n] = a1 + bgn; LG[2][n] = a2 + bgn; LG[3][n] = a3 + bgn; }
#pragma unroll
                for (int q = 0; q < 4; ++q) {
                    const int row = r0 + q;
                    int gsel = 0; float gmx = LG[q][0];
#pragma unroll
                    for (int i = 1; i < 4; ++i) if (LG[q][i] > gmx) { gmx = LG[q][i]; gsel = i; }
                    gsel = __builtin_amdgcn_readfirstlane(gsel);
                    float gsum = 0.f;
#pragma unroll
                    for (int i = 0; i < 4; ++i) gsum += __expf(LG[q][i] - gmx);
                    const float pg = frcp(gsum);
                    float le[8];
                    const LAS float* rte = rt + (4 + 8 * gsel) * RT_LD + 4 * lane;
#pragma unroll
                    for (int j8 = 0; j8 < 8; ++j8) { f32x2 c = {0.f, 0.f};
#pragma unroll
                        for (int j = 0; j < 4; ++j) { const f32x4 wv = *(const LAS f32x4*)(rte + j8 * RT_LD + 256 * j);
                            c = (f32x2){wv[0], wv[1]} * (f32x2){v[q][j][0], v[q][j][1]} + c; c = (f32x2){wv[2], wv[3]} * (f32x2){v[q][j][2], v[q][j][3]} + c; }
                        le[j8] = c[0] + c[1]; }
                    wave_sum4_u(le[0], le[1], le[2], le[3]); wave_sum4_u(le[4], le[5], le[6], le[7]);
#pragma unroll
                    for (int j8 = 0; j8 < 8; ++j8) le[j8] += rte[j8 * RT_LD + D - 4 * lane];
                    int e0 = 0; float m0 = le[0];
#pragma unroll
                    for (int j = 1; j < 8; ++j) if (le[j] > m0) { m0 = le[j]; e0 = j; }
                    int e1 = (e0 == 0) ? 1 : 0; float m1 = -3.0e38f;
#pragma unroll
                    for (int j = 0; j < 8; ++j) if (j != e0 && le[j] > m1) { m1 = le[j]; e1 = j; }
                    const float a1 = __expf(m1 - m0), inv = frcp(1.0f + a1);
                    const float w0 = pg * inv, w1 = pg * a1 * inv;
                    const int E0 = gsel * 8 + e0, E1 = gsel * 8 + e1;
                    if (row < M) {
                        unsigned p0 = 0, p1 = 0;
                        if (lane == 0) { p0 = __hip_atomic_fetch_add(lcnt + E0, 1u, __ATOMIC_RELAXED, __HIP_MEMORY_SCOPE_WORKGROUP); p1 = __hip_atomic_fetch_add(lcnt + E1, 1u, __ATOMIC_RELAXED, __HIP_MEMORY_SCOPE_WORKGROUP); }
                        p0 = __builtin_amdgcn_readfirstlane(p0); p1 = __builtin_amdgcn_readfirstlane(p1);
                        if (lane == nrow) { myE0 = E0; myE1 = E1; myP0 = (int)p0; myP1 = (int)p1; myW0 = w0; myW1 = w1; myRow = row; }
                        ++nrow;
                    }
                }
#pragma unroll
                for (int q = 0; q < 4; ++q)
#pragma unroll
                    for (int j = 0; j < 4; ++j) v[q][j] = vn[q][j];
            }
#undef T2_LOAD
            __syncthreads();
            if (tid < NEXP) { const unsigned c = lcnt[tid]; lbase[tid] = c ? __hip_atomic_fetch_add(cnt + tid * 64, c, __ATOMIC_RELAXED, __HIP_MEMORY_SCOPE_AGENT) : 0u; }
            __syncthreads();
            if (myRow >= 0) { const int q0 = myP0 + (int)lbase[myE0], q1 = myP1 + (int)lbase[myE1]; etok[myE0 * 16384 + q0] = myRow; etok[myE1 * 16384 + q1] = myRow;
                              tok_e[2 * myRow] = myE0; tok_e[2 * myRow + 1] = myE1; tok_pos[2 * myRow] = q0; tok_pos[2 * myRow + 1] = q1;
                              tok_w[2 * myRow] = myW0; tok_w[2 * myRow + 1] = myW1; }
            __syncthreads();
        }
        SEAM(pb + 5);
        if (IN(pb + 8) && EN(8)) {
            WSP();
            const unsigned* cnt = ctl + CW_CNT + l * NEXP * 64; unsigned* tcl = ctl + CW_TILE + l * MAXTILES * 16;
            int n1, n3, n4, R;
            int a_pm, a_pn, a_e, a_ts, a_cn, b_pm, b_pn, b_e, b_ts, b_cn, c_pm, c_pn, c_e, c_ts, c_cn;
            int d_pm, d_pn, d_e, d_ts, d_cn, e_pm, e_pn, e_e, e_ts, e_cn, f_pm, f_pn, f_e, f_ts, f_cn, g_pm, g_pn, g_e, g_ts, g_cn;
            {
                const int cv = (lane < NEXP) ? (int)__hip_atomic_load(cnt + lane * 64, __ATOMIC_RELAXED, __HIP_MEMORY_SCOPE_AGENT) : 0;
                const int tl = (cv + 255) >> 8; int tend = 0, ntile = 0;
#pragma unroll
                for (int e = 0; e < NEXP; ++e) { ntile += __builtin_amdgcn_readlane(tl, e); if (lane == e) tend = ntile; }
                const int U = 4 * ntile, nA = min(U, 2 * G), Nf = G - min(U - nA, G), nB = min(nA, 2 * Nf); R = min(U - nA, G);
                auto moe_unit = [&](int v, int& pm, int& pn, int& e, int& ts, int& cn) { const int t = min(v >> 2, ntile - 1); pm = t; pn = v & 3;
                    e = min((int)__builtin_popcountll(__ballot(lane < NEXP && tend <= t)), NEXP - 1); ts = __builtin_amdgcn_readlane(tend - tl, e); cn = max(__builtin_amdgcn_readlane(cv, e), 1); };
                moe_unit(vcu, a_pm, a_pn, a_e, a_ts, a_cn); moe_unit(G + vcu, b_pm, b_pn, b_e, b_ts, b_cn); moe_unit(nA + vcu, c_pm, c_pn, c_e, c_ts, c_cn);
                n1 = (vcu < nA ? 1 : 0) + (G + vcu < nA ? 1 : 0);
                const int v3 = vcu - R, v4 = nB + vcu;
                moe_unit(v3, d_pm, d_pn, d_e, d_ts, d_cn); moe_unit(v3 + Nf, e_pm, e_pn, e_e, e_ts, e_cn); n3 = (vcu >= R) ? (v3 < nB ? 1 : 0) + (v3 + Nf < nB ? 1 : 0) : 0;
                moe_unit(v4, f_pm, f_pn, f_e, f_ts, f_cn); moe_unit(v4 + G, g_pm, g_pn, g_e, g_ts, g_cn); n4 = (v4 < U ? 1 : 0) + (v4 + G < U ? 1 : 0);
            }
#define MOE_M1(n_, p0, p1) do { const pg8::MoeOrder S{(n_), p0##pm, p1##pm, p0##pn, p1##pn, p0##e, p1##e, (size_t)1024 * D * 2, p0##ts, p1##ts, p0##cn, p1##cn, etok, tcl}; \
            pg8::Gemm g{Hn, W13 + (size_t)l * NEXP * 1024 * D, D, D, D};            \
            EpiSwiglu E{HB}; pg8::gemm_phase<EpiSwiglu, pg8::MoeOrder, true, true, true>(lds, g, S, E); } while (0)
#define MOE_M2(n_, p0, p1) do { \
            if (wave == 0) { const int tb_ = (n_) > 1 ? p1##pm : p0##pm; unsigned sp_ = 0; \
                while ((unsigned)__builtin_amdgcn_readfirstlane((int)__hip_atomic_load(tcl + p0##pm * 16, __ATOMIC_RELAXED, __HIP_MEMORY_SCOPE_AGENT)) < 32u && ++sp_ < XB_SPIN_CAP) __builtin_amdgcn_s_sleep(2); \
                while ((unsigned)__builtin_amdgcn_readfirstlane((int)__hip_atomic_load(tcl + tb_ * 16, __ATOMIC_RELAXED, __HIP_MEMORY_SCOPE_AGENT)) < 32u && ++sp_ < XB_SPIN_CAP) __builtin_amdgcn_s_sleep(2); \
                __builtin_amdgcn_fence(__ATOMIC_ACQUIRE, "agent"); asm volatile("s_waitcnt vmcnt(0)" ::: "memory"); }        \
            __syncthreads(); \
            const pg8::MoeOrder S{(n_), p0##pm, p1##pm, p0##pn, p1##pn, p0##e, p1##e, (size_t)D * EH * 2, p0##ts, p1##ts, p0##cn, p1##cn, etok, nullptr}; \
            pg8::Gemm g{HB, W2 + (size_t)l * NEXP * D * EH, EH, EH, EH}; \
            EpiY E{YB}; pg8::gemm_phase<EpiY, pg8::MoeOrder>(lds, g, S, E); } while (0)
            if (n1) MOE_M1(n1, a_, b_);
            if (vcu < R) MOE_M1(1, c_, c_);
            if (n3) MOE_M2(n3, d_, e_);
            if (n4) MOE_M2(n4, f_, g_);
#undef MOE_M1
#undef MOE_M2
        }
        SEAM(pb + 8);
    }
    if (IN(NPHASE - 1) && EN(9)) {
        WSP();
        const float* modprev = modp + (size_t)(DEPTH - 1) * NBATCH * 6 * D;
        constexpr int RPW = M / (256 * NWAVES); const int rbase = gw * RPW, b = rbase / SEQ;
        int slot_v = 0; float w_v = 0.f;
        { const unsigned* cntp = ctl + CW_CNT + (DEPTH - 1) * NEXP * 64;
          const int cv = (lane < NEXP) ? (int)__hip_atomic_load(cntp + lane * 64, __ATOMIC_RELAXED, __HIP_MEMORY_SCOPE_AGENT) : 0;
          const int tl = (cv + 255) >> 8; int tstart = 0, run = 0;
#pragma unroll
          for (int e = 0; e < NEXP; ++e) { if (lane == e) tstart = run; run += __builtin_amdgcn_readlane(tl, e); }
          const int i = min(lane, 2 * RPW - 1);
          const int e = tok_e[2 * rbase + i], pos = tok_pos[2 * rbase + i]; w_v = tok_w[2 * rbase + i];
          slot_v = __builtin_amdgcn_ds_bpermute(4 * e, tstart) * 256 + pos; }
        f32x4 gf[4], fg[4];
#pragma unroll
        for (int j = 0; j < 4; ++j) { const int col = 4 * lane + 256 * j; gf[j] = *(const f32x4*)(modprev + (size_t)b * 6 * D + 5 * D + col); fg[j] = *(const f32x4*)(args.fin_g + col); }
#pragma unroll 1
        for (int r0 = rbase; r0 < rbase + RPW; r0 += 4) {
            u32x2 xr[4][4], y0[4][4], y1[4][4]; float w0[4], w1[4];
#pragma unroll
            for (int q = 0; q < 4; ++q) { const int ix = 2 * (r0 - rbase + q);
                const int s0 = __builtin_amdgcn_readlane(slot_v, ix), s1 = __builtin_amdgcn_readlane(slot_v, ix + 1);
                w0[q] = __builtin_bit_cast(float, __builtin_amdgcn_readlane(__builtin_bit_cast(int, w_v), ix)); w1[q] = __builtin_bit_cast(float, __builtin_amdgcn_readlane(__builtin_bit_cast(int, w_v), ix + 1));
#pragma unroll
                for (int j = 0; j < 4; ++j) { const int col = 4 * lane + 256 * j;
                    xr[q][j] = *(const u32x2*)(X + (size_t)(r0 + q) * D + col); y0[q][j] = *(const u32x2*)(YB + (size_t)s0 * D + col); y1[q][j] = *(const u32x2*)(YB + (size_t)s1 * D + col); } }
            f32x4 v[4][4]; float ssq[4];
#pragma unroll
            for (int q = 0; q < 4; ++q) { float ss = 0.f;
#pragma unroll
                for (int j = 0; j < 4; ++j) { const f32x4 yy = bf4(y0[q][j]) * w0[q] + bf4(y1[q][j]) * w1[q]; v[q][j] = bf4(xr[q][j]) + gf[j] * yy;
                    ss += (v[q][j][0] * v[q][j][0] + v[q][j][1] * v[q][j][1]) + (v[q][j][2] * v[q][j][2] + v[q][j][3] * v[q][j][3]); }
                ssq[q] = ss; }
            wave_sum4_u(ssq[0], ssq[1], ssq[2], ssq[3]);
#pragma unroll
            for (int q = 0; q < 4; ++q) { const int row = r0 + q;
                const float rstd = __builtin_amdgcn_rsqf(ssq[q] * (1.f / D) + NORM_EPS);
#pragma unroll
                for (int j = 0; j < 4; ++j) *(f32x4*)(args.out + (size_t)row * D + 4 * lane + 256 * j) = v[q][j] * rstd * fg[j];
            }
        }
    }
#undef IN
#undef SEAM
#undef GRID_BAR
}


#ifndef DBG
#define DBG 0
#endif
#if DBG
constexpr size_t WS_REP = WS_END;
__global__ void dbg_scan(const unsigned* buf, size_t nwords, int is_bf16, unsigned long long* rep) {
    unsigned long long nf = 0, ck = 0;
    for (size_t i = (size_t)blockIdx.x * blockDim.x + threadIdx.x; i < nwords; i += (size_t)gridDim.x * blockDim.x) {
        const unsigned w = buf[i]; ck += (unsigned long long)w * (unsigned long long)((i & 1023) + 1);
        if (is_bf16) { if ((w & 0x7f80u) >= (140u << 7)) ++nf; if ((w & 0x7f800000u) >= (140u << 23)) ++nf; }
        else if ((w & 0x7f800000u) >= (140u << 23)) ++nf;
    }
    for (int o = 32; o >= 1; o >>= 1) { nf += __shfl_xor(nf, o); ck += __shfl_xor(ck, o); }
    if ((threadIdx.x & 63) == 0) { if (nf) atomicAdd(rep, nf); atomicAdd(rep + 1, ck); }
}

__global__ void dbg_scan_cols(const unsigned short* buf, int c0, int c1, unsigned long long* rep) {
    unsigned long long nf = 0;
    const int w = c1 - c0;
    for (size_t i = (size_t)blockIdx.x * blockDim.x + threadIdx.x; i < (size_t)M * w; i += (size_t)gridDim.x * blockDim.x) {
        const size_t r = i / w; const int c = c0 + (int)(i % w); const unsigned v = buf[r * D + c];
        if ((v & 0x7f80u) >= (140u << 7)) ++nf; }
    for (int o = 32; o >= 1; o >>= 1) nf += __shfl_xor(nf, o);
    if ((threadIdx.x & 63) == 0 && nf) atomicAdd(rep, nf);
}
__global__ void dbg_encode(const unsigned long long* rep, float* out, size_t n, int nph) {
    int code = 80;
    for (int p = nph - 1; p >= 0; --p) if (rep[(64 + p) * 2 + 1] != rep[p * 2 + 1]) code = 40 + p;
    for (int p = nph - 1; p >= 0; --p) if (rep[p * 2] != 0ull || rep[(64 + p) * 2] != 0ull) code = 1 + p;
    if (code == 80) return;
    const float A = sqrtf((float)code * 0.1f);
    for (size_t i = (size_t)blockIdx.x * blockDim.x + threadIdx.x; i < n; i += (size_t)gridDim.x * blockDim.x) {
        unsigned h = (unsigned)i * 2654435761u; h ^= h >> 15; h *= 2246822519u; h ^= h >> 13;
        out[i] = (h & 1u) ? A : -A; }
}
#endif

extern "C" void kernel_launch(void* const* d_in, const int* in_sizes, int n_in, void* d_out, int out_size, void* d_ws, size_t ws_size, hipStream_t stream) {
    static int grid = 0;
    if (grid == 0) {
        if (n_in != 22 || in_sizes[0] != M * D || out_size != M * D || ws_size < WS_END + (1u << 20)) {
            fprintf(stderr, "kernel_launch: unexpected shapes (n_in %d, in0 %d, out %d, ws %zu, need %zu)\n", n_in, n_in > 0 ? in_sizes[0] : -1, out_size, ws_size, (size_t)WS_END); grid = -1; return; }
        int dev = 0, cus = 0, per_cu = 0;
        if (hipGetDevice(&dev) != hipSuccess || hipDeviceGetAttribute(&cus, hipDeviceAttributeMultiprocessorCount, dev) != hipSuccess) { grid = -1; return; }
        if (hipFuncSetAttribute((const void*)fwd_kernel, hipFuncAttributeMaxDynamicSharedMemorySize, LDS_BYTES) != hipSuccess) { fprintf(stderr, "kernel_launch: hipFuncSetAttribute failed\n"); grid = -1; return; }
        if (hipOccupancyMaxActiveBlocksPerMultiprocessor(&per_cu, (const void*)fwd_kernel, NWAVES * 64, LDS_BYTES) != hipSuccess || per_cu < 1)
            fprintf(stderr, "kernel_launch: occupancy query reports %d\n", per_cu);
        (void)hipGetLastError();
        if (cus != 256) { fprintf(stderr, "kernel_launch: built for 256 CUs (MoE unit deal, T2 row blocks), found %d\n", cus); grid = -1; return; }
        grid = cus;
    }
    if (grid < 0) return;
    if (hipMemsetAsync((char*)d_ws + WS_CTL, 0, CTL_ZERO_BYTES, stream) != hipSuccess) { fprintf(stderr, "kernel_launch: memset failed\n"); return; }
    Args a{};
    a.x = (const float*)d_in[0]; a.c = (const float*)d_in[1]; a.ada_w = (const float*)d_in[2]; a.ada_b = (const float*)d_in[3]; a.mix_g = (const float*)d_in[4]; a.ffn_g = (const float*)d_in[5];
    a.w_in = (const float*)d_in[6]; a.da_lambda = (const float*)d_in[7]; a.da_subln = (const float*)d_in[8]; a.na_rpb = (const float*)d_in[9];
    a.wpa = (const float*)d_in[10]; a.wpn = (const float*)d_in[11]; a.wpd = (const float*)d_in[12]; a.w_out = (const float*)d_in[13];
    a.rgw = (const float*)d_in[14]; a.rgb = (const float*)d_in[15]; a.rew = (const float*)d_in[16]; a.reb = (const float*)d_in[17];
    a.ew1 = (const float*)d_in[18]; a.ew3 = (const float*)d_in[19]; a.ew2 = (const float*)d_in[20]; a.fin_g = (const float*)d_in[21];
    a.out = (float*)d_out; a.ws = (unsigned char*)d_ws;
#if DBG
    {
        unsigned char* ws = (unsigned char*)d_ws;
        unsigned long long* rep = (unsigned long long*)(ws + WS_REP);
        (void)hipMemsetAsync(rep, 0, 2 * 64 * 2 * 8, stream);
        for (int run = 0; run < 2; ++run) {
            (void)hipMemsetAsync((char*)d_ws + WS_CTL, 0, CTL_ZERO_BYTES, stream);
            for (int p = 0; p < NPHASE; ++p) {
                a.ph_lo = p; a.ph_hi = p + 1;
                hipLaunchKernelGGL(fwd_kernel, dim3(grid), dim3(NWAVES * 64), LDS_BYTES, stream, a);
                unsigned long long* r = rep + (size_t)(run * 64 + p) * 2;
#define SCAN(off, bytes, isbf) hipLaunchKernelGGL(dbg_scan, dim3(1024), dim3(256), 0, stream, (const unsigned*)(ws + (off)), (size_t)(bytes) / 4, (isbf), r)
                const int ph = (p == 0) ? -1 : (p == NPHASE - 1) ? 9 : (p - 1) % 9;
                if (ph == -1) { SCAN(WS_MOD, (size_t)DEPTH * NBATCH * 6 * D * 4, 0); SCAN(WS_ROPE, (size_t)SEQ * 64 * 4, 0); SCAN(WS_WIN, WS_END - WS_WIN, 1); }
                else if (ph == 0) { SCAN(WS_X, (size_t)M * D * 4, 0); SCAN(WS_H, (size_t)M * D * 2, 1); }
                else if (ph == 1) { SCAN(WS_Z, (size_t)M * ZW * 2, 1); }
                else if (ph == 2) { SCAN(WS_OCAT, (size_t)M * D * 2, 1); }
                else if (ph == 3) { SCAN(WS_MERGED, (size_t)M * D * 2, 1); }
                else if (ph == 4) { SCAN(WS_X, (size_t)M * D * 4, 0); }
                else if (ph == 5) { SCAN(WS_H, (size_t)M * D * 2, 1); SCAN(WS_ROUTE, (size_t)2 * M * 4, 0); SCAN(WS_ROUTE + (size_t)4 * M * 4, (size_t)2 * M * 4, 0); }
                else if (ph == 9) { hipLaunchKernelGGL(dbg_scan, dim3(1024), dim3(256), 0, stream, (const unsigned*)d_out, (size_t)M * D, 0, r); }
#undef SCAN
            }
        }
        hipLaunchKernelGGL(dbg_encode, dim3(1024), dim3(256), 0, stream, (const unsigned long long*)rep, (float*)d_out, (size_t)M * D, NPHASE);
    }
#elif MK_PER_PHASE
    for (int p = 0; p < NPHASE; ++p) {
        a.ph_lo = p; a.ph_hi = p + 1;
        hipLaunchKernelGGL(fwd_kernel, dim3(grid), dim3(NWAVES * 64), LDS_BYTES, stream, a);
    }
#else
    a.ph_lo = 0; a.ph_hi = NPHASE;
    hipLaunchKernelGGL(fwd_kernel, dim3(grid), dim3(NWAVES * 64), LDS_BYTES, stream, a);
#endif
    const hipError_t le = hipPeekAtLastError();
    if (le != hipSuccess) fprintf(stderr, "kernel_launch: launch failed: %s\n", hipGetErrorName(le));
}
```

```cpp
#include <hip/hip_runtime.h>
#include <cstdio>
#include <cstdint>

#ifndef MK_PER_PHASE
#define MK_PER_PHASE 0
#endif

#define LAS __attribute__((address_space(3)))
#define GAS __attribute__((address_space(1)))
typedef unsigned short bf16_t;
typedef short bf16x8 __attribute__((ext_vector_type(8)));
typedef short s16x4 __attribute__((ext_vector_type(4)));
typedef float f32x4 __attribute__((ext_vector_type(4)));
typedef float f32x2 __attribute__((ext_vector_type(2)));
typedef float f32x16 __attribute__((ext_vector_type(16)));
typedef unsigned u32x4 __attribute__((ext_vector_type(4)));
typedef unsigned u32x2 __attribute__((ext_vector_type(2)));

constexpr int D = 1024, NBATCH = 4, SEQ = 4096, M = NBATCH * SEQ, DEPTH = 4, ZW = 7680;
constexpr int ZQA = 0, ZKA = 512, ZVA = 1024, ZQN = 1536, ZKN = 1792, ZVN = 2048, ZQD = 2304, ZKD = 3072, ZVD = 3840, ZG = 4608;
constexpr int NEXP = 32, EH = 512;
constexpr int MAXTILES = 160, XROWS = MAXTILES * 256;
constexpr float C2 = 0.125f * 1.4426950408889634f;
constexpr float LOG2E = 1.4426950408889634f;
constexpr float NORM_EPS = 1e-6f;
constexpr float NEGBIG = -1e30f;
constexpr float RESCALE_THR = 8.0f;

constexpr size_t MiB = 1u << 20;
constexpr size_t WS_CTL = 0, CTL_ZERO_BYTES = 1 * MiB;
constexpr size_t WS_RT = 1 * MiB;
constexpr size_t WS_MOD = 2 * MiB;
constexpr size_t WS_ROPE = 3 * MiB;
constexpr size_t WS_ROUTE = 4 * MiB;
constexpr size_t WS_X = 8 * MiB;
constexpr size_t WS_H = 72 * MiB;
constexpr size_t WS_OCAT = 104 * MiB;
constexpr size_t WS_MERGED = 136 * MiB;
constexpr size_t WS_Z = 168 * MiB;
constexpr size_t WS_XG = WS_Z;
constexpr size_t WS_HB = WS_Z + 80 * MiB;
constexpr size_t WS_YB = WS_Z + 120 * MiB;
constexpr size_t WS_WIN = 408 * MiB;
constexpr size_t WS_WPROJ = 468 * MiB;
constexpr size_t WS_WOUT = 476 * MiB;
constexpr size_t WS_W13 = 484 * MiB;
constexpr size_t WS_W2 = 740 * MiB;
constexpr size_t WS_END = 868 * MiB;
constexpr int CW_BAR = 4096;
constexpr int CW_CNT = 16384;
constexpr int CW_C0 = 49152;
constexpr int CW_TILE = 32768;

constexpr int RING_BYTES = 131072;
constexpr int RT_LD = 1028;
constexpr int RT_BYTES = 36 * RT_LD * 4;
constexpr int MISC_OFF = RT_BYTES;
constexpr int LDS_BYTES = MISC_OFF + 512;

__device__ __forceinline__ unsigned f2bf(float f) { unsigned u = __builtin_bit_cast(unsigned, f); return (u + 0x7fffu + ((u >> 16) & 1u)) >> 16; }
__device__ __forceinline__ unsigned pk2(float lo, float hi) { return f2bf(lo) | (f2bf(hi) << 16); }
__device__ __forceinline__ unsigned cvt_pk_bf16(float lo, float hi) { unsigned r; asm("v_cvt_pk_bf16_f32 %0, %1, %2" : "=v"(r) : "v"(lo), "v"(hi)); return r; }
typedef __bf16 bf16x2_t __attribute__((ext_vector_type(2)));
__device__ __forceinline__ unsigned cvtpk_s(float lo, float hi) { f32x2 v = {lo, hi}; bf16x2_t b = __builtin_convertvector(v, bf16x2_t); return __builtin_bit_cast(unsigned, b); }
__device__ __forceinline__ float bflo(unsigned u) { return __builtin_bit_cast(float, u << 16); }
__device__ __forceinline__ float bfhi(unsigned u) { return __builtin_bit_cast(float, u & 0xffff0000u); }
__device__ __forceinline__ f32x4 bf4(u32x2 r) { return (f32x4){bflo(r.x), bfhi(r.x), bflo(r.y), bfhi(r.y)}; }
__device__ __forceinline__ float fexp2(float x) { return __builtin_amdgcn_exp2f(x); }
__device__ __forceinline__ float frcp(float x) { return __builtin_amdgcn_rcpf(x); }
__device__ __forceinline__ void swap32(float& a, float& b) { asm volatile("s_nop 1\n\tv_permlane32_swap_b32 %0, %1\n\ts_nop 1" : "+v"(a), "+v"(b)); }
template <int X> __device__ __forceinline__ float xor_lane(float v) { return __builtin_bit_cast(float, __builtin_amdgcn_ds_swizzle(__builtin_bit_cast(int, v), (X << 10) | 0x1f)); }
__device__ __forceinline__ float half_sum(float v) { v += xor_lane<1>(v); v += xor_lane<2>(v); v += xor_lane<4>(v); v += xor_lane<8>(v); v += xor_lane<16>(v); return v; }
__device__ __forceinline__ float wave_sum(float v) {
    v = half_sum(v);
    float a = v, b = v; swap32(a, b);
    return a + b;
}
template <int CTRL> __device__ __forceinline__ float dpp_f(float v) { return __builtin_bit_cast(float, __builtin_amdgcn_update_dpp(0, __builtin_bit_cast(int, v), CTRL, 0xf, 0xf, false)); }
__device__ __forceinline__ float wave_sum_u(float v) {
    v += dpp_f<0xB1>(v); v += dpp_f<0x4E>(v); v += dpp_f<0x141>(v); v += dpp_f<0x140>(v);
    v += __builtin_bit_cast(float, __builtin_amdgcn_update_dpp(0, __builtin_bit_cast(int, v), 0x142, 0xa, 0xf, false));
    v += __builtin_bit_cast(float, __builtin_amdgcn_update_dpp(0, __builtin_bit_cast(int, v), 0x143, 0xc, 0xf, false));
    float r = __builtin_bit_cast(float, __builtin_amdgcn_readlane(__builtin_bit_cast(int, v), 63));
    asm volatile("" : "+v"(r));
    return r;
}
__device__ __forceinline__ void wave_sum4_u(float& a, float& b, float& c, float& d) {
    unsigned s0, s1, s2, s3;
#define WS4_STEP(ctl) "v_add_f32_dpp %0, %0, %0 " ctl "\n\tv_add_f32_dpp %1, %1, %1 " ctl "\n\tv_add_f32_dpp %2, %2, %2 " ctl "\n\tv_add_f32_dpp %3, %3, %3 " ctl "\n\t"
    asm volatile("s_nop 1\n\t"
        WS4_STEP("quad_perm:[1,0,3,2] row_mask:0xf bank_mask:0xf") WS4_STEP("quad_perm:[2,3,0,1] row_mask:0xf bank_mask:0xf") WS4_STEP("row_half_mirror row_mask:0xf bank_mask:0xf")
        WS4_STEP("row_mirror row_mask:0xf bank_mask:0xf") WS4_STEP("row_bcast:15 row_mask:0xa bank_mask:0xf") WS4_STEP("row_bcast:31 row_mask:0xc bank_mask:0xf")
        "v_readlane_b32 %4, %0, 63\n\tv_readlane_b32 %5, %1, 63\n\tv_readlane_b32 %6, %2, 63\n\tv_readlane_b32 %7, %3, 63\n\t"
        "v_mov_b32 %0, %4\n\tv_mov_b32 %1, %5\n\tv_mov_b32 %2, %6\n\tv_mov_b32 %3, %7"
        : "+v"(a), "+v"(b), "+v"(c), "+v"(d), "=&s"(s0), "=&s"(s1), "=&s"(s2), "=&s"(s3));
#undef WS4_STEP
}
__device__ __forceinline__ void st16_wt_nt(void* p, u32x4 v) { asm volatile("global_store_dwordx4 %0, %1, off sc1 nt\n\ts_nop 1" :: "v"(p), "v"(v) : "memory"); }
__device__ __forceinline__ void st4_wt(void* p, float v) { asm volatile("global_store_dword %0, %1, off sc1\n\ts_nop 1" :: "v"(p), "v"(v) : "memory"); }
__device__ __forceinline__ void st16_wt(void* p, u32x4 v) { asm volatile("global_store_dwordx4 %0, %1, off sc1\n\ts_nop 1" :: "v"(p), "v"(v) : "memory"); }
#define LDS_WAIT() asm volatile("s_waitcnt lgkmcnt(0)" ::: "memory")
#define VM_WAIT() asm volatile("s_waitcnt vmcnt(0)" ::: "memory")
#define CBAR() asm volatile("" ::: "memory")

namespace pg8 {
constexpr int BM = 256, BK = 64, HALF = 128, HTB = HALF * BK * 2, STAGE_BYTES = 8 * HTB, NXCD = 8, WGM = 8;
__host__ __device__ __forceinline__ int lds_byte(int r, int c) { const int st = (r >> 4) * 2 + (c >> 5), rr = r & 15, cc = c & 31, ob = rr * 64 + cc * 2; return st * 1024 + (ob ^ (((ob >> 9) & 1) << 5)); }
__host__ __device__ __forceinline__ void stage_rc(int b, int& R, int& C) { const int st = b / 1024, sb = b % 1024, swz = sb ^ (((sb >> 9) & 1) << 5); R = (st >> 1) * 16 + swz / 64; C = (st & 1) * 32 + (swz % 64) / 2; }
__host__ __device__ __forceinline__ int perm32(int rho) { const int n = rho >> 4, i = rho & 15; return 8 * (i >> 2) + 4 * n + (i & 3); }

struct Unit { int pm, pn, e, x0, x1; };
struct Gemm { const bf16_t* A; const bf16_t* Bt; int lda, ldb, K; };

struct StaticOrder {
    int nM, nN, nwg, G, c;
    __device__ void init(int M_, int N_, int G_, int c_) { nM = M_ / BM; nN = N_ / BM; nwg = nM * nN; G = G_; c = c_; }
    __device__ bool next(int i, Unit& u) const {
        const long L = (long)i * G + c; if (L >= nwg) return false;
        int wgid = (int)L; { const int q = nwg / NXCD, r = nwg % NXCD, xcd = wgid % NXCD, off = wgid / NXCD; wgid = (xcd < r ? xcd * (q + 1) : r * (q + 1) + (xcd - r) * q) + off; }
        const int nig = WGM * nN, gid = wgid / nig, fm = gid * WGM, gsz = (nM - fm) < WGM ? (nM - fm) : WGM;
        u.pm = fm + ((wgid % nig) % gsz); u.pn = (wgid % nig) / gsz; u.e = 0; u.x0 = 0; u.x1 = 0; return true;
    }
    __device__ __forceinline__ size_t aoff(const Gemm& g, const Unit& u) const { return (size_t)u.pm * BM * g.lda * 2; }
    __device__ __forceinline__ size_t boff(const Gemm& g, const Unit& u) const { return (size_t)u.pn * BM * g.ldb * 2; }
    __device__ __forceinline__ int ktiles(const Gemm& g, const Unit&) const { return g.K / BK; }
    __device__ __forceinline__ void done(const Unit&, int) const {}
};
struct MoeOrder {
    int n; int pm0, pm1, pn0, pn1, e0, e1; size_t estride;
    int ts0, ts1, cn0, cn1; const int* etok;
    unsigned* tcnt;
    __device__ __forceinline__ void done(const Unit& u, int lane) const {
        if (tcnt) { asm volatile("s_waitcnt vmcnt(0)" ::: "memory"); if (lane == 0) __hip_atomic_fetch_add(tcnt + u.pm * 16, 1u, __ATOMIC_RELAXED, __HIP_MEMORY_SCOPE_AGENT); }
    }
    __device__ bool next(int i, Unit& u) const {
        if (i >= n) return false;
        u.pm = i == 0 ? pm0 : pm1; u.pn = i == 0 ? pn0 : pn1; u.e = i == 0 ? e0 : e1;
        u.x0 = i == 0 ? ts0 : ts1; u.x1 = i == 0 ? cn0 : cn1; return true;
    }
    __device__ __forceinline__ size_t aoff(const Gemm& g, const Unit& u) const { return (size_t)u.pm * BM * g.lda * 2; }
    __device__ __forceinline__ size_t boff(const Gemm& g, const Unit& u) const { return (size_t)u.e * estride + (size_t)u.pn * BM * g.ldb * 2; }
    __device__ __forceinline__ int ktiles(const Gemm& g, const Unit&) const { return g.K / BK; }
    __device__ __forceinline__ int gather_row(const Unit& u, int r) const {
        const int pos = min((u.pm - u.x0) * BM + r, u.x1 - 1);
        return etok[u.e * 16384 + pos];
    }
};
struct ProjOrder {
    int pm, pn, rot;
    __device__ bool next(int i, Unit& u) const { if (i >= 3) return false; int seg = i + rot; seg = seg >= 3 ? seg - 3 : seg; u.pm = pm; u.pn = pn; u.e = seg | ((i == 0) ? 16 : 0); u.x0 = 0; u.x1 = 0; return true; }
    __device__ __forceinline__ int kofs(const Unit& u) const { const int seg = u.e & 15; return seg == 0 ? 0 : (seg == 1 ? 512 : 768); }
    __device__ __forceinline__ size_t aoff(const Gemm& g, const Unit& u) const { return (size_t)u.pm * BM * g.lda * 2 + (size_t)kofs(u) * 2; }
    __device__ __forceinline__ size_t boff(const Gemm& g, const Unit& u) const { return (size_t)u.pn * BM * g.ldb * 2 + (size_t)kofs(u) * 2; }
    __device__ __forceinline__ int ktiles(const Gemm&, const Unit& u) const { return (u.e & 15) == 0 ? 8 : 4; }
    __device__ __forceinline__ void done(const Unit&, int) const {}
};

template <class Epi, class Sched, bool ALIGN_EPI = true, bool SP2 = true, bool GATHER = false, bool ACOH = false>
__device__ __forceinline__ void gemm_phase(LAS unsigned char* lds, const Gemm g, const Sched& S, const Epi& E) {
    int tid_ = threadIdx.x; asm volatile("" : "+v"(tid_));
    const int tid = tid_, wid = __builtin_amdgcn_readfirstlane(tid >> 6), lane = tid & 63, wr = wid >> 2, wc = wid & 3, fr = lane & 15, fq = lane >> 4;
    int nt = S.ktiles(g, Unit{0, 0, 0, 0, 0});
    unsigned voffA[2], voffB[2];
#pragma unroll
    for (int i = 0; i < 2; ++i) { int R, C; stage_rc(tid * 16 + i * 8192, R, C); const int Rb = Epi::PERM ? ((R & ~31) + perm32(R & 31)) : R;
        voffA[i] = (unsigned)(R * g.lda + C) * 2u; voffB[i] = (unsigned)(Rb * g.ldb + C) * 2u; }
    const size_t kstep = (size_t)(BK * 2);
    const size_t hstepA = (size_t)HALF * g.lda * 2, hstepB = (size_t)HALF * g.ldb * 2;
    const unsigned ldsw = (unsigned)wid * 1024u;
    const int aoff = lds_byte(wr * 64 + fr, fq * 8), boff = lds_byte(wc * 32 + fr, fq * 8);
#define PG8_SA(b, h) (((b) * 2 + (h)) * HTB)
#define PG8_SB(b, h) ((4 + (b) * 2 + (h)) * HTB)
#define PG8_STAGE(bufoff, gbase, voff) do { _Pragma("unroll") for (int _i = 0; _i < 2; ++_i) \
        __builtin_amdgcn_global_load_lds((const unsigned*)((const char*)(gbase) + (voff)[_i]), (LAS unsigned*)(lds + (bufoff) + ldsw + _i * 8192), 16, 0, 0); } while (0)
#define PG8_STAGE_C(bufoff, gbase, voff) do { _Pragma("unroll") for (int _i = 0; _i < 2; ++_i) \
        __builtin_amdgcn_global_load_lds((const unsigned*)((const char*)(gbase) + (voff)[_i]), (LAS unsigned*)(lds + (bufoff) + ldsw + _i * 8192), 16, 0, 16); } while (0)
    unsigned vo0[2] = {0u, 0u}, vo1[2] = {0u, 0u}, nvo0[2] = {0u, 0u}, nvo1[2] = {0u, 0u};
#define PG8_GOFF(u_, d0_, d1_) do { _Pragma("unroll") for (int _i = 0; _i < 2; ++_i) { int R_, C_; stage_rc(tid * 16 + _i * 8192, R_, C_); \
        d0_[_i] = (unsigned)(S.gather_row(u_, R_) * g.lda + C_) * 2u; d1_[_i] = (unsigned)(S.gather_row(u_, HALF + R_) * g.lda + C_) * 2u; } } while (0)
#define PG8_STAGEA(bufoff, ptr, h, nx) do { if constexpr (GATHER) { unsigned o_[2]; o_[0] = (nx) ? ((h) ? nvo1[0] : nvo0[0]) : ((h) ? vo1[0] : vo0[0]); o_[1] = (nx) ? ((h) ? nvo1[1] : nvo0[1]) : ((h) ? vo1[1] : vo0[1]); \
        PG8_STAGE(bufoff, ptr, o_); } else if constexpr (ACOH) { PG8_STAGE_C(bufoff, (ptr) + ((h) ? hstepA : 0), voffA); } else { PG8_STAGE(bufoff, (ptr) + ((h) ? hstepA : 0), voffA); } } while (0)
#define PG8_LDA(dst, b, h) do { _Pragma("unroll") for (int m = 0; m < 4; ++m) _Pragma("unroll") for (int k = 0; k < 2; ++k) dst[m][k] = *(const LAS bf16x8*)(lds + PG8_SA(b, h) + aoff + m * 2048 + k * 1024); } while (0)
#define PG8_LDB(dst, b, h) do { _Pragma("unroll") for (int n = 0; n < 2; ++n) _Pragma("unroll") for (int k = 0; k < 2; ++k) dst[n][k] = *(const LAS bf16x8*)(lds + PG8_SB(b, h) + boff + n * 2048 + k * 1024); } while (0)
#define PG8_MMA(ai, bj, At, Bt) do { __builtin_amdgcn_s_setprio(1); _Pragma("unroll") for (int m = 0; m < 4; ++m) _Pragma("unroll") for (int n = 0; n < 2; ++n) _Pragma("unroll") for (int k = 0; k < 2; ++k) \
        acc[ai][bj][m][n] = __builtin_amdgcn_mfma_f32_16x16x32_bf16(Bt[n][k], At[m][k], acc[ai][bj][m][n], 0, 0, 0); __builtin_amdgcn_s_setprio(0); } while (0)
#define PG8_WAIT_V(n) asm volatile("s_waitcnt vmcnt(" #n ")" ::: "memory")
#define PG8_WAIT_L(n) asm volatile("s_waitcnt lgkmcnt(" #n ")" ::: "memory")
#define PG8_BAR __builtin_amdgcn_s_barrier()
#define PG8_SCHED __builtin_amdgcn_sched_barrier(0)
    Unit cur, nxt; int ui = 0;
    if (!S.next(0, cur)) return;
    nt = S.ktiles(g, cur);
    f32x4 acc[2][2][4][2];
#pragma unroll
    for (int a = 0; a < 2; ++a)
#pragma unroll
        for (int b = 0; b < 2; ++b)
#pragma unroll
            for (int m = 0; m < 4; ++m)
#pragma unroll
                for (int n = 0; n < 2; ++n) acc[a][b][m][n] = (f32x4){0.f, 0.f, 0.f, 0.f};
    bf16x8 At[4][2], B0[2][2], B1[2][2];
    const char* cA = (const char*)g.A + (GATHER ? (size_t)0 : S.aoff(g, cur)); const char* cB = (const char*)g.Bt + S.boff(g, cur);
    if constexpr (GATHER) { PG8_GOFF(cur, vo0, vo1); asm volatile("s_waitcnt vmcnt(0)" : "+v"(vo0[0]), "+v"(vo0[1]), "+v"(vo1[0]), "+v"(vo1[1]) :: "memory"); }
    if constexpr (SP2) {
        PG8_STAGE(PG8_SB(0, 0), cB, voffB); PG8_STAGE(PG8_SB(0, 1), cB + hstepB, voffB); PG8_STAGEA(PG8_SA(0, 0), cA, 0, false); PG8_STAGEA(PG8_SA(0, 1), cA, 1, false);
        if (wr == 1) PG8_BAR;
        PG8_WAIT_V(2); PG8_BAR;
        PG8_STAGE(PG8_SB(1, 0), cB + kstep, voffB); PG8_STAGEA(PG8_SA(1, 0), cA + kstep, 0, false); PG8_STAGE(PG8_SB(1, 1), cB + hstepB + kstep, voffB);
        PG8_WAIT_V(6); PG8_BAR;
    } else {
        PG8_STAGE(PG8_SB(0, 0), cB, voffB); PG8_STAGE(PG8_SA(0, 0), cA, voffA); PG8_STAGE(PG8_SB(0, 1), cB + hstepB, voffB); PG8_STAGE(PG8_SA(0, 1), cA + hstepA, voffA);
        if (wr == 1) PG8_BAR;
        PG8_WAIT_V(4); PG8_BAR;
        PG8_STAGE(PG8_SB(1, 0), cB + kstep, voffB); PG8_STAGE(PG8_SA(1, 0), cA + kstep, voffA); PG8_STAGE(PG8_SB(1, 1), cB + hstepB + kstep, voffB);
        PG8_WAIT_V(6); PG8_BAR;
    }
    for (;;) {
        const bool has_next = S.next(ui + 1, nxt);
        const char* nA = (has_next && !GATHER) ? (const char*)g.A + S.aoff(g, nxt) : cA; const char* nB = has_next ? (const char*)g.Bt + S.boff(g, nxt) : cB;
        if constexpr (GATHER) { if (has_next) { PG8_GOFF(nxt, nvo0, nvo1); } else { nvo0[0] = vo0[0]; nvo0[1] = vo0[1]; nvo1[0] = vo1[0]; nvo1[1] = vo1[1]; }
            asm volatile("s_waitcnt vmcnt(0)" : "+v"(nvo0[0]), "+v"(nvo0[1]), "+v"(nvo1[0]), "+v"(nvo1[1]) :: "memory"); }
        for (int t = 0; t < nt; t += 2) {
            const bool last = (t == nt - 2);
            const char* a1 = cA + (size_t)(t + 1) * kstep;
            const char* a2 = last ? nA : cA + (size_t)(t + 2) * kstep; const char* b2 = last ? nB : cB + (size_t)(t + 2) * kstep;
            const char* a3 = a2 + kstep; const char* b3 = b2 + kstep;
            if constexpr (SP2) {
            PG8_LDB(B0, 0, 0); PG8_LDB(B1, 0, 1); PG8_SCHED; PG8_LDA(At, 0, 0); PG8_STAGEA(PG8_SA(1, 1), a1, 1, false);
            PG8_WAIT_V(8); PG8_WAIT_L(0); PG8_BAR; PG8_MMA(0, 0, At, B0); PG8_MMA(0, 1, At, B1); PG8_BAR; PG8_SCHED;
            PG8_LDA(At, 0, 1); PG8_STAGE(PG8_SB(0, 0), b2, voffB); PG8_STAGE(PG8_SB(0, 1), b2 + hstepB, voffB); PG8_STAGEA(PG8_SA(0, 0), a2, 0, last);
            PG8_WAIT_V(8); PG8_WAIT_L(0); PG8_BAR; PG8_MMA(1, 0, At, B0); PG8_MMA(1, 1, At, B1); PG8_BAR; PG8_SCHED;
            PG8_LDB(B0, 1, 0); PG8_LDB(B1, 1, 1); PG8_SCHED; PG8_LDA(At, 1, 0); PG8_STAGEA(PG8_SA(0, 1), a2, 1, last);
            PG8_WAIT_V(8); PG8_WAIT_L(0); PG8_BAR; PG8_MMA(0, 0, At, B0); PG8_MMA(0, 1, At, B1); PG8_BAR; PG8_SCHED;
            PG8_LDA(At, 1, 1); PG8_STAGE(PG8_SB(1, 0), b3, voffB); PG8_STAGE(PG8_SB(1, 1), b3 + hstepB, voffB); PG8_STAGEA(PG8_SA(1, 0), a3, 0, last);
            PG8_WAIT_V(8); PG8_WAIT_L(0); PG8_BAR; PG8_MMA(1, 0, At, B0); PG8_MMA(1, 1, At, B1); PG8_BAR; PG8_SCHED;
            } else {
            PG8_LDB(B0, 0, 0); PG8_SCHED; PG8_LDA(At, 0, 0); PG8_STAGE(PG8_SA(1, 1), a1 + hstepA, voffA);
            PG8_WAIT_L(8); PG8_BAR; PG8_WAIT_L(0); PG8_MMA(0, 0, At, B0); PG8_BAR; PG8_SCHED;
            PG8_LDB(B1, 0, 1); PG8_STAGE(PG8_SB(0, 0), b2, voffB);
            PG8_BAR; PG8_WAIT_L(0); PG8_MMA(0, 1, At, B1); PG8_BAR;
            PG8_LDA(At, 0, 1); PG8_STAGE(PG8_SA(0, 0), a2, voffA);
            PG8_BAR; PG8_WAIT_L(0); PG8_MMA(1, 0, At, B0); PG8_BAR; PG8_SCHED;
            PG8_STAGE(PG8_SB(0, 1), b2 + hstepB, voffB);
            PG8_WAIT_V(6); PG8_BAR; PG8_MMA(1, 1, At, B1); PG8_BAR;
            PG8_LDB(B0, 1, 0); PG8_SCHED; PG8_LDA(At, 1, 0); PG8_STAGE(PG8_SA(0, 1), a2 + hstepA, voffA);
            PG8_WAIT_L(8); PG8_BAR; PG8_WAIT_L(0); PG8_MMA(0, 0, At, B0); PG8_BAR; PG8_SCHED;
            PG8_LDB(B1, 1, 1); PG8_STAGE(PG8_SB(1, 0), b3, voffB);
            PG8_BAR; PG8_WAIT_L(0); PG8_MMA(0, 1, At, B1); PG8_BAR;
            PG8_LDA(At, 1, 1); PG8_STAGE(PG8_SA(1, 0), a3, voffA);
            PG8_BAR; PG8_WAIT_L(0); PG8_MMA(1, 0, At, B0); PG8_BAR; PG8_SCHED;
            PG8_STAGE(PG8_SB(1, 1), b3 + hstepB, voffB);
            PG8_WAIT_V(6); PG8_BAR; PG8_MMA(1, 1, At, B1); PG8_BAR;
            }
        }
        if constexpr (ALIGN_EPI) { if (wr == 0) PG8_BAR; }
        E(acc, cur, wr, wc, fr, fq);
        S.done(cur, lane);
        if (!has_next) break;
#pragma unroll
        for (int a = 0; a < 2; ++a)
#pragma unroll
            for (int b = 0; b < 2; ++b)
#pragma unroll
                for (int m = 0; m < 4; ++m)
#pragma unroll
                    for (int n = 0; n < 2; ++n) acc[a][b][m][n] = (f32x4){0.f, 0.f, 0.f, 0.f};
        cur = nxt; cA = nA; cB = nB; ++ui; nt = S.ktiles(g, cur);
        if constexpr (GATHER) { vo0[0] = nvo0[0]; vo0[1] = nvo0[1]; vo1[0] = nvo1[0]; vo1[1] = nvo1[1]; }
        if constexpr (ALIGN_EPI) { if (wr == 1) PG8_BAR; }
    }
    PG8_WAIT_V(0);
    if constexpr (!ALIGN_EPI) { if (wr == 0) PG8_BAR; }
    PG8_BAR;
#undef PG8_SA
#undef PG8_SB
#undef PG8_STAGE
#undef PG8_LDA
#undef PG8_STAGEA
#undef PG8_GOFF
#undef PG8_LDB
#undef PG8_MMA
#undef PG8_WAIT_V
#undef PG8_WAIT_L
#undef PG8_BAR
#undef PG8_SCHED
}
}

#define XB_TMO      128
#define XB_XCNT(j)  (256  + 64 * (j))
#define XB_XSUB(j)  (1280 + 64 * (j))
#define XB_XGEN(j)  (2304 + 64 * (j))
#define XB_TOP      3328
#define XB_TOPGEN   3392
#define XCD_BAR_WORDS 3456
#define XB_SPIN_CAP (1u << 18)
__device__ __forceinline__ unsigned xb_ld(unsigned* p)              { return __hip_atomic_load(p, __ATOMIC_RELAXED, __HIP_MEMORY_SCOPE_AGENT); }
__device__ __forceinline__ unsigned xb_add(unsigned* p, unsigned v) { return __hip_atomic_fetch_add(p, v, __ATOMIC_RELAXED, __HIP_MEMORY_SCOPE_AGENT); }
__device__ __forceinline__ unsigned xb_xcc_id() { return (unsigned)__builtin_amdgcn_s_getreg((3 << 11) | 20) & 0xFu; }
#define XB_SPIN(cond, bar) do { unsigned _sp = 0; while (cond) { __builtin_amdgcn_s_sleep(1); \
    if ((++_sp & 255u) == 0u) { if (xb_ld(&(bar)[XB_TMO])) break; if (_sp > XB_SPIN_CAP) { atomicAdd(&(bar)[XB_TMO], 1u); break; } } } } while (0)
struct XcdBarrier { unsigned* bar; unsigned x; volatile LAS unsigned* st; };
__device__ __forceinline__ XcdBarrier xcd_barrier_post(unsigned* bar, volatile LAS unsigned* st) {
    XcdBarrier b; b.bar = bar; b.x = xb_xcc_id(); b.st = st;
    if (threadIdx.x == 0) (void)xb_add(&bar[XB_XCNT(b.x)], 1u);
    return b;
}
__device__ __forceinline__ void xcd_barrier_complete(unsigned* bar, unsigned x, unsigned& nloc, unsigned& nx) {
    const unsigned G = gridDim.x * gridDim.y * gridDim.z;
    unsigned sum, cnt, mine, sp = 0u;
    for (;;) {
        sum = 0u; cnt = 0u; mine = 0u;
#pragma unroll
        for (unsigned j = 0; j < 16; ++j) { const unsigned c = xb_ld(&bar[XB_XCNT(j)]); sum += c; cnt += (c > 0u) ? 1u : 0u; mine = (j == x) ? c : mine; }
        if (sum == G) break;
        __builtin_amdgcn_s_sleep(1);
        if ((++sp & 255u) == 0u) { if (xb_ld(&bar[XB_TMO])) break; if (sp > XB_SPIN_CAP) { atomicAdd(&bar[XB_TMO], 1u); break; } }
    }
    nloc = mine > 0u ? mine : 1u; nx = cnt > 0u ? cnt : 1u;
}
__device__ __forceinline__ void xcd_barrier(const XcdBarrier& b) {
    asm volatile("s_waitcnt vmcnt(0)" ::: "memory");
    __syncthreads();
    if (threadIdx.x == 0) {
        unsigned* bar = b.bar;
        __builtin_amdgcn_s_waitcnt(0);
        unsigned nloc = b.st[0], nx = b.st[1];
        if (nloc == 0u) { xcd_barrier_complete(bar, b.x, nloc, nx); b.st[0] = nloc; b.st[1] = nx; }
        const unsigned old = xb_add(&bar[XB_XSUB(b.x)], 1u);
        const unsigned gen = old / nloc;
        if (old + 1u == (gen + 1u) * nloc) {
            __builtin_amdgcn_fence(__ATOMIC_RELEASE, "agent");
            asm volatile("s_waitcnt vmcnt(0)" ::: "memory");
            const unsigned og = xb_add(&bar[XB_TOP], 1u);
            const unsigned tg = og / nx;
            if (og + 1u == (tg + 1u) * nx) xb_add(&bar[XB_TOPGEN], 1u);
            else XB_SPIN(xb_ld(&bar[XB_TOPGEN]) == tg, bar);
            __builtin_amdgcn_fence(__ATOMIC_ACQUIRE, "agent");
            xb_add(&bar[XB_XGEN(b.x)], 1u);
            asm volatile("s_waitcnt vmcnt(0)" ::: "memory");
        } else {
            XB_SPIN(xb_ld(&bar[XB_XGEN(b.x)]) == gen, bar);
            __builtin_amdgcn_fence(__ATOMIC_ACQUIRE, "agent");
            asm volatile("s_waitcnt vmcnt(0)" ::: "memory");
        }
    }
    __syncthreads();
}

struct Args {
    const float* x; const float* c; const float* ada_w; const float* ada_b; const float* mix_g; const float* ffn_g; const float* w_in;
    const float* da_lambda; const float* da_subln; const float* na_rpb; const float* wpa; const float* wpn; const float* wpd; const float* w_out;
    const float* rgw; const float* rgb; const float* rew; const float* reb; const float* ew1; const float* ew3; const float* ew2; const float* fin_g;
    float* out; unsigned char* ws; int ph_lo, ph_hi; int variant, pad;
};

__device__ const double ROPE_INV[32] = {
    1.0, 0.7498942093324559, 0.5623413251903491, 0.4216965034285822, 0.31622776601683794, 0.23713737056616552, 0.1778279410038923, 0.1333521432163324,
    0.1, 0.07498942093324558, 0.05623413251903491, 0.04216965034285822, 0.031622776601683794, 0.023713737056616554, 0.01778279410038923, 0.01333521432163324,
    0.01, 0.007498942093324558, 0.005623413251903491, 0.004216965034285822, 0.0031622776601683794, 0.0023713737056616554, 0.001778279410038923, 0.001333521432163324,
    0.001, 0.0007498942093324559, 0.0005623413251903491, 0.0004216965034285822, 0.00031622776601683794, 0.00023713737056616554, 0.0001778279410038923, 0.0001333521432163324};

__device__ __forceinline__ void sincos_d(double a, float& s, float& c) {
    const double k = __builtin_rint(a * 0.6366197723675814);
    double t = __builtin_fma(-k, 1.5707963267948966, a); t = __builtin_fma(-k, 6.123233995736766e-17, t);
    const double t2 = t * t;
    double sp = -1.0 / 1307674368000.0; sp = sp * t2 + 1.0 / 6227020800.0; sp = sp * t2 - 1.0 / 39916800.0; sp = sp * t2 + 1.0 / 362880.0; sp = sp * t2 - 1.0 / 5040.0; sp = sp * t2 + 1.0 / 120.0; sp = sp * t2 - 1.0 / 6.0; sp = sp * t2 + 1.0; sp *= t;
    double cp = 1.0 / 87178291200.0; cp = cp * t2 - 1.0 / 479001600.0; cp = cp * t2 + 1.0 / 3628800.0; cp = cp * t2 - 1.0 / 40320.0; cp = cp * t2 + 1.0 / 720.0; cp = cp * t2 - 1.0 / 24.0; cp = cp * t2 + 0.5; cp = 1.0 - cp * t2;
    const int q = ((int)k) & 3;
    const double ss = (q == 0) ? sp : (q == 1) ? cp : (q == 2) ? -sp : -cp;
    const double cc = (q == 0) ? cp : (q == 1) ? -sp : (q == 2) ? -cp : sp;
    s = (float)ss; c = (float)cc;
}

__device__ __forceinline__ int dst_row(int mode, int n) {
    if (mode == 1) { const bool rot = (n < 1024) || (n >= ZQD && n < ZVD); if (rot) { const int j = n & 63; return (n & ~63) + ((j & 31) << 1) + (j >> 5); } return n; }
    if (mode == 2) return 256 * (n >> 7) + (n & 127);
    if (mode == 3) return 256 * (n >> 7) + 128 + (n & 127);
    return n;
}
template <int UNR>
__device__ __forceinline__ void tr_item(const float* W, int N, bf16_t* WT, int ldt, int koff, int mode, LAS float* scr, int item, int lane) {
    const int nblk = N / 32, kb = item / nblk, nb = item % nblk, k0 = 64 * kb, n0 = 32 * nb;
    if constexpr (UNR == 32) {
        float v[32];
#pragma unroll
        for (int i = 0; i < 32; ++i) { const int kk = 2 * i + (lane >> 5); v[i] = __builtin_nontemporal_load(&W[(size_t)(k0 + kk) * N + n0 + (lane & 31)]); }
        __builtin_amdgcn_sched_barrier(0); asm volatile("" ::: "memory"); __builtin_amdgcn_sched_barrier(0);
#pragma unroll
        for (int i = 0; i < 32; ++i) { const int kk = 2 * i + (lane >> 5); scr[kk * 33 + (lane & 31)] = v[i]; }
    } else {
#pragma unroll UNR
    for (int i = 0; i < 32; ++i) { const int kk = 2 * i + (lane >> 5); scr[kk * 33 + (lane & 31)] = __builtin_nontemporal_load(&W[(size_t)(k0 + kk) * N + n0 + (lane & 31)]); }
    }
    LDS_WAIT();
    const int c = lane & 7;
#pragma unroll
    for (int j = 0; j < 4; ++j) { const int n = (lane >> 3) + 8 * j; const LAS float* s = scr + (8 * c) * 33 + n;
        float f = 1.0f; if (mode == 1) { const int nn = n0 + n; f = (nn < ZKA || (nn >= ZQN && nn < ZKN) || (nn >= ZQD && nn < ZKD)) ? C2 : (nn >= ZG ? -LOG2E : 1.0f); }
        u32x4 o; o.x = cvt_pk_bf16(s[0 * 33] * f, s[1 * 33] * f); o.y = cvt_pk_bf16(s[2 * 33] * f, s[3 * 33] * f); o.z = cvt_pk_bf16(s[4 * 33] * f, s[5 * 33] * f); o.w = cvt_pk_bf16(s[6 * 33] * f, s[7 * 33] * f);
        __builtin_nontemporal_store(o, (u32x4*)(WT + (size_t)dst_row(mode, n0 + n) * ldt + koff + k0 + 8 * c)); }
    LDS_WAIT();
}

constexpr int CV_WIN = 16 * 240, CV_PA = 8 * 32, CV_PN = 4 * 32, CV_WO = 16 * 32, CV_E = 256, CV_PER_L = CV_WIN + CV_PA + 2 * CV_PN + CV_WO + NEXP * 3 * CV_E;
#ifndef CV_NDEF
#define CV_NDEF 8192
#endif
template <int UNR>
__device__ __forceinline__ void conv_item(const Args& args, int l, int r, bf16_t* WIN, bf16_t* WPR, bf16_t* WOU, bf16_t* W13, bf16_t* W2, LAS float* scr, int lane) {
    if (r < CV_WIN) { tr_item<UNR>(args.w_in + (size_t)l * D * ZW, ZW, WIN + (size_t)l * ZW * D, D, 0, 1, scr, r, lane); return; } r -= CV_WIN;
    if (r < CV_PA) { tr_item<UNR>(args.wpa + (size_t)l * 512 * D, D, WPR + (size_t)l * D * D, D, 0, 0, scr, r, lane); return; } r -= CV_PA;
    if (r < CV_PN) { tr_item<UNR>(args.wpn + (size_t)l * 256 * D, D, WPR + (size_t)l * D * D, D, 512, 0, scr, r, lane); return; } r -= CV_PN;
    if (r < CV_PN) { tr_item<UNR>(args.wpd + (size_t)l * 256 * D, D, WPR + (size_t)l * D * D, D, 768, 0, scr, r, lane); return; } r -= CV_PN;
    if (r < CV_WO) { tr_item<UNR>(args.w_out + (size_t)l * D * D, D, WOU + (size_t)l * D * D, D, 0, 0, scr, r, lane); return; } r -= CV_WO;
    const int e = r / (3 * CV_E), q = r % (3 * CV_E); const size_t le = (size_t)l * NEXP + e;
    if (q < CV_E) tr_item<UNR>(args.ew1 + le * D * EH, EH, W13 + le * 1024 * D, D, 0, 2, scr, q, lane);
    else if (q < 2 * CV_E) tr_item<UNR>(args.ew3 + le * D * EH, EH, W13 + le * 1024 * D, D, 0, 3, scr, q - CV_E, lane);
    else tr_item<UNR>(args.ew2 + le * EH * D, D, W2 + le * D * EH, EH, 0, 0, scr, q - 2 * CV_E, lane);
}

__device__ __forceinline__ float max3f(float a, float b, float c) { float r; asm("v_max3_f32 %0, %1, %2, %3" : "=v"(r) : "v"(a), "v"(b), "v"(c)); return r; }
__device__ __forceinline__ int crow(int r, int hi) { return (r & 3) + 8 * (r >> 2) + 4 * hi; }
__device__ __forceinline__ float swapmax(float m) { float a = m, b = m; swap32(a, b); return __builtin_fmaxf(a, b); }
__device__ __forceinline__ float swapsum(float m) { float a = m, b = m; swap32(a, b); return a + b; }
typedef short v4i16_t __attribute__((ext_vector_type(4)));
__device__ __forceinline__ s16x4 vtr(const LAS unsigned char* p) { return __builtin_bit_cast(s16x4, __builtin_amdgcn_ds_read_tr16_b64_v4i16((LAS v4i16_t*)p)); }

template <int DV> struct AttnCfg { static constexpr int ND = DV / 32, NCH = DV / 16, VST = DV * 2 + 64; };

template <int DV> struct TileRegs { u32x4 kr[4]; u32x4 vr[4]; };
template <int DV>
__device__ __forceinline__ void tile_load(TileRegs<DV>& T, const char* zb, const unsigned (&roff)[4], unsigned kcol, unsigned vcol) {
    const unsigned cb = 16u * (threadIdx.x & 7);
#pragma unroll
    for (int i = 0; i < 4; ++i) { T.kr[i] = *(const u32x4*)(zb + (size_t)(roff[i] + kcol + cb)); T.vr[i] = *(const u32x4*)(zb + (size_t)(roff[i] + vcol + cb)); }
}
__device__ __forceinline__ float max16m(const f32x16& p, float m) { float a, b;
    asm("v_max3_f32 %0, %2, %3, %4\n\tv_max3_f32 %1, %5, %6, %7\n\tv_max3_f32 %0, %0, %8, %9\n\tv_max3_f32 %1, %1, %10, %11\n\tv_max3_f32 %0, %0, %12, %13\n\tv_max3_f32 %1, %1, %14, %15\n\t"
        "v_max3_f32 %0, %0, %16, %17\n\tv_max3_f32 %0, %0, %1, %18"
        : "=&v"(a), "=&v"(b) : "v"(p[0]), "v"(p[1]), "v"(p[2]), "v"(p[3]), "v"(p[4]), "v"(p[5]), "v"(p[6]), "v"(p[7]), "v"(p[8]), "v"(p[9]), "v"(p[10]), "v"(p[11]), "v"(p[12]), "v"(p[13]), "v"(p[14]), "v"(p[15]), "v"(m));
    return a; }
template <int DV, class MaskF, class Reload>
__device__ __forceinline__ void attn_tile(f32x16 (&o)[DV / 32], float& m, float& l, const bf16x8 (&qf)[4], TileRegs<DV>& T,
                                          LAS unsigned char* vlds, LAS float* wsf, const MaskF& maskf, const Reload& reload, int lane, int hi) {
    constexpr int ND = AttnCfg<DV>::ND, VST = AttnCfg<DV>::VST, KST = 144;
    static_assert(DV == 64, "gather tiles are 64 wide");
    CBAR();
    { LAS unsigned char* kw = vlds + 6144 + (lane >> 3) * KST + (lane & 7) * 16; LAS unsigned char* vw = vlds + (lane >> 3) * VST + (lane & 7) * 16;
#pragma unroll
      for (int i = 0; i < 4; ++i) { *(LAS u32x4*)(kw + 8 * i * KST) = T.kr[i]; *(LAS u32x4*)(vw + 8 * i * VST) = T.vr[i]; } }
    CBAR();
    reload(T);
    f32x16 p; maskf(p);
    { const LAS unsigned char* kp = vlds + 6144 + (lane & 31) * KST + hi * 16;
#pragma unroll
      for (int d0 = 0; d0 < 4; ++d0) { const bf16x8 kf = *(const LAS bf16x8*)(kp + 32 * d0); p = __builtin_amdgcn_mfma_f32_32x32x16_bf16(kf, qf[d0], p, 0, 0, 0); } }
    asm volatile("s_nop 15\n\ts_nop 7" : "+v"(p));
    float mx = max16m(p, m);
    { float a = mx, b = mx; swap32(a, b); mx = max3f(a, b, m); }
    const float mn = (mx > m + RESCALE_THR) ? mx : m;
    const float alpha = fexp2(m - mn);
    m = mn;
    float rs = 0.f;
#pragma unroll
    for (int r = 0; r < 16; ++r) { p[r] = fexp2(p[r] - mn); rs += p[r]; }
    l = l * alpha + rs;
    if (__any(alpha != 1.0f)) {
        CBAR();
        if (hi == 0) wsf[lane & 31] = alpha;
        CBAR();
#pragma unroll
        for (int g4 = 0; g4 < 4; ++g4) { const f32x4 a4 = *(const LAS f32x4*)(wsf + 8 * g4 + 4 * hi);
#pragma unroll
            for (int d0 = 0; d0 < ND; ++d0) { o[d0][4 * g4 + 0] *= a4[0]; o[d0][4 * g4 + 1] *= a4[1]; o[d0][4 * g4 + 2] *= a4[2]; o[d0][4 * g4 + 3] *= a4[3]; } }
        CBAR();
    }
    CBAR();
    u32x4 pw0, pw1;
    pw0.x = cvtpk_s(p[0], p[1]); pw0.y = cvtpk_s(p[2], p[3]); pw0.z = cvtpk_s(p[4], p[5]); pw0.w = cvtpk_s(p[6], p[7]);
    pw1.x = cvtpk_s(p[8], p[9]); pw1.y = cvtpk_s(p[10], p[11]); pw1.z = cvtpk_s(p[12], p[13]); pw1.w = cvtpk_s(p[14], p[15]);
    const bf16x8 pa0 = __builtin_bit_cast(bf16x8, pw0), pa1 = __builtin_bit_cast(bf16x8, pw1);
    const int li = lane & 15, g16 = lane >> 4;
    const LAS unsigned char* vb = vlds + (4 * hi + (li >> 2)) * VST + (16 * (g16 & 1) + 4 * (li & 3)) * 2;
    s16x4 vlo[2][ND], vhi[2][ND];
#pragma unroll
    for (int s = 0; s < 2; ++s)
#pragma unroll
        for (int d0 = 0; d0 < ND; ++d0) { vlo[s][d0] = vtr(vb + (16 * s) * VST + d0 * 64); vhi[s][d0] = vtr(vb + (16 * s + 8) * VST + d0 * 64); }
    __builtin_amdgcn_sched_barrier(0);
#pragma unroll
    for (int s = 0; s < 2; ++s)
#pragma unroll
        for (int d0 = 0; d0 < ND; ++d0) {
            const bf16x8 vf = (bf16x8){vlo[s][d0][0], vlo[s][d0][1], vlo[s][d0][2], vlo[s][d0][3], vhi[s][d0][0], vhi[s][d0][1], vhi[s][d0][2], vhi[s][d0][3]};
            o[d0] = __builtin_amdgcn_mfma_f32_32x32x16_bf16(s == 0 ? pa0 : pa1, vf, o[d0], 0, 0, 0);
        }
    CBAR();
}
template <int ND>
__device__ __forceinline__ void attn_finish(f32x16 (&o)[ND], float l, LAS float* wsf, int lane, int hi) {
    const float inv = frcp(swapsum(l));
    CBAR();
    if (hi == 0) wsf[lane & 31] = inv;
    CBAR();
#pragma unroll
    for (int g4 = 0; g4 < 4; ++g4) { const f32x4 a4 = *(const LAS f32x4*)(wsf + 8 * g4 + 4 * hi);
#pragma unroll
        for (int d0 = 0; d0 < ND; ++d0) { o[d0][4 * g4 + 0] *= a4[0]; o[d0][4 * g4 + 1] *= a4[1]; o[d0][4 * g4 + 2] *= a4[2]; o[d0][4 * g4 + 3] *= a4[3]; } }
    CBAR();
}

__device__ __forceinline__ void glds16s(const void* sbase, unsigned voff, unsigned lds_dst) { unsigned keep;
    asm volatile("s_mov_b32 %0, m0\n\ts_mov_b32 m0, %2\n\ts_nop 0\n\tglobal_load_lds_dwordx4 %1, %3\n\ts_mov_b32 m0, %0" : "=&s"(keep) : "v"(voff), "s"(lds_dst), "s"(sbase) : "memory"); }
__device__ __forceinline__ void glds16(const void* gsrc, unsigned lds_dst) { unsigned keep;
    asm volatile("s_mov_b32 %0, m0\n\ts_mov_b32 m0, %2\n\ts_nop 0\n\tglobal_load_lds_dwordx4 %1, off\n\ts_mov_b32 m0, %0" : "=&s"(keep) : "v"(gsrc), "s"(lds_dst) : "memory"); }
__device__ __forceinline__ void diff_qk(f32x16& p0, f32x16& p1, const LAS unsigned char* qlds, const LAS unsigned char* kb, int lane, int hi) {
    const int r32 = lane & 31, sw = (r32 >> 1) & 7;
    const LAS unsigned char* kp = kb + r32 * 128;
    p0 = f32x16{}; p1 = f32x16{};
#pragma unroll
    for (int d0 = 0; d0 < 4; ++d0) {
        const bf16x8 q = *(const LAS bf16x8*)(qlds + d0 * 1024 + lane * 16);
        const int po = ((2 * d0 + hi) ^ sw) << 4;
        const bf16x8 k0 = *(const LAS bf16x8*)(kp + po), k1 = *(const LAS bf16x8*)(kp + po + 4096);
        p0 = __builtin_amdgcn_mfma_f32_32x32x16_bf16(k0, q, p0, 0, 0, 0);
        p1 = __builtin_amdgcn_mfma_f32_32x32x16_bf16(k1, q, p1, 0, 0, 0);
    }
}
__device__ __forceinline__ void diff_sm_pv(f32x16 (&o)[4], float& m, float& l, f32x16& p0, f32x16& p1, const LAS unsigned char* vbuf, LAS float* wsf, int lane, int hi) {
    const int r32 = lane & 31;
    float ma = max3f(p0[0], p0[1], p1[0]), mb = max3f(p0[2], p0[3], p1[1]); ma = max3f(ma, p1[2], p1[3]);
#pragma unroll
    for (int r = 4; r < 16; r += 4) { ma = max3f(ma, p0[r], p0[r + 1]); mb = max3f(mb, p0[r + 2], p0[r + 3]); ma = max3f(ma, p1[r], p1[r + 1]); mb = max3f(mb, p1[r + 2], p1[r + 3]); }
    float mx = max3f(ma, mb, m);
    { float a = mx, b = mx; swap32(a, b); mx = max3f(a, b, m); }
    const float mn = (mx > m + RESCALE_THR) ? mx : m;
    const float alpha = fexp2(m - mn);
    m = mn;
    float rs = 0.f;
#pragma unroll
    for (int r = 0; r < 16; ++r) { p0[r] = fexp2(p0[r] - mn); p1[r] = fexp2(p1[r] - mn); rs += p0[r] + p1[r]; }
    l = l * alpha + rs;
    if (__any(alpha != 1.0f)) {
        CBAR();
        if (hi == 0) wsf[r32] = alpha;
        CBAR();
#pragma unroll
        for (int g4 = 0; g4 < 4; ++g4) { const f32x4 a4 = *(const LAS f32x4*)(wsf + 8 * g4 + 4 * hi);
#pragma unroll
            for (int d0 = 0; d0 < 4; ++d0) { o[d0][4 * g4 + 0] *= a4[0]; o[d0][4 * g4 + 1] *= a4[1]; o[d0][4 * g4 + 2] *= a4[2]; o[d0][4 * g4 + 3] *= a4[3]; } }
        CBAR();
    }
    u32x4 pw[4];
#pragma unroll
    for (int i = 0; i < 4; ++i) { pw[0][i] = cvtpk_s(p0[2 * i], p0[2 * i + 1]); pw[1][i] = cvtpk_s(p0[8 + 2 * i], p0[9 + 2 * i]); pw[2][i] = cvtpk_s(p1[2 * i], p1[2 * i + 1]); pw[3][i] = cvtpk_s(p1[8 + 2 * i], p1[9 + 2 * i]); }
    const int li = lane & 15, g16 = lane >> 4;
    const LAS unsigned char* vp = vbuf + hi * 1024 + (li >> 2) * 64 + (16 * (g16 & 1) + 4 * (li & 3)) * 2;
#pragma unroll
    for (int s4 = 0; s4 < 4; ++s4) {
        const bf16x8 pa = __builtin_bit_cast(bf16x8, pw[s4]);
#pragma unroll
        for (int d0 = 0; d0 < 4; ++d0) {
            const s16x4 lo = vtr(vp + s4 * 4096 + d0 * 256), hh = vtr(vp + s4 * 4096 + 2048 + d0 * 256);
            const bf16x8 vf = (bf16x8){lo[0], lo[1], lo[2], lo[3], hh[0], hh[1], hh[2], hh[3]};
            o[d0] = __builtin_amdgcn_mfma_f32_32x32x16_bf16(pa, vf, o[d0], 0, 0, 0);
        }
    }
}

__device__ __forceinline__ void diff_sm(f32x16 (&o)[4], float& m, float& l, f32x16& p0, f32x16& p1, u32x4 (&pw)[4], LAS float* wsf, int lane, int hi) {
    const int r32 = lane & 31;
    float ma = max3f(p0[0], p0[1], p1[0]), mb = max3f(p0[2], p0[3], p1[1]); ma = max3f(ma, p1[2], p1[3]);
#pragma unroll
    for (int r = 4; r < 16; r += 4) { ma = max3f(ma, p0[r], p0[r + 1]); mb = max3f(mb, p0[r + 2], p0[r + 3]); ma = max3f(ma, p1[r], p1[r + 1]); mb = max3f(mb, p1[r + 2], p1[r + 3]); }
    float mx = max3f(ma, mb, m);
    { float a = mx, b = mx; swap32(a, b); mx = max3f(a, b, m); }
    const float mn = (mx > m + RESCALE_THR) ? mx : m;
    const float alpha = fexp2(m - mn);
    m = mn;
    float rs = 0.f;
#pragma unroll
    for (int r = 0; r < 16; ++r) { p0[r] = fexp2(p0[r] - mn); p1[r] = fexp2(p1[r] - mn); rs += p0[r] + p1[r]; }
    l = l * alpha + rs;
    if (__any(alpha != 1.0f)) {
        CBAR();
        if (hi == 0) wsf[r32] = alpha;
        CBAR();
#pragma unroll
        for (int g4 = 0; g4 < 4; ++g4) { const f32x4 a4 = *(const LAS f32x4*)(wsf + 8 * g4 + 4 * hi);
#pragma unroll
            for (int d0 = 0; d0 < 4; ++d0) { o[d0][4 * g4 + 0] *= a4[0]; o[d0][4 * g4 + 1] *= a4[1]; o[d0][4 * g4 + 2] *= a4[2]; o[d0][4 * g4 + 3] *= a4[3]; } }
        CBAR();
    }
#pragma unroll
    for (int i = 0; i < 4; ++i) { pw[0][i] = cvtpk_s(p0[2 * i], p0[2 * i + 1]); pw[1][i] = cvtpk_s(p0[8 + 2 * i], p0[9 + 2 * i]); pw[2][i] = cvtpk_s(p1[2 * i], p1[2 * i + 1]); pw[3][i] = cvtpk_s(p1[8 + 2 * i], p1[9 + 2 * i]); }
}
__device__ __forceinline__ void diff_pv2(f32x16 (&o0)[4], f32x16 (&o1)[4], const u32x4 (&pw0)[4], const u32x4 (&pw1)[4], const LAS unsigned char* vbuf, int lane_, int hi_) {
    int lane = lane_; asm volatile("" : "+v"(lane));
    const int hi = lane >> 5; (void)hi_;
    const int li = lane & 15, g16 = lane >> 4;
    const LAS unsigned char* vp = vbuf + hi * 1024 + (li >> 2) * 64 + (16 * (g16 & 1) + 4 * (li & 3)) * 2;
    __builtin_amdgcn_s_setprio(1);
#pragma unroll
    for (int s4 = 0; s4 < 4; ++s4) {
        const bf16x8 pa0 = __builtin_bit_cast(bf16x8, pw0[s4]), pa1 = __builtin_bit_cast(bf16x8, pw1[s4]);
#pragma unroll
        for (int d0 = 0; d0 < 4; ++d0) {
            const s16x4 lo = vtr(vp + s4 * 4096 + d0 * 256), hh = vtr(vp + s4 * 4096 + 2048 + d0 * 256);
            const bf16x8 vf = (bf16x8){lo[0], lo[1], lo[2], lo[3], hh[0], hh[1], hh[2], hh[3]};
            o0[d0] = __builtin_amdgcn_mfma_f32_32x32x16_bf16(pa0, vf, o0[d0], 0, 0, 0);
            o1[d0] = __builtin_amdgcn_mfma_f32_32x32x16_bf16(pa1, vf, o1[d0], 0, 0, 0);
        }
    }
    __builtin_amdgcn_s_setprio(0);
}
__device__ __forceinline__ void diff_qk_f(f32x16& p0, f32x16& p1, const LAS unsigned char* qlds, const LAS unsigned char* kb, const LAS unsigned char* ap, const LAS unsigned char* bp, int lane_, int hi_) {
    int lane = lane_; asm volatile("" : "+v"(lane));
    const int hi = lane >> 5; (void)hi_;
    const int r32 = lane & 31, sw = (r32 >> 1) & 7;
    const LAS unsigned char* kp = kb + r32 * 128;
    { const bf16x8 a1 = *(const LAS bf16x8*)ap, bm = *(const LAS bf16x8*)bp;
      p0 = __builtin_amdgcn_mfma_f32_32x32x16_bf16(a1, bm, f32x16{}, 0, 0, 0);
      p1 = __builtin_amdgcn_mfma_f32_32x32x16_bf16(a1, bm, f32x16{}, 0, 0, 0); }
#pragma unroll
    for (int d0 = 0; d0 < 4; ++d0) {
        const bf16x8 q = *(const LAS bf16x8*)(qlds + d0 * 1024 + lane * 16);
        const int po = ((2 * d0 + hi) ^ sw) << 4;
        const bf16x8 k0 = *(const LAS bf16x8*)(kp + po), k1 = *(const LAS bf16x8*)(kp + po + 4096);
        p0 = __builtin_amdgcn_mfma_f32_32x32x16_bf16(k0, q, p0, 0, 0, 0);
        p1 = __builtin_amdgcn_mfma_f32_32x32x16_bf16(k1, q, p1, 0, 0, 0);
    }
}
__device__ __forceinline__ void diff_sm_head(f32x16 (&o)[4], float& m, float& l, f32x16& p0, f32x16& p1, LAS float* wsf, LAS unsigned char* bslot, bool first, int lane, int hi) {
    float ma = max3f(p0[0], p0[1], p1[0]), mb = max3f(p0[2], p0[3], p1[1]); ma = max3f(ma, p1[2], p1[3]);
#pragma unroll
    for (int r = 4; r < 16; r += 4) { ma = max3f(ma, p0[r], p0[r + 1]); mb = max3f(mb, p0[r + 2], p0[r + 3]); ma = max3f(ma, p1[r], p1[r + 1]); mb = max3f(mb, p1[r + 2], p1[r + 3]); }
    float mx = __builtin_fmaxf(ma, mb);
    { float a = mx, b = mx; swap32(a, b); mx = __builtin_fmaxf(a, b); }
    const bool up = first || (mx > RESCALE_THR);
    if (__any(up)) {
        const float mnew = up ? __builtin_bit_cast(float, f2bf(m + mx) << 16) : m, delta = mnew - m;
        const float alpha = fexp2(-delta);
        m = mnew; l *= alpha;
        CBAR();
        int l2 = lane; asm volatile("" : "+v"(l2));
        if (hi == 0) { wsf[l2 & 31] = alpha; *(LAS unsigned*)bslot = f2bf(-mnew); }
        CBAR();
#pragma unroll
        for (int g4 = 0; g4 < 4; ++g4) { const f32x4 a4 = *(const LAS f32x4*)(wsf + 8 * g4 + 4 * (l2 >> 5));
#pragma unroll
            for (int d0 = 0; d0 < 4; ++d0) { o[d0][4 * g4 + 0] *= a4[0]; o[d0][4 * g4 + 1] *= a4[1]; o[d0][4 * g4 + 2] *= a4[2]; o[d0][4 * g4 + 3] *= a4[3]; } }
#pragma unroll
        for (int r = 0; r < 16; ++r) { p0[r] -= delta; p1[r] -= delta; }
        CBAR();
    }
}
__device__ __forceinline__ void diff_sm_tail(float& l, f32x16& p0, f32x16& p1, u32x4 (&pw)[4]) {
    float rs = 0.f;
#pragma unroll
    for (int r = 0; r < 16; ++r) { p0[r] = fexp2(p0[r]); p1[r] = fexp2(p1[r]); rs += p0[r] + p1[r]; }
    l += rs;
#pragma unroll
    for (int i = 0; i < 4; ++i) { pw[0][i] = cvtpk_s(p0[2 * i], p0[2 * i + 1]); pw[1][i] = cvtpk_s(p0[8 + 2 * i], p0[9 + 2 * i]); pw[2][i] = cvtpk_s(p1[2 * i], p1[2 * i + 1]); pw[3][i] = cvtpk_s(p1[8 + 2 * i], p1[9 + 2 * i]); }
}
__device__ __forceinline__ void diff_tail_pv2(f32x16 (&o0)[4], f32x16 (&o1)[4], float& l0, float& l1, const f32x16& a0, const f32x16& a1, const f32x16& b0, const f32x16& b1, const LAS unsigned char* vbuf, int lane_) {
    int lane = lane_; asm volatile("" : "+v"(lane));
    const int hi = lane >> 5, li = lane & 15, g16 = lane >> 4;
    const LAS unsigned char* vp = vbuf + hi * 1024 + (li >> 2) * 64 + (16 * (g16 & 1) + 4 * (li & 3)) * 2;
    float rs0 = 0.f, rs1 = 0.f;
    u32x4 pa, pb, pan = {0u, 0u, 0u, 0u}, pbn = {0u, 0u, 0u, 0u};
#define TP_A(st, i) do { const int r_ = ((st) & 1) * 8 + 2 * (i); const float e0_ = fexp2((st) < 2 ? a0[r_] : a1[r_]), e1_ = fexp2((st) < 2 ? a0[r_ + 1] : a1[r_ + 1]); rs0 += e0_; rs0 += e1_; asm volatile("" : "+v"(rs0)); pan[i] = cvtpk_s(e0_, e1_); } while (0)
#define TP_B(st, i) do { const int r_ = ((st) & 1) * 8 + 2 * (i); const float e0_ = fexp2((st) < 2 ? b0[r_] : b1[r_]), e1_ = fexp2((st) < 2 ? b0[r_ + 1] : b1[r_ + 1]); rs1 += e0_; rs1 += e1_; asm volatile("" : "+v"(rs1)); pbn[i] = cvtpk_s(e0_, e1_); } while (0)
#pragma unroll
    for (int i = 0; i < 4; ++i) { TP_A(0, i); TP_B(0, i); }
    pa = pan; pb = pbn;
    s16x4 flo[3], fhh[3];
#define TP_RD(c) do { flo[(c) % 3] = vtr(vp + ((c) >> 2) * 4096 + ((c) & 3) * 256); fhh[(c) % 3] = vtr(vp + ((c) >> 2) * 4096 + 2048 + ((c) & 3) * 256); } while (0)
    TP_RD(0); TP_RD(1);
    __builtin_amdgcn_sched_barrier(0);
#pragma unroll
    for (int c = 0; c < 16; ++c) {
        const int st = c >> 2, d0 = c & 3;
        if (c + 2 < 16) TP_RD(c + 2);
        const bf16x8 vf = (bf16x8){flo[c % 3][0], flo[c % 3][1], flo[c % 3][2], flo[c % 3][3], fhh[c % 3][0], fhh[c % 3][1], fhh[c % 3][2], fhh[c % 3][3]};
        o0[d0] = __builtin_amdgcn_mfma_f32_32x32x16_bf16(__builtin_bit_cast(bf16x8, pa), vf, o0[d0], 0, 0, 0);
        if (st < 3) TP_A(st + 1, d0);
        __builtin_amdgcn_sched_barrier(0);
        o1[d0] = __builtin_amdgcn_mfma_f32_32x32x16_bf16(__builtin_bit_cast(bf16x8, pb), vf, o1[d0], 0, 0, 0);
        if (st < 3) TP_B(st + 1, d0);
        __builtin_amdgcn_sched_barrier(0);
        if (d0 == 3) { pa = pan; pb = pbn; }
    }
#undef TP_A
#undef TP_B
#undef TP_RD
    l0 += rs0; l1 += rs1;
}
__device__ __forceinline__ void hm_step(int k, float& ma, float& mb, const f32x16& p0, const f32x16& p1) {
    if (k == 0) ma = max3f(p0[0], p0[1], p1[0]);
    else if (k == 1) mb = max3f(p0[2], p0[3], p1[1]);
    else if (k == 2) ma = max3f(ma, p1[2], p1[3]);
    else { const int j = (k - 3) >> 2, w = (k - 3) & 3, r = 4 + 4 * j;
        if (w == 0) ma = max3f(ma, p0[r], p0[r + 1]); else if (w == 1) mb = max3f(mb, p0[r + 2], p0[r + 3]); else if (w == 2) ma = max3f(ma, p1[r], p1[r + 1]); else mb = max3f(mb, p1[r + 2], p1[r + 3]); }
}
__device__ __forceinline__ void hm_finish(f32x16 (&o)[4], float& m, float& l, float ma, float mb, f32x16& p0, f32x16& p1, LAS float* wsf, LAS unsigned char* bslot, bool first, int lane) {
    float mx = __builtin_fmaxf(ma, mb);
    { float a = mx, b = mx; swap32(a, b); mx = __builtin_fmaxf(a, b); }
    const bool up = first || (mx > RESCALE_THR);
    if (__any(up)) {
        const float mnew = up ? __builtin_bit_cast(float, f2bf(m + mx) << 16) : m, delta = mnew - m;
        const float alpha = fexp2(-delta);
        m = mnew; l *= alpha;
        CBAR();
        int l2 = lane; asm volatile("" : "+v"(l2));
        if ((l2 >> 5) == 0) { wsf[l2 & 31] = alpha; *(LAS unsigned*)bslot = f2bf(-mnew); }
        CBAR();
#pragma unroll
        for (int g4 = 0; g4 < 4; ++g4) { const f32x4 a4 = *(const LAS f32x4*)(wsf + 8 * g4 + 4 * (l2 >> 5));
#pragma unroll
            for (int d0 = 0; d0 < 4; ++d0) { o[d0][4 * g4 + 0] *= a4[0]; o[d0][4 * g4 + 1] *= a4[1]; o[d0][4 * g4 + 2] *= a4[2]; o[d0][4 * g4 + 3] *= a4[3]; } }
#pragma unroll
        for (int r = 0; r < 16; ++r) { p0[r] -= delta; p1[r] -= delta; }
        CBAR();
    }
}
__device__ __forceinline__ void diffA_step(f32x16 (&o0)[4], f32x16 (&o1)[4], float& m0, float& l0, float& m1, float& l1, const LAS unsigned char* qlds, const LAS unsigned char* kb0, const LAS unsigned char* kb1,
                                           const LAS unsigned char* vbuf, LAS unsigned char* bsel, LAS float* wsf, bool first, int lane_) {
    int lane = lane_; asm volatile("" : "+v"(lane));
    const int hi = lane >> 5;
    f32x16 s0, s1, s2, s3;
    diff_qk_f(s0, s1, qlds, kb0, bsel + 32, bsel, lane, hi);
#define SB() __builtin_amdgcn_sched_barrier(0)
    const int r32 = lane & 31, sw = (r32 >> 1) & 7;
    const LAS unsigned char* kp = kb1 + r32 * 128; const LAS unsigned char* qp = qlds + 4096 + lane * 16;
    float ma = 0.f, mb = 0.f, rs0 = 0.f, rs1 = 0.f;
    u32x4 pa, pb, pan, pbn;
#define TP_A(st, i) do { const int r_ = ((st) & 1) * 8 + 2 * (i); const float e0_ = fexp2((st) < 2 ? s0[r_] : s1[r_]), e1_ = fexp2((st) < 2 ? s0[r_ + 1] : s1[r_ + 1]); rs0 += e0_; rs0 += e1_; asm volatile("" : "+v"(rs0)); pan[i] = cvtpk_s(e0_, e1_); } while (0)
#define TP_B(st, i) do { const int r_ = ((st) & 1) * 8 + 2 * (i); const float e0_ = fexp2((st) < 2 ? s2[r_] : s3[r_]), e1_ = fexp2((st) < 2 ? s2[r_ + 1] : s3[r_ + 1]); rs1 += e0_; rs1 += e1_; asm volatile("" : "+v"(rs1)); pbn[i] = cvtpk_s(e0_, e1_); } while (0)
    {
        const bf16x8 a1 = *(const LAS bf16x8*)(bsel + 32), bm = *(const LAS bf16x8*)(bsel + 16);
        bf16x8 qf[2], k0f, k1f;
#define RD_Q(d0)  qf[(d0) & 1] = *(const LAS bf16x8*)(qp + (d0) * 1024)
#define RD_K0(d0) k0f = *(const LAS bf16x8*)(kp + (((2 * (d0) + hi) ^ sw) << 4))
#define RD_K1(d0) k1f = *(const LAS bf16x8*)(kp + (((2 * (d0) + hi) ^ sw) << 4) + 4096)
        RD_Q(0); RD_K0(0); RD_K1(0); RD_Q(1);
        SB();
        s2 = __builtin_amdgcn_mfma_f32_32x32x16_bf16(a1, bm, f32x16{}, 0, 0, 0);
        asm volatile("s_nop 7" : "+v"(s0), "+v"(s1));
        hm_step(0, ma, mb, s0, s1); hm_step(1, ma, mb, s0, s1);
        SB();
        s3 = __builtin_amdgcn_mfma_f32_32x32x16_bf16(a1, bm, f32x16{}, 0, 0, 0);
        hm_step(2, ma, mb, s0, s1); hm_step(3, ma, mb, s0, s1); hm_step(4, ma, mb, s0, s1);
        SB();
        s2 = __builtin_amdgcn_mfma_f32_32x32x16_bf16(k0f, qf[0], s2, 0, 0, 0);
        RD_K0(1);
        hm_step(5, ma, mb, s0, s1); hm_step(6, ma, mb, s0, s1); hm_step(7, ma, mb, s0, s1);
        SB();
        s3 = __builtin_amdgcn_mfma_f32_32x32x16_bf16(k1f, qf[0], s3, 0, 0, 0);
        RD_K1(1); RD_Q(2);
        hm_step(8, ma, mb, s0, s1); hm_step(9, ma, mb, s0, s1); hm_step(10, ma, mb, s0, s1);
        SB();
        s2 = __builtin_amdgcn_mfma_f32_32x32x16_bf16(k0f, qf[1], s2, 0, 0, 0);
        RD_K0(2);
        hm_step(11, ma, mb, s0, s1); hm_step(12, ma, mb, s0, s1);
        SB();
        s3 = __builtin_amdgcn_mfma_f32_32x32x16_bf16(k1f, qf[1], s3, 0, 0, 0);
        RD_K1(2); RD_Q(3);
        hm_step(13, ma, mb, s0, s1); hm_step(14, ma, mb, s0, s1);
        SB();
        hm_finish(o0, m0, l0, ma, mb, s0, s1, wsf, bsel, first, lane);
        SB();
        s2 = __builtin_amdgcn_mfma_f32_32x32x16_bf16(k0f, qf[0], s2, 0, 0, 0);
        RD_K0(3);
        TP_A(0, 0);
        SB();
        s3 = __builtin_amdgcn_mfma_f32_32x32x16_bf16(k1f, qf[0], s3, 0, 0, 0);
        RD_K1(3);
        TP_A(0, 1);
        SB();
        s2 = __builtin_amdgcn_mfma_f32_32x32x16_bf16(k0f, qf[1], s2, 0, 0, 0);
        TP_A(0, 2);
        SB();
        s3 = __builtin_amdgcn_mfma_f32_32x32x16_bf16(k1f, qf[1], s3, 0, 0, 0);
        TP_A(0, 3);
        SB();
#undef RD_Q
#undef RD_K0
#undef RD_K1
#define QK_RD(x)
#undef QK_RD
    }
    pa = pan;
    asm volatile("s_nop 15\n\ts_nop 7" : "+v"(s2), "+v"(s3));
    ma = 0.f; mb = 0.f;
#pragma unroll
    for (int k = 0; k < 15; ++k) hm_step(k, ma, mb, s2, s3);
    hm_finish(o1, m1, l1, ma, mb, s2, s3, wsf, bsel + 16, first, lane);
#pragma unroll
    for (int i = 0; i < 4; ++i) TP_B(0, i);
    pb = pbn;
    const int li = lane & 15, g16 = lane >> 4;
    const LAS unsigned char* vp = vbuf + hi * 1024 + (li >> 2) * 64 + (16 * (g16 & 1) + 4 * (li & 3)) * 2;
    s16x4 flo[3], fhh[3];
#define TP_RD(c) do { flo[(c) % 3] = vtr(vp + (((c) & 15) >> 2) * 4096 + ((c) & 3) * 256); fhh[(c) % 3] = vtr(vp + (((c) & 15) >> 2) * 4096 + 2048 + ((c) & 3) * 256); } while (0)
#define TP_VF(c) ((bf16x8){flo[(c) % 3][0], flo[(c) % 3][1], flo[(c) % 3][2], flo[(c) % 3][3], fhh[(c) % 3][0], fhh[(c) % 3][1], fhh[(c) % 3][2], fhh[(c) % 3][3]})
    TP_RD(0); TP_RD(1);
    SB();
#pragma unroll
    for (int c = 0; c < 16; ++c) {
        const int st = c >> 2, d0 = c & 3;
        if (c + 2 < 16) TP_RD(c + 2);
        o0[d0] = __builtin_amdgcn_mfma_f32_32x32x16_bf16(__builtin_bit_cast(bf16x8, pa), TP_VF(c), o0[d0], 0, 0, 0);
        if (st < 3) TP_A(st + 1, d0);
        SB();
        o1[d0] = __builtin_amdgcn_mfma_f32_32x32x16_bf16(__builtin_bit_cast(bf16x8, pb), TP_VF(c), o1[d0], 0, 0, 0);
        if (st < 3) TP_B(st + 1, d0);
        SB();
        if (d0 == 3) { pa = pan; pb = pbn; }
    }
#undef TP_A
#undef TP_B
#undef TP_RD
#undef TP_VF
#undef SB
    l0 += rs0; l1 += rs1;
}
struct NoMask { __device__ __forceinline__ void operator()(f32x16&) const {} };

using pg8::Unit;
struct EpiZ {
    static constexpr bool PERM = true;
    bf16_t* Z; const float* ropec; const float* ropes;
    __device__ __forceinline__ void operator()(const f32x4 (&acc)[2][2][4][2], const Unit& u, int wr, int wc, int fr, int fq) const {
        const int pn = u.pn;
        const int type = (pn < 2) ? 0 : (pn < 4) ? 1 : (pn < 6) ? 2 : (pn == 6) ? 3 : (pn < 9) ? 2 : (pn < 12) ? 0 : (pn < 15) ? 1 : (pn < 18) ? 2 : 4;
        const int row0 = u.pm * 256 + wr * 64 + fr, col0 = pn * 256 + wc * 32 + 8 * fq;
        const int j0 = 16 * (wc & 1) + 4 * fq;
#pragma unroll
        for (int ai = 0; ai < 2; ++ai) {
            f32x4 cq[4], sq[4];
#pragma unroll
            for (int m = 0; m < 4; ++m) { const int pos = (row0 + ai * 128 + m * 16) & (SEQ - 1); cq[m] = (f32x4){1.f, 1.f, 1.f, 1.f}; sq[m] = (f32x4){0.f, 0.f, 0.f, 0.f};
                if (type < 2) { cq[m] = *(const f32x4*)(ropec + pos * 32 + j0); sq[m] = *(const f32x4*)(ropes + pos * 32 + j0); } }
#pragma unroll
            for (int m = 0; m < 4; ++m) {
                const int row = row0 + ai * 128 + m * 16;
                const f32x4 c4 = cq[m], s4 = sq[m];
                bf16_t* rowp = Z + (size_t)row * ZW + col0;
#pragma unroll
                for (int bj = 0; bj < 2; ++bj) {
                    f32x4 v0 = acc[ai][bj][m][0], v1 = acc[ai][bj][m][1];
                    if (type < 2) {
                        f32x4 w0, w1;
                        w0[0] = v0[0] * c4[0] - v0[1] * s4[0]; w0[1] = v0[1] * c4[0] + v0[0] * s4[0];
                        w0[2] = v0[2] * c4[1] - v0[3] * s4[1]; w0[3] = v0[3] * c4[1] + v0[2] * s4[1];
                        w1[0] = v1[0] * c4[2] - v1[1] * s4[2]; w1[1] = v1[1] * c4[2] + v1[0] * s4[2];
                        w1[2] = v1[2] * c4[3] - v1[3] * s4[3]; w1[3] = v1[3] * c4[3] + v1[2] * s4[3];
                        v0 = w0; v1 = w1;
                    }
                    if (type == 4) {
#pragma unroll
                        for (int j = 0; j < 4; ++j) { v0[j] = __builtin_fmaxf(frcp(1.f + fexp2(v0[j])), 0.f); v1[j] = __builtin_fmaxf(frcp(1.f + fexp2(v1[j])), 0.f); }
                    }
                    u32x4 w; w.x = cvt_pk_bf16(v0[0], v0[1]); w.y = cvt_pk_bf16(v0[2], v0[3]); w.z = cvt_pk_bf16(v1[0], v1[1]); w.w = cvt_pk_bf16(v1[2], v1[3]);
                    if (type == 4) st16_wt_nt(rowp + bj * 128, w); else st16_wt(rowp + bj * 128, w);
                }
                CBAR();
            }
        }
    }
};
struct EpiProj {
    static constexpr bool PERM = true;
    bf16_t* Mg; const bf16_t* Zg0;
    __device__ __forceinline__ void operator()(const f32x4 (&acc)[2][2][4][2], const Unit& u, int wr, int wc, int fr, int fq) const {
        const int row0 = u.pm * 256 + wr * 64 + fr, col0 = u.pn * 256 + wc * 32 + 8 * fq;
        const bf16_t* Zg = Zg0 + (u.e & 15) * 1024; const int first = u.e >> 4;
#pragma unroll
        for (int ai = 0; ai < 2; ++ai) {
            u32x4 gq[4][2], oq[4][2];
#pragma unroll
            for (int m = 0; m < 4; ++m)
#pragma unroll
                for (int bj = 0; bj < 2; ++bj) { const int row = row0 + ai * 128 + m * 16, col = col0 + bj * 128;
                    gq[m][bj] = *(const u32x4*)(Zg + (size_t)row * ZW + col);
                    oq[m][bj] = first ? (u32x4){0u, 0u, 0u, 0u} : *(const u32x4*)(Mg + (size_t)row * D + col); }
#pragma unroll
            for (int m = 0; m < 4; ++m)
#pragma unroll
                for (int bj = 0; bj < 2; ++bj) { const int row = row0 + ai * 128 + m * 16, col = col0 + bj * 128;
                    const u32x4 g = gq[m][bj], o = oq[m][bj];
                    const f32x4 v0 = acc[ai][bj][m][0], v1 = acc[ai][bj][m][1];
                    const float r0 = bflo(g.x) * v0[0] + bflo(o.x), r1 = bfhi(g.x) * v0[1] + bfhi(o.x), r2 = bflo(g.y) * v0[2] + bflo(o.y), r3 = bfhi(g.y) * v0[3] + bfhi(o.y);
                    const float r4 = bflo(g.z) * v1[0] + bflo(o.z), r5 = bfhi(g.z) * v1[1] + bfhi(o.z), r6 = bflo(g.w) * v1[2] + bflo(o.w), r7 = bfhi(g.w) * v1[3] + bfhi(o.w);
                    u32x4 w; w.x = cvt_pk_bf16(r0, r1); w.y = cvt_pk_bf16(r2, r3); w.z = cvt_pk_bf16(r4, r5); w.w = cvt_pk_bf16(r6, r7);
                    *(u32x4*)(Mg + (size_t)row * D + col) = w; }
            CBAR();
        }
    }
};
struct EpiOut {
    static constexpr bool PERM = true;
    bf16_t* X; const float* gate;
    __device__ __forceinline__ void operator()(const f32x4 (&acc)[2][2][4][2], const Unit& u, int wr, int wc, int fr, int fq) const {
        const int row0 = u.pm * 256 + wr * 64 + fr, col0 = u.pn * 256 + wc * 32 + 8 * fq;
        const int b = (u.pm * 256) / SEQ;
        f32x4 gv[2][2];
#pragma unroll
        for (int bj = 0; bj < 2; ++bj)
#pragma unroll
            for (int n = 0; n < 2; ++n) gv[bj][n] = *(const f32x4*)(gate + (size_t)b * 6 * D + col0 + bj * 128 + 4 * n);
        u32x4 xq[2][4][2];
#pragma unroll
        for (int ai = 0; ai < 2; ++ai)
#pragma unroll
            for (int m = 0; m < 4; ++m)
#pragma unroll
                for (int bj = 0; bj < 2; ++bj) xq[ai][m][bj] = *(const u32x4*)(X + (size_t)(row0 + ai * 128 + m * 16) * D + col0 + bj * 128);
#pragma unroll
        for (int ai = 0; ai < 2; ++ai) {
#pragma unroll
            for (int m = 0; m < 4; ++m)
#pragma unroll
                for (int bj = 0; bj < 2; ++bj) { const u32x4 o = xq[ai][m][bj];
                    const f32x4 r0 = (f32x4){bflo(o.x), bfhi(o.x), bflo(o.y), bfhi(o.y)} + gv[bj][0] * acc[ai][bj][m][0], r1 = (f32x4){bflo(o.z), bfhi(o.z), bflo(o.w), bfhi(o.w)} + gv[bj][1] * acc[ai][bj][m][1];
                    u32x4 w; w.x = cvt_pk_bf16(r0[0], r0[1]); w.y = cvt_pk_bf16(r0[2], r0[3]); w.z = cvt_pk_bf16(r1[0], r1[1]); w.w = cvt_pk_bf16(r1[2], r1[3]);
                    *(u32x4*)(X + (size_t)(row0 + ai * 128 + m * 16) * D + col0 + bj * 128) = w; }
            CBAR();
        }
    }
};
struct EpiSwiglu {
    static constexpr bool PERM = true;
    bf16_t* H;
    __device__ __forceinline__ void operator()(const f32x4 (&acc)[2][2][4][2], const Unit& u, int wr, int wc, int fr, int fq) const {
        const int row0 = u.pm * 256 + wr * 64 + fr, hc = u.pn * 128 + wc * 32 + 8 * fq;
#pragma unroll
        for (int ai = 0; ai < 2; ++ai)
#pragma unroll
            for (int m = 0; m < 4; ++m) {
                const int row = row0 + ai * 128 + m * 16;
                float h[8];
#pragma unroll
                for (int n = 0; n < 2; ++n) { const f32x4 a = acc[ai][0][m][n], b = acc[ai][1][m][n];
#pragma unroll
                    for (int j = 0; j < 4; ++j) h[4 * n + j] = a[j] * frcp(1.f + fexp2(-a[j] * LOG2E)) * b[j]; }
                u32x4 w; w.x = cvt_pk_bf16(h[0], h[1]); w.y = cvt_pk_bf16(h[2], h[3]); w.z = cvt_pk_bf16(h[4], h[5]); w.w = cvt_pk_bf16(h[6], h[7]);
                st16_wt(H + (size_t)row * EH + hc, w);
            }
    }
};
struct EpiY {
    static constexpr bool PERM = true;
    bf16_t* Y;
    __device__ __forceinline__ void operator()(const f32x4 (&acc)[2][2][4][2], const Unit& u, int wr, int wc, int fr, int fq) const {
        const int row0 = u.pm * 256 + wr * 64 + fr, col0 = u.pn * 256 + wc * 32 + 8 * fq;
#pragma unroll
        for (int ai = 0; ai < 2; ++ai)
#pragma unroll
            for (int m = 0; m < 4; ++m) { bf16_t* rowp = Y + (size_t)(row0 + ai * 128 + m * 16) * D + col0;
#pragma unroll
                for (int bj = 0; bj < 2; ++bj) { const f32x4 v0 = acc[ai][bj][m][0], v1 = acc[ai][bj][m][1];
                    u32x4 w; w.x = cvt_pk_bf16(v0[0], v0[1]); w.y = cvt_pk_bf16(v0[2], v0[3]); w.z = cvt_pk_bf16(v1[0], v1[1]); w.w = cvt_pk_bf16(v1[2], v1[3]);
                    *(u32x4*)(rowp + bj * 128) = w; } }
    }
};

constexpr int NWAVES = 8;
constexpr int NPHASE = 2 + 9 * DEPTH;

__global__ void __launch_bounds__(NWAVES * 64, 2) fwd_kernel(Args args) {
    extern __shared__ __attribute__((aligned(16))) unsigned char lds_raw[];
    LAS unsigned char* lds = (LAS unsigned char*)lds_raw;
    volatile LAS unsigned* MISC = (volatile LAS unsigned*)(lds + MISC_OFF);
    const int tid0 = threadIdx.x;
    const int G = gridDim.x, bx = blockIdx.x;
    const int vcu = (G % 8 == 0) ? (bx % 8) * (G / 8) + bx / 8 : bx;
    const int NGW = G * NWAVES;
#define WSP() size_t wsz_ = 0; asm volatile("" : "+s"(wsz_)); unsigned char* ws = args.ws + wsz_; \
    int tid = tid0; asm volatile("" : "+v"(tid)); const int lane = tid & 63, wave = __builtin_amdgcn_readfirstlane(tid >> 6), hi = lane >> 5, gw = vcu * NWAVES + wave; (void)hi; (void)gw; (void)lane; (void)wave; \
    unsigned* ctl = (unsigned*)(ws + WS_CTL); float* rtab = (float*)(ws + WS_RT); (void)rtab; float* modp = (float*)(ws + WS_MOD); float* ropec = (float*)(ws + WS_ROPE); float* ropes = ropec + SEQ * 32; \
    int* tok_e = (int*)(ws + WS_ROUTE); int* tok_pos = tok_e + 2 * M; float* tok_w = (float*)(tok_pos + 2 * M); int* tok_slot = (int*)(tok_w + 2 * M); int* etok = (int*)(ws + WS_ROUTE + 2 * MiB); \
    bf16_t* X = (bf16_t*)(ws + WS_X); bf16_t* Hn = (bf16_t*)(ws + WS_H); bf16_t* OC = (bf16_t*)(ws + WS_OCAT); bf16_t* MG = (bf16_t*)(ws + WS_MERGED); bf16_t* Z = (bf16_t*)(ws + WS_Z); \
    bf16_t* XG = (bf16_t*)(ws + WS_XG); bf16_t* HB = (bf16_t*)(ws + WS_HB); bf16_t* YB = (bf16_t*)(ws + WS_YB); \
    bf16_t* WIN = (bf16_t*)(ws + WS_WIN); bf16_t* WPR = (bf16_t*)(ws + WS_WPROJ); bf16_t* WOU = (bf16_t*)(ws + WS_WOUT); bf16_t* W13 = (bf16_t*)(ws + WS_W13); bf16_t* W2 = (bf16_t*)(ws + WS_W2); \
    (void)ctl; (void)modp; (void)ropec; (void)ropes; (void)tok_e; (void)tok_pos; (void)tok_w; (void)tok_slot; (void)etok; (void)X; (void)Hn; (void)OC; (void)MG; (void)Z; (void)XG; (void)HB; (void)YB; (void)WIN; (void)WPR; (void)WOU; (void)W13; (void)W2;
    for (int u = tid0; u < 128; u += NWAVES * 64) MISC[u] = 0u;
    __syncthreads();
#if !MK_PER_PHASE
    XcdBarrier bar = xcd_barrier_post((unsigned*)(args.ws + WS_CTL) + CW_BAR, MISC + 8);
#define GRID_BAR() xcd_barrier(bar)
#else
#define GRID_BAR() do {} while (0)
#endif
    const int lo = args.ph_lo, hi_ph = args.ph_hi;
#define IN(k) (lo <= (k) && (k) < hi_ph)
#ifndef EN_MASK
#define EN_MASK 0x3ff
#endif
#define EN(k) ((EN_MASK >> (k)) & 1)
#ifndef DUPK
#define DUPK -1
#endif
#define REP(k) for (int rep_ = 0; rep_ < ((k) == DUPK ? 2 : 1); ++rep_, __syncthreads())
#define SEAM(k) do { if (IN(k) && IN((k) + 1)) GRID_BAR(); } while (0)

    if (IN(0) && EN(0)) REP(0) {
        WSP();
        {
            LAS float* cact = (LAS float*)lds;
            LAS float* part = (LAS float*)(lds + 16384);
            for (int i = tid; i < NBATCH * D; i += NWAVES * 64) { const int b = i / D, k = i % D; const float v = args.c[i]; cact[k * 4 + b] = v / (1.f + __expf(-v)); }
            __syncthreads();
            for (int it = bx; it < DEPTH * 96; it += G) {
                const int l = it / 96, cc = it % 96, col = cc * 64 + lane;
                const float* wp = args.ada_w + (size_t)l * D * 6 * D + col;
                float a0 = 0.f, a1 = 0.f, a2 = 0.f, a3 = 0.f;
#pragma unroll 1
                for (int k0 = 0; k0 < 128; k0 += 32) {
                    float wv[32];
#pragma unroll
                    for (int kk = 0; kk < 32; ++kk) wv[kk] = __builtin_nontemporal_load(&wp[(size_t)(wave * 128 + k0 + kk) * 6 * D]);
#pragma unroll
                    for (int kk = 0; kk < 32; ++kk) { const f32x4 cv = *(const LAS f32x4*)(cact + (wave * 128 + k0 + kk) * 4);
                        a0 += cv[0] * wv[kk]; a1 += cv[1] * wv[kk]; a2 += cv[2] * wv[kk]; a3 += cv[3] * wv[kk]; } }
                part[(wave * 4 + 0) * 64 + lane] = a0; part[(wave * 4 + 1) * 64 + lane] = a1; part[(wave * 4 + 2) * 64 + lane] = a2; part[(wave * 4 + 3) * 64 + lane] = a3;
                __syncthreads();
                if (tid < 256) { const int b = tid >> 6, cl = tid & 63; float s = 0.f;
#pragma unroll
                    for (int w = 0; w < 8; ++w) s += part[(w * 4 + b) * 64 + cl];
                    modp[((size_t)l * NBATCH + b) * 6 * D + cc * 64 + cl] = s + args.ada_b[(size_t)l * 6 * D + cc * 64 + cl]; }
                __syncthreads();
            }
        }
        for (int i = (vcu * NWAVES * 64) + tid; i < SEQ * 32; i += G * NWAVES * 64) { const int pos = i >> 5, j = i & 31; float s, c; sincos_d((double)pos * ROPE_INV[j], s, c); ropec[i] = c; ropes[i] = s; }
        for (int i = (vcu * NWAVES * 64) + tid; i < DEPTH * 36 * D; i += G * NWAVES * 64) { const int k = i & (D - 1), n = (i >> 10) % 36, l2 = i / (36 * D);
            rtab[i] = n < 4 ? args.rgw[((size_t)l2 * D + k) * 4 + n] : args.rew[((size_t)l2 * D + k) * NEXP + (n - 4)]; }
        {
            LAS float* scr = (LAS float*)(lds + wave * 16384);
            constexpr int NEARLY = CV_PER_L + (DEPTH - 1) * (CV_PER_L - CV_NDEF);
            for (int it = gw; it < NEARLY; it += NGW) {
                int l = 0, r = it;
                if (it >= CV_PER_L) { const int j = it - CV_PER_L; l = 1 + j / (CV_PER_L - CV_NDEF); r = CV_NDEF + j % (CV_PER_L - CV_NDEF); }
                conv_item<8>(args, l, r, WIN, WPR, WOU, W13, W2, scr, lane);
            }
        }
    }
    SEAM(0);

    for (int l = 0; l < DEPTH; ++l) {
        const int pb = 1 + 9 * l;
        if (IN(pb + 0) && EN(1)) {
            WSP(); const float* modl = modp + (size_t)l * NBATCH * 6 * D; (void)modl;
            const float* gam = args.mix_g + (size_t)l * D;
            const float* modprev = modp + (size_t)(l > 0 ? l - 1 : 0) * NBATCH * 6 * D;
            constexpr int RPW = M / (256 * NWAVES); const int rbase = gw * RPW, b = rbase / SEQ;
            int slot_v = 0; float w_v = 0.f;
            if (l > 0) {
                const unsigned* cntp = ctl + CW_CNT + (l - 1) * NEXP * 64;
                const int cv = (lane < NEXP) ? (int)__hip_atomic_load(cntp + lane * 64, __ATOMIC_RELAXED, __HIP_MEMORY_SCOPE_AGENT) : 0;
                const int tl = (cv + 255) >> 8; int tstart = 0, run = 0;
#pragma unroll
                for (int e = 0; e < NEXP; ++e) { if (lane == e) tstart = run; run += __builtin_amdgcn_readlane(tl, e); }
                const int i = min(lane, 2 * RPW - 1);
                const int e = tok_e[2 * rbase + i], pos = tok_pos[2 * rbase + i]; w_v = tok_w[2 * rbase + i];
                slot_v = __builtin_amdgcn_ds_bpermute(4 * e, tstart) * 256 + pos;
            }
            f32x4 ca[4], cb[4], gf[4];
#pragma unroll
            for (int j = 0; j < 4; ++j) { const int col = 4 * lane + 256 * j;
                const f32x4 g4 = *(const f32x4*)(gam + col), sc = *(const f32x4*)(modl + (size_t)b * 6 * D + 1 * D + col), sh = *(const f32x4*)(modl + (size_t)b * 6 * D + col);
                ca[j] = g4 * (sc + 1.0f); cb[j] = sh; gf[j] = *(const f32x4*)(modprev + (size_t)b * 6 * D + 5 * D + col); }
#pragma unroll 1
            for (int r0 = rbase; r0 < rbase + RPW; r0 += 4) {
                f32x4 v[4][4];
                if (l == 0) {
#pragma unroll
                    for (int q = 0; q < 4; ++q)
#pragma unroll
                        for (int j = 0; j < 4; ++j) v[q][j] = __builtin_nontemporal_load((const f32x4*)(args.x + (size_t)(r0 + q) * D + 4 * lane + 256 * j));
                } else {
                    u32x2 xr[4][4], y0[4][4], y1[4][4]; float w0[4], w1[4];
#pragma unroll
                    for (int q = 0; q < 4; ++q) { const int ix = 2 * (r0 - rbase + q);
                        const int s0 = __builtin_amdgcn_readlane(slot_v, ix), s1 = __builtin_amdgcn_readlane(slot_v, ix + 1);
                        w0[q] = __builtin_bit_cast(float, __builtin_amdgcn_readlane(__builtin_bit_cast(int, w_v), ix)); w1[q] = __builtin_bit_cast(float, __builtin_amdgcn_readlane(__builtin_bit_cast(int, w_v), ix + 1));
#pragma unroll
                        for (int j = 0; j < 4; ++j) { const int col = 4 * lane + 256 * j;
                            xr[q][j] = *(const u32x2*)(X + (size_t)(r0 + q) * D + col); y0[q][j] = __builtin_nontemporal_load((const u32x2*)(YB + (size_t)s0 * D + col)); y1[q][j] = __builtin_nontemporal_load((const u32x2*)(YB + (size_t)s1 * D + col)); } }
#pragma unroll
                    for (int q = 0; q < 4; ++q)
#pragma unroll
                        for (int j = 0; j < 4; ++j) { const f32x4 yy = bf4(y0[q][j]) * w0[q] + bf4(y1[q][j]) * w1[q]; v[q][j] = bf4(xr[q][j]) + gf[j] * yy; }
                }
                float ssq[4];
#pragma unroll
                for (int q = 0; q < 4; ++q) { const int row = r0 + q;
                    float ss = 0.f;
#pragma unroll
                    for (int j = 0; j < 4; ++j) { u32x2 xw; xw.x = cvt_pk_bf16(v[q][j][0], v[q][j][1]); xw.y = cvt_pk_bf16(v[q][j][2], v[q][j][3]); *(u32x2*)(X + (size_t)row * D + 4 * lane + 256 * j) = xw;
                        ss += (v[q][j][0] * v[q][j][0] + v[q][j][1] * v[q][j][1]) + (v[q][j][2] * v[q][j][2] + v[q][j][3] * v[q][j][3]); }
                    ssq[q] = ss; }
                wave_sum4_u(ssq[0], ssq[1], ssq[2], ssq[3]);
#pragma unroll
                for (int q = 0; q < 4; ++q) { const int row = r0 + q;
                    const float rstd = __builtin_amdgcn_rsqf(ssq[q] * (1.f / D) + NORM_EPS);
#pragma unroll
                    for (int j = 0; j < 4; ++j) { const int col = 4 * lane + 256 * j;
                        const f32x4 hv = v[q][j] * rstd * ca[j] + cb[j];
                        u32x2 w; w.x = cvt_pk_bf16(hv[0], hv[1]); w.y = cvt_pk_bf16(hv[2], hv[3]);
                        *(u32x2*)(Hn + (size_t)row * D + col) = w; }
                }
            }
        }
        SEAM(pb + 0);
        if (IN(pb + 1) && EN(2)) REP(2) {
            WSP(); const float* modl = modp + (size_t)l * NBATCH * 6 * D; (void)modl;
            pg8::Gemm g{Hn, WIN + (size_t)l * ZW * D, D, D, D}; pg8::StaticOrder S; S.init(M, ZW, G, bx);
            EpiZ E{Z, ropec, ropes};
            pg8::gemm_phase<EpiZ, pg8::StaticOrder>(lds, g, S, E);
            constexpr int G1_TAIL0 = ((M / 256) * (ZW / 256)) % 256;
            if (l + 1 < DEPTH && bx >= G1_TAIL0) {
                __syncthreads();
                LAS float* scr = (LAS float*)(lds + wave * 16384);
                for (int r = (bx - G1_TAIL0) * NWAVES + wave; r < CV_NDEF; r += (256 - G1_TAIL0) * NWAVES) conv_item<32>(args, l + 1, r, WIN, WPR, WOU, W13, W2, scr, lane);
            }
        }
        SEAM(pb + 1);
        if (IN(pb + 2) && EN(3)) REP(3) {
            WSP(); const float* modl = modp + (size_t)l * NBATCH * 6 * D; (void)modl;
            float* cst_o = (float*)(ws + 40 * MiB); float* cst_ml = (float*)(ws + 60 * MiB);
            unsigned* c0cnt = ctl + CW_C0 + l * 128 * 16;
            {
                int tidm = tid0; asm volatile("" : "+v"(tidm)); const int lane = tidm & 63, hi = lane >> 5;
                LAS unsigned char* vlds = lds + wave * 12288; LAS float* wsf = (LAS float*)(lds + 98304 + wave * 256);
                const char* zb = (const char*)Z;
                for (int wu = gw; wu < NBATCH * 4 * 8 * 16; wu += NGW) {
                    const int j = wu & 15, sb = (wu >> 4) & 7, hs = (wu >> 7) & 3, b = wu >> 9;
                    const int rowb = b * SEQ, qi = lane & 31, q0 = 512 * sb + 32 * j, tq = q0 + qi;
                    f32x16 o[2]; o[0] = f32x16{}; o[1] = f32x16{};
                    float mrun = NEGBIG, lrun = 0.f;
                    bf16x8 qf[4];
                    { const unsigned qoff = (unsigned)(((rowb + tq) * ZW + ZQD + hs * 64 + 8 * hi) * 2);
#pragma unroll
                      for (int d0 = 0; d0 < 4; ++d0) qf[d0] = *(const bf16x8*)(zb + (size_t)(qoff + 32u * d0)); }
                    const unsigned kcol = (unsigned)((ZKD + hs * 64) * 2), vcol = (unsigned)((ZVD + hs * 64) * 2);
                    const int lo_v = max(tq - 64, 0), span = min(tq + 64, SEQ - 1) - lo_v;
                    auto ld = [&](TileRegs<64>& T, int kbx) { unsigned rr[4];
#pragma unroll
                        for (int i = 0; i < 4; ++i) rr[i] = (unsigned)((rowb + min(max(kbx + 8 * i + (lane >> 3), 0), SEQ - 1)) * ZW * 2);
                        tile_load<64>(T, zb, rr, kcol, vcol); };
                    TileRegs<64> cur;
                    int kb = q0 - 64;
                    ld(cur, kb);
#pragma unroll 1
                    for (int t = 0; t < 5; ++t, kb += 32) {
                        auto reload = [&](TileRegs<64>& T) { ld(T, (t + 1 < 5) ? kb + 32 : kb); };
                        const int u0 = kb + 4 * hi - lo_v;
                        auto maskf = [&](f32x16& p) {
#pragma unroll
                            for (int r = 0; r < 16; ++r) { const int co = (r & 3) + 8 * (r >> 2); p[r] = ((unsigned)(u0 + co) <= (unsigned)span) ? 0.f : NEGBIG; }
                        };
                        attn_tile<64>(o, mrun, lrun, qf, cur, vlds, wsf, maskf, reload, lane, hi);
                    }
                    const size_t sl0 = (size_t)(b * 4 + hs) * SEQ + q0;
#pragma unroll
                    for (int r = 0; r < 16; ++r) { float* op = cst_o + (sl0 + crow(r, hi)) * 64 + (lane & 31); st4_wt(op, o[0][r]); st4_wt(op + 32, o[1][r]); }
                    { float* mp = cst_ml + ((sl0 + qi) * 2 + hi) * 2; st4_wt(mp, mrun); st4_wt(mp + 1, lrun); }
                    asm volatile("s_waitcnt vmcnt(0)" ::: "memory");
                    if (lane == 0) __hip_atomic_fetch_add(c0cnt + (wu >> 4) * 16, 1u, __ATOMIC_RELAXED, __HIP_MEMORY_SCOPE_AGENT);
                }
                asm volatile("s_waitcnt vmcnt(0) lgkmcnt(0)" ::: "memory"); __builtin_amdgcn_s_barrier();
            }
            {
                int tidm = tid0; asm volatile("" : "+v"(tidm)); const int lane = tidm & 63, hi = lane >> 5;
                LAS unsigned char* vlds = lds + wave * 12288; LAS float* wsf = (LAS float*)(lds + 98304 + wave * 256);
                const float* lp = args.da_lambda + (size_t)l * 4 * 64;
                const float s01 = wave_sum(lp[lane] * lp[64 + lane]), s23 = wave_sum(lp[128 + lane] * lp[192 + lane]);
                const float lam_init = 0.8f - 0.6f * __expf(-0.3f * (float)l);
                const float lam = __expf(s01) - __expf(s23) + lam_init;
                LAS float* wsfA = (LAS float*)(lds + 131072 + wave * 128);
                const unsigned lds0 = (unsigned)(uintptr_t)lds;
                for (int un = vcu; un < NBATCH * 4 * 16; un += G) {
                    const int b = un >> 6, h = (un >> 4) & 3, qb = un & 15;
                    const size_t rowbase = (size_t)b * SEQ; const int q0 = qb * 256 + wave * 32;
                    LAS unsigned char* qlds = lds + 65536 + wave * 8192;
                    { bf16x8 qf[8];
                      const bf16_t* qp = Z + (rowbase + q0 + (lane & 31)) * ZW + ZQA + h * 128 + 8 * hi;
#pragma unroll
                      for (int i = 0; i < 8; ++i) qf[i] = *(const bf16x8*)(qp + 16 * i);
                      asm volatile("s_waitcnt vmcnt(0)" : "+v"(qf[0]), "+v"(qf[1]), "+v"(qf[2]), "+v"(qf[3]), "+v"(qf[4]), "+v"(qf[5]), "+v"(qf[6]), "+v"(qf[7]) :: "memory");
#pragma unroll
                      for (int i = 0; i < 8; ++i) *(LAS bf16x8*)(qlds + i * 1024 + lane * 16) = qf[i]; }
                    f32x16 o0[4], o1[4];
#pragma unroll
                    for (int d0 = 0; d0 < 4; ++d0) { o0[d0] = f32x16{}; o1[d0] = f32x16{}; }
                    float m0 = 0.f, l0 = 0.f, m1 = 0.f, l1 = 0.f;
                    LAS unsigned char* bsel = lds + 132096 + (hi ? 0 : 64 + (wave * 32 + (lane & 31)) * 48);
                    { unsigned z0 = 0u, e0 = hi ? 0u : 0x3F80u; asm volatile("" : "+v"(z0), "+v"(e0));
                      *(LAS u32x4*)bsel = (u32x4){z0, z0, z0, z0}; *(LAS u32x4*)(bsel + 16) = (u32x4){z0, z0, z0, z0}; *(LAS u32x4*)(bsel + 32) = (u32x4){e0, z0, z0, z0}; }
                    const int krow = 8 * wave + (lane >> 3);
                    const unsigned koff = (unsigned)(((rowbase + krow) * ZW + ZKA + h * 128) * 2 + (((lane & 7) ^ ((krow >> 1) & 7)) << 4));
                    const unsigned voff = (unsigned)(((rowbase + 8 * wave + ((lane >> 2) & 3)) * ZW + ZVA + h * 128 + (4 * (lane >> 4) + (lane & 3)) * 8) * 2);
#define DIFF_DMA(t, bo) do { const char* zb_ = (const char*)Z + (size_t)(t) * 64 * ZW * 2; \
        glds16s(zb_, koff, (unsigned)__builtin_amdgcn_readfirstlane((int)(lds0 + ((bo) * 2 + 0) * 8192 + wave * 1024))); \
        glds16s(zb_ + 128, koff, (unsigned)__builtin_amdgcn_readfirstlane((int)(lds0 + ((bo) * 2 + 1) * 8192 + wave * 1024))); \
        glds16s(zb_, voff, (unsigned)__builtin_amdgcn_readfirstlane((int)(lds0 + 32768 + (bo) * 16384 + wave * 2048))); \
        glds16s(zb_ + (size_t)4 * ZW * 2, voff, (unsigned)__builtin_amdgcn_readfirstlane((int)(lds0 + 32768 + (bo) * 16384 + wave * 2048 + 1024))); } while (0)
#define DIFF_SYNC() do { asm volatile("s_waitcnt vmcnt(0) lgkmcnt(0)" ::: "memory"); __builtin_amdgcn_s_barrier(); asm volatile("" ::: "memory"); } while (0)
                    DIFF_DMA(0, 0);
#pragma unroll 1
                    for (int t = 0; t < SEQ / 64; ++t) {
                        const int bo = t & 1;
                        DIFF_SYNC();
                        if (t + 1 < SEQ / 64) DIFF_DMA(t + 1, bo ^ 1);
                        diffA_step(o0, o1, m0, l0, m1, l1, qlds, lds + (bo * 2 + 0) * 8192, lds + (bo * 2 + 1) * 8192, lds + 32768 + bo * 16384, bsel, wsfA, t == 0, lane);
                    }
                    DIFF_SYNC();
#undef DIFF_DMA
#undef DIFF_SYNC
                    int lane_e = lane; asm volatile("" : "+v"(lane_e)); const int hi_e = lane_e >> 5;
                    attn_finish<4>(o0, l0, wsfA, lane_e, hi_e);
                    attn_finish<4>(o1, l1, wsfA, lane_e, hi_e);
                    const float* sg = args.da_subln + (size_t)l * 128;
                    float g4[4];
#pragma unroll
                    for (int d0 = 0; d0 < 4; ++d0) g4[d0] = sg[32 * d0 + (lane_e & 31)] * (1.0f - lam_init);
#pragma unroll
                    for (int r0 = 0; r0 < 16; r0 += 4) {
                        float ov[4][4], ss[4], tt[4];
#pragma unroll
                        for (int k = 0; k < 4; ++k) {
#pragma unroll
                            for (int d0 = 0; d0 < 4; ++d0) ov[k][d0] = o0[d0][r0 + k] - lam * o1[d0][r0 + k];
                            ss[k] = ov[k][0] * ov[k][0] + ov[k][1] * ov[k][1] + ov[k][2] * ov[k][2] + ov[k][3] * ov[k][3]; }
#pragma unroll
                        for (int k = 0; k < 4; ++k) ss[k] += dpp_f<0xB1>(ss[k]);
#pragma unroll
                        for (int k = 0; k < 4; ++k) ss[k] += dpp_f<0x4E>(ss[k]);
#pragma unroll
                        for (int k = 0; k < 4; ++k) ss[k] += dpp_f<0x141>(ss[k]);
#pragma unroll
                        for (int k = 0; k < 4; ++k) ss[k] += dpp_f<0x140>(ss[k]);
#pragma unroll
                        for (int k = 0; k < 4; ++k) tt[k] = xor_lane<16>(ss[k]);
#pragma unroll
                        for (int k = 0; k < 4; ++k) { const int r = r0 + k;
                            const float rn = __builtin_amdgcn_rsqf((ss[k] + tt[k]) * (1.f / 128.f) + NORM_EPS);
                            bf16_t* op = OC + (rowbase + q0 + crow(r, hi_e)) * D + h * 128 + (lane_e & 31);
#pragma unroll
                            for (int d0 = 0; d0 < 4; ++d0) { const float ovn = ov[k][d0] * rn * g4[d0]; op[32 * d0] = (bf16_t)(cvt_pk_bf16(ovn, ovn) & 0xffffu); } }
                    }
                }
                asm volatile("s_waitcnt vmcnt(0) lgkmcnt(0)" ::: "memory"); __builtin_amdgcn_s_barrier();
            }
            {
                int tidm = tid0; asm volatile("" : "+v"(tidm)); const int lane = tidm & 63, hi = lane >> 5;
                LAS unsigned char* vlds = lds + wave * 12288; LAS float* wsf = (LAS float*)(lds + 98304 + wave * 256);
                LAS float* tab = (LAS float*)(lds + 100352);
                { const float* rpb = args.na_rpb + (size_t)l * 4 * 15 * 31;
                  for (int i = wave * 64 + lane; i < 4 * 15 * 128; i += NWAVES * 64) { const int j = (i & 127) - 48, hb = i >> 7; tab[i] = (j >= 0 && j <= 30) ? rpb[hb * 31 + j] * LOG2E : 0.f; } }
                asm volatile("s_waitcnt vmcnt(0) lgkmcnt(0)" ::: "memory"); __builtin_amdgcn_s_barrier(); asm volatile("" ::: "memory");
                const char* zb = (const char*)Z;
                for (int wu = gw; wu < NBATCH * 4 * 64 * 2; wu += NGW) {
                    const int half = wu & 1, gr = (wu >> 1) & 63, h = (wu >> 7) & 3, b = wu >> 9;
                    const int rowb = b * SEQ; const int c0 = half * 32, cq = c0 + (lane & 31);
                    const int kr0 = min(max(gr - 4, 0), 56), cs = min(max(cq - 8, 0), 48);
                    bf16x8 qf[4];
                    { const unsigned qoff = (unsigned)(((rowb + gr * 64 + cq) * ZW + ZQN + h * 64 + 8 * hi) * 2);
#pragma unroll
                      for (int d0 = 0; d0 < 4; ++d0) qf[d0] = *(const bf16x8*)(zb + (size_t)(qoff + 32u * d0)); }
                    f32x16 o[2]; o[0] = f32x16{}; o[1] = f32x16{};
                    float mrun = NEGBIG, lrun = 0.f;
                    const unsigned kcol = (unsigned)((ZKN + h * 64) * 2), vcol = (unsigned)((ZVN + h * 64) * 2);
                    unsigned rb0[4];
#pragma unroll
                    for (int i = 0; i < 4; ++i) rb0[i] = (unsigned)((rowb + (kr0 + (i >> 1)) * 64 + 16 * half + 8 * (i & 1) + (lane >> 3)) * ZW * 2);
                    TileRegs<64> cur;
                    tile_load<64>(cur, zb, rb0, kcol, vcol);
#pragma unroll 1
                    for (int t = 0, rp = 0, cc = 0; t < 12; ++t) {
                        const int kr = kr0 + 2 * rp, chunk = half + cc;
                        const int cn = (cc == 2) ? 0 : cc + 1, rn = (cc == 2) ? rp + 1 : rp;
                        auto reload = [&](TileRegs<64>& T) { const unsigned adv = (unsigned)((t + 1 < 12) ? (2 * rn * 64 + 16 * cn) : (2 * rp * 64 + 16 * cc)) * (ZW * 2u); unsigned rr[4];
#pragma unroll
                          for (int i = 0; i < 4; ++i) rr[i] = rb0[i] + adv;
                          tile_load<64>(T, zb, rr, kcol, vcol); };
                        const LAS float* bp = tab + (h * 15 + (kr - gr + 7)) * 128 + (16 * chunk + 4 * hi - cq + 63);
                        const int u0 = 16 * chunk + 4 * hi - cs;
                        auto maskf = [&](f32x16& p) {
#pragma unroll
                            for (int r = 0; r < 16; ++r) { const int co = (r & 3) + 8 * (r >> 2);
                                const float bv = bp[(co >> 4) * 128 + (co & 15)]; p[r] = ((unsigned)(u0 + (co & 15)) <= 15u) ? bv : NEGBIG; }
                        };
                        attn_tile<64>(o, mrun, lrun, qf, cur, vlds, wsf, maskf, reload, lane, hi);
                        cc = cn; rp = rn;
                    }
                    attn_finish<2>(o, lrun, wsf, lane, hi);
#pragma unroll
                    for (int r = 0; r < 16; ++r) { bf16_t* op = OC + (size_t)(rowb + gr * 64 + c0 + crow(r, hi)) * D + 512 + h * 64 + (lane & 31);
                        const unsigned w = cvt_pk_bf16(o[0][r], o[1][r]); op[0] = (bf16_t)(w & 0xffffu); op[32] = (bf16_t)(w >> 16); }
                }
            }
            {
                int tidm = tid0; asm volatile("" : "+v"(tidm)); const int lane = tidm & 63, hi = lane >> 5;
                LAS unsigned char* vlds = lds + wave * 12288; LAS float* wsf = (LAS float*)(lds + 98304 + wave * 256);
                const char* zb = (const char*)Z;
                for (int wu = gw; wu < NBATCH * 4 * 8 * 16; wu += NGW) {
                    const int rho = wu & 15, sb = (wu >> 4) & 7, hs = (wu >> 7) & 3, b = wu >> 9;
                    const int rowb = b * SEQ; const int qi = lane & 31; const int tq = 512 * sb + rho + 16 * qi;
                    const unsigned qoff0 = (unsigned)(((rowb + tq) * ZW + ZQD + hs * 64 + 8 * hi) * 2);
                    bf16x8 qf1[4], qf2[4];
#pragma unroll
                    for (int d0 = 0; d0 < 4; ++d0) { qf1[d0] = *(const bf16x8*)(zb + (size_t)(qoff0 + 512u + 32u * d0)); qf2[d0] = *(const bf16x8*)(zb + (size_t)(qoff0 + 1024u + 32u * d0)); }
                    TileRegs<64> cur;
                    { const int kb0 = ((512 * sb + rho) >> 2) - 64;
                      const unsigned rb1 = (unsigned)((rowb + (rho & 3)) * ZW * 2); unsigned rr[4];
#pragma unroll
                      for (int i = 0; i < 4; ++i) rr[i] = rb1 + __umul24((unsigned)(min(max(kb0 + 8 * i + (lane >> 3), 0), (SEQ >> 2) - 1) << 2), ZW * 2u);
                      tile_load<64>(cur, zb, rr, (unsigned)((ZKD + 256 + hs * 64) * 2), (unsigned)((ZVD + 256 + hs * 64) * 2)); }
                    { unsigned* cp = c0cnt + (wu >> 4) * 16; unsigned sp_ = 0;
                      while ((unsigned)__builtin_amdgcn_readfirstlane((int)__hip_atomic_load(cp, __ATOMIC_RELAXED, __HIP_MEMORY_SCOPE_AGENT)) < 16u && ++sp_ < XB_SPIN_CAP) __builtin_amdgcn_s_sleep(2);
                      asm volatile("" ::: "memory"); }
                    f32x16 o[2]; float mrun, lrun;
                    { const size_t slb = (size_t)(b * 4 + hs) * SEQ + 512 * sb + rho;
                      auto ldc = [](const float* q) { return __builtin_bit_cast(float, __hip_atomic_load((const unsigned*)q, __ATOMIC_RELAXED, __HIP_MEMORY_SCOPE_AGENT)); };
#pragma unroll
                      for (int r = 0; r < 16; ++r) { const float* ip = cst_o + (slb + 16 * crow(r, hi)) * 64 + (lane & 31); o[0][r] = ldc(ip); o[1][r] = ldc(ip + 32); }
                      const float* mp = cst_ml + ((slb + 16 * qi) * 2 + hi) * 2; mrun = ldc(mp); lrun = ldc(mp + 1); }
#pragma unroll 1
                    for (int gi = 1; gi < 3; ++gi) {
                        const int sh = 2 * gi, res = rho & ((1 << sh) - 1), qa = (512 * sb + rho) >> sh, qk = qa + (16 >> sh) * qi, nsub = SEQ >> sh, ntile = (gi == 0) ? 20 : (gi == 1) ? 8 : 5;
                        const int lo_v = max(qk - 64, 0), span = min(qk + 64, nsub - 1) - lo_v;
                        const unsigned kcol = (unsigned)((ZKD + gi * 256 + hs * 64) * 2), vcol = (unsigned)((ZVD + gi * 256 + hs * 64) * 2), rbase = (unsigned)((rowb + res) * ZW * 2);
                        const int sh2 = sh + 2, res2 = rho & ((1 << sh2) - 1), kbn = ((512 * sb + rho) >> sh2) - 64, nsub2 = SEQ >> sh2;
                        bf16x8 qf[4];
#pragma unroll
                        for (int d0 = 0; d0 < 4; ++d0) qf[d0] = (gi == 1) ? qf1[d0] : qf2[d0];
                        int kb = qa - 64;
#pragma unroll 1
                        for (int t = 0; t < ntile; ++t, kb += 32) {
                            auto reload = [&](TileRegs<64>& T) { const bool same = (t + 1 < ntile); const int kbx = same ? kb + 32 : kbn, nsx = same ? nsub : nsub2, shx = same ? sh : sh2;
                              const unsigned rbx = same ? rbase : (unsigned)((rowb + res2) * ZW * 2), kcx = same ? kcol : kcol + 512u, vcx = same ? vcol : vcol + 512u; unsigned rr[4];
                              if (kbx >= 0 && kbx + 32 <= nsx) {
                                  const unsigned b0 = rbx + __umul24((unsigned)((kbx + (lane >> 3)) << shx), ZW * 2u), inc = (8u << shx) * (ZW * 2u);
#pragma unroll
                                  for (int i = 0; i < 4; ++i) rr[i] = b0 + (unsigned)i * inc;
                              } else {
#pragma unroll
                                  for (int i = 0; i < 4; ++i) rr[i] = rbx + __umul24((unsigned)(min(max(kbx + 8 * i + (lane >> 3), 0), nsx - 1) << shx), ZW * 2u);
                              }
                              tile_load<64>(T, zb, rr, kcx, vcx); };
                            const int u0 = kb + 4 * hi - lo_v;
                            auto maskf = [&](f32x16& p) {
#pragma unroll
                                for (int r = 0; r < 16; ++r) { const int co = (r & 3) + 8 * (r >> 2); p[r] = ((unsigned)(u0 + co) <= (unsigned)span) ? 0.f : NEGBIG; }
                            };
                            attn_tile<64>(o, mrun, lrun, qf, cur, vlds, wsf, maskf, reload, lane, hi);
                        }
                    }
                    attn_finish<2>(o, lrun, wsf, lane, hi);
#pragma unroll
                    for (int r = 0; r < 16; ++r) { bf16_t* op = OC + (size_t)(rowb + 512 * sb + rho + 16 * crow(r, hi)) * D + 768 + hs * 64 + (lane & 31);
                        const unsigned w = cvt_pk_bf16(o[0][r], o[1][r]); op[0] = (bf16_t)(w & 0xffffu); op[32] = (bf16_t)(w >> 16); }
                }
            }
        }
        SEAM(pb + 2);
        if (IN(pb + 3) && EN(4)) REP(4) {
            WSP(); const float* modl = modp + (size_t)l * NBATCH * 6 * D; (void)modl;
            pg8::StaticOrder S0; S0.init(M, D, G, bx); pg8::Unit u0; pg8::ProjOrder S; S.pm = 0; S.pn = 0; S.rot = bx & 1;
            const bool have = S0.next(0, u0); S.pm = u0.pm; S.pn = u0.pn;
            if (have) { pg8::Gemm g{OC, WPR + (size_t)l * D * D, D, D, D}; EpiProj E{MG, Z + ZG}; pg8::gemm_phase<EpiProj, pg8::ProjOrder>(lds, g, S, E); }
        }
        SEAM(pb + 3);
        if (IN(pb + 4) && EN(5)) {
            WSP(); const float* modl = modp + (size_t)l * NBATCH * 6 * D; (void)modl;
            pg8::Gemm g{MG, WOU + (size_t)l * D * D, D, D, D}; pg8::StaticOrder S; S.init(M, D, G, bx);
            EpiOut E{X, modl + 2 * D};
            pg8::gemm_phase<EpiOut, pg8::StaticOrder>(lds, g, S, E);
        }
        SEAM(pb + 4);
        if (IN(pb + 5) && EN(6)) {
            WSP(); const float* modl = modp + (size_t)l * NBATCH * 6 * D; (void)modl;
            LAS float* rt = (LAS float*)lds;
            LAS unsigned* lcnt = (LAS unsigned*)(lds + MISC_OFF) + 16;
            LAS unsigned* lbase = lcnt + 32;
            { const float* rsrc = rtab + (size_t)l * 36 * D + 4 * lane; const unsigned lds0 = (unsigned)(uintptr_t)lds;
              for (int pc = wave; pc < 144; pc += NWAVES) glds16(rsrc + (pc >> 2) * D + (pc & 3) * 256, (unsigned)__builtin_amdgcn_readfirstlane((int)(lds0 + (pc >> 2) * (RT_LD * 4) + (pc & 3) * 1024)));
              if (tid < 64) lcnt[tid] = 0u;
              if (tid < 36) rt[tid * RT_LD + D] = tid < 4 ? args.rgb[(size_t)l * 4 + tid] : args.reb[(size_t)l * NEXP + tid - 4];
              asm volatile("s_waitcnt vmcnt(0)" ::: "memory");
            }
            __syncthreads();
            const float* gam = args.ffn_g + (size_t)l * D;
            unsigned* cnt = ctl + CW_CNT + l * NEXP * 64;
            int myE0 = 0, myE1 = 0, myP0 = 0, myP1 = 0, myRow = -1; float myW0 = 0.f, myW1 = 0.f; int nrow = 0;
            f32x4 v[4][4], vn[4][4];
            constexpr int RPW = M / (256 * NWAVES); const int rbase = gw * RPW;
            f32x4 ca[4], cb[4];
            { const int b = rbase / SEQ;
#pragma unroll
              for (int j = 0; j < 4; ++j) { const int col = 4 * lane + 256 * j;
                  const f32x4 g4 = *(const f32x4*)(gam + col), sc = *(const f32x4*)(modl + (size_t)b * 6 * D + 4 * D + col), sh = *(const f32x4*)(modl + (size_t)b * 6 * D + 3 * D + col);
                  ca[j] = g4 * (sc + 1.0f); cb[j] = sh; } }
#define T2_LOAD(dst, rb) do { _Pragma("unroll") for (int q = 0; q < 4; ++q) { const int row = min((rb) + q, M - 1); \
                _Pragma("unroll") for (int j = 0; j < 4; ++j) dst[q][j] = bf4(*(const u32x2*)(X + (size_t)row * D + 4 * lane + 256 * j)); } } while (0)
            T2_LOAD(v, rbase);
#pragma unroll 1
            for (int r0 = rbase; r0 < rbase + RPW; r0 += 4) {
                T2_LOAD(vn, min(r0 + 4, M - 4));
                float ssq[4];
#pragma unroll
                for (int q = 0; q < 4; ++q) { f32x2 s2 = {0.f, 0.f};
#pragma unroll
                    for (int j = 0; j < 4; ++j) { const f32x2 lo = {v[q][j][0], v[q][j][1]}, hi2 = {v[q][j][2], v[q][j][3]}; s2 = lo * lo + s2; s2 = hi2 * hi2 + s2; }
                    ssq[q] = s2[0] + s2[1]; }
                wave_sum4_u(ssq[0], ssq[1], ssq[2], ssq[3]);
#pragma unroll
                for (int q = 0; q < 4; ++q) {
                    const int row = r0 + q;
                    const float rstd = __builtin_amdgcn_rsqf(ssq[q] * (1.f / D) + NORM_EPS);
#pragma unroll
                    for (int j = 0; j < 4; ++j) { const int col = 4 * lane + 256 * j;
                        v[q][j] = v[q][j] * rstd * ca[j] + cb[j];
                        u32x2 w; w.x = cvt_pk_bf16(v[q][j][0], v[q][j][1]); w.y = cvt_pk_bf16(v[q][j][2], v[q][j][3]);
                        *(u32x2*)(Hn + (size_t)row * D + col) = w; }
                }
                float LG[4][4];
#pragma unroll
                for (int n = 0; n < 4; ++n) { f32x2 c0 = {0.f, 0.f}, c1 = c0, c2 = c0, c3 = c0;
#pragma unroll
                    for (int j = 0; j < 4; ++j) { const f32x4 wv = *(const LAS f32x4*)(rt + n * RT_LD + 4 * lane + 256 * j); const f32x2 wl = {wv[0], wv[1]}, wh = {wv[2], wv[3]};
                        c0 = wl * (f32x2){v[0][j][0], v[0][j][1]} + c0; c0 = wh * (f32x2){v[0][j][2], v[0][j][3]} + c0;
                        c1 = wl * (f32x2){v[1][j][0], v[1][j][1]} + c1; c1 = wh * (f32x2){v[1][j][2], v[1][j][3]} + c1;
                        c2 = wl * (f32x2){v[2][j][0], v[2][j][1]} + c2; c2 = wh * (f32x2){v[2][j][2], v[2][j][3]} + c2;
                        c3 = wl * (f32x2){v[3][j][0], v[3][j][1]} + c3; c3 = wh * (f32x2){v[3][j][2], v[3][j][3]} + c3; }
                    float a0 = c0[0] + c0[1], a1 = c1[0] + c1[1], a2 = c2[0] + c2[1], a3 = c3[0] + c3[1];
                    wave_sum4_u(a0, a1, a2, a3);
                    const float bgn = rt[n * RT_LD + D]; LG[0][n] = a0 + bgn; LG[1][n] = a1 + bgn; LG[2][n] = a2 + bgn; LG[3][n] = a3 + bgn; }
#pragma unroll
                for (int q = 0; q < 4; ++q) {
                    const int row = r0 + q;
                    int gsel = 0; float gmx = LG[q][0];
#pragma unroll
                    for (int i = 1; i < 4; ++i) if (LG[q][i] > gmx) { gmx = LG[q][i]; gsel = i; }
                    gsel = __builtin_amdgcn_readfirstlane(gsel);
                    float gsum = 0.f;
#pragma unroll
                    for (int i = 0; i < 4; ++i) gsum += __expf(LG[q][i] - gmx);
                    const float pg = frcp(gsum);
                    float le[8];
                    const LAS float* rte = rt + (4 + 8 * gsel) * RT_LD + 4 * lane;
#pragma unroll
                    for (int j8 = 0; j8 < 8; ++j8) { f32x2 c = {0.f, 0.f};
#pragma unroll
                        for (int j = 0; j < 4; ++j) { const f32x4 wv = *(const LAS f32x4*)(rte + j8 * RT_LD + 256 * j);
                            c = (f32x2){wv[0], wv[1]} * (f32x2){v[q][j][0], v[q][j][1]} + c; c = (f32x2){wv[2], wv[3]} * (f32x2){v[q][j][2], v[q][j][3]} + c; }
                        le[j8] = c[0] + c[1]; }
                    wave_sum4_u(le[0], le[1], le[2], le[3]); wave_sum4_u(le[4], le[5], le[6], le[7]);
#pragma unroll
                    for (int j8 = 0; j8 < 8; ++j8) le[j8] += rte[j8 * RT_LD + D - 4 * lane];
                    int e0 = 0; float m0 = le[0];
#pragma unroll
                    for (int j = 1; j < 8; ++j) if (le[j] > m0) { m0 = le[j]; e0 = j; }
                    int e1 = (e0 == 0) ? 1 : 0; float m1 = -3.0e38f;
#pragma unroll
                    for (int j = 0; j < 8; ++j) if (j != e0 && le[j] > m1) { m1 = le[j]; e1 = j; }
                    const float a1 = __expf(m1 - m0), inv = frcp(1.0f + a1);
                    const float w0 = pg * inv, w1 = pg * a1 * inv;
                    const int E0 = gsel * 8 + e0, E1 = gsel * 8 + e1;
                    if (row < M) {
                        unsigned p0 = 0, p1 = 0;
                        if (lane == 0) { p0 = __hip_atomic_fetch_add(lcnt + E0, 1u, __ATOMIC_RELAXED, __HIP_MEMORY_SCOPE_WORKGROUP); p1 = __hip_atomic_fetch_add(lcnt + E1, 1u, __ATOMIC_RELAXED, __HIP_MEMORY_SCOPE_WORKGROUP); }
                        p0 = __builtin_amdgcn_readfirstlane(p0); p1 = __builtin_amdgcn_readfirstlane(p1);
                        if (lane == nrow) { myE0 = E0; myE1 = E1; myP0 = (int)p0; myP1 = (int)p1; myW0 = w0; myW1 = w1; myRow = row; }
                        ++nrow;
                    }
                }
#pragma unroll
                for (int q = 0; q < 4; ++q)
#pragma unroll
                    for (int j = 0; j < 4; ++j) v[q][j] = vn[q][j];
            }
#undef T2_LOAD
            __syncthreads();
            if (tid < NEXP) { const unsigned c = lcnt[tid]; lbase[tid] = c ? __hip_atomic_fetch_add(cnt + tid * 64, c, __ATOMIC_RELAXED, __HIP_MEMORY_SCOPE_AGENT) : 0u; }
            __syncthreads();
            if (myRow >= 0) { const int q0 = myP0 + (int)lbase[myE0], q1 = myP1 + (int)lbase[myE1]; etok[myE0 * 16384 + q0] = myRow; etok[myE1 * 16384 + q1] = myRow;
                              tok_e[2 * myRow] = myE0; tok_e[2 * myRow + 1] = myE1; tok_pos[2 * myRow] = q0; tok_pos[2 * myRow + 1] = q1;
                              tok_w[2 * myRow] = myW0; tok_w[2 * myRow + 1] = myW1; }
            __syncthreads();
        }
        SEAM(pb + 5);
        if (IN(pb + 8) && EN(8)) {
            WSP();
            const unsigned* cnt = ctl + CW_CNT + l * NEXP * 64; unsigned* tcl = ctl + CW_TILE + l * MAXTILES * 16;
            int n1, n3, n4, R;
            int a_pm, a_pn, a_e, a_ts, a_cn, b_pm, b_pn, b_e, b_ts, b_cn, c_pm, c_pn, c_e, c_ts, c_cn;
            int d_pm, d_pn, d_e, d_ts, d_cn, e_pm, e_pn, e_e, e_ts, e_cn, f_pm, f_pn, f_e, f_ts, f_cn, g_pm, g_pn, g_e, g_ts, g_cn;
            {
                const int cv = (lane < NEXP) ? (int)__hip_atomic_load(cnt + lane * 64, __ATOMIC_RELAXED, __HIP_MEMORY_SCOPE_AGENT) : 0;
                const int tl = (cv + 255) >> 8; int tend = 0, ntile = 0;
#pragma unroll
                for (int e = 0; e < NEXP; ++e) { ntile += __builtin_amdgcn_readlane(tl, e); if (lane == e) tend = ntile; }
                const int U = 4 * ntile, nA = min(U, 2 * G), Nf = G - min(U - nA, G), nB = min(nA, 2 * Nf); R = min(U - nA, G);
                auto moe_unit = [&](int v, int& pm, int& pn, int& e, int& ts, int& cn) { const int t = min(v >> 2, ntile - 1); pm = t; pn = v & 3;
                    e = min((int)__builtin_popcountll(__ballot(lane < NEXP && tend <= t)), NEXP - 1); ts = __builtin_amdgcn_readlane(tend - tl, e); cn = max(__builtin_amdgcn_readlane(cv, e), 1); };
                moe_unit(vcu, a_pm, a_pn, a_e, a_ts, a_cn); moe_unit(G + vcu, b_pm, b_pn, b_e, b_ts, b_cn); moe_unit(nA + vcu, c_pm, c_pn, c_e, c_ts, c_cn);
                n1 = (vcu < nA ? 1 : 0) + (G + vcu < nA ? 1 : 0);
                const int v3 = vcu - R, v4 = nB + vcu;
                moe_unit(v3, d_pm, d_pn, d_e, d_ts, d_cn); moe_unit(v3 + Nf, e_pm, e_pn, e_e, e_ts, e_cn); n3 = (vcu >= R) ? (v3 < nB ? 1 : 0) + (v3 + Nf < nB ? 1 : 0) : 0;
                moe_unit(v4, f_pm, f_pn, f_e, f_ts, f_cn); moe_unit(v4 + G, g_pm, g_pn, g_e, g_ts, g_cn); n4 = (v4 < U ? 1 : 0) + (v4 + G < U ? 1 : 0);
            }
#define MOE_M1(n_, p0, p1) do { const pg8::MoeOrder S{(n_), p0##pm, p1##pm, p0##pn, p1##pn, p0##e, p1##e, (size_t)1024 * D * 2, p0##ts, p1##ts, p0##cn, p1##cn, etok, tcl}; \
            pg8::Gemm g{Hn, W13 + (size_t)l * NEXP * 1024 * D, D, D, D};            \
            EpiSwiglu E{HB}; pg8::gemm_phase<EpiSwiglu, pg8::MoeOrder, true, true, true>(lds, g, S, E); } while (0)
#define MOE_M2(n_, p0, p1) do { \
            if (wave == 0) { const int tb_ = (n_) > 1 ? p1##pm : p0##pm; unsigned sp_ = 0; \
                while ((unsigned)__builtin_amdgcn_readfirstlane((int)__hip_atomic_load(tcl + p0##pm * 16, __ATOMIC_RELAXED, __HIP_MEMORY_SCOPE_AGENT)) < 32u && ++sp_ < XB_SPIN_CAP) __builtin_amdgcn_s_sleep(2); \
                while ((unsigned)__builtin_amdgcn_readfirstlane((int)__hip_atomic_load(tcl + tb_ * 16, __ATOMIC_RELAXED, __HIP_MEMORY_SCOPE_AGENT)) < 32u && ++sp_ < XB_SPIN_CAP) __builtin_amdgcn_s_sleep(2); \
                asm volatile("s_waitcnt vmcnt(0)" ::: "memory"); }        \
            __syncthreads(); \
            const pg8::MoeOrder S{(n_), p0##pm, p1##pm, p0##pn, p1##pn, p0##e, p1##e, (size_t)D * EH * 2, p0##ts, p1##ts, p0##cn, p1##cn, etok, nullptr}; \
            pg8::Gemm g{HB, W2 + (size_t)l * NEXP * D * EH, EH, EH, EH}; \
            EpiY E{YB}; pg8::gemm_phase<EpiY, pg8::MoeOrder, true, true, false, true>(lds, g, S, E); } while (0)
            if (n1) MOE_M1(n1, a_, b_);
            if (vcu < R) MOE_M1(1, c_, c_);
            if (n3) MOE_M2(n3, d_, e_);
            if (n4) MOE_M2(n4, f_, g_);
#undef MOE_M1
#undef MOE_M2
        }
        SEAM(pb + 8);
    }
    if (IN(NPHASE - 1) && EN(9)) {
        WSP();
        const float* modprev = modp + (size_t)(DEPTH - 1) * NBATCH * 6 * D;
        constexpr int RPW = M / (256 * NWAVES); const int rbase = gw * RPW, b = rbase / SEQ;
        int slot_v = 0; float w_v = 0.f;
        { const unsigned* cntp = ctl + CW_CNT + (DEPTH - 1) * NEXP * 64;
          const int cv = (lane < NEXP) ? (int)__hip_atomic_load(cntp + lane * 64, __ATOMIC_RELAXED, __HIP_MEMORY_SCOPE_AGENT) : 0;
          const int tl = (cv + 255) >> 8; int tstart = 0, run = 0;
#pragma unroll
          for (int e = 0; e < NEXP; ++e) { if (lane == e) tstart = run; run += __builtin_amdgcn_readlane(tl, e); }
          const int i = min(lane, 2 * RPW - 1);
          const int e = tok_e[2 * rbase + i], pos = tok_pos[2 * rbase + i]; w_v = tok_w[2 * rbase + i];
          slot_v = __builtin_amdgcn_ds_bpermute(4 * e, tstart) * 256 + pos; }
        f32x4 gf[4], fg[4];
#pragma unroll
        for (int j = 0; j < 4; ++j) { const int col = 4 * lane + 256 * j; gf[j] = *(const f32x4*)(modprev + (size_t)b * 6 * D + 5 * D + col); fg[j] = *(const f32x4*)(args.fin_g + col); }
#pragma unroll 1
        for (int r0 = rbase; r0 < rbase + RPW; r0 += 4) {
            u32x2 xr[4][4], y0[4][4], y1[4][4]; float w0[4], w1[4];
#pragma unroll
            for (int q = 0; q < 4; ++q) { const int ix = 2 * (r0 - rbase + q);
                const int s0 = __builtin_amdgcn_readlane(slot_v, ix), s1 = __builtin_amdgcn_readlane(slot_v, ix + 1);
                w0[q] = __builtin_bit_cast(float, __builtin_amdgcn_readlane(__builtin_bit_cast(int, w_v), ix)); w1[q] = __builtin_bit_cast(float, __builtin_amdgcn_readlane(__builtin_bit_cast(int, w_v), ix + 1));
#pragma unroll
                for (int j = 0; j < 4; ++j) { const int col = 4 * lane + 256 * j;
                    xr[q][j] = *(const u32x2*)(X + (size_t)(r0 + q) * D + col); y0[q][j] = __builtin_nontemporal_load((const u32x2*)(YB + (size_t)s0 * D + col)); y1[q][j] = __builtin_nontemporal_load((const u32x2*)(YB + (size_t)s1 * D + col)); } }
            f32x4 v[4][4]; float ssq[4];
#pragma unroll
            for (int q = 0; q < 4; ++q) { float ss = 0.f;
#pragma unroll
                for (int j = 0; j < 4; ++j) { const f32x4 yy = bf4(y0[q][j]) * w0[q] + bf4(y1[q][j]) * w1[q]; v[q][j] = bf4(xr[q][j]) + gf[j] * yy;
                    ss += (v[q][j][0] * v[q][j][0] + v[q][j][1] * v[q][j][1]) + (v[q][j][2] * v[q][j][2] + v[q][j][3] * v[q][j][3]); }
                ssq[q] = ss; }
            wave_sum4_u(ssq[0], ssq[1], ssq[2], ssq[3]);
#pragma unroll
            for (int q = 0; q < 4; ++q) { const int row = r0 + q;
                const float rstd = __builtin_amdgcn_rsqf(ssq[q] * (1.f / D) + NORM_EPS);
#pragma unroll
                for (int j = 0; j < 4; ++j) __builtin_nontemporal_store(v[q][j] * rstd * fg[j], (f32x4*)(args.out + (size_t)row * D + 4 * lane + 256 * j));
            }
        }
    }
#undef IN
#undef SEAM
#undef GRID_BAR
}


#ifndef DBG
#define DBG 0
#endif
#if DBG
constexpr size_t WS_REP = WS_END;
__global__ void dbg_scan(const unsigned* buf, size_t nwords, int is_bf16, unsigned long long* rep) {
    unsigned long long nf = 0, ck = 0;
    for (size_t i = (size_t)blockIdx.x * blockDim.x + threadIdx.x; i < nwords; i += (size_t)gridDim.x * blockDim.x) {
        const unsigned w = buf[i]; ck += (unsigned long long)w * (unsigned long long)((i & 1023) + 1);
        if (is_bf16) { if ((w & 0x7f80u) >= (140u << 7)) ++nf; if ((w & 0x7f800000u) >= (140u << 23)) ++nf; }
        else if ((w & 0x7f800000u) >= (140u << 23)) ++nf;
    }
    for (int o = 32; o >= 1; o >>= 1) { nf += __shfl_xor(nf, o); ck += __shfl_xor(ck, o); }
    if ((threadIdx.x & 63) == 0) { if (nf) atomicAdd(rep, nf); atomicAdd(rep + 1, ck); }
}

__global__ void dbg_scan_cols(const unsigned short* buf, int c0, int c1, unsigned long long* rep) {
    unsigned long long nf = 0;
    const int w = c1 - c0;
    for (size_t i = (size_t)blockIdx.x * blockDim.x + threadIdx.x; i < (size_t)M * w; i += (size_t)gridDim.x * blockDim.x) {
        const size_t r = i / w; const int c = c0 + (int)(i % w); const unsigned v = buf[r * D + c];
        if ((v & 0x7f80u) >= (140u << 7)) ++nf; }
    for (int o = 32; o >= 1; o >>= 1) nf += __shfl_xor(nf, o);
    if ((threadIdx.x & 63) == 0 && nf) atomicAdd(rep, nf);
}
__global__ void dbg_encode(const unsigned long long* rep, float* out, size_t n, int nph) {
    int code = 80;
    for (int p = nph - 1; p >= 0; --p) if (rep[(64 + p) * 2 + 1] != rep[p * 2 + 1]) code = 40 + p;
    for (int p = nph - 1; p >= 0; --p) if (rep[p * 2] != 0ull || rep[(64 + p) * 2] != 0ull) code = 1 + p;
    if (code == 80) return;
    const float A = sqrtf((float)code * 0.1f);
    for (size_t i = (size_t)blockIdx.x * blockDim.x + threadIdx.x; i < n; i += (size_t)gridDim.x * blockDim.x) {
        unsigned h = (unsigned)i * 2654435761u; h ^= h >> 15; h *= 2246822519u; h ^= h >> 13;
        out[i] = (h & 1u) ? A : -A; }
}
#endif

extern "C" void kernel_launch(void* const* d_in, const int* in_sizes, int n_in, void* d_out, int out_size, void* d_ws, size_t ws_size, hipStream_t stream) {
    static int grid = 0;
    if (grid == 0) {
        if (n_in != 22 || in_sizes[0] != M * D || out_size != M * D || ws_size < WS_END + (1u << 20)) {
            fprintf(stderr, "kernel_launch: unexpected shapes (n_in %d, in0 %d, out %d, ws %zu, need %zu)\n", n_in, n_in > 0 ? in_sizes[0] : -1, out_size, ws_size, (size_t)WS_END); grid = -1; return; }
        int dev = 0, cus = 0, per_cu = 0;
        if (hipGetDevice(&dev) != hipSuccess || hipDeviceGetAttribute(&cus, hipDeviceAttributeMultiprocessorCount, dev) != hipSuccess) { grid = -1; return; }
        if (hipFuncSetAttribute((const void*)fwd_kernel, hipFuncAttributeMaxDynamicSharedMemorySize, LDS_BYTES) != hipSuccess) { fprintf(stderr, "kernel_launch: hipFuncSetAttribute failed\n"); grid = -1; return; }
        if (hipOccupancyMaxActiveBlocksPerMultiprocessor(&per_cu, (const void*)fwd_kernel, NWAVES * 64, LDS_BYTES) != hipSuccess || per_cu < 1)
            fprintf(stderr, "kernel_launch: occupancy query reports %d\n", per_cu);
        (void)hipGetLastError();
        if (cus != 256) { fprintf(stderr, "kernel_launch: built for 256 CUs (MoE unit deal, T2 row blocks), found %d\n", cus); grid = -1; return; }
        grid = cus;
    }
    if (grid < 0) return;
    if (hipMemsetAsync((char*)d_ws + WS_CTL, 0, CTL_ZERO_BYTES, stream) != hipSuccess) { fprintf(stderr, "kernel_launch: memset failed\n"); return; }
    Args a{};
    a.x = (const float*)d_in[0]; a.c = (const float*)d_in[1]; a.ada_w = (const float*)d_in[2]; a.ada_b = (const float*)d_in[3]; a.mix_g = (const float*)d_in[4]; a.ffn_g = (const float*)d_in[5];
    a.w_in = (const float*)d_in[6]; a.da_lambda = (const float*)d_in[7]; a.da_subln = (const float*)d_in[8]; a.na_rpb = (const float*)d_in[9];
    a.wpa = (const float*)d_in[10]; a.wpn = (const float*)d_in[11]; a.wpd = (const float*)d_in[12]; a.w_out = (const float*)d_in[13];
    a.rgw = (const float*)d_in[14]; a.rgb = (const float*)d_in[15]; a.rew = (const float*)d_in[16]; a.reb = (const float*)d_in[17];
    a.ew1 = (const float*)d_in[18]; a.ew3 = (const float*)d_in[19]; a.ew2 = (const float*)d_in[20]; a.fin_g = (const float*)d_in[21];
    a.out = (float*)d_out; a.ws = (unsigned char*)d_ws;
#if DBG
    {
        unsigned char* ws = (unsigned char*)d_ws;
        unsigned long long* rep = (unsigned long long*)(ws + WS_REP);
        (void)hipMemsetAsync(rep, 0, 2 * 64 * 2 * 8, stream);
        for (int run = 0; run < 2; ++run) {
            (void)hipMemsetAsync((char*)d_ws + WS_CTL, 0, CTL_ZERO_BYTES, stream);
            for (int p = 0; p < NPHASE; ++p) {
                a.ph_lo = p; a.ph_hi = p + 1;
                hipLaunchKernelGGL(fwd_kernel, dim3(grid), dim3(NWAVES * 64), LDS_BYTES, stream, a);
                unsigned long long* r = rep + (size_t)(run * 64 + p) * 2;
#define SCAN(off, bytes, isbf) hipLaunchKernelGGL(dbg_scan, dim3(1024), dim3(256), 0, stream, (const unsigned*)(ws + (off)), (size_t)(bytes) / 4, (isbf), r)
                const int ph = (p == 0) ? -1 : (p == NPHASE - 1) ? 9 : (p - 1) % 9;
                if (ph == -1) { SCAN(WS_MOD, (size_t)DEPTH * NBATCH * 6 * D * 4, 0); SCAN(WS_ROPE, (size_t)SEQ * 64 * 4, 0); SCAN(WS_WIN, WS_END - WS_WIN, 1); }
                else if (ph == 0) { SCAN(WS_X, (size_t)M * D * 4, 0); SCAN(WS_H, (size_t)M * D * 2, 1); }
                else if (ph == 1) { SCAN(WS_Z, (size_t)M * ZW * 2, 1); }
                else if (ph == 2) { SCAN(WS_OCAT, (size_t)M * D * 2, 1); }
                else if (ph == 3) { SCAN(WS_MERGED, (size_t)M * D * 2, 1); }
                else if (ph == 4) { SCAN(WS_X, (size_t)M * D * 4, 0); }
                else if (ph == 5) { SCAN(WS_H, (size_t)M * D * 2, 1); SCAN(WS_ROUTE, (size_t)2 * M * 4, 0); SCAN(WS_ROUTE + (size_t)4 * M * 4, (size_t)2 * M * 4, 0); }
                else if (ph == 9) { hipLaunchKernelGGL(dbg_scan, dim3(1024), dim3(256), 0, stream, (const unsigned*)d_out, (size_t)M * D, 0, r); }
#undef SCAN
            }
        }
        hipLaunchKernelGGL(dbg_encode, dim3(1024), dim3(256), 0, stream, (const unsigned long long*)rep, (float*)d_out, (size_t)M * D, NPHASE);
    }
#elif MK_PER_PHASE
    for (int p = 0; p < NPHASE; ++p) {
        a.ph_lo = p; a.ph_hi = p + 1;
        hipLaunchKernelGGL(fwd_kernel, dim3(grid), dim3(NWAVES * 64), LDS_BYTES, stream, a);
    }
#else
    a.ph_lo = 0; a.ph_hi = NPHASE;
    hipLaunchKernelGGL(fwd_kernel, dim3(grid), dim3(NWAVES * 64), LDS_BYTES, stream, a);
#endif
    const hipError_t le = hipPeekAtLastError();
    if (le != hipSuccess) fprintf(stderr, "kernel_launch: launch failed: %s\n", hipGetErrorName(le));
}
```
